# Optimizing an MI355X kernel written in HIP

```python
import jax, jax.numpy as jnp
from jax import lax
import numpy as np

D_MODEL = 1024
BATCH = 32
SEQ = 2048
DEPTH = 2
DEC_BATCH = 16
DEC_SEQ = 32
PAST_LEN = 4096

CHUNK = 64
PLE_DIM = 256
MLA_HEADS = 8
NOPE_DIM = 64
ROPE_DIM = 32
V_DIM = 64
Q_LORA = 384
KV_LORA = 256
ROPE_THETA = 10000.0
Q_BLOCK = 128
ATTN_SCALE = (NOPE_DIM + ROPE_DIM) ** -0.5
HG_HEADS = 4
HG_DK = 128
HG_DV = 128
HG_FDIM = HG_HEADS * HG_DK
HG_IDIM = HG_HEADS * HG_DV
HG_BLOCK = 16
N_GROUPS = 4
EXPERTS_PER_GROUP = 8
N_EXPERTS = N_GROUPS * EXPERTS_PER_GROUP
TOP_K = 2
D_EXPERT = 512
MOE_BLOCK = 128
DN_ALPHA = (2 * DEPTH) ** 0.25
DN_BETA = (8 * DEPTH) ** -0.25
EPS = 1e-6
SPLITS = (Q_LORA, KV_LORA, ROPE_DIM, HG_FDIM, HG_FDIM, HG_IDIM, HG_IDIM, D_MODEL, D_MODEL)
D_IN = Q_LORA + KV_LORA + ROPE_DIM + 2 * HG_FDIM + 2 * HG_IDIM + 2 * D_MODEL

kernel_name = 'hybrid_mla_hgrn2_hmoe_stream_step'


def layernorm(x, g, b):
    xf = x.astype(jnp.float32)
    mu = xf.mean(-1, keepdims=True)
    var = jnp.square(xf - mu).mean(-1, keepdims=True)
    return ((xf - mu) * lax.rsqrt(var + EPS)).astype(x.dtype) * g + b


def rmsnorm(x, g):
    xf = x.astype(jnp.float32)
    return (xf * lax.rsqrt(jnp.square(xf).mean(-1, keepdims=True) + EPS)).astype(x.dtype) * g


def rope(x, pos):
    half = ROPE_DIM // 2
    inv = ROPE_THETA ** (-jnp.arange(half, dtype=jnp.float32) / half)
    ang = pos.astype(jnp.float32)[:, None] * inv[None, :]
    shape = (1, x.shape[1]) + (1,) * (x.ndim - 3) + (half,)
    c, s = jnp.cos(ang).reshape(shape), jnp.sin(ang).reshape(shape)
    xf = x.astype(jnp.float32)
    x1, x2 = xf[..., :half], xf[..., half:]
    return jnp.concatenate([x1 * c - x2 * s, x2 * c + x1 * s], axis=-1).astype(x.dtype)


def mla_prompt_attention(q_nope, q_rope, ckv, k_rope, w_uk, w_uv):
    B, S = ckv.shape[:2]
    k_nope = jnp.einsum('bsc,chn->bshn', ckv, w_uk)
    v = jnp.einsum('bsc,chv->bshv', ckv, w_uv)
    nqb = S // Q_BLOCK
    key_chunk = jnp.arange(S) // CHUNK

    def block(args):
        qn, qr, j = args
        s = jnp.einsum('bqhn,bkhn->bhqk', qn, k_nope) + jnp.einsum('bqhr,bkr->bhqk', qr, k_rope)
        s = s.astype(jnp.float32) * ATTN_SCALE
        q_chunk = (j * Q_BLOCK + jnp.arange(Q_BLOCK)) // CHUNK
        mask = key_chunk[None, :] <= q_chunk[:, None]
        p = jax.nn.softmax(jnp.where(mask, s, -jnp.inf), axis=-1).astype(v.dtype)
        return jnp.einsum('bhqk,bkhv->bqhv', p, v)

    qn_b = q_nope.reshape(B, nqb, Q_BLOCK, MLA_HEADS, NOPE_DIM).swapaxes(0, 1)
    qr_b = q_rope.reshape(B, nqb, Q_BLOCK, MLA_HEADS, ROPE_DIM).swapaxes(0, 1)
    out = lax.map(block, (qn_b, qr_b, jnp.arange(nqb)))
    return out.swapaxes(0, 1).reshape(B, S, MLA_HEADS * V_DIM)


def mla_sample_attention(q_nope, q_rope, ckv_all, krope_all, w_uk, w_uv):
    B, L = q_nope.shape[:2]
    q_lat = jnp.einsum('bqhn,chn->bqhc', q_nope, w_uk)
    s = jnp.einsum('bqhc,bkc->bhqk', q_lat, ckv_all) + jnp.einsum('bqhr,bkr->bhqk', q_rope, krope_all)
    p = jax.nn.softmax(s.astype(jnp.float32) * ATTN_SCALE, axis=-1).astype(ckv_all.dtype)
    lat = jnp.einsum('bhqk,bkc->bqhc', p, ckv_all)
    out = jnp.einsum('bqhc,chv->bqhv', lat, w_uv)
    return out.reshape(B, L, MLA_HEADS * V_DIM)


def hgrn2_lower_bounds(hg_lb):
    c = jnp.cumsum(jax.nn.softmax(hg_lb.astype(jnp.float32), axis=0), axis=0)
    return c - c[0:1]


def hgrn2_features(f_pre, q_pre, i_pre, lb):
    B, L, _ = f_pre.shape
    z = f_pre.astype(jnp.float32).reshape(B, L, HG_HEADS, HG_DK)
    lb = lb.reshape(HG_HEADS, HG_DK)
    log_f = jnp.logaddexp(jnp.log(lb), jnp.log1p(-lb) + jax.nn.log_sigmoid(z))
    k = (1.0 - lb) * jax.nn.sigmoid(-z)
    q = jax.nn.silu(q_pre.astype(jnp.float32)).reshape(B, L, HG_HEADS, HG_DK)
    v = i_pre.astype(jnp.float32).reshape(B, L, HG_HEADS, HG_DV)
    return q, k, v, log_f


def hgrn2_block(q, k, v, log_f, S0):
    L = q.shape[1]
    b = jnp.cumsum(log_f, axis=1)
    inter = jnp.einsum('blhk,bhkv->blhv', q * jnp.exp(b), S0)
    diff = b[:, :, None] - b[:, None, :]
    causal = (jnp.arange(L)[:, None] >= jnp.arange(L)[None, :])[None, :, :, None, None]
    decay = jnp.exp(jnp.where(causal, diff, -jnp.inf))
    A = jnp.einsum('bthk,btshk,bshk->bhts', q, decay, k)
    o = inter + jnp.einsum('bhts,bshv->bthv', A, v)
    b_end = b[:, -1]
    S = jnp.exp(b_end)[..., None] * S0 + jnp.einsum('bshk,bshv->bhkv', k * jnp.exp(b_end[:, None] - b), v)
    return o, S


def hgrn2_prompt(q, k, v, log_f):
    B, L = q.shape[:2]
    nb = L // HG_BLOCK

    def to_blocks(t):
        return t.reshape((B, nb, HG_BLOCK) + t.shape[2:]).swapaxes(0, 1)

    def step(S, blk):
        qb, kb, vb, fb = blk
        o, S = hgrn2_block(qb, kb, vb, fb, S)
        return S, o

    S0 = jnp.zeros((B, HG_HEADS, HG_DK, HG_DV), jnp.float32)
    S, o = lax.scan(step, S0, (to_blocks(q), to_blocks(k), to_blocks(v), to_blocks(log_f)))
    return o.swapaxes(0, 1).reshape(B, L, HG_HEADS, HG_DV), S


def moe_dispatch(xt, eidx, wts, w1, w3, w2):
    T, D = xt.shape
    A = T * TOP_K
    flat_e = eidx.reshape(A).astype(jnp.int32)
    flat_tok = jnp.repeat(jnp.arange(T, dtype=jnp.int32), TOP_K)
    flat_w = wts.reshape(A)
    order = jnp.argsort(flat_e)
    se, stok, sw = flat_e[order], flat_tok[order], flat_w[order]
    counts = jnp.zeros((N_EXPERTS,), jnp.int32).at[flat_e].add(1)
    start = jnp.cumsum(counts) - counts
    padded = (counts + MOE_BLOCK - 1) // MOE_BLOCK * MOE_BLOCK
    pend = jnp.cumsum(padded)
    pstart = pend - padded
    pos = pstart[se] + jnp.arange(A, dtype=jnp.int32) - start[se]
    n_blk = (A + N_EXPERTS * (MOE_BLOCK - 1) + MOE_BLOCK - 1) // MOE_BLOCK
    buf = jnp.zeros((n_blk * MOE_BLOCK, D), xt.dtype).at[pos].set(xt[stok])
    blk_e = jnp.searchsorted(pend, jnp.arange(n_blk, dtype=jnp.int32) * MOE_BLOCK, side='right')
    blk_e = jnp.minimum(blk_e, N_EXPERTS - 1)

    def expert_block(args):
        xb, e = args
        h = jax.nn.silu(xb @ w1[e]) * (xb @ w3[e])
        return h @ w2[e]

    out = lax.map(expert_block, (buf.reshape(n_blk, MOE_BLOCK, D), blk_e)).reshape(n_blk * MOE_BLOCK, D)
    return jnp.zeros((T, D), xt.dtype).at[stok].add(out[pos] * sw[:, None].astype(xt.dtype))


def hier_moe(x, w_rg, w_re, w1, w3, w2):
    B, L, D = x.shape
    xt = x.reshape(B * L, D)
    T = B * L
    g_prob = jax.nn.softmax((xt @ w_rg).astype(jnp.float32), axis=-1)
    g_top, g_idx = lax.top_k(g_prob, 1)
    e_logits = (xt @ w_re).astype(jnp.float32).reshape(T, N_GROUPS, EXPERTS_PER_GROUP)
    e_logits = jnp.take_along_axis(e_logits, g_idx[:, :, None], axis=1)[:, 0]
    e_top, e_idx = lax.top_k(jax.nn.softmax(e_logits, axis=-1), TOP_K)
    e_top = e_top / e_top.sum(-1, keepdims=True)
    wts = g_top * e_top
    eidx = g_idx * EXPERTS_PER_GROUP + e_idx
    return moe_dispatch(xt, eidx, wts, w1, w3, w2).reshape(B, L, D)


def trunk_layer(x, ple, pos, lp, lb, cache):
    B, L, _ = x.shape
    proj = x @ lp['w_in']
    cq, ckv, kr, f_pre, q_pre, i_pre, g_pre, ga, gb = jnp.split(proj, np.cumsum(SPLITS)[:-1].tolist(), axis=-1)
    q = (rmsnorm(cq, lp['q_norm']) @ lp['w_uq']).reshape(B, L, MLA_HEADS, NOPE_DIM + ROPE_DIM)
    q_nope, q_rope = q[..., :NOPE_DIM], rope(q[..., NOPE_DIM:], pos)
    ckv = rmsnorm(ckv, lp['kv_norm'])
    kr = rope(kr, pos)
    hq, hk, hv, hlogf = hgrn2_features(f_pre, q_pre, i_pre, lb)
    if cache is None:
        a = mla_prompt_attention(q_nope, q_rope, ckv, kr, lp['w_uk'], lp['w_uv'])
        o, S = hgrn2_prompt(hq, hk, hv, hlogf)
    else:
        ckv_all = jnp.concatenate([cache[0], ckv], axis=1)
        kr_all = jnp.concatenate([cache[1], kr], axis=1)
        a = mla_sample_attention(q_nope, q_rope, ckv_all, kr_all, lp['w_uk'], lp['w_uv'])
        o, S = hgrn2_block(hq, hk, hv, hlogf, cache[2].astype(jnp.float32))
    o = o * lax.rsqrt(jnp.square(o).mean(-1, keepdims=True) + EPS) * lp['hg_norm'].reshape(HG_HEADS, HG_DV).astype(jnp.float32)
    o = o * jax.nn.silu(g_pre.astype(jnp.float32)).reshape(B, L, HG_HEADS, HG_DV)
    o = o.reshape(B, L, HG_IDIM).astype(x.dtype)
    merged = jax.nn.sigmoid(ga) * (a @ lp['w_br_a']) + jax.nn.sigmoid(gb) * (o @ lp['w_br_b'])
    x = layernorm(DN_ALPHA * x + merged @ lp['w_out'], lp['ln1_g'], lp['ln1_b'])
    moe_out = hier_moe(x, lp['w_rg'], lp['w_re'], lp['w1'], lp['w3'], lp['w2'])
    ple_term = jax.nn.sigmoid(x @ lp['w_ple_gate']) * (ple @ lp['w_ple'])
    x = layernorm(DN_ALPHA * x + moe_out + ple_term, lp['ln2_g'], lp['ln2_b'])
    return x, ckv, kr, S.astype(x.dtype)


def setup_inputs(seed: int = 0) -> dict:
    key = jax.random.key(seed)
    ks = jax.random.split(key, 40)

    def nrm(k, shape, scale):
        return jax.random.normal(k, shape, jnp.float32) * scale

    col_scale = jnp.concatenate([
        jnp.ones((Q_LORA + KV_LORA + ROPE_DIM + 2 * HG_FDIM,), jnp.float32),
        jnp.full((HG_IDIM,), DN_BETA, jnp.float32),
        jnp.ones((HG_IDIM + 2 * D_MODEL,), jnp.float32)])
    return {
        'x_prompt': nrm(ks[0], (BATCH, SEQ, D_MODEL), 1.0),
        'x_sample': nrm(ks[1], (DEC_BATCH, DEC_SEQ, D_MODEL), 1.0),
        'p_prompt': nrm(ks[2], (DEPTH, BATCH, SEQ, PLE_DIM), 1.0),
        'p_sample': nrm(ks[3], (DEPTH, DEC_BATCH, DEC_SEQ, PLE_DIM), 1.0),
        'cache_ckv': nrm(ks[4], (DEPTH, DEC_BATCH, PAST_LEN, KV_LORA), 1.0),
        'cache_krope': nrm(ks[5], (DEPTH, DEC_BATCH, PAST_LEN, ROPE_DIM), 1.0),
        'state_hgrn': nrm(ks[6], (DEPTH, DEC_BATCH, HG_HEADS, HG_DK, HG_DV), 0.3),
        'ln0_g': 1.0 + nrm(ks[7], (D_MODEL,), 0.05),
        'ln0_b': nrm(ks[8], (D_MODEL,), 0.02),
        'w_in': nrm(ks[9], (DEPTH, D_MODEL, D_IN), D_MODEL ** -0.5) * col_scale,
        'q_norm': 1.0 + nrm(ks[10], (DEPTH, Q_LORA), 0.05),
        'w_uq': nrm(ks[11], (DEPTH, Q_LORA, MLA_HEADS * (NOPE_DIM + ROPE_DIM)), Q_LORA ** -0.5),
        'kv_norm': 1.0 + nrm(ks[12], (DEPTH, KV_LORA), 0.05),
        'w_uk': nrm(ks[13], (DEPTH, KV_LORA, MLA_HEADS, NOPE_DIM), KV_LORA ** -0.5),
        'w_uv': nrm(ks[14], (DEPTH, KV_LORA, MLA_HEADS, V_DIM), KV_LORA ** -0.5 * DN_BETA),
        'hg_lb': nrm(ks[15], (DEPTH, HG_FDIM), 0.5),
        'hg_norm': 1.0 + nrm(ks[16], (DEPTH, HG_IDIM), 0.05),
        'w_br_a': nrm(ks[17], (DEPTH, MLA_HEADS * V_DIM, D_MODEL), (MLA_HEADS * V_DIM) ** -0.5),
        'w_br_b': nrm(ks[18], (DEPTH, HG_IDIM, D_MODEL), HG_IDIM ** -0.5),
        'w_out': nrm(ks[19], (DEPTH, D_MODEL, D_MODEL), D_MODEL ** -0.5 * DN_BETA),
        'ln1_g': 1.0 + nrm(ks[20], (DEPTH, D_MODEL), 0.05),
        'ln1_b': nrm(ks[21], (DEPTH, D_MODEL), 0.02),
        'w_router_group': nrm(ks[22], (DEPTH, D_MODEL, N_GROUPS), D_MODEL ** -0.5),
        'w_router_expert': nrm(ks[23], (DEPTH, D_MODEL, N_EXPERTS), D_MODEL ** -0.5),
        'w_e_gate': nrm(ks[24], (DEPTH, N_EXPERTS, D_MODEL, D_EXPERT), D_MODEL ** -0.5 * DN_BETA),
        'w_e_up': nrm(ks[25], (DEPTH, N_EXPERTS, D_MODEL, D_EXPERT), D_MODEL ** -0.5 * DN_BETA),
        'w_e_down': nrm(ks[26], (DEPTH, N_EXPERTS, D_EXPERT, D_MODEL), D_EXPERT ** -0.5 * DN_BETA),
        'w_ple': nrm(ks[27], (DEPTH, PLE_DIM, D_MODEL), PLE_DIM ** -0.5),
        'w_ple_gate': nrm(ks[28], (DEPTH, D_MODEL, D_MODEL), D_MODEL ** -0.5),
        'ln2_g': 1.0 + nrm(ks[29], (DEPTH, D_MODEL), 0.05),
        'ln2_b': nrm(ks[30], (DEPTH, D_MODEL), 0.02),
    }


def reference(x_prompt, x_sample, p_prompt, p_sample, cache_ckv, cache_krope, state_hgrn,
              ln0_g, ln0_b, w_in, q_norm, w_uq, kv_norm, w_uk, w_uv, hg_lb, hg_norm,
              w_br_a, w_br_b, w_out, ln1_g, ln1_b, w_router_group, w_router_expert,
              w_e_gate, w_e_up, w_e_down, w_ple, w_ple_gate, ln2_g, ln2_b):
    lbs = hgrn2_lower_bounds(hg_lb)
    xp = layernorm(x_prompt, ln0_g, ln0_b)
    xs = layernorm(x_sample, ln0_g, ln0_b)
    pos_p = jnp.arange(x_prompt.shape[1], dtype=jnp.int32)
    pos_s = PAST_LEN + jnp.arange(x_sample.shape[1], dtype=jnp.int32)
    ckv_p, kr_p, st_p, ckv_s, kr_s, st_s = [], [], [], [], [], []
    for i in range(DEPTH):
        lp = {'w_in': w_in[i], 'q_norm': q_norm[i], 'w_uq': w_uq[i], 'kv_norm': kv_norm[i],
              'w_uk': w_uk[i], 'w_uv': w_uv[i], 'hg_norm': hg_norm[i], 'w_br_a': w_br_a[i],
              'w_br_b': w_br_b[i], 'w_out': w_out[i], 'ln1_g': ln1_g[i], 'ln1_b': ln1_b[i],
              'w_rg': w_router_group[i], 'w_re': w_router_expert[i], 'w1': w_e_gate[i],
              'w3': w_e_up[i], 'w2': w_e_down[i], 'w_ple': w_ple[i], 'w_ple_gate': w_ple_gate[i],
              'ln2_g': ln2_g[i], 'ln2_b': ln2_b[i]}
        xp, c, r, s = trunk_layer(xp, p_prompt[i], pos_p, lp, lbs[i], None)
        ckv_p.append(c)
        kr_p.append(r)
        st_p.append(s)
        xs, c, r, s = trunk_layer(xs, p_sample[i], pos_s, lp, lbs[i], (cache_ckv[i], cache_krope[i], state_hgrn[i]))
        ckv_s.append(c)
        kr_s.append(r)
        st_s.append(s)
    return (xp, xs, jnp.stack(ckv_p), jnp.stack(kr_p), jnp.stack(st_p), jnp.stack(ckv_s), jnp.stack(kr_s), jnp.stack(st_s))
```

```cpp
#include <hip/hip_runtime.h>
#include <hip/hip_cooperative_groups.h>
#include <stdint.h>
#include <stdio.h>
namespace cg = cooperative_groups;

#define DEVI __device__ __forceinline__
typedef unsigned short bf16_t;
typedef short bf16x8 __attribute__((ext_vector_type(8)));
typedef float f32x4 __attribute__((ext_vector_type(4)));
typedef float f32x16 __attribute__((ext_vector_type(16)));

constexpr int NTOK = 66048, TP = 65536, TS = 512;
constexpr int NCH = NTOK / 32;
constexpr int KPAD = 4160;
constexpr float DN_ALPHA = 1.4142135623730951f;
constexpr float EPS = 1e-6f;
constexpr float QSCALE = 0.10206207261596575f * 1.4426950408889634f;

constexpr size_t OUT_Y = 0;
constexpr size_t OUT_CKV_P = 67633152ull;
constexpr size_t OUT_KR_P = 101187584ull;
constexpr size_t OUT_ST_P = 105381888ull;
constexpr size_t OUT_CKV_S = 109576192ull;
constexpr size_t OUT_KR_S = 109838336ull;
constexpr size_t OUT_ST_S = 109871104ull;

constexpr size_t WO_IN = 0, WO_G = WO_IN + 2816ull * 1024, WO_UQ = WO_G + 2048ull * 1024, WO_KV = WO_UQ + 768ull * 384,
                 WO_BRA = WO_KV + 1024ull * 256, WO_BRB = WO_BRA + 1024ull * 512, WO_OUT = WO_BRB + 1024ull * 512,
                 WO_PG = WO_OUT + 1024ull * 1024, WO_PLE = WO_PG + 1024ull * 1024, WO_END = WO_PLE + 1024ull * 256;
static_assert(WO_END == 8945664ull, "small weights");

constexpr size_t al(size_t x) { return (x + 255) & ~size_t(255); }
constexpr size_t SZ_XB = (size_t)(NTOK + 1) * 1024 * 2, SZ_LIST = 32ull * NTOK * 4, SZ_KRS = 2ull * 16 * KPAD * 32 * 2,
                 SZ_G = (size_t)NTOK * 512 * 2, SZ_CQ = (size_t)NTOK * 384 * 2, SZ_CKR = (size_t)NTOK * 288 * 4,
                 SZ_FQ = (size_t)NTOK * 1024 * 2, SZ_CKVN = (size_t)NTOK * 256 * 2, SZ_KRB = (size_t)NTOK * 32 * 2,
                 SZ_QB = (size_t)NTOK * 768 * 2, SZ_AM = (size_t)NCH * 4 * 32 * 32 * 2, SZ_EB = (size_t)NCH * 4 * 128 * 4,
                 SZ_VT = 32ull * 8 * 64 * 2048 * 2, SZ_KNS = 16ull * KPAD * 512 * 2, SZ_VTS = 16ull * 8 * 64 * KPAD * 2,
                 SZ_PRE = (size_t)NTOK * 1024 * 4, SZ_WE = 3ull * 32 * 512 * 1024 * 2, SZ_H = 1064ull * 128 * 512 * 2,
                 SZ_YM = (size_t)NTOK * 2 * 1024 * 2;
constexpr size_t O_WS = 0;
constexpr size_t O_WR = O_WS + al(2 * WO_END * 2);
constexpr size_t O_ROPE = O_WR + al(2ull * 36 * 1024 * 4);
constexpr size_t O_CNT = O_ROPE + al(2080ull * 16 * 2 * 4);
constexpr size_t O_XB = O_CNT + 4096;
constexpr size_t O_LTOK = O_XB + al(SZ_XB);
constexpr size_t O_LW = O_LTOK + al(SZ_LIST);
constexpr size_t O_KRS = O_LW + al(SZ_LIST);
constexpr size_t O_G = O_KRS + al(SZ_KRS);
constexpr size_t O_VT2 = O_G + al(SZ_G);
constexpr size_t O_CQ = O_VT2 + al(SZ_G);
constexpr size_t O_CKR = O_CQ + al(SZ_CQ);
constexpr size_t O_FQ = O_CKR + al(SZ_CKR);
constexpr size_t O_CKVN = O_FQ + al(SZ_FQ);
constexpr size_t O_KRB = O_CKVN + al(SZ_CKVN);
constexpr size_t O_QB = O_KRB + al(SZ_KRB);
constexpr size_t O_QT = O_QB + al(SZ_QB);
constexpr size_t O_KHT = O_QT + al(SZ_G);
constexpr size_t O_AM = O_KHT + al(SZ_G);
constexpr size_t O_EB = O_AM + al(SZ_AM);
constexpr size_t O_KN = O_EB + al(SZ_EB);
constexpr size_t O_HO = O_KN + al(SZ_G);
constexpr size_t WS_END = O_HO + al(SZ_G);
constexpr size_t O_VT = O_CQ;
constexpr size_t O_KNS = O_VT + al(SZ_VT);
constexpr size_t O_VTS = O_KNS + al(SZ_KNS);
constexpr size_t O_AO = O_VTS + al(SZ_VTS);
constexpr size_t O_MG = O_QB;
constexpr size_t O_PRE = O_G;
constexpr size_t O_WE = O_VTS;
constexpr size_t O_H = O_WE + al(SZ_WE);
constexpr size_t O_YM = O_H + al(SZ_H);
static_assert(O_AO + SZ_G <= O_KRB, "AO");
static_assert(O_AO >= O_VTS + SZ_VTS, "AO2");
static_assert(O_MG + SZ_XB <= O_KN, "MG");
static_assert(O_PRE + SZ_PRE <= O_WE, "PRE");
static_assert(O_YM + SZ_YM <= WS_END, "YM");
static_assert(WS_END <= (1ull << 30), "workspace");

struct Params { const float* in[31]; float* out_; unsigned char* ws_; };
typedef const __attribute__((address_space(4))) unsigned char* KAP;
#define PIN(i) (*(const float* const __attribute__((address_space(4)))*)(KA + 8 * (i)))

enum { I_XP = 0, I_XS, I_PP, I_PS, I_CCKV, I_CKR, I_ST, I_LN0G, I_LN0B, I_WIN, I_QN, I_WUQ, I_KVN, I_WUK, I_WUV, I_HGLB, I_HGN,
       I_WBRA, I_WBRB, I_WOUT, I_LN1G, I_LN1B, I_WRG, I_WRE, I_WE1, I_WE3, I_WE2, I_WPLE, I_WPG, I_LN2G, I_LN2B };

DEVI float bf2f(bf16_t h) { return __uint_as_float(((uint32_t)h) << 16); }
DEVI bf16_t f2bf(float f) { uint32_t u = __float_as_uint(f); u += 0x7fffu + ((u >> 16) & 1u); return (bf16_t)(u >> 16); }
typedef float f32x2_t __attribute__((ext_vector_type(2)));
typedef __bf16 bf16x2_t __attribute__((ext_vector_type(2)));
DEVI uint32_t pack2(float lo, float hi) { f32x2_t v = {lo, hi}; bf16x2_t b = __builtin_convertvector(v, bf16x2_t); return __builtin_bit_cast(uint32_t, b); }
DEVI float lo2f(uint32_t u) { return __uint_as_float(u << 16); }
DEVI float hi2f(uint32_t u) { return __uint_as_float(u & 0xffff0000u); }
DEVI float wave_sum(float v) {
#pragma unroll
  for (int o = 32; o; o >>= 1) v += __shfl_xor(v, o);
  return v;
}
DEVI float sigmoidf_(float x) { return 1.f / (1.f + __expf(-x)); }
DEVI float siluf_(float x) { return x / (1.f + __expf(-x)); }
DEVI f32x4 mfma16(bf16x8 a, bf16x8 b, f32x4 c) { return __builtin_amdgcn_mfma_f32_16x16x32_bf16(a, b, c, 0, 0, 0); }
DEVI f32x16 mfma32(bf16x8 a, bf16x8 b, f32x16 c) { return __builtin_amdgcn_mfma_f32_32x32x16_bf16(a, b, c, 0, 0, 0); }
DEVI bf16x8 mk8(uint32_t a, uint32_t b, uint32_t c, uint32_t d) { uint4 u = make_uint4(a, b, c, d); return *(bf16x8*)&u; }
DEVI bf16x8 mk8(uint2 lo, uint2 hi) { uint4 u = make_uint4(lo.x, lo.y, hi.x, hi.y); return *(bf16x8*)&u; }

constexpr int SMEM_GEMM = 2 * 2 * 128 * 72 * 2;
constexpr int SMEM_TOTAL = SMEM_GEMM + 2048;

template <bool SWAP, bool AF32, class RP>
DEVI void gemm_main(const int TIDX, const int BIDX, const int GDIM, f32x4 (&acc)[4][4], RP rowoff, const bf16_t* __restrict__ Bt, int ldb, int K, unsigned char* smem) {
  bf16_t* sa = (bf16_t*)smem;
  bf16_t* sb = sa + 2 * 128 * 72;
  const int tid = TIDX, c = tid & 7, r0 = tid >> 3;
  const int lane = tid & 63, w = tid >> 6, wr = w >> 1, wc = w & 1, li = lane & 15, lg = lane >> 4;
  const unsigned char* abase = rowoff.base;
  const unsigned char* bbase = (const unsigned char*)Bt;
  uint32_t ao[4];
  const uint32_t bo = (uint32_t)(r0 * ldb + c * 8) * 2u, bstep = (uint32_t)(32 * ldb) * 2u;
#pragma unroll
  for (int p = 0; p < 4; ++p) {
    ao[p] = rowoff(r0 + 32 * p) + (uint32_t)c * (AF32 ? 32u : 16u);
  }
  uint4 ra0, ra1, ra2, ra3, rb0, rb1, rb2, rb3;
  const uint32_t ao0 = ao[0], ao1 = ao[1], ao2 = ao[2], ao3 = ao[3];
#define GM_LA(dst, aoff, kt_)                                                                                  \
  if (AF32) {                                                                                                  \
    const float4* s_ = (const float4*)(abase + (aoff) + (uint32_t)(kt_) * 256u);                               \
    const float4 x_ = s_[0], y_ = s_[1];                                                                       \
    dst = make_uint4(pack2(x_.x, x_.y), pack2(x_.z, x_.w), pack2(y_.x, y_.y), pack2(y_.z, y_.w));              \
  } else {                                                                                                     \
    dst = *(const uint4*)(abase + (aoff) + (uint32_t)(kt_) * 128u);                                            \
  }
#define GM_GLOAD(kt_)                                                                                          \
  {                                                                                                            \
    GM_LA(ra0, ao0, kt_) GM_LA(ra1, ao1, kt_) GM_LA(ra2, ao2, kt_) GM_LA(ra3, ao3, kt_)                        \
    rb0 = *(const uint4*)(bbase + bo + (uint32_t)(kt_) * 128u);                                                \
    rb1 = *(const uint4*)(bbase + bo + bstep + (uint32_t)(kt_) * 128u);                                        \
    rb2 = *(const uint4*)(bbase + bo + 2u * bstep + (uint32_t)(kt_) * 128u);                                   \
    rb3 = *(const uint4*)(bbase + bo + 3u * bstep + (uint32_t)(kt_) * 128u);                                   \
  }
#define GM_SWRITE(buf_)                                                                                        \
  {                                                                                                            \
    bf16_t* a_ = sa + (buf_) * 128 * 72 + r0 * 72 + c * 8;                                                     \
    bf16_t* b_ = sb + (buf_) * 128 * 72 + r0 * 72 + c * 8;                                                     \
    *(uint4*)(a_) = ra0; *(uint4*)(a_ + 32 * 72) = ra1; *(uint4*)(a_ + 64 * 72) = ra2; *(uint4*)(a_ + 96 * 72) = ra3; \
    *(uint4*)(b_) = rb0; *(uint4*)(b_ + 32 * 72) = rb1; *(uint4*)(b_ + 64 * 72) = rb2; *(uint4*)(b_ + 96 * 72) = rb3; \
  }
  const int nk = K >> 6;
  GM_GLOAD(0);
  GM_SWRITE(0);
  __syncthreads();
  for (int kt = 0; kt < nk; ++kt) {
    const int buf = kt & 1;
    if (kt + 1 < nk) GM_GLOAD(kt + 1);
    const bf16_t* A = sa + buf * 128 * 72 + (wr * 64 + li) * 72 + lg * 8;
    const bf16_t* B = sb + buf * 128 * 72 + (wc * 64 + li) * 72 + lg * 8;
#pragma unroll
    for (int ks = 0; ks < 2; ++ks) {
      bf16x8 af[4], bfr[4];
#pragma unroll
      for (int i = 0; i < 4; ++i) {
        af[i] = *(const bf16x8*)(A + i * 16 * 72 + ks * 32);
        bfr[i] = *(const bf16x8*)(B + i * 16 * 72 + ks * 32);
      }
#pragma unroll
      for (int mi = 0; mi < 4; ++mi)
#pragma unroll
        for (int ni = 0; ni < 4; ++ni)
          acc[mi][ni] = SWAP ? mfma16(bfr[ni], af[mi], acc[mi][ni]) : mfma16(af[mi], bfr[ni], acc[mi][ni]);
    }
    if (kt + 1 < nk) GM_SWRITE(buf ^ 1);
    __syncthreads();
  }
}
DEVI float zero_f() { float z = 0.f; asm volatile("" : "+v"(z)); return z; }
DEVI void zero_acc(f32x4 (&acc)[4][4]) {
  const float z = zero_f();
#pragma unroll
  for (int i = 0; i < 4; ++i)
#pragma unroll
    for (int j = 0; j < 4; ++j) acc[i][j] = (f32x4){z, z, z, z};
}
#define EPI_SWAP_BEGIN(m0, n0)                                                                     \
  {                                                                                                \
    const int _lane = TIDX & 63, _w = TIDX >> 6;                                     \
    const int _rb = (m0) + (_w >> 1) * 64 + (_lane & 15), _cb = (n0) + (_w & 1) * 64 + 4 * (_lane >> 4); \
    _Pragma("unroll") for (int mi = 0; mi < 4; ++mi) {                                             \
      const int row = _rb + mi * 16;                                                               \
      _Pragma("unroll") for (int ni = 0; ni < 4; ++ni) {                                           \
        const int col = _cb + ni * 16;
#define EPI_END } __builtin_amdgcn_sched_barrier(0); } }

struct RowLin {
  const unsigned char* base; uint32_t stride;
  DEVI uint32_t operator()(int r) const { return (uint32_t)r * stride; }
};

struct CMap {
  int mode;
  DEVI int operator()(int n) const {
    if (mode == 0) return n;
    if (mode == 1) return n < 672 ? n : (n < 768 ? -1 : n - 96);
    if (mode == 2) return n + 2720;
    if (n < 512) return (n >> 6) * 96 + (n & 63);
    const int m = n - 512, h = m >> 5, w = m & 31;
    return h * 96 + (w < 16 ? 64 + w : 80 + (w - 16));
  }
};
DEVI void transpose_tile(const int TIDX, const int BIDX, const int GDIM, const float* __restrict__ src, int ld, int K, bf16_t* __restrict__ dst, int k0, int n0, CMap cm,
                         const float* kscale, float* tile) {
  const int tx = TIDX & 63, ty = TIDX >> 6;
  const int sc = cm(n0 + tx);
#pragma unroll 4
  for (int p = 0; p < 16; ++p) {
    const int i = ty + 4 * p;
    float v = 0.f;
    if (sc >= 0) { v = src[(size_t)(k0 + i) * ld + sc]; if (kscale) v *= kscale[k0 + i]; }
    tile[i * 65 + tx] = v;
  }
  __syncthreads();
#pragma unroll 4
  for (int p = 0; p < 16; ++p) {
    const int j = ty + 4 * p;
    dst[(size_t)(n0 + j) * K + k0 + tx] = f2bf(tile[tx * 65 + j]);
  }
  __syncthreads();
}
DEVI void run_transpose(const int TIDX, const int BIDX, const int GDIM, const float* src, int ld, int K, int N, bf16_t* dst, int mode, const float* kscale, float* tile) {
  const int nkt = K >> 6, tiles = nkt * (N >> 6);
  CMap cm{mode};
  for (int t = BIDX; t < tiles; t += GDIM) transpose_tile(TIDX, BIDX, GDIM, src, ld, K, dst, (t % nkt) * 64, (t / nkt) * 64, cm, kscale, tile);
}

DEVI void ln_inplace(float4 (&v)[4], const float* __restrict__ g, const float* __restrict__ b, int lane) {
  float s = 0.f;
#pragma unroll
  for (int j = 0; j < 4; ++j) s += v[j].x + v[j].y + v[j].z + v[j].w;
  s = wave_sum(s);
  const float mu = s * (1.f / 1024.f);
  float q = 0.f;
#pragma unroll
  for (int j = 0; j < 4; ++j) {
    float a = v[j].x - mu, bq = v[j].y - mu, cq = v[j].z - mu, d = v[j].w - mu;
    q += a * a + bq * bq + cq * cq + d * d;
  }
  q = wave_sum(q);
  const float rs = rsqrtf(q * (1.f / 1024.f) + EPS);
#pragma unroll
  for (int j = 0; j < 4; ++j) {
    const float4 gg = *(const float4*)(g + j * 256 + lane * 4), bb = *(const float4*)(b + j * 256 + lane * 4);
    v[j].x = (v[j].x - mu) * rs * gg.x + bb.x;
    v[j].y = (v[j].y - mu) * rs * gg.y + bb.y;
    v[j].z = (v[j].z - mu) * rs * gg.z + bb.z;
    v[j].w = (v[j].w - mu) * rs * gg.w + bb.w;
  }
}
DEVI void store_row(const float4 (&v)[4], float* x32, bf16_t* x16, int lane) {
#pragma unroll
  for (int j = 0; j < 4; ++j) {
    *(float4*)(x32 + j * 256 + lane * 4) = v[j];
    *(uint2*)(x16 + j * 256 + lane * 4) = make_uint2(pack2(v[j].x, v[j].y), pack2(v[j].z, v[j].w));
  }
}
DEVI int pos_index(int row) { return row < TP ? (row & 2047) : 2048 + ((row - TP) & 31); }

DEVI void phase_prep(const int TIDX, const int BIDX, const int GDIM, KAP KA, unsigned char* WSB, float* OUTB, unsigned char* smem) {
  float* tile = (float*)smem;
  bf16_t* WS = (bf16_t*)(WSB + O_WS);
  const int tid = TIDX, gtid = BIDX * 256 + tid, gsz = GDIM * 256;
  if (gtid < 1024) ((int*)(WSB + O_CNT))[gtid] = 0;
  if (gtid < 512) ((uint32_t*)(WSB + O_XB + (size_t)NTOK * 2048))[gtid] = 0u;
  for (int i = gtid; i < 2080 * 16; i += gsz) {
    const int pi = i >> 4, k = i & 15;
    const int pos = pi < 2048 ? pi : 4096 + (pi - 2048);
    const float inv = exp2f(-(float)k * (13.287712379549449f / 16.f));
    const float ang = (float)pos * inv;
    double rev = (double)ang * 0.15915494309189535;
    rev -= __builtin_rint(rev);
    const float fr = (float)rev;
    float2 cs = make_float2(__builtin_amdgcn_cosf(fr), __builtin_amdgcn_sinf(fr));
    ((float2*)(WSB + O_ROPE))[i] = cs;
  }
  for (int i = gtid; i < 2 * 36 * 1024; i += gsz) {
    const int l = i / (36 * 1024), r = i % (36 * 1024), c = r >> 10, k = r & 1023;
    float v = c < 4 ? PIN(I_WRG)[((size_t)l * 1024 + k) * 4 + c] : PIN(I_WRE)[((size_t)l * 1024 + k) * 32 + (c - 4)];
    ((float*)(WSB + O_WR))[i] = v;
  }
  for (int i = gtid; i < 2 * 16 * 4096 * 8; i += gsz) {
    const int e = i * 4, lb = e / (4096 * 32), r = e % (4096 * 32);
    const float4 v = *(const float4*)(PIN(I_CKR) + (size_t)e);
    *(uint2*)((bf16_t*)(WSB + O_KRS) + (size_t)lb * KPAD * 32 + r) = make_uint2(pack2(v.x, v.y), pack2(v.z, v.w));
  }
  {
    const int lane = tid & 63, wid = BIDX * 4 + (tid >> 6), nw = GDIM * 4;
    for (int row = wid; row < NTOK; row += nw) {
      const float* src = row < TP ? PIN(I_XP) + (size_t)row * 1024 : PIN(I_XS) + (size_t)(row - TP) * 1024;
      float4 v[4];
#pragma unroll
      for (int j = 0; j < 4; ++j) v[j] = *(const float4*)(src + j * 256 + lane * 4);
      ln_inplace(v, PIN(I_LN0G), PIN(I_LN0B), lane);
      store_row(v, OUTB + (size_t)row * 1024, (bf16_t*)(WSB + O_XB) + (size_t)row * 1024, lane);
    }
  }
  for (int l = 0; l < 2; ++l) {
    bf16_t* W = WS + (size_t)l * WO_END;
    run_transpose(TIDX, BIDX, GDIM, PIN(I_WIN) + (size_t)l * 1024 * 4768, 4768, 1024, 2816, W + WO_IN, 1, nullptr, tile);
    run_transpose(TIDX, BIDX, GDIM, PIN(I_WIN) + (size_t)l * 1024 * 4768, 4768, 1024, 2048, W + WO_G, 2, nullptr, tile);
    run_transpose(TIDX, BIDX, GDIM, PIN(I_WUQ) + (size_t)l * 384 * 768, 768, 384, 768, W + WO_UQ, 3, PIN(I_QN) + l * 384, tile);
    run_transpose(TIDX, BIDX, GDIM, PIN(I_WUK) + (size_t)l * 256 * 512, 512, 256, 512, W + WO_KV, 0, nullptr, tile);
    run_transpose(TIDX, BIDX, GDIM, PIN(I_WUV) + (size_t)l * 256 * 512, 512, 256, 512, W + WO_KV + 512 * 256, 0, nullptr, tile);
    run_transpose(TIDX, BIDX, GDIM, PIN(I_WBRA) + (size_t)l * 512 * 1024, 1024, 512, 1024, W + WO_BRA, 0, nullptr, tile);
    run_transpose(TIDX, BIDX, GDIM, PIN(I_WBRB) + (size_t)l * 512 * 1024, 1024, 512, 1024, W + WO_BRB, 0, nullptr, tile);
    run_transpose(TIDX, BIDX, GDIM, PIN(I_WOUT) + (size_t)l * 1024 * 1024, 1024, 1024, 1024, W + WO_OUT, 0, nullptr, tile);
    run_transpose(TIDX, BIDX, GDIM, PIN(I_WPG) + (size_t)l * 1024 * 1024, 1024, 1024, 1024, W + WO_PG, 0, nullptr, tile);
    run_transpose(TIDX, BIDX, GDIM, PIN(I_WPLE) + (size_t)l * 256 * 1024, 1024, 256, 1024, W + WO_PLE, 0, nullptr, tile);
  }
}

DEVI void phase_p1(const int TIDX, const int BIDX, const int GDIM, KAP KA, unsigned char* WSB, float* OUTB, int l, unsigned char* smem) {
  const bf16_t* XB = (const bf16_t*)(WSB + O_XB);
  const bf16_t* W = (const bf16_t*)(WSB + O_WS) + (size_t)l * WO_END + WO_IN;
  bf16_t* CQ = (bf16_t*)(WSB + O_CQ);
  float* CKR = (float*)(WSB + O_CKR);
  bf16_t* FQ = (bf16_t*)(WSB + O_FQ);
  bf16_t* VT2 = (bf16_t*)(WSB + O_VT2);
  bf16_t* G = (bf16_t*)(WSB + O_G);
  for (int item = BIDX; item < 516 * 22; item += GDIM) {
    const int mt = item / 22, nt = item % 22, m0 = mt * 128;
    f32x4 acc[4][4];
    zero_acc(acc);
    RowLin rp{(const unsigned char*)(XB + (size_t)m0 * 1024), 2048};
    if (nt >= 14 && nt < 18) {
      gemm_main<false, false>(TIDX, BIDX, GDIM, acc, rp, W + (size_t)nt * 128 * 1024, 1024, 1024, smem);
      const int h = nt - 14, lane = TIDX & 63, w = TIDX >> 6;
      const int rb = m0 + (w >> 1) * 64 + 4 * (lane >> 4), cb = (w & 1) * 64 + (lane & 15);
#pragma unroll
      for (int mi = 0; mi < 4; ++mi) {
        const int row = rb + mi * 16, ch = row >> 5, s = row & 31;
#pragma unroll
        for (int ni = 0; ni < 4; ++ni) {
          const int dv = cb + ni * 16;
          const f32x4 a = acc[mi][ni];
          *(uint2*)(VT2 + ((size_t)(ch * 4 + h) * 128 + dv) * 32 + s) = make_uint2(pack2(a[0], a[1]), pack2(a[2], a[3]));
        }
      }
    } else {
      gemm_main<true, false>(TIDX, BIDX, GDIM, acc, rp, W + (size_t)nt * 128 * 1024, 1024, 1024, smem);
      EPI_SWAP_BEGIN(m0, 0)
        const f32x4 a = acc[mi][ni];
        if (nt < 3) {
          *(uint2*)(CQ + (size_t)row * 384 + nt * 128 + col) = make_uint2(pack2(a[0], a[1]), pack2(a[2], a[3]));
        } else if (nt < 5) {
          *(f32x4*)(CKR + (size_t)row * 288 + (nt - 3) * 128 + col) = a;
        } else if (nt == 5) {
          if (col < 32) *(f32x4*)(CKR + (size_t)row * 288 + 256 + col) = a;
        } else if (nt < 14) {
          *(uint2*)(FQ + (size_t)row * 1024 + (nt - 6) * 128 + col) = make_uint2(pack2(a[0], a[1]), pack2(a[2], a[3]));
        } else {
          *(uint2*)(G + (size_t)row * 512 + (nt - 18) * 128 + col) = make_uint2(pack2(a[0], a[1]), pack2(a[2], a[3]));
        }
      EPI_END
    }
  }
}

DEVI void phase_p2(const int TIDX, const int BIDX, const int GDIM, KAP KA, unsigned char* WSB, float* OUTB, int l, unsigned char* smem) {
  const int tid = TIDX, lane = tid & 63;
  const float2* ROPE = (const float2*)(WSB + O_ROPE);
  {
    const bf16_t* CQ = (const bf16_t*)(WSB + O_CQ);
    const bf16_t* W = (const bf16_t*)(WSB + O_WS) + (size_t)l * WO_END + WO_UQ;
    bf16_t* QB = (bf16_t*)(WSB + O_QB);
    float* srow = (float*)(smem + SMEM_GEMM);
    for (int item = BIDX; item < 516 * 6; item += GDIM) {
      const int mt = item / 6, nt = item % 6, m0 = mt * 128;
      {
        const int r = tid >> 1, hf = tid & 1;
        const uint4* s = (const uint4*)(CQ + (size_t)(m0 + r) * 384 + hf * 192);
        float ss = 0.f;
#pragma unroll 4
        for (int j = 0; j < 24; ++j) {
          const uint4 u = s[j];
          float a;
          a = lo2f(u.x); ss += a * a; a = hi2f(u.x); ss += a * a;
          a = lo2f(u.y); ss += a * a; a = hi2f(u.y); ss += a * a;
          a = lo2f(u.z); ss += a * a; a = hi2f(u.z); ss += a * a;
          a = lo2f(u.w); ss += a * a; a = hi2f(u.w); ss += a * a;
        }
        ss += __shfl_xor(ss, 1);
        if (hf == 0) srow[r] = rsqrtf(ss * (1.f / 384.f) + EPS) * QSCALE;
      }
      f32x4 acc[4][4];
      zero_acc(acc);
      RowLin rp{(const unsigned char*)(CQ + (size_t)m0 * 384), 768};
      gemm_main<true, false>(TIDX, BIDX, GDIM, acc, rp, W + (size_t)nt * 128 * 384, 384, 384, smem);
      if (nt < 4) {
        EPI_SWAP_BEGIN(m0, nt * 128)
          const float sc = srow[row - m0];
          const f32x4 a = acc[mi][ni] * sc;
          const int hh = col >> 6, d = col & 63;
          *(uint2*)(QB + (size_t)row * 768 + hh * 96 + d) = make_uint2(pack2(a[0], a[1]), pack2(a[2], a[3]));
        EPI_END
      } else {
        const int w = tid >> 6;
        const int rb = m0 + (w >> 1) * 64 + (lane & 15), i0 = 4 * (lane >> 4);
#pragma unroll
        for (int mi = 0; mi < 4; ++mi) {
          const int row = rb + mi * 16;
          const float sc = srow[row - m0];
          const float2* rt = ROPE + (size_t)pos_index(row) * 16 + i0;
#pragma unroll
          for (int pr = 0; pr < 2; ++pr) {
            const int hh = (nt - 4) * 4 + (w & 1) * 2 + pr;
            const f32x4 x1 = acc[mi][2 * pr] * sc, x2 = acc[mi][2 * pr + 1] * sc;
            float o1[4], o2[4];
#pragma unroll
            for (int r = 0; r < 4; ++r) {
              const float2 cs = rt[r];
              o1[r] = x1[r] * cs.x - x2[r] * cs.y;
              o2[r] = x2[r] * cs.x + x1[r] * cs.y;
            }
            *(uint2*)(QB + (size_t)row * 768 + hh * 96 + 64 + i0) = make_uint2(pack2(o1[0], o1[1]), pack2(o1[2], o1[3]));
            *(uint2*)(QB + (size_t)row * 768 + hh * 96 + 80 + i0) = make_uint2(pack2(o2[0], o2[1]), pack2(o2[2], o2[3]));
          }
        }
      }
      __syncthreads();
    }
  }
  {
    const bf16_t* FQ = (const bf16_t*)(WSB + O_FQ);
    bf16_t* QT = (bf16_t*)(WSB + O_QT);
    bf16_t* KHT = (bf16_t*)(WSB + O_KHT);
    bf16_t* AM = (bf16_t*)(WSB + O_AM);
    float* EBp = (float*)(WSB + O_EB);
    bf16_t* sQ = (bf16_t*)smem;
    bf16_t* sK = sQ + 32 * 136;
    for (int item = BIDX; item < NCH * 4; item += GDIM) {
      const int ch = item >> 2, h = item & 3, cid = item;
      if (tid < 128) {
        const int k = tid, colh = h * 128 + k;
        float lb = 0.f;
        if (l == 1) { const float a0 = PIN(I_HGLB)[colh], a1 = PIN(I_HGLB)[512 + colh]; lb = 1.f / (1.f + expf(a0 - a1)); }
        const float oml = 1.f - lb;
        float bt[32], kk[32];
        float b = 0.f;
#pragma unroll
        for (int t = 0; t < 32; ++t) {
          const size_t row = (size_t)ch * 32 + t;
          const float z = bf2f(FQ[row * 1024 + colh]);
          const float qp = bf2f(FQ[row * 1024 + 512 + colh]);
          const float e = expf(-z);
          const float inv = 1.f / (1.f + e);
          const float f = lb + oml * inv;
          const float kv = oml * e * inv;
          b += logf(f);
          bt[t] = b;
          kk[t] = kv;
          const float qs = qp / (1.f + expf(-qp));
          const bf16_t qt = f2bf(qs * expf(b));
          QT[((size_t)cid * 32 + t) * 128 + k] = qt;
          sQ[t * 136 + k] = qt;
          sK[t * 136 + k] = f2bf(kv * expf(fminf(-b, 80.f)));
        }
        EBp[(size_t)cid * 128 + k] = expf(b);
        uint32_t pk[16];
#pragma unroll
        for (int t = 0; t < 16; ++t) pk[t] = pack2(kk[2 * t] * expf(b - bt[2 * t]), kk[2 * t + 1] * expf(b - bt[2 * t + 1]));
        uint4* dst = (uint4*)(KHT + ((size_t)cid * 128 + k) * 32);
#pragma unroll
        for (int j = 0; j < 4; ++j) dst[j] = make_uint4(pk[4 * j], pk[4 * j + 1], pk[4 * j + 2], pk[4 * j + 3]);
      }
      __syncthreads();
      if (tid < 64) {
        const int c = lane & 31, hh = lane >> 5;
        f32x16 am;
        const float zf = zero_f();
#pragma unroll
        for (int r = 0; r < 16; ++r) am[r] = zf;
#pragma unroll
        for (int st = 0; st < 8; ++st) {
          const bf16x8 a = *(const bf16x8*)(sQ + c * 136 + st * 16 + hh * 8);
          const bf16x8 bb = *(const bf16x8*)(sK + c * 136 + st * 16 + hh * 8);
          am = mfma32(a, bb, am);
        }
#pragma unroll
        for (int r = 0; r < 16; ++r) {
          const int t = (r & 3) + 8 * (r >> 2) + 4 * hh;
          AM[((size_t)cid * 32 + t) * 32 + c] = f2bf(c <= t ? am[r] : 0.f);
        }
      }
      __syncthreads();
    }
  }
  {
    const float* CKR = (const float*)(WSB + O_CKR);
    bf16_t* CKVN = (bf16_t*)(WSB + O_CKVN);
    bf16_t* KRB = (bf16_t*)(WSB + O_KRB);
    bf16_t* KRS = (bf16_t*)(WSB + O_KRS) + (size_t)l * 16 * KPAD * 32;
    const float* kvn = PIN(I_KVN) + l * 256;
    const int wid = BIDX * 4 + (tid >> 6), nw = GDIM * 4;
    for (int row = wid; row < NTOK; row += nw) {
      const float* src = CKR + (size_t)row * 288;
      const float4 v = *(const float4*)(src + lane * 4);
      float ss = wave_sum(v.x * v.x + v.y * v.y + v.z * v.z + v.w * v.w);
      const float rs = rsqrtf(ss * (1.f / 256.f) + EPS);
      const float4 g = *(const float4*)(kvn + lane * 4);
      const float4 o = make_float4(v.x * rs * g.x, v.y * rs * g.y, v.z * rs * g.z, v.w * rs * g.w);
      float* oc = row < TP ? OUTB + OUT_CKV_P + ((size_t)l * TP + row) * 256 : OUTB + OUT_CKV_S + ((size_t)l * TS + (row - TP)) * 256;
      *(float4*)(oc + lane * 4) = o;
      *(uint2*)(CKVN + (size_t)row * 256 + lane * 4) = make_uint2(pack2(o.x, o.y), pack2(o.z, o.w));
      if (lane < 16) {
        const float x1 = src[256 + lane], x2 = src[272 + lane];
        const float2 cs = ROPE[(size_t)pos_index(row) * 16 + lane];
        const float o1 = x1 * cs.x - x2 * cs.y, o2 = x2 * cs.x + x1 * cs.y;
        float* ok = row < TP ? OUTB + OUT_KR_P + ((size_t)l * TP + row) * 32 : OUTB + OUT_KR_S + ((size_t)l * TS + (row - TP)) * 32;
        ok[lane] = o1;
        ok[16 + lane] = o2;
        bf16_t* kb = row < TP ? KRB + (size_t)row * 32 : KRS + ((size_t)((row - TP) >> 5) * KPAD + 4096 + ((row - TP) & 31)) * 32;
        kb[lane] = f2bf(o1);
        kb[16 + lane] = f2bf(o2);
      }
    }
  }
}

DEVI void phase_p3(const int TIDX, const int BIDX, const int GDIM, KAP KA, unsigned char* WSB, float* OUTB, int l, unsigned char* smem) {
  const bf16_t* W = (const bf16_t*)(WSB + O_WS) + (size_t)l * WO_END + WO_KV;
  const bf16_t* CKVN = (const bf16_t*)(WSB + O_CKVN);
  bf16_t* KN = (bf16_t*)(WSB + O_KN);
  bf16_t* VT = (bf16_t*)(WSB + O_VT);
  bf16_t* KNS = (bf16_t*)(WSB + O_KNS);
  bf16_t* VTS = (bf16_t*)(WSB + O_VTS);
  const float* cache = PIN(I_CCKV) + (size_t)l * 16 * 4096 * 256;
  for (int i = BIDX * 256 + TIDX; i < 16 * 8 * 64 * 4; i += GDIM * 256) {
    const uint32_t z = __float_as_uint(zero_f());
    *(uint4*)(VTS + (size_t)(i >> 2) * KPAD + 4128 + (i & 3) * 8) = make_uint4(z, z, z, z);
  }
  for (int item = BIDX; item < (516 + 512) * 8; item += GDIM) {
    const int mt = item >> 3, nt = item & 7;
    const bool is_cache = mt >= 516;
    const int m0 = is_cache ? (mt - 516) * 128 : mt * 128;
    f32x4 acc[4][4];
    zero_acc(acc);
    bf16_t* kdst; bf16_t* vdst; size_t ldv; int key0;
    if (is_cache) { const int b = m0 >> 12; key0 = m0 & 4095; kdst = KNS + ((size_t)b * KPAD + key0) * 512; vdst = VTS + (size_t)b * 8 * 64 * KPAD; ldv = KPAD; }
    else if (m0 >= TP) { kdst = nullptr; vdst = nullptr; ldv = KPAD; key0 = 0; }
    else { const int b = m0 >> 11; key0 = m0 & 2047; kdst = KN + (size_t)m0 * 512; vdst = VT + (size_t)b * 8 * 64 * 2048; ldv = 2048; }
    if (nt < 4) {
      if (is_cache) { RowLin rp{(const unsigned char*)(cache + (size_t)m0 * 256), 1024}; gemm_main<true, true>(TIDX, BIDX, GDIM, acc, rp, W + (size_t)nt * 128 * 256, 256, 256, smem); }
      else { RowLin rp{(const unsigned char*)(CKVN + (size_t)m0 * 256), 512}; gemm_main<true, false>(TIDX, BIDX, GDIM, acc, rp, W + (size_t)nt * 128 * 256, 256, 256, smem); }
      EPI_SWAP_BEGIN(0, nt * 128)
        const f32x4 a = acc[mi][ni];
        bf16_t* d;
        if (kdst) d = kdst + (size_t)row * 512 + col;
        else { const int sr = m0 - TP + row; d = KNS + ((size_t)(sr >> 5) * KPAD + 4096 + (sr & 31)) * 512 + col; }
        *(uint2*)d = make_uint2(pack2(a[0], a[1]), pack2(a[2], a[3]));
      EPI_END
    } else {
      if (is_cache) { RowLin rp{(const unsigned char*)(cache + (size_t)m0 * 256), 1024}; gemm_main<false, true>(TIDX, BIDX, GDIM, acc, rp, W + (size_t)nt * 128 * 256, 256, 256, smem); }
      else { RowLin rp{(const unsigned char*)(CKVN + (size_t)m0 * 256), 512}; gemm_main<false, false>(TIDX, BIDX, GDIM, acc, rp, W + (size_t)nt * 128 * 256, 256, 256, smem); }
      const int lane = TIDX & 63, w = TIDX >> 6;
      const int rb = (w >> 1) * 64 + 4 * (lane >> 4), cb = (nt - 4) * 128 + (w & 1) * 64 + (lane & 15);
#pragma unroll
      for (int mi = 0; mi < 4; ++mi) {
        const int row = rb + mi * 16;
#pragma unroll
        for (int ni = 0; ni < 4; ++ni) {
          const int hv = cb + ni * 16;
          const f32x4 a = acc[mi][ni];
          bf16_t* d;
          if (vdst) d = vdst + (size_t)hv * ldv + key0 + row;
          else { const int sr = m0 - TP + row; d = VTS + ((size_t)(sr >> 5) * 512 + hv) * KPAD + 4096 + (sr & 31); }
          *(uint2*)d = make_uint2(pack2(a[0], a[1]), pack2(a[2], a[3]));
        }
      }
    }
  }
}

DEVI void attn_item(const int TIDX, const int BIDX, const int GDIM, const bf16_t* __restrict__ Q, int qrow0, int nq, const bf16_t* __restrict__ Kn, const bf16_t* __restrict__ Kr,
                    const bf16_t* __restrict__ VT, size_t ldv, int nkeys, bf16_t* __restrict__ O, unsigned char* smem) {
  const int tid = TIDX, lane = tid & 63, w = tid >> 6, li = lane & 15, lg = lane >> 4;
  bf16_t* sK = (bf16_t*)smem;
  bf16_t* sV = sK + 2 * 64 * 104;
  const int ql = 16 * w + li;
  const int qrow = qrow0 + (ql < nq ? ql : nq - 1);
  bf16x8 qf[3];
#pragma unroll
  for (int ds = 0; ds < 3; ++ds) qf[ds] = *(const bf16x8*)(Q + (size_t)qrow * 768 + ds * 32 + lg * 8);
  f32x4 oT[4];
  const float zf = zero_f();
#pragma unroll
  for (int i = 0; i < 4; ++i) oT[i] = (f32x4){zf, zf, zf, zf};
  float mrun = -INFINITY, lrun = 0.f;
  const int nt = (nkeys + 63) >> 6;
  uint4 rk0, rk1, rk2, rv0, rv1;
  const int ar0 = tid >> 3, ac0 = tid & 7, ar1 = ar0 + 32;
  const bf16_t* gk0 = Kn + (size_t)ar0 * 512 + ac0 * 8;
  const bf16_t* gk1 = Kn + (size_t)ar1 * 512 + ac0 * 8;
  const bf16_t* gk2 = Kr + (size_t)(tid >> 2) * 32 + (tid & 3) * 8;
  const bf16_t* gv0 = VT + (size_t)ar0 * ldv + ac0 * 8;
  const bf16_t* gv1 = VT + (size_t)ar1 * ldv + ac0 * 8;
#define ATT_GLOAD(kt_) { const size_t key0_ = (size_t)(kt_) * 64; rk0 = *(const uint4*)(gk0 + key0_ * 512); rk1 = *(const uint4*)(gk1 + key0_ * 512); \
    rk2 = *(const uint4*)(gk2 + key0_ * 32); rv0 = *(const uint4*)(gv0 + key0_); rv1 = *(const uint4*)(gv1 + key0_); }
#define ATT_SWRITE(buf_) { bf16_t* k_ = sK + (buf_) * 64 * 104; bf16_t* v_ = sV + (buf_) * 64 * 72; \
    *(uint4*)(k_ + ar0 * 104 + ac0 * 8) = rk0; *(uint4*)(k_ + ar1 * 104 + ac0 * 8) = rk1; *(uint4*)(k_ + (tid >> 2) * 104 + 64 + (tid & 3) * 8) = rk2; \
    *(uint4*)(v_ + ar0 * 72 + ac0 * 8) = rv0; *(uint4*)(v_ + ar1 * 72 + ac0 * 8) = rv1; }
  ATT_GLOAD(0);
  ATT_SWRITE(0);
  __syncthreads();
  for (int kt = 0; kt < nt; ++kt) {
    const int buf = kt & 1;
    if (kt + 1 < nt) ATT_GLOAD(kt + 1);
    const bf16_t* K = sK + buf * 64 * 104;
    const bf16_t* V = sV + buf * 64 * 72;
    f32x4 sT[4];
#pragma unroll
    for (int kb = 0; kb < 4; ++kb) {
      sT[kb] = (f32x4){zf, zf, zf, zf};
#pragma unroll
      for (int ds = 0; ds < 3; ++ds) {
        const bf16x8 kf = *(const bf16x8*)(K + (kb * 16 + li) * 104 + ds * 32 + lg * 8);
        sT[kb] = mfma16(kf, qf[ds], sT[kb]);
      }
    }
    if (kt == nt - 1 && (nkeys & 63)) {
#pragma unroll
      for (int kb = 0; kb < 4; ++kb)
#pragma unroll
        for (int r = 0; r < 4; ++r)
          if (kt * 64 + kb * 16 + 4 * lg + r >= nkeys) sT[kb][r] = -INFINITY;
    }
    float mx = sT[0][0];
#pragma unroll
    for (int kb = 0; kb < 4; ++kb)
#pragma unroll
      for (int r = 0; r < 4; ++r) mx = fmaxf(mx, sT[kb][r]);
    mx = fmaxf(mx, __shfl_xor(mx, 16));
    mx = fmaxf(mx, __shfl_xor(mx, 32));
    const float mnew = fmaxf(mrun, mx);
    const float alpha = __builtin_amdgcn_exp2f(mrun - mnew);
    mrun = mnew;
    float ps = 0.f;
#pragma unroll
    for (int kb = 0; kb < 4; ++kb)
#pragma unroll
      for (int r = 0; r < 4; ++r) { const float pv = __builtin_amdgcn_exp2f(sT[kb][r] - mnew); sT[kb][r] = pv; ps += pv; }
    lrun = lrun * alpha + ps;
#pragma unroll
    for (int vb = 0; vb < 4; ++vb) oT[vb] *= alpha;
#pragma unroll
    for (int s = 0; s < 2; ++s) {
      const bf16x8 pf = mk8(pack2(sT[2 * s][0], sT[2 * s][1]), pack2(sT[2 * s][2], sT[2 * s][3]),
                            pack2(sT[2 * s + 1][0], sT[2 * s + 1][1]), pack2(sT[2 * s + 1][2], sT[2 * s + 1][3]));
#pragma unroll
      for (int vb = 0; vb < 4; ++vb) {
        const uint2 lo = *(const uint2*)(V + (vb * 16 + li) * 72 + s * 32 + 4 * lg);
        const uint2 hi = *(const uint2*)(V + (vb * 16 + li) * 72 + s * 32 + 16 + 4 * lg);
        oT[vb] = mfma16(mk8(lo, hi), pf, oT[vb]);
      }
    }
    if (kt + 1 < nt) ATT_SWRITE(buf ^ 1);
    __syncthreads();
  }
  lrun += __shfl_xor(lrun, 16);
  lrun += __shfl_xor(lrun, 32);
  const float inv = 1.f / lrun;
  if (ql < nq) {
#pragma unroll
    for (int vb = 0; vb < 4; ++vb) {
      const f32x4 o = oT[vb] * inv;
      *(uint2*)(O + (size_t)(qrow0 + ql) * 512 + vb * 16 + 4 * lg) = make_uint2(pack2(o[0], o[1]), pack2(o[2], o[3]));
    }
  }
}

DEVI void hgrn_item(const int TIDX, const int BIDX, const int GDIM, KAP KA, unsigned char* WSB, float* OUTB, int l, int g0, int nchunks, int h, const float* __restrict__ S0, float* __restrict__ Sout, int rowbase,
                    unsigned char* smem) {
  const bf16_t* QT = (const bf16_t*)(WSB + O_QT);
  const bf16_t* KHT = (const bf16_t*)(WSB + O_KHT);
  const bf16_t* AM = (const bf16_t*)(WSB + O_AM);
  const float* EBp = (const float*)(WSB + O_EB);
  const bf16_t* VT2 = (const bf16_t*)(WSB + O_VT2);
  const bf16_t* G = (const bf16_t*)(WSB + O_G);
  bf16_t* HO = (bf16_t*)(WSB + O_HO);
  const float* hgn = PIN(I_HGN) + l * 512 + h * 128;
  float* sred = (float*)(smem + SMEM_GEMM);
  const int tid = TIDX, lane = tid & 63, w = tid >> 6, c = lane & 31, hh = lane >> 5;
  const int dvg = 32 * w + c;
  f32x16 S[4];
#pragma unroll
  for (int kt = 0; kt < 4; ++kt)
#pragma unroll
    for (int r = 0; r < 16; ++r) S[kt][r] = S0 ? S0[(size_t)(32 * kt + (r & 3) + 8 * (r >> 2) + 4 * hh) * 128 + dvg] : 0.f;
  for (int ch = 0; ch < nchunks; ++ch) {
    const size_t cid = (size_t)(g0 + ch) * 4 + h;
    bf16x8 vf[2], af[2];
#pragma unroll
    for (int s = 0; s < 2; ++s) {
      vf[s] = *(const bf16x8*)(VT2 + (cid * 128 + dvg) * 32 + 16 * s + 8 * hh);
      af[s] = *(const bf16x8*)(AM + (cid * 32 + c) * 32 + 16 * s + 8 * hh);
    }
    f32x16 oT;
    const float zf = zero_f();
#pragma unroll
    for (int r = 0; r < 16; ++r) oT[r] = zf;
#pragma unroll
    for (int kt = 0; kt < 4; ++kt) {
#pragma unroll
      for (int s = 0; s < 2; ++s) {
        const uint2 lo = *(const uint2*)(QT + (cid * 32 + c) * 128 + 32 * kt + 16 * s + 4 * hh);
        const uint2 hi = *(const uint2*)(QT + (cid * 32 + c) * 128 + 32 * kt + 16 * s + 8 + 4 * hh);
        const bf16x8 sa = mk8(pack2(S[kt][8 * s + 0], S[kt][8 * s + 1]), pack2(S[kt][8 * s + 2], S[kt][8 * s + 3]),
                              pack2(S[kt][8 * s + 4], S[kt][8 * s + 5]), pack2(S[kt][8 * s + 6], S[kt][8 * s + 7]));
        oT = mfma32(sa, mk8(lo, hi), oT);
      }
    }
#pragma unroll
    for (int s = 0; s < 2; ++s) oT = mfma32(vf[s], af[s], oT);
#pragma unroll
    for (int kt = 0; kt < 4; ++kt) {
#pragma unroll
      for (int q = 0; q < 4; ++q) {
        const float4 e = *(const float4*)(EBp + cid * 128 + 32 * kt + 8 * q + 4 * hh);
        S[kt][4 * q + 0] *= e.x; S[kt][4 * q + 1] *= e.y; S[kt][4 * q + 2] *= e.z; S[kt][4 * q + 3] *= e.w;
      }
#pragma unroll
      for (int s = 0; s < 2; ++s) {
        const bf16x8 kf = *(const bf16x8*)(KHT + (cid * 128 + 32 * kt + c) * 32 + 16 * s + 8 * hh);
        S[kt] = mfma32(kf, vf[s], S[kt]);
      }
    }
    float ss = 0.f;
#pragma unroll
    for (int r = 0; r < 16; ++r) ss += oT[r] * oT[r];
    ss += __shfl_xor(ss, 32);
    if (lane < 32) sred[w * 32 + c] = ss;
    __syncthreads();
    const float tot = sred[c] + sred[32 + c] + sred[64 + c] + sred[96 + c];
    __syncthreads();
    const float rs = rsqrtf(tot * (1.f / 128.f) + EPS);
    const size_t row = (size_t)rowbase + ch * 32 + c;
#pragma unroll
    for (int q = 0; q < 4; ++q) {
      const int dv0 = 32 * w + 8 * q + 4 * hh;
      const float4 gn = *(const float4*)(hgn + dv0);
      const uint2 gp = *(const uint2*)(G + row * 512 + h * 128 + dv0);
      const float o0 = oT[4 * q + 0] * rs * gn.x * siluf_(lo2f(gp.x));
      const float o1 = oT[4 * q + 1] * rs * gn.y * siluf_(hi2f(gp.x));
      const float o2 = oT[4 * q + 2] * rs * gn.z * siluf_(lo2f(gp.y));
      const float o3 = oT[4 * q + 3] * rs * gn.w * siluf_(hi2f(gp.y));
      *(uint2*)(HO + row * 512 + h * 128 + dv0) = make_uint2(pack2(o0, o1), pack2(o2, o3));
    }
  }
#pragma unroll
  for (int kt = 0; kt < 4; ++kt)
#pragma unroll
    for (int r = 0; r < 16; ++r) Sout[(size_t)(32 * kt + (r & 3) + 8 * (r >> 2) + 4 * hh) * 128 + dvg] = S[kt][r];
}

DEVI void phase_p4(const int TIDX, const int BIDX, const int GDIM, KAP KA, unsigned char* WSB, float* OUTB, int l, unsigned char* smem) {
  int* qctr = (int*)(WSB + O_CNT) + 128 + l;
  int* sitem = (int*)(smem + SMEM_GEMM + 1024);
  const bf16_t* QB = (const bf16_t*)(WSB + O_QB);
  bf16_t* AO = (bf16_t*)(WSB + O_AO);
  const int total = 128 + 128 + 8192 + 64;
  for (;;) {
    if (TIDX == 0) *sitem = atomicAdd(qctr, 1);
    __syncthreads();
    const int it = *sitem;
    __syncthreads();
    if (it >= total) break;
    if (it < 128) {
      const int b = it >> 2, h = it & 3;
      hgrn_item(TIDX, BIDX, GDIM, KA, WSB, OUTB, l, b * 64, 64, h, nullptr, OUTB + OUT_ST_P + ((size_t)(l * 32 + b) * 4 + h) * 16384, b * 2048, smem);
    } else if (it < 256) {
      const int i2 = it - 128, b = i2 >> 3, h = i2 & 7;
      attn_item(TIDX, BIDX, GDIM, QB + h * 96, TP + b * 32, 32, (const bf16_t*)(WSB + O_KNS) + (size_t)b * KPAD * 512 + h * 64,
                (const bf16_t*)(WSB + O_KRS) + ((size_t)l * 16 + b) * KPAD * 32,
                (const bf16_t*)(WSB + O_VTS) + (size_t)(b * 8 + h) * 64 * KPAD, KPAD, 4128, AO + h * 64, smem);
    } else if (it < 256 + 8192) {
      const int i2 = it - 256, c = 31 - (i2 >> 8), bh = i2 & 255, b = bh >> 3, h = bh & 7;
      attn_item(TIDX, BIDX, GDIM, QB + h * 96, b * 2048 + c * 64, 64, (const bf16_t*)(WSB + O_KN) + (size_t)b * 2048 * 512 + h * 64,
                (const bf16_t*)(WSB + O_KRB) + (size_t)b * 2048 * 32,
                (const bf16_t*)(WSB + O_VT) + (size_t)(b * 8 + h) * 64 * 2048, 2048, 64 * (c + 1), AO + h * 64, smem);
    } else {
      const int i2 = it - 256 - 8192, b = i2 >> 2, h = i2 & 3;
      hgrn_item(TIDX, BIDX, GDIM, KA, WSB, OUTB, l, 2048 + b, 1, h, PIN(I_ST) + ((size_t)(l * 16 + b) * 4 + h) * 16384,
                OUTB + OUT_ST_S + ((size_t)(l * 16 + b) * 4 + h) * 16384, TP + b * 32, smem);
    }
  }
}

DEVI void phase_p5(const int TIDX, const int BIDX, const int GDIM, KAP KA, unsigned char* WSB, float* OUTB, int l, unsigned char* smem) {
  const bf16_t* XB = (const bf16_t*)(WSB + O_XB);
  const bf16_t* AO = (const bf16_t*)(WSB + O_AO);
  const bf16_t* HO = (const bf16_t*)(WSB + O_HO);
  const bf16_t* W = (const bf16_t*)(WSB + O_WS) + (size_t)l * WO_END;
  bf16_t* MG = (bf16_t*)(WSB + O_MG);
  for (int item = BIDX; item < 516 * 8; item += GDIM) {
    const int mt = item >> 3, nt = item & 7, m0 = mt * 128, n0 = nt * 128;
    f32x4 acc[4][4];
    bf16_t* TMP = (bf16_t*)(WSB + O_G);
    RowLin rx{(const unsigned char*)(XB + (size_t)m0 * 1024), 2048};
    RowLin ra{(const unsigned char*)(AO + (size_t)m0 * 512), 1024};
    RowLin ro{(const unsigned char*)(HO + (size_t)m0 * 512), 1024};
    zero_acc(acc);
    gemm_main<true, false>(TIDX, BIDX, GDIM, acc, rx, W + WO_G + (size_t)n0 * 1024, 1024, 1024, smem);
    EPI_SWAP_BEGIN(m0, n0)
      const f32x4 a = acc[mi][ni];
      *(uint2*)(MG + (size_t)row * 1024 + col) = make_uint2(pack2(sigmoidf_(a[0]), sigmoidf_(a[1])), pack2(sigmoidf_(a[2]), sigmoidf_(a[3])));
    EPI_END
    zero_acc(acc);
    gemm_main<true, false>(TIDX, BIDX, GDIM, acc, rx, W + WO_G + (size_t)(1024 + n0) * 1024, 1024, 1024, smem);
    EPI_SWAP_BEGIN(m0, n0)
      const f32x4 a = acc[mi][ni];
      *(uint2*)(TMP + (size_t)row * 1024 + col) = make_uint2(pack2(sigmoidf_(a[0]), sigmoidf_(a[1])), pack2(sigmoidf_(a[2]), sigmoidf_(a[3])));
    EPI_END
    zero_acc(acc);
    gemm_main<true, false>(TIDX, BIDX, GDIM, acc, ra, W + WO_BRA + (size_t)n0 * 512, 512, 512, smem);
    EPI_SWAP_BEGIN(m0, n0)
      const f32x4 a = acc[mi][ni];
      const uint2 g = *(const uint2*)(MG + (size_t)row * 1024 + col);
      *(uint2*)(MG + (size_t)row * 1024 + col) = make_uint2(pack2(a[0] * lo2f(g.x), a[1] * hi2f(g.x)), pack2(a[2] * lo2f(g.y), a[3] * hi2f(g.y)));
    EPI_END
    zero_acc(acc);
    gemm_main<true, false>(TIDX, BIDX, GDIM, acc, ro, W + WO_BRB + (size_t)n0 * 512, 512, 512, smem);
    EPI_SWAP_BEGIN(m0, n0)
      const f32x4 a = acc[mi][ni];
      const uint2 g = *(const uint2*)(TMP + (size_t)row * 1024 + col), m = *(const uint2*)(MG + (size_t)row * 1024 + col);
      const float o0 = lo2f(m.x) + a[0] * lo2f(g.x), o1 = hi2f(m.x) + a[1] * hi2f(g.x), o2 = lo2f(m.y) + a[2] * lo2f(g.y), o3 = hi2f(m.y) + a[3] * hi2f(g.y);
      *(uint2*)(MG + (size_t)row * 1024 + col) = make_uint2(pack2(o0, o1), pack2(o2, o3));
    EPI_END
  }
}

DEVI void phase_p6(const int TIDX, const int BIDX, const int GDIM, KAP KA, unsigned char* WSB, float* OUTB, int l, unsigned char* smem) {
  const bf16_t* MG = (const bf16_t*)(WSB + O_MG);
  const bf16_t* W = (const bf16_t*)(WSB + O_WS) + (size_t)l * WO_END + WO_OUT;
  float* PRE = (float*)(WSB + O_PRE);
  for (int item = BIDX; item < 516 * 8; item += GDIM) {
    const int mt = item >> 3, nt = item & 7, m0 = mt * 128, n0 = nt * 128;
    f32x4 acc[4][4];
    zero_acc(acc);
    RowLin rp{(const unsigned char*)(MG + (size_t)m0 * 1024), 2048};
    gemm_main<true, false>(TIDX, BIDX, GDIM, acc, rp, W + (size_t)n0 * 1024, 1024, 1024, smem);
    EPI_SWAP_BEGIN(m0, n0)
      const f32x4 x = *(const f32x4*)(OUTB + (size_t)row * 1024 + col);
      *(f32x4*)(PRE + (size_t)row * 1024 + col) = x * DN_ALPHA + acc[mi][ni];
    EPI_END
  }
}

DEVI void phase_p7(const int TIDX, const int BIDX, const int GDIM, KAP KA, unsigned char* WSB, float* OUTB, int l, unsigned char* smem) {
  const int tid = TIDX, lane = tid & 63;
  {
    const float* PRE = (const float*)(WSB + O_PRE);
    bf16_t* XB = (bf16_t*)(WSB + O_XB);
    const float* WR = (const float*)(WSB + O_WR) + (size_t)l * 36 * 1024;
    int* cnt = (int*)(WSB + O_CNT) + l * 32;
    int* ltok = (int*)(WSB + O_LTOK);
    float* lw = (float*)(WSB + O_LW);
    const float* g1 = PIN(I_LN1G) + l * 1024; const float* b1 = PIN(I_LN1B) + l * 1024;
    const int wid = BIDX * 4 + (tid >> 6), nw = GDIM * 4;
    for (int r4 = wid; r4 < NTOK / 4; r4 += nw) {
      float4 v[4][4];
#pragma unroll
      for (int t = 0; t < 4; ++t) {
        const size_t row = (size_t)r4 * 4 + t;
#pragma unroll
        for (int j = 0; j < 4; ++j) v[t][j] = *(const float4*)(PRE + row * 1024 + j * 256 + lane * 4);
        ln_inplace(v[t], g1, b1, lane);
        store_row(v[t], OUTB + row * 1024, XB + row * 1024, lane);
      }
      float mine[4] = {0.f, 0.f, 0.f, 0.f};
      for (int c = 0; c < 36; ++c) {
        float4 wv[4];
#pragma unroll
        for (int j = 0; j < 4; ++j) wv[j] = *(const float4*)(WR + c * 1024 + j * 256 + lane * 4);
#pragma unroll
        for (int t = 0; t < 4; ++t) {
          float s = 0.f;
#pragma unroll
          for (int j = 0; j < 4; ++j) s += v[t][j].x * wv[j].x + v[t][j].y * wv[j].y + v[t][j].z * wv[j].z + v[t][j].w * wv[j].w;
          s = wave_sum(s);
          if (lane == c) mine[t] = s;
        }
      }
#pragma unroll
      for (int t = 0; t < 4; ++t) {
        const int tok = r4 * 4 + t;
        float gl[4];
#pragma unroll
        for (int j = 0; j < 4; ++j) gl[j] = __shfl(mine[t], j);
        int gi = 0; float gm = gl[0];
#pragma unroll
        for (int j = 1; j < 4; ++j) if (gl[j] > gm) { gm = gl[j]; gi = j; }
        float gs = 0.f;
#pragma unroll
        for (int j = 0; j < 4; ++j) gs += expf(gl[j] - gm);
        const float gtop = 1.f / gs;
        float el[8];
#pragma unroll
        for (int j = 0; j < 8; ++j) el[j] = __shfl(mine[t], 4 + gi * 8 + j);
        float em = el[0];
#pragma unroll
        for (int j = 1; j < 8; ++j) em = fmaxf(em, el[j]);
        float pe[8], es = 0.f;
#pragma unroll
        for (int j = 0; j < 8; ++j) { pe[j] = expf(el[j] - em); es += pe[j]; }
#pragma unroll
        for (int j = 0; j < 8; ++j) pe[j] = pe[j] / es;
        int i1 = 0; float p1 = pe[0];
#pragma unroll
        for (int j = 1; j < 8; ++j) if (pe[j] > p1) { p1 = pe[j]; i1 = j; }
        int i2 = -1; float p2 = -1.f;
#pragma unroll
        for (int j = 0; j < 8; ++j) if (j != i1 && pe[j] > p2) { p2 = pe[j]; i2 = j; }
        const float den = p1 + p2;
        if (lane == 0) {
          const int e1 = gi * 8 + i1, e2 = gi * 8 + i2;
          const int s1 = atomicAdd(cnt + e1, 1);
          ltok[(size_t)e1 * NTOK + s1] = tok * 2;
          lw[(size_t)e1 * NTOK + s1] = gtop * (p1 / den);
          const int s2 = atomicAdd(cnt + e2, 1);
          ltok[(size_t)e2 * NTOK + s2] = tok * 2 + 1;
          lw[(size_t)e2 * NTOK + s2] = gtop * (p2 / den);
        }
      }
    }
  }
  {
    bf16_t* PLEB = (bf16_t*)(WSB + O_YM);
    const float* pp = PIN(I_PP) + (size_t)l * TP * 256;
    const float* ps = PIN(I_PS) + (size_t)l * TS * 256;
    for (size_t i = (size_t)BIDX * 256 + tid; i < (size_t)NTOK * 64; i += (size_t)GDIM * 256) {
      const size_t e = i * 4;
      const float4 v = e < (size_t)TP * 256 ? *(const float4*)(pp + e) : *(const float4*)(ps + (e - (size_t)TP * 256));
      *(uint2*)(PLEB + e) = make_uint2(pack2(v.x, v.y), pack2(v.z, v.w));
    }
  }
  {
    float* tile = (float*)smem;
    bf16_t* WE = (bf16_t*)(WSB + O_WE);
    CMap cm{0};
    for (int t = BIDX; t < 96 * 128; t += GDIM) {
      const int mat = t >> 7, tt = t & 127, kind = mat >> 5, e = mat & 31;
      const float* src = PIN(kind == 0 ? I_WE1 : (kind == 1 ? I_WE3 : I_WE2)) + ((size_t)l * 32 + e) * 524288;
      bf16_t* dst = WE + ((size_t)kind * 32 + e) * 524288;
      if (kind < 2) transpose_tile(TIDX, BIDX, GDIM, src, 512, 1024, dst, (tt & 15) * 64, (tt >> 4) * 64, cm, nullptr, tile);
      else transpose_tile(TIDX, BIDX, GDIM, src, 1024, 512, dst, (tt & 7) * 64, (tt >> 3) * 64, cm, nullptr, tile);
    }
  }
}

DEVI int moe_table(const int TIDX, const int BIDX, const int GDIM, KAP KA, unsigned char* WSB, float* OUTB, int l, int* tstart  ) {
  if (TIDX == 0) {
    const int* cnt = (const int*)(WSB + O_CNT) + l * 32;
    int acc = 0;
    for (int e = 0; e < 32; ++e) { tstart[e] = acc; acc += (cnt[e] + 127) >> 7; }
    tstart[32] = acc;
  }
  __syncthreads();
  return tstart[32];
}
DEVI int moe_find(const int* tstart, int mt) {
  int e = 0;
  for (int i = 1; i < 32; ++i) if (mt >= tstart[i]) e = i;
  return e;
}
struct RowGather {
  const unsigned char* base; const int* ltok; int pos0; int cnt;
  DEVI uint32_t operator()(int r) const {
    const int pos = pos0 + r;
    return pos < cnt ? (uint32_t)(ltok[pos] >> 1) * 2048u : (uint32_t)NTOK * 2048u;
  }
};

DEVI void phase_p8(const int TIDX, const int BIDX, const int GDIM, KAP KA, unsigned char* WSB, float* OUTB, int l, unsigned char* smem) {
  int* tstart = (int*)(smem + SMEM_GEMM + 1024 + 64);
  const int NT = moe_table(TIDX, BIDX, GDIM, KA, WSB, OUTB, l, tstart);
  const bf16_t* XB = (const bf16_t*)(WSB + O_XB);
  const bf16_t* WE = (const bf16_t*)(WSB + O_WE);
  bf16_t* H = (bf16_t*)(WSB + O_H);
  const int* cnt = (const int*)(WSB + O_CNT) + l * 32;
  const int* ltok = (const int*)(WSB + O_LTOK);
  for (int item = BIDX; item < NT * 4; item += GDIM) {
    const int mt = item >> 2, nt = item & 3, e = moe_find(tstart, mt), lt = mt - tstart[e];
    RowGather rg{(const unsigned char*)XB, ltok + (size_t)e * NTOK, lt * 128, cnt[e]};
    f32x4 acc[4][4];
    uint2 sg[4][4];
    zero_acc(acc);
    gemm_main<true, false>(TIDX, BIDX, GDIM, acc, rg, WE + ((size_t)e * 512 + nt * 128) * 1024, 1024, 1024, smem);
#pragma unroll
    for (int i = 0; i < 4; ++i)
#pragma unroll
      for (int j = 0; j < 4; ++j) sg[i][j] = make_uint2(pack2(siluf_(acc[i][j][0]), siluf_(acc[i][j][1])), pack2(siluf_(acc[i][j][2]), siluf_(acc[i][j][3])));
    zero_acc(acc);
    gemm_main<true, false>(TIDX, BIDX, GDIM, acc, rg, WE + ((size_t)(32 + e) * 512 + nt * 128) * 1024, 1024, 1024, smem);
    EPI_SWAP_BEGIN(mt * 128, nt * 128)
      const f32x4 a = acc[mi][ni];
      const uint2 g = sg[mi][ni];
      *(uint2*)(H + (size_t)row * 512 + col) = make_uint2(pack2(a[0] * lo2f(g.x), a[1] * hi2f(g.x)), pack2(a[2] * lo2f(g.y), a[3] * hi2f(g.y)));
    EPI_END
  }
  {
    const bf16_t* W = (const bf16_t*)(WSB + O_WS) + (size_t)l * WO_END;
    float* PRE = (float*)(WSB + O_PRE);
    for (int item = BIDX; item < 516 * 8; item += GDIM) {
      const int mt = item >> 3, nt = item & 7, m0 = mt * 128, n0 = nt * 128;
      f32x4 acc[4][4];
      uint2 gp[4][4];
      zero_acc(acc);
      RowLin rx{(const unsigned char*)(XB + (size_t)m0 * 1024), 2048};
      gemm_main<true, false>(TIDX, BIDX, GDIM, acc, rx, W + WO_PG + (size_t)n0 * 1024, 1024, 1024, smem);
#pragma unroll
      for (int i = 0; i < 4; ++i)
#pragma unroll
        for (int j = 0; j < 4; ++j) gp[i][j] = make_uint2(pack2(sigmoidf_(acc[i][j][0]), sigmoidf_(acc[i][j][1])), pack2(sigmoidf_(acc[i][j][2]), sigmoidf_(acc[i][j][3])));
      zero_acc(acc);
      RowLin rpl{(const unsigned char*)((const bf16_t*)(WSB + O_YM) + (size_t)m0 * 256), 512};
      gemm_main<true, false>(TIDX, BIDX, GDIM, acc, rpl, W + WO_PLE + (size_t)n0 * 256, 256, 256, smem);
      EPI_SWAP_BEGIN(m0, n0)
        const f32x4 x = *(const f32x4*)(OUTB + (size_t)row * 1024 + col);
        const f32x4 a = acc[mi][ni];
        const uint2 g = gp[mi][ni];
        f32x4 o;
        o[0] = x[0] * DN_ALPHA + a[0] * lo2f(g.x); o[1] = x[1] * DN_ALPHA + a[1] * hi2f(g.x);
        o[2] = x[2] * DN_ALPHA + a[2] * lo2f(g.y); o[3] = x[3] * DN_ALPHA + a[3] * hi2f(g.y);
        *(f32x4*)(PRE + (size_t)row * 1024 + col) = o;
      EPI_END
    }
  }
}

DEVI void phase_p9(const int TIDX, const int BIDX, const int GDIM, KAP KA, unsigned char* WSB, float* OUTB, int l, unsigned char* smem) {
  int* tstart = (int*)(smem + SMEM_GEMM + 1024 + 64);
  const int NT = moe_table(TIDX, BIDX, GDIM, KA, WSB, OUTB, l, tstart);
  const bf16_t* WE = (const bf16_t*)(WSB + O_WE) + 64ull * 524288;
  const bf16_t* H = (const bf16_t*)(WSB + O_H);
  bf16_t* YM = (bf16_t*)(WSB + O_YM);
  const int* cnt = (const int*)(WSB + O_CNT) + l * 32;
  const int* ltok = (const int*)(WSB + O_LTOK);
  const float* lw = (const float*)(WSB + O_LW);
  for (int item = BIDX; item < NT * 8; item += GDIM) {
    const int mt = item >> 3, nt = item & 7, e = moe_find(tstart, mt), lt = mt - tstart[e], ce = cnt[e];
    f32x4 acc[4][4];
    zero_acc(acc);
    RowLin rp{(const unsigned char*)(H + (size_t)mt * 128 * 512), 1024};
    gemm_main<true, false>(TIDX, BIDX, GDIM, acc, rp, WE + ((size_t)e * 1024 + nt * 128) * 512, 512, 512, smem);
    EPI_SWAP_BEGIN(0, nt * 128)
      const int pos = lt * 128 + row;
      if (pos < ce) {
        const int tk = ltok[(size_t)e * NTOK + pos];
        const float wt = lw[(size_t)e * NTOK + pos];
        const f32x4 a = acc[mi][ni] * wt;
        *(uint2*)(YM + (size_t)tk * 1024 + col) = make_uint2(pack2(a[0], a[1]), pack2(a[2], a[3]));
      }
    EPI_END
  }
}

DEVI void phase_p10(const int TIDX, const int BIDX, const int GDIM, KAP KA, unsigned char* WSB, float* OUTB, int l) {
  const int tid = TIDX, lane = tid & 63;
  const float* PRE = (const float*)(WSB + O_PRE);
  const bf16_t* YM = (const bf16_t*)(WSB + O_YM);
  bf16_t* XB = (bf16_t*)(WSB + O_XB);
  const float* g2 = PIN(I_LN2G) + l * 1024; const float* b2 = PIN(I_LN2B) + l * 1024;
  const int wid = BIDX * 4 + (tid >> 6), nw = GDIM * 4;
  for (int row = wid; row < NTOK; row += nw) {
    float4 v[4];
#pragma unroll
    for (int j = 0; j < 4; ++j) {
      v[j] = *(const float4*)(PRE + (size_t)row * 1024 + j * 256 + lane * 4);
      const uint2 y0 = *(const uint2*)(YM + (size_t)row * 2048 + j * 256 + lane * 4);
      const uint2 y1 = *(const uint2*)(YM + (size_t)row * 2048 + 1024 + j * 256 + lane * 4);
      v[j].x += lo2f(y0.x) + lo2f(y1.x); v[j].y += hi2f(y0.x) + hi2f(y1.x);
      v[j].z += lo2f(y0.y) + lo2f(y1.y); v[j].w += hi2f(y0.y) + hi2f(y1.y);
    }
    ln_inplace(v, g2, b2, lane);
    store_row(v, OUTB + (size_t)row * 1024, XB + (size_t)row * 1024, lane);
  }
}

DEVI void* launder_ptr(const void* q) {
  uint32_t lo = (uint32_t)(uintptr_t)q, hi = (uint32_t)((uintptr_t)q >> 32);
  asm volatile("" : "+v"(lo), "+v"(hi));
  lo = __builtin_amdgcn_readfirstlane(lo);
  hi = __builtin_amdgcn_readfirstlane(hi);
  return (void*)(((uintptr_t)hi << 32) | lo);
}
__global__ void __launch_bounds__(256, 2) mega(Params p, int ph0, int ph1) {
  __shared__ __attribute__((aligned(16))) unsigned char smem[SMEM_TOTAL];
  const int wave_in_block = __builtin_amdgcn_readfirstlane((int)(__builtin_amdgcn_workitem_id_x() >> 6));
  for (int ph = ph0; ph < ph1; ++ph) {
    int wv_ = wave_in_block;
    asm volatile("" : "+s"(wv_));
    int TIDX = wv_ * 64 + (int)__lane_id();
    asm volatile("" : "+v"(TIDX));
    int BIDX = __builtin_amdgcn_workgroup_id_x(), GDIM = (int)gridDim.x;
    asm volatile("" : "+s"(BIDX), "+s"(GDIM));
    KAP KA;
    {
      uintptr_t q = (uintptr_t)__builtin_amdgcn_kernarg_segment_ptr();
      uint32_t lo = (uint32_t)q, hi = (uint32_t)(q >> 32);
      asm volatile("" : "+s"(lo), "+s"(hi));
      KA = (KAP)(((uintptr_t)hi << 32) | lo);
    }
    float* OUTB = (float*)PIN(31);
    unsigned char* WSB = (unsigned char*)PIN(32);
#ifndef PHSEL
#define PHSEL -1
#endif
    if (ph == 0) { if (PHSEL < 0 || PHSEL == 10) phase_prep(TIDX, BIDX, GDIM, KA, WSB, OUTB, smem); }
    else {
      const int l = (ph - 1) / 10, s = (ph - 1) % 10;
      switch (s) {
        case 0: if (PHSEL < 0 || PHSEL == 0) phase_p1(TIDX, BIDX, GDIM, KA, WSB, OUTB, l, smem); break;
        case 1: if (PHSEL < 0 || PHSEL == 1) phase_p2(TIDX, BIDX, GDIM, KA, WSB, OUTB, l, smem); break;
        case 2: if (PHSEL < 0 || PHSEL == 2) phase_p3(TIDX, BIDX, GDIM, KA, WSB, OUTB, l, smem); break;
        case 3: if (PHSEL < 0 || PHSEL == 3) phase_p4(TIDX, BIDX, GDIM, KA, WSB, OUTB, l, smem); break;
        case 4: if (PHSEL < 0 || PHSEL == 4) phase_p5(TIDX, BIDX, GDIM, KA, WSB, OUTB, l, smem); break;
        case 5: if (PHSEL < 0 || PHSEL == 5) phase_p6(TIDX, BIDX, GDIM, KA, WSB, OUTB, l, smem); break;
        case 6: if (PHSEL < 0 || PHSEL == 6) phase_p7(TIDX, BIDX, GDIM, KA, WSB, OUTB, l, smem); break;
        case 7: if (PHSEL < 0 || PHSEL == 7) phase_p8(TIDX, BIDX, GDIM, KA, WSB, OUTB, l, smem); break;
        case 8: if (PHSEL < 0 || PHSEL == 8) phase_p9(TIDX, BIDX, GDIM, KA, WSB, OUTB, l, smem); break;
        default: if (PHSEL < 0 || PHSEL == 9) phase_p10(TIDX, BIDX, GDIM, KA, WSB, OUTB, l); break;
      }
    }
    if (ph + 1 < ph1) cg::this_grid().sync();
  }
}

#ifndef MK_MULTI
#define MK_MULTI 0
#endif

extern "C" void kernel_launch(void* const* d_in, const int* in_sizes, int n_in, void* d_out, int out_size, void* d_ws, size_t ws_size,
                              hipStream_t stream) {
  static int grid_blocks = 0;
  if (!grid_blocks) {
    int dev = 0, cus = 0, per_cu = 0;
    hipGetDevice(&dev);
    hipDeviceGetAttribute(&cus, hipDeviceAttributeMultiprocessorCount, dev);
    hipOccupancyMaxActiveBlocksPerMultiprocessor(&per_cu, mega, 256, 0);
    if (per_cu > 2) per_cu = 2;
    if (per_cu < 1) per_cu = 1;
    grid_blocks = cus * per_cu;
  }
  Params p{};
  for (int i = 0; i < 31; ++i) p.in[i] = (const float*)d_in[i];
  p.out_ = (float*)d_out;
  p.ws_ = (unsigned char*)d_ws;
  if (ws_size < WS_END) fprintf(stderr, "workspace too small: %zu < %zu\n", ws_size, (size_t)WS_END);
#if MK_MULTI
  for (int ph = 0; ph < 21; ++ph) mega<<<dim3(grid_blocks), dim3(256), 0, stream>>>(p, ph, ph + 1);
#else
  int ph0 = 0, ph1 = 21;
  void* args[] = {&p, &ph0, &ph1};
  hipError_t e = hipLaunchCooperativeKernel((void*)mega, dim3(grid_blocks), dim3(256), args, 0, stream);
  if (e != hipSuccess) fprintf(stderr, "cooperative launch failed: %s (grid %d)\n", hipGetErrorString(e), grid_blocks);
#endif
}
```

```cpp
#include <hip/hip_runtime.h>
#include <hip/hip_cooperative_groups.h>
#include <stdint.h>
#include <stdio.h>
namespace cg = cooperative_groups;

#define DEVI __device__ __forceinline__
typedef unsigned short bf16_t;
typedef short bf16x8 __attribute__((ext_vector_type(8)));
typedef float f32x4 __attribute__((ext_vector_type(4)));
typedef float f32x16 __attribute__((ext_vector_type(16)));

constexpr int NTOK = 66048, TP = 65536, TS = 512;
constexpr int NCH = NTOK / 32;
constexpr int KPAD = 4160;
constexpr float DN_ALPHA = 1.4142135623730951f;
constexpr float EPS = 1e-6f;
constexpr float QSCALE = 0.10206207261596575f * 1.4426950408889634f;

constexpr size_t OUT_Y = 0;
constexpr size_t OUT_CKV_P = 67633152ull;
constexpr size_t OUT_KR_P = 101187584ull;
constexpr size_t OUT_ST_P = 105381888ull;
constexpr size_t OUT_CKV_S = 109576192ull;
constexpr size_t OUT_KR_S = 109838336ull;
constexpr size_t OUT_ST_S = 109871104ull;

constexpr size_t WO_IN = 0, WO_G = WO_IN + 2816ull * 1024, WO_UQ = WO_G + 2048ull * 1024, WO_KV = WO_UQ + 768ull * 384,
                 WO_BRA = WO_KV + 1024ull * 256, WO_BRB = WO_BRA + 1024ull * 512, WO_OUT = WO_BRB + 1024ull * 512,
                 WO_PG = WO_OUT + 1024ull * 1024, WO_PLE = WO_PG + 1024ull * 1024, WO_END = WO_PLE + 1024ull * 256;
static_assert(WO_END == 8945664ull, "small weights");

constexpr size_t al(size_t x) { return (x + 255) & ~size_t(255); }
constexpr size_t SZ_XB = (size_t)(NTOK + 1) * 1024 * 2, SZ_LIST = 32ull * NTOK * 4, SZ_KRS = 2ull * 16 * KPAD * 32 * 2,
                 SZ_G = (size_t)NTOK * 512 * 2, SZ_CQ = (size_t)NTOK * 384 * 2, SZ_CKR = (size_t)NTOK * 288 * 4,
                 SZ_FQ = (size_t)NTOK * 1024 * 2, SZ_CKVN = (size_t)NTOK * 256 * 2, SZ_KRB = (size_t)NTOK * 32 * 2,
                 SZ_QB = (size_t)NTOK * 768 * 2, SZ_AM = (size_t)NCH * 4 * 32 * 32 * 2, SZ_EB = (size_t)NCH * 4 * 128 * 4,
                 SZ_VT = 32ull * 8 * 64 * 2048 * 2, SZ_KNS = 16ull * KPAD * 512 * 2, SZ_VTS = 16ull * 8 * 64 * KPAD * 2,
                 SZ_PRE = (size_t)NTOK * 1024 * 4, SZ_WE = 3ull * 32 * 512 * 1024 * 2, SZ_H = 1064ull * 128 * 512 * 2,
                 SZ_YM = (size_t)NTOK * 2 * 1024 * 2;
constexpr size_t O_WS = 0;
constexpr size_t O_WR = O_WS + al(2 * WO_END * 2);
constexpr size_t O_ROPE = O_WR + al(2ull * 36 * 1024 * 4);
constexpr size_t O_CNT = O_ROPE + al(2080ull * 16 * 2 * 4);
constexpr size_t O_XB = O_CNT + 4096;
constexpr size_t O_LTOK = O_XB + al(SZ_XB);
constexpr size_t O_LW = O_LTOK + al(SZ_LIST);
constexpr size_t O_KRS = O_LW + al(SZ_LIST);
constexpr size_t O_G = O_KRS + al(SZ_KRS);
constexpr size_t O_VT2 = O_G + al(SZ_G);
constexpr size_t O_CQ = O_VT2 + al(SZ_G);
constexpr size_t O_CKR = O_CQ + al(SZ_CQ);
constexpr size_t O_FQ = O_CKR + al(SZ_CKR);
constexpr size_t O_CKVN = O_FQ + al(SZ_FQ);
constexpr size_t O_KRB = O_CKVN + al(SZ_CKVN);
constexpr size_t O_QB = O_KRB + al(SZ_KRB);
constexpr size_t O_QT = O_QB + al(SZ_QB);
constexpr size_t O_KHT = O_QT + al(SZ_G);
constexpr size_t O_AM = O_KHT + al(SZ_G);
constexpr size_t O_EB = O_AM + al(SZ_AM);
constexpr size_t O_KN = O_EB + al(SZ_EB);
constexpr size_t O_HO = O_KN + al(SZ_G);
constexpr size_t O_CCB = O_HO + al(SZ_G);
constexpr size_t WS_END = O_CCB + 16ull * 4096 * 256 * 2;
constexpr size_t O_VT = O_CQ;
constexpr size_t O_KNS = O_VT + al(SZ_VT);
constexpr size_t O_VTS = O_KNS + al(SZ_KNS);
constexpr size_t O_AO = O_VTS + al(SZ_VTS);
constexpr size_t O_MG = O_QB;
constexpr size_t O_PRE = O_G;
constexpr size_t O_WE = O_VTS;
constexpr size_t O_H = O_WE + al(SZ_WE);
constexpr size_t O_YM = O_H + al(SZ_H);
static_assert(O_AO + SZ_G <= O_KRB, "AO");
static_assert(O_AO >= O_VTS + SZ_VTS, "AO2");
static_assert(O_MG + SZ_XB <= O_KN, "MG");
static_assert(O_PRE + SZ_PRE <= O_WE, "PRE");
static_assert(O_YM + SZ_YM <= WS_END, "YM");
static_assert(WS_END <= (1ull << 30), "workspace");

struct Params { const float* in[31]; float* out_; unsigned char* ws_; };
typedef const __attribute__((address_space(4))) unsigned char* KAP;
#define PIN(i) (*(const float* const __attribute__((address_space(4)))*)(KA + 8 * (i)))

enum { I_XP = 0, I_XS, I_PP, I_PS, I_CCKV, I_CKR, I_ST, I_LN0G, I_LN0B, I_WIN, I_QN, I_WUQ, I_KVN, I_WUK, I_WUV, I_HGLB, I_HGN,
       I_WBRA, I_WBRB, I_WOUT, I_LN1G, I_LN1B, I_WRG, I_WRE, I_WE1, I_WE3, I_WE2, I_WPLE, I_WPG, I_LN2G, I_LN2B };

DEVI float bf2f(bf16_t h) { return __uint_as_float(((uint32_t)h) << 16); }
DEVI bf16_t f2bf(float f) { uint32_t u = __float_as_uint(f); u += 0x7fffu + ((u >> 16) & 1u); return (bf16_t)(u >> 16); }
typedef float f32x2_t __attribute__((ext_vector_type(2)));
typedef __bf16 bf16x2_t __attribute__((ext_vector_type(2)));
DEVI uint32_t pack2(float lo, float hi) { f32x2_t v = {lo, hi}; bf16x2_t b = __builtin_convertvector(v, bf16x2_t); return __builtin_bit_cast(uint32_t, b); }
DEVI float lo2f(uint32_t u) { return __uint_as_float(u << 16); }
DEVI float hi2f(uint32_t u) { return __uint_as_float(u & 0xffff0000u); }
DEVI float wave_sum(float v) {
#pragma unroll
  for (int o = 32; o; o >>= 1) v += __shfl_xor(v, o);
  return v;
}
DEVI float sigmoidf_(float x) { return 1.f / (1.f + __expf(-x)); }
DEVI float siluf_(float x) { return x / (1.f + __expf(-x)); }
DEVI f32x4 mfma16(bf16x8 a, bf16x8 b, f32x4 c) { return __builtin_amdgcn_mfma_f32_16x16x32_bf16(a, b, c, 0, 0, 0); }
DEVI f32x16 mfma32(bf16x8 a, bf16x8 b, f32x16 c) { return __builtin_amdgcn_mfma_f32_32x32x16_bf16(a, b, c, 0, 0, 0); }
DEVI bf16x8 mk8(uint32_t a, uint32_t b, uint32_t c, uint32_t d) { uint4 u = make_uint4(a, b, c, d); return *(bf16x8*)&u; }
DEVI bf16x8 mk8(uint2 lo, uint2 hi) { uint4 u = make_uint4(lo.x, lo.y, hi.x, hi.y); return *(bf16x8*)&u; }

constexpr int SMEM_GEMM = 2 * 2 * 128 * 72 * 2;
constexpr int SMEM_TOTAL = SMEM_GEMM + 2048;

template <bool SWAP, class RP>
DEVI void gemm_main(const int TIDX, const int BIDX, const int GDIM, f32x4 (&acc)[4][4], RP rowoff, const bf16_t* __restrict__ Bt, int ldb, int K, unsigned char* smem) {
  const int tid = TIDX;
  const int lane = tid & 63, w = tid >> 6, wr = w >> 1, wc = w & 1, li = lane & 15, lg = lane >> 4;
  const unsigned char* abase = rowoff.base;
  const unsigned char* bbase = (const unsigned char*)Bt;
  const uint32_t schunk = (uint32_t)((lane & 7) ^ (((lane >> 4) + 4 * (w & 1)) & 7)) * 16u;
  uint32_t ao0, ao1, ao2, ao3;
  const int rsub = w * 8 + (lane >> 3);
  ao0 = rowoff(rsub) + schunk; ao1 = rowoff(rsub + 32) + schunk; ao2 = rowoff(rsub + 64) + schunk; ao3 = rowoff(rsub + 96) + schunk;
  const uint32_t bo = (uint32_t)(rsub * ldb) * 2u + schunk, bstep = (uint32_t)(32 * ldb) * 2u;
  unsigned char* sbase = smem + w * 1024;
#define GM_STAGE(kt_, buf_)                                                                                                       \
  {                                                                                                                              \
    unsigned char* da_ = sbase + (buf_) * 32768;                                                                                 \
    unsigned char* db_ = da_ + 16384;                                                                                            \
    const uint32_t ko_ = (uint32_t)(kt_) * 128u;                                                                                 \
    __builtin_amdgcn_global_load_lds((const unsigned*)(abase + ao0 + ko_), (unsigned*)(da_), 16, 0, 0);                         \
    __builtin_amdgcn_global_load_lds((const unsigned*)(abase + ao1 + ko_), (unsigned*)(da_ + 4096), 16, 0, 0);                  \
    __builtin_amdgcn_global_load_lds((const unsigned*)(abase + ao2 + ko_), (unsigned*)(da_ + 8192), 16, 0, 0);                  \
    __builtin_amdgcn_global_load_lds((const unsigned*)(abase + ao3 + ko_), (unsigned*)(da_ + 12288), 16, 0, 0);                 \
    __builtin_amdgcn_global_load_lds((const unsigned*)(bbase + bo + ko_), (unsigned*)(db_), 16, 0, 0);                          \
    __builtin_amdgcn_global_load_lds((const unsigned*)(bbase + bo + bstep + ko_), (unsigned*)(db_ + 4096), 16, 0, 0);           \
    __builtin_amdgcn_global_load_lds((const unsigned*)(bbase + bo + 2u * bstep + ko_), (unsigned*)(db_ + 8192), 16, 0, 0);      \
    __builtin_amdgcn_global_load_lds((const unsigned*)(bbase + bo + 3u * bstep + ko_), (unsigned*)(db_ + 12288), 16, 0, 0);     \
  }
  const int nk = K >> 6;
  const int px = lg ^ (li >> 1);
  GM_STAGE(0, 0);
  for (int kt = 0; kt < nk; ++kt) {
    const int buf = kt & 1;
    asm volatile("s_waitcnt vmcnt(0)" ::: "memory");
    __syncthreads();
    if (kt + 1 < nk) GM_STAGE(kt + 1, buf ^ 1);
    const unsigned char* A = smem + buf * 32768 + (wr * 64 + li) * 128;
    const unsigned char* B = smem + buf * 32768 + 16384 + (wc * 64 + li) * 128;
#pragma unroll
    for (int ks = 0; ks < 2; ++ks) {
      const int po = (px ^ (ks * 4)) * 16;
      bf16x8 af[4], bfr[4];
#pragma unroll
      for (int i = 0; i < 4; ++i) {
        af[i] = *(const bf16x8*)(A + i * 2048 + po);
        bfr[i] = *(const bf16x8*)(B + i * 2048 + po);
      }
#pragma unroll
      for (int mi = 0; mi < 4; ++mi)
#pragma unroll
        for (int ni = 0; ni < 4; ++ni)
          acc[mi][ni] = SWAP ? mfma16(bfr[ni], af[mi], acc[mi][ni]) : mfma16(af[mi], bfr[ni], acc[mi][ni]);
    }
  }
  __syncthreads();
}
DEVI float zero_f() { float z = 0.f; asm volatile("" : "+v"(z)); return z; }
DEVI void zero_acc(f32x4 (&acc)[4][4]) {
  const float z = zero_f();
#pragma unroll
  for (int i = 0; i < 4; ++i)
#pragma unroll
    for (int j = 0; j < 4; ++j) acc[i][j] = (f32x4){z, z, z, z};
}
#define EPI_SWAP_BEGIN(m0, n0)                                                                     \
  {                                                                                                \
    const int _lane = TIDX & 63, _w = TIDX >> 6;                                     \
    const int _rb = (m0) + (_w >> 1) * 64 + (_lane & 15), _cb = (n0) + (_w & 1) * 64 + 4 * (_lane >> 4); \
    _Pragma("unroll") for (int mi = 0; mi < 4; ++mi) {                                             \
      const int row = _rb + mi * 16;                                                               \
      _Pragma("unroll") for (int ni = 0; ni < 4; ++ni) {                                           \
        const int col = _cb + ni * 16;
#define EPI_END } __builtin_amdgcn_sched_barrier(0); } }

struct RowLin {
  const unsigned char* base; uint32_t stride;
  DEVI uint32_t operator()(int r) const { return (uint32_t)r * stride; }
};

struct CMap {
  int mode;
  DEVI int operator()(int n) const {
    if (mode == 0) return n;
    if (mode == 1) return n < 672 ? n : (n < 768 ? -1 : n - 96);
    if (mode == 2) return n + 2720;
    if (n < 512) return (n >> 6) * 96 + (n & 63);
    const int m = n - 512, h = m >> 5, w = m & 31;
    return h * 96 + (w < 16 ? 64 + w : 80 + (w - 16));
  }
};
DEVI void transpose_tile(const int TIDX, const int BIDX, const int GDIM, const float* __restrict__ src, int ld, int K, bf16_t* __restrict__ dst, int k0, int n0, CMap cm,
                         const float* kscale, float* tile) {
  const int t = TIDX;
  {
    const int n4 = (t & 15) * 4, kr = t >> 4;
    const int sc = cm(n0 + n4);
#pragma unroll
    for (int p = 0; p < 4; ++p) {
      const int k = kr + 16 * p;
      float4 v = make_float4(0.f, 0.f, 0.f, 0.f);
      if (sc >= 0) {
        v = *(const float4*)(src + (size_t)(k0 + k) * ld + sc);
        if (kscale) { const float sck = kscale[k0 + k]; v.x *= sck; v.y *= sck; v.z *= sck; v.w *= sck; }
      }
      float* d = tile + k * 65 + n4;
      d[0] = v.x; d[1] = v.y; d[2] = v.z; d[3] = v.w;
    }
  }
  __syncthreads();
  {
    const int kc = (t & 7) * 8, nr = t >> 3;
#pragma unroll
    for (int q = 0; q < 2; ++q) {
      const int n = nr + 32 * q;
      const float* sp = tile + kc * 65 + n;
      const uint4 o = make_uint4(pack2(sp[0], sp[65]), pack2(sp[130], sp[195]), pack2(sp[260], sp[325]), pack2(sp[390], sp[455]));
      *(uint4*)(dst + (size_t)(n0 + n) * K + k0 + kc) = o;
    }
  }
  __syncthreads();
}
DEVI void run_transpose(const int TIDX, const int BIDX, const int GDIM, const float* src, int ld, int K, int N, bf16_t* dst, int mode, const float* kscale, float* tile) {
  const int nkt = K >> 6, tiles = nkt * (N >> 6);
  CMap cm{mode};
  for (int t = BIDX; t < tiles; t += GDIM) transpose_tile(TIDX, BIDX, GDIM, src, ld, K, dst, (t % nkt) * 64, (t / nkt) * 64, cm, kscale, tile);
}

DEVI void ln_inplace(float4 (&v)[4], const float* __restrict__ g, const float* __restrict__ b, int lane) {
  float s = 0.f;
#pragma unroll
  for (int j = 0; j < 4; ++j) s += v[j].x + v[j].y + v[j].z + v[j].w;
  s = wave_sum(s);
  const float mu = s * (1.f / 1024.f);
  float q = 0.f;
#pragma unroll
  for (int j = 0; j < 4; ++j) {
    float a = v[j].x - mu, bq = v[j].y - mu, cq = v[j].z - mu, d = v[j].w - mu;
    q += a * a + bq * bq + cq * cq + d * d;
  }
  q = wave_sum(q);
  const float rs = rsqrtf(q * (1.f / 1024.f) + EPS);
#pragma unroll
  for (int j = 0; j < 4; ++j) {
    const float4 gg = *(const float4*)(g + j * 256 + lane * 4), bb = *(const float4*)(b + j * 256 + lane * 4);
    v[j].x = (v[j].x - mu) * rs * gg.x + bb.x;
    v[j].y = (v[j].y - mu) * rs * gg.y + bb.y;
    v[j].z = (v[j].z - mu) * rs * gg.z + bb.z;
    v[j].w = (v[j].w - mu) * rs * gg.w + bb.w;
  }
}
DEVI void store_row(const float4 (&v)[4], float* x32, bf16_t* x16, int lane) {
#pragma unroll
  for (int j = 0; j < 4; ++j) {
    *(float4*)(x32 + j * 256 + lane * 4) = v[j];
    *(uint2*)(x16 + j * 256 + lane * 4) = make_uint2(pack2(v[j].x, v[j].y), pack2(v[j].z, v[j].w));
  }
}
DEVI int pos_index(int row) { return row < TP ? (row & 2047) : 2048 + ((row - TP) & 31); }

DEVI void phase_prep(const int TIDX, const int BIDX, const int GDIM, KAP KA, unsigned char* WSB, float* OUTB, unsigned char* smem) {
  float* tile = (float*)smem;
  bf16_t* WS = (bf16_t*)(WSB + O_WS);
  const int tid = TIDX, gtid = BIDX * 256 + tid, gsz = GDIM * 256;
  if (gtid < 512) ((int*)(WSB + O_CNT))[gtid] = 0;
  if (gtid < 512) ((uint32_t*)(WSB + O_XB + (size_t)NTOK * 2048))[gtid] = 0u;
  for (int i = gtid; i < 2080 * 16; i += gsz) {
    const int pi = i >> 4, k = i & 15;
    const int pos = pi < 2048 ? pi : 4096 + (pi - 2048);
    const float inv = exp2f(-(float)k * (13.287712379549449f / 16.f));
    const float ang = (float)pos * inv;
    double rev = (double)ang * 0.15915494309189535;
    rev -= __builtin_rint(rev);
    const float fr = (float)rev;
    float2 cs = make_float2(__builtin_amdgcn_cosf(fr), __builtin_amdgcn_sinf(fr));
    ((float2*)(WSB + O_ROPE))[i] = cs;
  }
  for (int i = gtid; i < 2 * 36 * 1024; i += gsz) {
    const int l = i / (36 * 1024), r = i % (36 * 1024), c = r >> 10, k = r & 1023;
    float v = c < 4 ? PIN(I_WRG)[((size_t)l * 1024 + k) * 4 + c] : PIN(I_WRE)[((size_t)l * 1024 + k) * 32 + (c - 4)];
    ((float*)(WSB + O_WR))[i] = v;
  }
  for (int i = gtid; i < 2 * 16 * 4096 * 8; i += gsz) {
    const int e = i * 4, lb = e / (4096 * 32), r = e % (4096 * 32);
    const float4 v = *(const float4*)(PIN(I_CKR) + (size_t)e);
    *(uint2*)((bf16_t*)(WSB + O_KRS) + (size_t)lb * KPAD * 32 + r) = make_uint2(pack2(v.x, v.y), pack2(v.z, v.w));
  }
  {
    const int lane = tid & 63, wid = BIDX * 4 + (tid >> 6), nw = GDIM * 4;
    for (int row = wid; row < NTOK; row += nw) {
      const float* src = row < TP ? PIN(I_XP) + (size_t)row * 1024 : PIN(I_XS) + (size_t)(row - TP) * 1024;
      float4 v[4];
#pragma unroll
      for (int j = 0; j < 4; ++j) v[j] = *(const float4*)(src + j * 256 + lane * 4);
      ln_inplace(v, PIN(I_LN0G), PIN(I_LN0B), lane);
      store_row(v, OUTB + (size_t)row * 1024, (bf16_t*)(WSB + O_XB) + (size_t)row * 1024, lane);
    }
  }
  for (int l = 0; l < 2; ++l) {
    bf16_t* W = WS + (size_t)l * WO_END;
    run_transpose(TIDX, BIDX, GDIM, PIN(I_WIN) + (size_t)l * 1024 * 4768, 4768, 1024, 2816, W + WO_IN, 1, nullptr, tile);
    run_transpose(TIDX, BIDX, GDIM, PIN(I_WIN) + (size_t)l * 1024 * 4768, 4768, 1024, 2048, W + WO_G, 2, nullptr, tile);
    run_transpose(TIDX, BIDX, GDIM, PIN(I_WUQ) + (size_t)l * 384 * 768, 768, 384, 768, W + WO_UQ, 3, PIN(I_QN) + l * 384, tile);
    run_transpose(TIDX, BIDX, GDIM, PIN(I_WUK) + (size_t)l * 256 * 512, 512, 256, 512, W + WO_KV, 0, nullptr, tile);
    run_transpose(TIDX, BIDX, GDIM, PIN(I_WUV) + (size_t)l * 256 * 512, 512, 256, 512, W + WO_KV + 512 * 256, 0, nullptr, tile);
    run_transpose(TIDX, BIDX, GDIM, PIN(I_WBRA) + (size_t)l * 512 * 1024, 1024, 512, 1024, W + WO_BRA, 0, nullptr, tile);
    run_transpose(TIDX, BIDX, GDIM, PIN(I_WBRB) + (size_t)l * 512 * 1024, 1024, 512, 1024, W + WO_BRB, 0, nullptr, tile);
    run_transpose(TIDX, BIDX, GDIM, PIN(I_WOUT) + (size_t)l * 1024 * 1024, 1024, 1024, 1024, W + WO_OUT, 0, nullptr, tile);
    run_transpose(TIDX, BIDX, GDIM, PIN(I_WPG) + (size_t)l * 1024 * 1024, 1024, 1024, 1024, W + WO_PG, 0, nullptr, tile);
    run_transpose(TIDX, BIDX, GDIM, PIN(I_WPLE) + (size_t)l * 256 * 1024, 1024, 256, 1024, W + WO_PLE, 0, nullptr, tile);
  }
}

DEVI void phase_p1(const int TIDX, const int BIDX, const int GDIM, KAP KA, unsigned char* WSB, float* OUTB, int l, unsigned char* smem) {
  const bf16_t* XB = (const bf16_t*)(WSB + O_XB);
  const bf16_t* W = (const bf16_t*)(WSB + O_WS) + (size_t)l * WO_END + WO_IN;
  bf16_t* CQ = (bf16_t*)(WSB + O_CQ);
  float* CKR = (float*)(WSB + O_CKR);
  bf16_t* FQ = (bf16_t*)(WSB + O_FQ);
  bf16_t* VT2 = (bf16_t*)(WSB + O_VT2);
  bf16_t* G = (bf16_t*)(WSB + O_G);
  for (int item = BIDX; item < 516 * 22; item += GDIM) {
    const int mt = item / 22, nt = item % 22, m0 = mt * 128;
    f32x4 acc[4][4];
    zero_acc(acc);
    RowLin rp{(const unsigned char*)(XB + (size_t)m0 * 1024), 2048};
    if (nt >= 14 && nt < 18) {
      gemm_main<false>(TIDX, BIDX, GDIM, acc, rp, W + (size_t)nt * 128 * 1024, 1024, 1024, smem);
      const int h = nt - 14, lane = TIDX & 63, w = TIDX >> 6;
      const int rb = m0 + (w >> 1) * 64 + 4 * (lane >> 4), cb = (w & 1) * 64 + (lane & 15);
#pragma unroll
      for (int mi = 0; mi < 4; ++mi) {
        const int row = rb + mi * 16, ch = row >> 5, s = row & 31;
#pragma unroll
        for (int ni = 0; ni < 4; ++ni) {
          const int dv = cb + ni * 16;
          const f32x4 a = acc[mi][ni];
          *(uint2*)(VT2 + ((size_t)(ch * 4 + h) * 128 + dv) * 32 + s) = make_uint2(pack2(a[0], a[1]), pack2(a[2], a[3]));
        }
      }
    } else {
      gemm_main<true>(TIDX, BIDX, GDIM, acc, rp, W + (size_t)nt * 128 * 1024, 1024, 1024, smem);
      EPI_SWAP_BEGIN(m0, 0)
        const f32x4 a = acc[mi][ni];
        if (nt < 3) {
          *(uint2*)(CQ + (size_t)row * 384 + nt * 128 + col) = make_uint2(pack2(a[0], a[1]), pack2(a[2], a[3]));
        } else if (nt < 5) {
          *(f32x4*)(CKR + (size_t)row * 288 + (nt - 3) * 128 + col) = a;
        } else if (nt == 5) {
          if (col < 32) *(f32x4*)(CKR + (size_t)row * 288 + 256 + col) = a;
        } else if (nt < 14) {
          *(uint2*)(FQ + (size_t)row * 1024 + (nt - 6) * 128 + col) = make_uint2(pack2(a[0], a[1]), pack2(a[2], a[3]));
        } else {
          *(uint2*)(G + (size_t)row * 512 + (nt - 18) * 128 + col) = make_uint2(pack2(a[0], a[1]), pack2(a[2], a[3]));
        }
      EPI_END
    }
  }
}

DEVI void phase_p2(const int TIDX, const int BIDX, const int GDIM, KAP KA, unsigned char* WSB, float* OUTB, int l, unsigned char* smem) {
  const int tid = TIDX, lane = tid & 63;
  const float2* ROPE = (const float2*)(WSB + O_ROPE);
  {
    const bf16_t* CQ = (const bf16_t*)(WSB + O_CQ);
    const bf16_t* W = (const bf16_t*)(WSB + O_WS) + (size_t)l * WO_END + WO_UQ;
    bf16_t* QB = (bf16_t*)(WSB + O_QB);
    float* srow = (float*)(smem + SMEM_GEMM);
    for (int item = BIDX; item < 516 * 6; item += GDIM) {
      const int mt = item / 6, nt = item % 6, m0 = mt * 128;
      {
        const int r = tid >> 1, hf = tid & 1;
        const uint4* s = (const uint4*)(CQ + (size_t)(m0 + r) * 384 + hf * 192);
        float ss = 0.f;
#pragma unroll 4
        for (int j = 0; j < 24; ++j) {
          const uint4 u = s[j];
          float a;
          a = lo2f(u.x); ss += a * a; a = hi2f(u.x); ss += a * a;
          a = lo2f(u.y); ss += a * a; a = hi2f(u.y); ss += a * a;
          a = lo2f(u.z); ss += a * a; a = hi2f(u.z); ss += a * a;
          a = lo2f(u.w); ss += a * a; a = hi2f(u.w); ss += a * a;
        }
        ss += __shfl_xor(ss, 1);
        if (hf == 0) srow[r] = rsqrtf(ss * (1.f / 384.f) + EPS) * QSCALE;
      }
      f32x4 acc[4][4];
      zero_acc(acc);
      RowLin rp{(const unsigned char*)(CQ + (size_t)m0 * 384), 768};
      gemm_main<true>(TIDX, BIDX, GDIM, acc, rp, W + (size_t)nt * 128 * 384, 384, 384, smem);
      if (nt < 4) {
        EPI_SWAP_BEGIN(m0, nt * 128)
          const float sc = srow[row - m0];
          const f32x4 a = acc[mi][ni] * sc;
          const int hh = col >> 6, d = col & 63;
          *(uint2*)(QB + (size_t)row * 768 + hh * 96 + d) = make_uint2(pack2(a[0], a[1]), pack2(a[2], a[3]));
        EPI_END
      } else {
        const int w = tid >> 6;
        const int rb = m0 + (w >> 1) * 64 + (lane & 15), i0 = 4 * (lane >> 4);
#pragma unroll
        for (int mi = 0; mi < 4; ++mi) {
          const int row = rb + mi * 16;
          const float sc = srow[row - m0];
          const float2* rt = ROPE + (size_t)pos_index(row) * 16 + i0;
#pragma unroll
          for (int pr = 0; pr < 2; ++pr) {
            const int hh = (nt - 4) * 4 + (w & 1) * 2 + pr;
            const f32x4 x1 = acc[mi][2 * pr] * sc, x2 = acc[mi][2 * pr + 1] * sc;
            float o1[4], o2[4];
#pragma unroll
            for (int r = 0; r < 4; ++r) {
              const float2 cs = rt[r];
              o1[r] = x1[r] * cs.x - x2[r] * cs.y;
              o2[r] = x2[r] * cs.x + x1[r] * cs.y;
            }
            *(uint2*)(QB + (size_t)row * 768 + hh * 96 + 64 + i0) = make_uint2(pack2(o1[0], o1[1]), pack2(o1[2], o1[3]));
            *(uint2*)(QB + (size_t)row * 768 + hh * 96 + 80 + i0) = make_uint2(pack2(o2[0], o2[1]), pack2(o2[2], o2[3]));
          }
        }
      }
      __syncthreads();
    }
  }
  {
    const bf16_t* FQ = (const bf16_t*)(WSB + O_FQ);
    bf16_t* QT = (bf16_t*)(WSB + O_QT);
    bf16_t* KHT = (bf16_t*)(WSB + O_KHT);
    bf16_t* AM = (bf16_t*)(WSB + O_AM);
    float* EBp = (float*)(WSB + O_EB);
    bf16_t* sQ = (bf16_t*)smem;
    bf16_t* sK = sQ + 32 * 136;
    for (int item = BIDX; item < NCH * 4; item += GDIM) {
      const int ch = item >> 2, h = item & 3, cid = item;
      {
        const int k = tid & 127, half = tid >> 7, colh = h * 128 + k;
        float* sB = (float*)(smem + 2 * 32 * 136 * 2);
        float lb = 0.f;
        if (l == 1) { const float a0 = PIN(I_HGLB)[colh], a1 = PIN(I_HGLB)[512 + colh]; lb = 1.f / (1.f + expf(a0 - a1)); }
        const float oml = 1.f - lb;
        float bt[16], kk[16], qv[16];
        float bl = 0.f;
#pragma unroll
        for (int j = 0; j < 16; ++j) {
          const size_t row = (size_t)ch * 32 + half * 16 + j;
          const float z = bf2f(FQ[row * 1024 + colh]);
          qv[j] = bf2f(FQ[row * 1024 + 512 + colh]);
          const float e = __expf(-z);
          const float inv = __builtin_amdgcn_rcpf(1.f + e);
          const float f = lb + oml * inv;
          kk[j] = oml * e * inv;
          bl += __logf(f);
          bt[j] = bl;
        }
        sB[half * 128 + k] = bl;
        __syncthreads();
        const float b0 = sB[k], b1 = sB[128 + k];
        const float off = half ? b0 : 0.f, bend = b0 + b1;
        uint32_t pk[8];
#pragma unroll
        for (int j = 0; j < 16; ++j) {
          const int t = half * 16 + j;
          const float b = bt[j] + off;
          const float qs = qv[j] * __builtin_amdgcn_rcpf(1.f + __expf(-qv[j]));
          const bf16_t qt = f2bf(qs * __expf(b));
          QT[((size_t)cid * 32 + t) * 128 + k] = qt;
          sQ[t * 136 + k] = qt;
          sK[t * 136 + k] = f2bf(kk[j] * __expf(fminf(-b, 80.f)));
          bt[j] = kk[j] * __expf(bend - b);
        }
#pragma unroll
        for (int j = 0; j < 8; ++j) pk[j] = pack2(bt[2 * j], bt[2 * j + 1]);
        if (half == 0) EBp[(size_t)cid * 128 + k] = __expf(bend);
        uint4* dst = (uint4*)(KHT + ((size_t)cid * 128 + k) * 32 + half * 16);
        dst[0] = make_uint4(pk[0], pk[1], pk[2], pk[3]);
        dst[1] = make_uint4(pk[4], pk[5], pk[6], pk[7]);
      }
      __syncthreads();
      if (tid < 64) {
        const int c = lane & 31, hh = lane >> 5;
        f32x16 am;
        const float zf = zero_f();
#pragma unroll
        for (int r = 0; r < 16; ++r) am[r] = zf;
#pragma unroll
        for (int st = 0; st < 8; ++st) {
          const bf16x8 a = *(const bf16x8*)(sQ + c * 136 + st * 16 + hh * 8);
          const bf16x8 bb = *(const bf16x8*)(sK + c * 136 + st * 16 + hh * 8);
          am = mfma32(a, bb, am);
        }
#pragma unroll
        for (int r = 0; r < 16; ++r) {
          const int t = (r & 3) + 8 * (r >> 2) + 4 * hh;
          AM[((size_t)cid * 32 + t) * 32 + c] = f2bf(c <= t ? am[r] : 0.f);
        }
      }
      __syncthreads();
    }
  }
  {
    const float* src = PIN(I_CCKV) + (size_t)l * 16 * 4096 * 256;
    bf16_t* CCB = (bf16_t*)(WSB + O_CCB);
    for (size_t i = (size_t)BIDX * 256 + tid; i < 16ull * 4096 * 64; i += (size_t)GDIM * 256) {
      const float4 v = *(const float4*)(src + i * 4);
      *(uint2*)(CCB + i * 4) = make_uint2(pack2(v.x, v.y), pack2(v.z, v.w));
    }
  }
  {
    const float* CKR = (const float*)(WSB + O_CKR);
    bf16_t* CKVN = (bf16_t*)(WSB + O_CKVN);
    bf16_t* KRB = (bf16_t*)(WSB + O_KRB);
    bf16_t* KRS = (bf16_t*)(WSB + O_KRS) + (size_t)l * 16 * KPAD * 32;
    const float* kvn = PIN(I_KVN) + l * 256;
    const int wid = BIDX * 4 + (tid >> 6), nw = GDIM * 4;
    for (int row = wid; row < NTOK; row += nw) {
      const float* src = CKR + (size_t)row * 288;
      const float4 v = *(const float4*)(src + lane * 4);
      float ss = wave_sum(v.x * v.x + v.y * v.y + v.z * v.z + v.w * v.w);
      const float rs = rsqrtf(ss * (1.f / 256.f) + EPS);
      const float4 g = *(const float4*)(kvn + lane * 4);
      const float4 o = make_float4(v.x * rs * g.x, v.y * rs * g.y, v.z * rs * g.z, v.w * rs * g.w);
      float* oc = row < TP ? OUTB + OUT_CKV_P + ((size_t)l * TP + row) * 256 : OUTB + OUT_CKV_S + ((size_t)l * TS + (row - TP)) * 256;
      *(float4*)(oc + lane * 4) = o;
      *(uint2*)(CKVN + (size_t)row * 256 + lane * 4) = make_uint2(pack2(o.x, o.y), pack2(o.z, o.w));
      if (lane < 16) {
        const float x1 = src[256 + lane], x2 = src[272 + lane];
        const float2 cs = ROPE[(size_t)pos_index(row) * 16 + lane];
        const float o1 = x1 * cs.x - x2 * cs.y, o2 = x2 * cs.x + x1 * cs.y;
        float* ok = row < TP ? OUTB + OUT_KR_P + ((size_t)l * TP + row) * 32 : OUTB + OUT_KR_S + ((size_t)l * TS + (row - TP)) * 32;
        ok[lane] = o1;
        ok[16 + lane] = o2;
        bf16_t* kb = row < TP ? KRB + (size_t)row * 32 : KRS + ((size_t)((row - TP) >> 5) * KPAD + 4096 + ((row - TP) & 31)) * 32;
        kb[lane] = f2bf(o1);
        kb[16 + lane] = f2bf(o2);
      }
    }
  }
}

DEVI void phase_p3(const int TIDX, const int BIDX, const int GDIM, KAP KA, unsigned char* WSB, float* OUTB, int l, unsigned char* smem) {
  const bf16_t* W = (const bf16_t*)(WSB + O_WS) + (size_t)l * WO_END + WO_KV;
  const bf16_t* CKVN = (const bf16_t*)(WSB + O_CKVN);
  bf16_t* KN = (bf16_t*)(WSB + O_KN);
  bf16_t* VT = (bf16_t*)(WSB + O_VT);
  bf16_t* KNS = (bf16_t*)(WSB + O_KNS);
  bf16_t* VTS = (bf16_t*)(WSB + O_VTS);
  const bf16_t* cache = (const bf16_t*)(WSB + O_CCB);
  for (int i = BIDX * 256 + TIDX; i < 16 * 8 * 64 * 4; i += GDIM * 256) {
    const uint32_t z = __float_as_uint(zero_f());
    *(uint4*)(VTS + (size_t)(i >> 2) * KPAD + 4128 + (i & 3) * 8) = make_uint4(z, z, z, z);
  }
  for (int item = BIDX; item < (516 + 512) * 8; item += GDIM) {
    const int mt = item >> 3, nt = item & 7;
    const bool is_cache = mt >= 516;
    const int m0 = is_cache ? (mt - 516) * 128 : mt * 128;
    f32x4 acc[4][4];
    zero_acc(acc);
    bf16_t* kdst; bf16_t* vdst; size_t ldv; int key0;
    if (is_cache) { const int b = m0 >> 12; key0 = m0 & 4095; kdst = KNS + ((size_t)b * KPAD + key0) * 512; vdst = VTS + (size_t)b * 8 * 64 * KPAD; ldv = KPAD; }
    else if (m0 >= TP) { kdst = nullptr; vdst = nullptr; ldv = KPAD; key0 = 0; }
    else { const int b = m0 >> 11; key0 = m0 & 2047; kdst = KN + (size_t)m0 * 512; vdst = VT + (size_t)b * 8 * 64 * 2048; ldv = 2048; }
    if (nt < 4) {
      if (is_cache) { RowLin rp{(const unsigned char*)(cache + (size_t)m0 * 256), 512}; gemm_main<true>(TIDX, BIDX, GDIM, acc, rp, W + (size_t)nt * 128 * 256, 256, 256, smem); }
      else { RowLin rp{(const unsigned char*)(CKVN + (size_t)m0 * 256), 512}; gemm_main<true>(TIDX, BIDX, GDIM, acc, rp, W + (size_t)nt * 128 * 256, 256, 256, smem); }
      EPI_SWAP_BEGIN(0, nt * 128)
        const f32x4 a = acc[mi][ni];
        bf16_t* d;
        if (kdst) d = kdst + (size_t)row * 512 + col;
        else { const int sr = m0 - TP + row; d = KNS + ((size_t)(sr >> 5) * KPAD + 4096 + (sr & 31)) * 512 + col; }
        *(uint2*)d = make_uint2(pack2(a[0], a[1]), pack2(a[2], a[3]));
      EPI_END
    } else {
      if (is_cache) { RowLin rp{(const unsigned char*)(cache + (size_t)m0 * 256), 512}; gemm_main<false>(TIDX, BIDX, GDIM, acc, rp, W + (size_t)nt * 128 * 256, 256, 256, smem); }
      else { RowLin rp{(const unsigned char*)(CKVN + (size_t)m0 * 256), 512}; gemm_main<false>(TIDX, BIDX, GDIM, acc, rp, W + (size_t)nt * 128 * 256, 256, 256, smem); }
      const int lane = TIDX & 63, w = TIDX >> 6;
      const int rb = (w >> 1) * 64 + 4 * (lane >> 4), cb = (nt - 4) * 128 + (w & 1) * 64 + (lane & 15);
#pragma unroll
      for (int mi = 0; mi < 4; ++mi) {
        const int row = rb + mi * 16;
#pragma unroll
        for (int ni = 0; ni < 4; ++ni) {
          const int hv = cb + ni * 16;
          const f32x4 a = acc[mi][ni];
          bf16_t* d;
          if (vdst) d = vdst + (size_t)hv * ldv + key0 + row;
          else { const int sr = m0 - TP + row; d = VTS + ((size_t)(sr >> 5) * 512 + hv) * KPAD + 4096 + (sr & 31); }
          *(uint2*)d = make_uint2(pack2(a[0], a[1]), pack2(a[2], a[3]));
        }
      }
    }
  }
}

DEVI void attn_item(const int TIDX, const int BIDX, const int GDIM, const bf16_t* __restrict__ Q, int qrow0, int nq, int ng, const bf16_t* __restrict__ Kn, const bf16_t* __restrict__ Kr,
                    const bf16_t* __restrict__ VT, size_t ldv, int nkeys, bf16_t* __restrict__ O, unsigned char* smem) {
  const int tid = TIDX, lane = tid & 63, w = tid >> 6, li = lane & 15, lg = lane >> 4;
  const int ql = 16 * w + li;
  bf16x8 qf[2][3];
  f32x4 oT[2][4];
  float mrun[2], lrun[2];
  const float zf = zero_f();
#pragma unroll
  for (int g = 0; g < 2; ++g) {
    const int qr = qrow0 + (g == 0 ? (ql < nq ? ql : nq - 1) : 64 + ql);
    const int qrc = (g == 1 && ng < 2) ? qrow0 : qr;
#pragma unroll
    for (int ds = 0; ds < 3; ++ds) qf[g][ds] = *(const bf16x8*)(Q + (size_t)qrc * 768 + ds * 32 + lg * 8);
#pragma unroll
    for (int i = 0; i < 4; ++i) oT[g][i] = (f32x4){zf, zf, zf, zf};
    mrun[g] = -INFINITY; lrun[g] = 0.f;
  }
  const int nt = (nkeys + 63) >> 6;
  const int r8 = lane >> 3;
  const uint32_t sch = (uint32_t)((lane & 7) ^ (((lane >> 4) + 4 * (w & 1)) & 7)) * 16u;
  const unsigned char* kn0 = (const unsigned char*)Kn + (size_t)(w * 8 + r8) * 1024 + sch;
  const unsigned char* kr0 = (const unsigned char*)Kr + (size_t)(w * 16 + (lane >> 2)) * 64 + (uint32_t)((lane & 3) ^ (((lane >> 5) & 1) << 1)) * 16u;
  const unsigned char* v0 = (const unsigned char*)VT + (size_t)(w * 8 + r8) * ldv * 2 + sch;
  const size_t v32 = (size_t)32 * ldv * 2;
  unsigned char* sw = smem + w * 1024;
#define ATT_STAGE(kt_)                                                                                                  \
  {                                                                                                                     \
    unsigned char* st_ = sw + ((kt_) % 3) * 20480;                                                                      \
    const size_t kb_ = (size_t)(kt_) * 64;                                                                              \
    __builtin_amdgcn_global_load_lds((const unsigned*)(kn0 + kb_ * 1024), (unsigned*)(st_), 16, 0, 0);                  \
    __builtin_amdgcn_global_load_lds((const unsigned*)(kn0 + kb_ * 1024 + 32768), (unsigned*)(st_ + 4096), 16, 0, 0);   \
    __builtin_amdgcn_global_load_lds((const unsigned*)(kr0 + kb_ * 64), (unsigned*)(st_ + 8192), 16, 0, 0);             \
    __builtin_amdgcn_global_load_lds((const unsigned*)(v0 + kb_ * 2), (unsigned*)(st_ + 12288), 16, 0, 0);              \
    __builtin_amdgcn_global_load_lds((const unsigned*)(v0 + v32 + kb_ * 2), (unsigned*)(st_ + 12288 + 4096), 16, 0, 0); \
  }
  ATT_STAGE(0);
  if (nt > 1) ATT_STAGE(1);
  const int pk0 = (lg ^ (li >> 1)) * 16;
  const int pkr = (lg ^ (((li >> 3) & 1) << 1)) * 16;
  const int pv0 = ((lg >> 1) ^ (li >> 1)) * 16 + (lg & 1) * 8;
  for (int kt = 0; kt < nt; ++kt) {
    if (kt + 1 < nt) asm volatile("s_waitcnt vmcnt(5)" ::: "memory");
    else asm volatile("s_waitcnt vmcnt(0)" ::: "memory");
    __builtin_amdgcn_s_barrier();
    asm volatile("" ::: "memory");
    if (kt + 2 < nt) ATT_STAGE(kt + 2);
    const unsigned char* st = smem + (kt % 3) * 20480;
    const bool tail = (kt == nt - 1) && (nkeys & 63);
    const bool two = (ng == 2);
    const bool g0on = !(two && kt == nt - 1);
    f32x4 sT[2][4];
#pragma unroll
    for (int kb = 0; kb < 4; ++kb) {
      const unsigned char* kr_ = st + (kb * 16 + li) * 128;
      const bf16x8 k0 = *(const bf16x8*)(kr_ + pk0), k1 = *(const bf16x8*)(kr_ + (pk0 ^ 64)), k2 = *(const bf16x8*)(st + 8192 + (kb * 16 + li) * 64 + pkr);
      sT[0][kb] = (f32x4){zf, zf, zf, zf};
      sT[1][kb] = (f32x4){zf, zf, zf, zf};
      if (g0on) {
        sT[0][kb] = mfma16(k0, qf[0][0], sT[0][kb]);
        sT[0][kb] = mfma16(k1, qf[0][1], sT[0][kb]);
        sT[0][kb] = mfma16(k2, qf[0][2], sT[0][kb]);
      }
      if (two) {
        sT[1][kb] = mfma16(k0, qf[1][0], sT[1][kb]);
        sT[1][kb] = mfma16(k1, qf[1][1], sT[1][kb]);
        sT[1][kb] = mfma16(k2, qf[1][2], sT[1][kb]);
      }
    }
    bf16x8 pf[2][2];
#pragma unroll
    for (int g = 0; g < 2; ++g) {
      if (g == 0 ? g0on : two) {
        if (tail) {
#pragma unroll
          for (int kb = 0; kb < 4; ++kb)
#pragma unroll
            for (int r = 0; r < 4; ++r)
              if (kt * 64 + kb * 16 + 4 * lg + r >= nkeys) sT[g][kb][r] = -INFINITY;
        }
        float mx = sT[g][0][0];
#pragma unroll
        for (int kb = 0; kb < 4; ++kb)
#pragma unroll
          for (int r = 0; r < 4; ++r) mx = fmaxf(mx, sT[g][kb][r]);
        mx = fmaxf(mx, __shfl_xor(mx, 16));
        mx = fmaxf(mx, __shfl_xor(mx, 32));
        const float mnew = fmaxf(mrun[g], mx);
        const float alpha = __builtin_amdgcn_exp2f(mrun[g] - mnew);
        mrun[g] = mnew;
        float ps = 0.f;
#pragma unroll
        for (int kb = 0; kb < 4; ++kb)
#pragma unroll
          for (int r = 0; r < 4; ++r) { const float pv = __builtin_amdgcn_exp2f(sT[g][kb][r] - mnew); sT[g][kb][r] = pv; ps += pv; }
        lrun[g] = lrun[g] * alpha + ps;
#pragma unroll
        for (int vb = 0; vb < 4; ++vb) oT[g][vb] *= alpha;
      }
#pragma unroll
      for (int s2 = 0; s2 < 2; ++s2)
        pf[g][s2] = mk8(pack2(sT[g][2 * s2][0], sT[g][2 * s2][1]), pack2(sT[g][2 * s2][2], sT[g][2 * s2][3]),
                        pack2(sT[g][2 * s2 + 1][0], sT[g][2 * s2 + 1][1]), pack2(sT[g][2 * s2 + 1][2], sT[g][2 * s2 + 1][3]));
    }
#pragma unroll
    for (int s2 = 0; s2 < 2; ++s2) {
#pragma unroll
      for (int vb = 0; vb < 4; ++vb) {
        const unsigned char* vr_ = st + 12288 + (vb * 16 + li) * 128;
        const uint2 lo = *(const uint2*)(vr_ + (pv0 ^ (s2 * 64)));
        const uint2 hi = *(const uint2*)(vr_ + (pv0 ^ (s2 * 64) ^ 32));
        const bf16x8 vfr = mk8(lo, hi);
        if (g0on) oT[0][vb] = mfma16(vfr, pf[0][s2], oT[0][vb]);
        if (two) oT[1][vb] = mfma16(vfr, pf[1][s2], oT[1][vb]);
      }
    }
  }
#pragma unroll
  for (int g = 0; g < 2; ++g) {
    float lr = lrun[g];
    lr += __shfl_xor(lr, 16);
    lr += __shfl_xor(lr, 32);
    const float inv = 1.f / lr;
    const bool st_ok = g == 0 ? (ql < nq) : (ng == 2);
    if (st_ok) {
#pragma unroll
      for (int vb = 0; vb < 4; ++vb) {
        const f32x4 o = oT[g][vb] * inv;
        *(uint2*)(O + (size_t)(qrow0 + g * 64 + ql) * 512 + vb * 16 + 4 * lg) = make_uint2(pack2(o[0], o[1]), pack2(o[2], o[3]));
      }
    }
  }
  __syncthreads();
}

DEVI void hgrn_item(const int TIDX, const int BIDX, const int GDIM, KAP KA, unsigned char* WSB, float* OUTB, int l, int g0, int nchunks, int h, const float* __restrict__ S0, float* __restrict__ Sout, int rowbase,
                    unsigned char* smem) {
  constexpr int STG = 35840;
  const unsigned char* QT = WSB + O_QT;
  const unsigned char* KHT = WSB + O_KHT;
  const unsigned char* AM = WSB + O_AM;
  const unsigned char* EBp = WSB + O_EB;
  const unsigned char* VT2 = WSB + O_VT2;
  const unsigned char* G = WSB + O_G;
  bf16_t* HO = (bf16_t*)(WSB + O_HO);
  const float* hgn = PIN(I_HGN) + l * 512 + h * 128;
  float* sred = (float*)(smem + SMEM_GEMM);
  const int tid = TIDX, lane = tid & 63, w = tid >> 6, c = lane & 31, hh = lane >> 5;
  const int dvg = 32 * w + c;
  f32x16 S[4];
#pragma unroll
  for (int kt = 0; kt < 4; ++kt)
#pragma unroll
    for (int r = 0; r < 16; ++r) S[kt][r] = S0 ? S0[(size_t)(32 * kt + (r & 3) + 8 * (r >> 2) + 4 * hh) * 128 + dvg] : 0.f;
  float4 gn[4];
#pragma unroll
  for (int q = 0; q < 4; ++q) gn[q] = *(const float4*)(hgn + 32 * w + 8 * q + 4 * hh);
  const uint32_t lo16 = (uint32_t)lane * 16u;
  const uint32_t goff = (uint32_t)(w * 4 + (lane >> 4)) * 1024u + (uint32_t)h * 256u + (uint32_t)(lane & 15) * 16u;
#define HG_STAGE(ch_)                                                                                                                  \
  {                                                                                                                                    \
    unsigned char* st_ = smem + ((ch_) & 1) * STG + w * 1024;                                                                          \
    const size_t cid_ = (size_t)(g0 + (ch_)) * 4 + h;                                                                                  \
    const size_t grow_ = ((size_t)rowbase + (size_t)(ch_) * 32) * 1024;                                                                \
    __builtin_amdgcn_global_load_lds((const unsigned*)(QT + cid_ * 8192 + w * 1024 + lo16), (unsigned*)(st_), 16, 0, 0);              \
    __builtin_amdgcn_global_load_lds((const unsigned*)(QT + cid_ * 8192 + 4096 + w * 1024 + lo16), (unsigned*)(st_ + 4096), 16, 0, 0); \
    __builtin_amdgcn_global_load_lds((const unsigned*)(KHT + cid_ * 8192 + w * 1024 + lo16), (unsigned*)(st_ + 8192), 16, 0, 0);       \
    __builtin_amdgcn_global_load_lds((const unsigned*)(KHT + cid_ * 8192 + 4096 + w * 1024 + lo16), (unsigned*)(st_ + 12288), 16, 0, 0); \
    __builtin_amdgcn_global_load_lds((const unsigned*)(VT2 + cid_ * 8192 + w * 1024 + lo16), (unsigned*)(st_ + 16384), 16, 0, 0);      \
    __builtin_amdgcn_global_load_lds((const unsigned*)(VT2 + cid_ * 8192 + 4096 + w * 1024 + lo16), (unsigned*)(st_ + 20480), 16, 0, 0); \
    __builtin_amdgcn_global_load_lds((const unsigned*)(G + grow_ + goff), (unsigned*)(st_ + 24576), 16, 0, 0);                         \
    __builtin_amdgcn_global_load_lds((const unsigned*)(G + grow_ + 16384 + goff), (unsigned*)(st_ + 28672), 16, 0, 0);                 \
    if (w < 2) __builtin_amdgcn_global_load_lds((const unsigned*)(AM + cid_ * 2048 + w * 1024 + lo16), (unsigned*)(st_ + 32768), 16, 0, 0); \
    else if (w == 2) __builtin_amdgcn_global_load_lds((const unsigned*)(EBp + cid_ * 512 + lo16), (unsigned*)(smem + ((ch_) & 1) * STG + 34816), 16, 0, 0); \
  }
  HG_STAGE(0);
  for (int ch = 0; ch < nchunks; ++ch) {
    asm volatile("s_waitcnt vmcnt(0)" ::: "memory");
    __builtin_amdgcn_s_barrier();
    asm volatile("" ::: "memory");
    if (ch + 1 < nchunks) HG_STAGE(ch + 1);
    const unsigned char* st = smem + (ch & 1) * STG;
    bf16x8 vf[2], af[2];
#pragma unroll
    for (int s2 = 0; s2 < 2; ++s2) {
      vf[s2] = *(const bf16x8*)(st + 16384 + dvg * 64 + 32 * s2 + 16 * hh);
      af[s2] = *(const bf16x8*)(st + 32768 + c * 64 + 32 * s2 + 16 * hh);
    }
    f32x16 oT;
    const float zf = zero_f();
#pragma unroll
    for (int r = 0; r < 16; ++r) oT[r] = zf;
#pragma unroll
    for (int kt = 0; kt < 4; ++kt) {
#pragma unroll
      for (int s2 = 0; s2 < 2; ++s2) {
        const uint2 lo = *(const uint2*)(st + c * 256 + 64 * kt + 32 * s2 + 8 * hh);
        const uint2 hi = *(const uint2*)(st + c * 256 + 64 * kt + 32 * s2 + 16 + 8 * hh);
        const bf16x8 sa = mk8(pack2(S[kt][8 * s2 + 0], S[kt][8 * s2 + 1]), pack2(S[kt][8 * s2 + 2], S[kt][8 * s2 + 3]),
                              pack2(S[kt][8 * s2 + 4], S[kt][8 * s2 + 5]), pack2(S[kt][8 * s2 + 6], S[kt][8 * s2 + 7]));
        oT = mfma32(sa, mk8(lo, hi), oT);
      }
    }
#pragma unroll
    for (int s2 = 0; s2 < 2; ++s2) oT = mfma32(vf[s2], af[s2], oT);
#pragma unroll
    for (int kt = 0; kt < 4; ++kt) {
#pragma unroll
      for (int q = 0; q < 4; ++q) {
        const float4 e = *(const float4*)(st + 34816 + (32 * kt + 8 * q + 4 * hh) * 4);
        S[kt][4 * q + 0] *= e.x; S[kt][4 * q + 1] *= e.y; S[kt][4 * q + 2] *= e.z; S[kt][4 * q + 3] *= e.w;
      }
#pragma unroll
      for (int s2 = 0; s2 < 2; ++s2) {
        const bf16x8 kf = *(const bf16x8*)(st + 8192 + (32 * kt + c) * 64 + 32 * s2 + 16 * hh);
        S[kt] = mfma32(kf, vf[s2], S[kt]);
      }
    }
    float ss = 0.f;
#pragma unroll
    for (int r = 0; r < 16; ++r) ss += oT[r] * oT[r];
    ss += __shfl_xor(ss, 32);
    float* sr = sred + (ch & 1) * 128;
    if (lane < 32) sr[w * 32 + c] = ss;
    asm volatile("s_waitcnt lgkmcnt(0)" ::: "memory");
    __builtin_amdgcn_s_barrier();
    asm volatile("" ::: "memory");
    const float tot = sr[c] + sr[32 + c] + sr[64 + c] + sr[96 + c];
    const float rs = rsqrtf(tot * (1.f / 128.f) + EPS);
    const size_t row = (size_t)rowbase + ch * 32 + c;
#pragma unroll
    for (int q = 0; q < 4; ++q) {
      const int dv0 = 32 * w + 8 * q + 4 * hh;
      const uint2 gp = *(const uint2*)(st + 24576 + c * 256 + dv0 * 2);
      const float o0 = oT[4 * q + 0] * rs * gn[q].x * siluf_(lo2f(gp.x));
      const float o1 = oT[4 * q + 1] * rs * gn[q].y * siluf_(hi2f(gp.x));
      const float o2 = oT[4 * q + 2] * rs * gn[q].z * siluf_(lo2f(gp.y));
      const float o3 = oT[4 * q + 3] * rs * gn[q].w * siluf_(hi2f(gp.y));
      *(uint2*)(HO + row * 512 + h * 128 + dv0) = make_uint2(pack2(o0, o1), pack2(o2, o3));
    }
  }
#pragma unroll
  for (int kt = 0; kt < 4; ++kt)
#pragma unroll
    for (int r = 0; r < 16; ++r) Sout[(size_t)(32 * kt + (r & 3) + 8 * (r >> 2) + 4 * hh) * 128 + dvg] = S[kt][r];
  __syncthreads();
}

DEVI void phase_p4(const int TIDX, const int BIDX, const int GDIM, KAP KA, unsigned char* WSB, float* OUTB, int l, unsigned char* smem, int dup = 0) {
  const int q = BIDX & 7;
  int* qctr = (int*)(WSB + O_CNT) + 128 + l * 8 + q + 16 * dup;
  int* sitem = (int*)(smem + SMEM_GEMM + 1024);
  const bf16_t* QB = (const bf16_t*)(WSB + O_QB);
  bf16_t* AO = (bf16_t*)(WSB + O_AO);
  const int total = 16 + 16 + 512 + 8;
  for (;;) {
    if (TIDX == 0) *sitem = atomicAdd(qctr, 1);
    __syncthreads();
    const int it = *sitem;
    __syncthreads();
    if (it >= total) break;
    if (it < 16) {
      const int i2 = q * 16 + it, b = i2 >> 2, h = i2 & 3;
      hgrn_item(TIDX, BIDX, GDIM, KA, WSB, OUTB, l, b * 64, 64, h, nullptr, OUTB + OUT_ST_P + ((size_t)(l * 32 + b) * 4 + h) * 16384, b * 2048, smem);
    } else if (it < 32) {
      const int b = it - 16, h = q;
      attn_item(TIDX, BIDX, GDIM, QB + h * 96, TP + b * 32, 32, 1, (const bf16_t*)(WSB + O_KNS) + (size_t)b * KPAD * 512 + h * 64,
                (const bf16_t*)(WSB + O_KRS) + ((size_t)l * 16 + b) * KPAD * 32,
                (const bf16_t*)(WSB + O_VTS) + (size_t)(b * 8 + h) * 64 * KPAD, KPAD, 4128, AO + h * 64, smem);
    } else if (it < 32 + 512) {
      const int jj = it - 32, b = jj >> 4, cp = 15 - (jj & 15), h = q;
      attn_item(TIDX, BIDX, GDIM, QB + h * 96, b * 2048 + cp * 128, 64, 2, (const bf16_t*)(WSB + O_KN) + (size_t)b * 2048 * 512 + h * 64,
                (const bf16_t*)(WSB + O_KRB) + (size_t)b * 2048 * 32,
                (const bf16_t*)(WSB + O_VT) + (size_t)(b * 8 + h) * 64 * 2048, 2048, 128 * (cp + 1), AO + h * 64, smem);
    } else {
      const int i2 = q * 8 + (it - 32 - 512), b = i2 >> 2, h = i2 & 3;
      hgrn_item(TIDX, BIDX, GDIM, KA, WSB, OUTB, l, 2048 + b, 1, h, PIN(I_ST) + ((size_t)(l * 16 + b) * 4 + h) * 16384,
                OUTB + OUT_ST_S + ((size_t)(l * 16 + b) * 4 + h) * 16384, TP + b * 32, smem);
    }
  }
}

DEVI void phase_p5(const int TIDX, const int BIDX, const int GDIM, KAP KA, unsigned char* WSB, float* OUTB, int l, unsigned char* smem) {
  const bf16_t* XB = (const bf16_t*)(WSB + O_XB);
  const bf16_t* AO = (const bf16_t*)(WSB + O_AO);
  const bf16_t* HO = (const bf16_t*)(WSB + O_HO);
  const bf16_t* W = (const bf16_t*)(WSB + O_WS) + (size_t)l * WO_END;
  bf16_t* MG = (bf16_t*)(WSB + O_MG);
  for (int item = BIDX; item < 516 * 8; item += GDIM) {
    const int mt = item >> 3, nt = item & 7, m0 = mt * 128, n0 = nt * 128;
    f32x4 acc[4][4];
    bf16_t* TMP = (bf16_t*)(WSB + O_G);
    RowLin rx{(const unsigned char*)(XB + (size_t)m0 * 1024), 2048};
    RowLin ra{(const unsigned char*)(AO + (size_t)m0 * 512), 1024};
    RowLin ro{(const unsigned char*)(HO + (size_t)m0 * 512), 1024};
    zero_acc(acc);
    gemm_main<true>(TIDX, BIDX, GDIM, acc, rx, W + WO_G + (size_t)n0 * 1024, 1024, 1024, smem);
    EPI_SWAP_BEGIN(m0, n0)
      const f32x4 a = acc[mi][ni];
      *(uint2*)(MG + (size_t)row * 1024 + col) = make_uint2(pack2(sigmoidf_(a[0]), sigmoidf_(a[1])), pack2(sigmoidf_(a[2]), sigmoidf_(a[3])));
    EPI_END
    zero_acc(acc);
    gemm_main<true>(TIDX, BIDX, GDIM, acc, rx, W + WO_G + (size_t)(1024 + n0) * 1024, 1024, 1024, smem);
    EPI_SWAP_BEGIN(m0, n0)
      const f32x4 a = acc[mi][ni];
      *(uint2*)(TMP + (size_t)row * 1024 + col) = make_uint2(pack2(sigmoidf_(a[0]), sigmoidf_(a[1])), pack2(sigmoidf_(a[2]), sigmoidf_(a[3])));
    EPI_END
    zero_acc(acc);
    gemm_main<true>(TIDX, BIDX, GDIM, acc, ra, W + WO_BRA + (size_t)n0 * 512, 512, 512, smem);
    EPI_SWAP_BEGIN(m0, n0)
      const f32x4 a = acc[mi][ni];
      const uint2 g = *(const uint2*)(MG + (size_t)row * 1024 + col);
      *(uint2*)(MG + (size_t)row * 1024 + col) = make_uint2(pack2(a[0] * lo2f(g.x), a[1] * hi2f(g.x)), pack2(a[2] * lo2f(g.y), a[3] * hi2f(g.y)));
    EPI_END
    zero_acc(acc);
    gemm_main<true>(TIDX, BIDX, GDIM, acc, ro, W + WO_BRB + (size_t)n0 * 512, 512, 512, smem);
    EPI_SWAP_BEGIN(m0, n0)
      const f32x4 a = acc[mi][ni];
      const uint2 g = *(const uint2*)(TMP + (size_t)row * 1024 + col), m = *(const uint2*)(MG + (size_t)row * 1024 + col);
      const float o0 = lo2f(m.x) + a[0] * lo2f(g.x), o1 = hi2f(m.x) + a[1] * hi2f(g.x), o2 = lo2f(m.y) + a[2] * lo2f(g.y), o3 = hi2f(m.y) + a[3] * hi2f(g.y);
      *(uint2*)(MG + (size_t)row * 1024 + col) = make_uint2(pack2(o0, o1), pack2(o2, o3));
    EPI_END
  }
}

DEVI void phase_p6(const int TIDX, const int BIDX, const int GDIM, KAP KA, unsigned char* WSB, float* OUTB, int l, unsigned char* smem) {
  const bf16_t* MG = (const bf16_t*)(WSB + O_MG);
  const bf16_t* W = (const bf16_t*)(WSB + O_WS) + (size_t)l * WO_END + WO_OUT;
  float* PRE = (float*)(WSB + O_PRE);
  for (int item = BIDX; item < 516 * 8; item += GDIM) {
    const int mt = item >> 3, nt = item & 7, m0 = mt * 128, n0 = nt * 128;
    f32x4 acc[4][4];
    zero_acc(acc);
    RowLin rp{(const unsigned char*)(MG + (size_t)m0 * 1024), 2048};
    gemm_main<true>(TIDX, BIDX, GDIM, acc, rp, W + (size_t)n0 * 1024, 1024, 1024, smem);
    EPI_SWAP_BEGIN(m0, n0)
      const f32x4 x = *(const f32x4*)(OUTB + (size_t)row * 1024 + col);
      *(f32x4*)(PRE + (size_t)row * 1024 + col) = x * DN_ALPHA + acc[mi][ni];
    EPI_END
  }
}

DEVI void phase_p7(const int TIDX, const int BIDX, const int GDIM, KAP KA, unsigned char* WSB, float* OUTB, int l, unsigned char* smem) {
  const int tid = TIDX, lane = tid & 63;
  {
    const float* PRE = (const float*)(WSB + O_PRE);
    bf16_t* XB = (bf16_t*)(WSB + O_XB);
    const float* WR = (const float*)(WSB + O_WR) + (size_t)l * 36 * 1024;
    int* cnt = (int*)(WSB + O_CNT) + l * 32;
    int* ltok = (int*)(WSB + O_LTOK);
    float* lw = (float*)(WSB + O_LW);
    const float* g1 = PIN(I_LN1G) + l * 1024; const float* b1 = PIN(I_LN1B) + l * 1024;
    const int wid = BIDX * 4 + (tid >> 6), nw = GDIM * 4;
    for (int r4 = wid; r4 < NTOK / 4; r4 += nw) {
      float4 v[4][4];
#pragma unroll
      for (int t = 0; t < 4; ++t) {
        const size_t row = (size_t)r4 * 4 + t;
#pragma unroll
        for (int j = 0; j < 4; ++j) v[t][j] = *(const float4*)(PRE + row * 1024 + j * 256 + lane * 4);
        ln_inplace(v[t], g1, b1, lane);
        store_row(v[t], OUTB + row * 1024, XB + row * 1024, lane);
      }
      float mine[4] = {0.f, 0.f, 0.f, 0.f};
      for (int c = 0; c < 36; ++c) {
        float4 wv[4];
#pragma unroll
        for (int j = 0; j < 4; ++j) wv[j] = *(const float4*)(WR + c * 1024 + j * 256 + lane * 4);
#pragma unroll
        for (int t = 0; t < 4; ++t) {
          float s = 0.f;
#pragma unroll
          for (int j = 0; j < 4; ++j) s += v[t][j].x * wv[j].x + v[t][j].y * wv[j].y + v[t][j].z * wv[j].z + v[t][j].w * wv[j].w;
          s = wave_sum(s);
          if (lane == c) mine[t] = s;
        }
      }
#pragma unroll
      for (int t = 0; t < 4; ++t) {
        const int tok = r4 * 4 + t;
        float gl[4];
#pragma unroll
        for (int j = 0; j < 4; ++j) gl[j] = __shfl(mine[t], j);
        int gi = 0; float gm = gl[0];
#pragma unroll
        for (int j = 1; j < 4; ++j) if (gl[j] > gm) { gm = gl[j]; gi = j; }
        float gs = 0.f;
#pragma unroll
        for (int j = 0; j < 4; ++j) gs += expf(gl[j] - gm);
        const float gtop = 1.f / gs;
        float el[8];
#pragma unroll
        for (int j = 0; j < 8; ++j) el[j] = __shfl(mine[t], 4 + gi * 8 + j);
        float em = el[0];
#pragma unroll
        for (int j = 1; j < 8; ++j) em = fmaxf(em, el[j]);
        float pe[8], es = 0.f;
#pragma unroll
        for (int j = 0; j < 8; ++j) { pe[j] = expf(el[j] - em); es += pe[j]; }
#pragma unroll
        for (int j = 0; j < 8; ++j) pe[j] = pe[j] / es;
        int i1 = 0; float p1 = pe[0];
#pragma unroll
        for (int j = 1; j < 8; ++j) if (pe[j] > p1) { p1 = pe[j]; i1 = j; }
        int i2 = -1; float p2 = -1.f;
#pragma unroll
        for (int j = 0; j < 8; ++j) if (j != i1 && pe[j] > p2) { p2 = pe[j]; i2 = j; }
        const float den = p1 + p2;
        if (lane == 0) {
          const int e1 = gi * 8 + i1, e2 = gi * 8 + i2;
          const int s1 = atomicAdd(cnt + e1, 1);
          ltok[(size_t)e1 * NTOK + s1] = tok * 2;
          lw[(size_t)e1 * NTOK + s1] = gtop * (p1 / den);
          const int s2 = atomicAdd(cnt + e2, 1);
          ltok[(size_t)e2 * NTOK + s2] = tok * 2 + 1;
          lw[(size_t)e2 * NTOK + s2] = gtop * (p2 / den);
        }
      }
    }
  }
  {
    bf16_t* PLEB = (bf16_t*)(WSB + O_YM);
    const float* pp = PIN(I_PP) + (size_t)l * TP * 256;
    const float* ps = PIN(I_PS) + (size_t)l * TS * 256;
    for (size_t i = (size_t)BIDX * 256 + tid; i < (size_t)NTOK * 64; i += (size_t)GDIM * 256) {
      const size_t e = i * 4;
      const float4 v = e < (size_t)TP * 256 ? *(const float4*)(pp + e) : *(const float4*)(ps + (e - (size_t)TP * 256));
      *(uint2*)(PLEB + e) = make_uint2(pack2(v.x, v.y), pack2(v.z, v.w));
    }
  }
  {
    float* tile = (float*)smem;
    bf16_t* WE = (bf16_t*)(WSB + O_WE);
    CMap cm{0};
    for (int t = BIDX; t < 96 * 128; t += GDIM) {
      const int mat = t >> 7, tt = t & 127, kind = mat >> 5, e = mat & 31;
      const float* src = PIN(kind == 0 ? I_WE1 : (kind == 1 ? I_WE3 : I_WE2)) + ((size_t)l * 32 + e) * 524288;
      bf16_t* dst = WE + ((size_t)kind * 32 + e) * 524288;
      if (kind < 2) transpose_tile(TIDX, BIDX, GDIM, src, 512, 1024, dst, (tt & 15) * 64, (tt >> 4) * 64, cm, nullptr, tile);
      else transpose_tile(TIDX, BIDX, GDIM, src, 1024, 512, dst, (tt & 7) * 64, (tt >> 3) * 64, cm, nullptr, tile);
    }
  }
}

DEVI int moe_table(const int TIDX, const int BIDX, const int GDIM, KAP KA, unsigned char* WSB, float* OUTB, int l, int* tstart  ) {
  if (TIDX == 0) {
    const int* cnt = (const int*)(WSB + O_CNT) + l * 32;
    int acc = 0;
    for (int e = 0; e < 32; ++e) { tstart[e] = acc; acc += (cnt[e] + 127) >> 7; }
    tstart[32] = acc;
  }
  __syncthreads();
  return tstart[32];
}
DEVI int moe_find(const int* tstart, int mt) {
  int e = 0;
  for (int i = 1; i < 32; ++i) if (mt >= tstart[i]) e = i;
  return e;
}
struct RowGather {
  const unsigned char* base; const int* ltok; int pos0; int cnt;
  DEVI uint32_t operator()(int r) const {
    const int pos = pos0 + r;
    return pos < cnt ? (uint32_t)(ltok[pos] >> 1) * 2048u : (uint32_t)NTOK * 2048u;
  }
};

DEVI void phase_p8(const int TIDX, const int BIDX, const int GDIM, KAP KA, unsigned char* WSB, float* OUTB, int l, unsigned char* smem) {
  int* tstart = (int*)(smem + SMEM_GEMM + 1024 + 64);
  const int NT = moe_table(TIDX, BIDX, GDIM, KA, WSB, OUTB, l, tstart);
  const bf16_t* XB = (const bf16_t*)(WSB + O_XB);
  const bf16_t* WE = (const bf16_t*)(WSB + O_WE);
  bf16_t* H = (bf16_t*)(WSB + O_H);
  const int* cnt = (const int*)(WSB + O_CNT) + l * 32;
  const int* ltok = (const int*)(WSB + O_LTOK);
  for (int item = BIDX; item < NT * 4; item += GDIM) {
    const int mt = item >> 2, nt = item & 3, e = moe_find(tstart, mt), lt = mt - tstart[e];
    RowGather rg{(const unsigned char*)XB, ltok + (size_t)e * NTOK, lt * 128, cnt[e]};
    f32x4 acc[4][4];
    uint2 sg[4][4];
    zero_acc(acc);
    gemm_main<true>(TIDX, BIDX, GDIM, acc, rg, WE + ((size_t)e * 512 + nt * 128) * 1024, 1024, 1024, smem);
#pragma unroll
    for (int i = 0; i < 4; ++i)
#pragma unroll
      for (int j = 0; j < 4; ++j) sg[i][j] = make_uint2(pack2(siluf_(acc[i][j][0]), siluf_(acc[i][j][1])), pack2(siluf_(acc[i][j][2]), siluf_(acc[i][j][3])));
    zero_acc(acc);
    gemm_main<true>(TIDX, BIDX, GDIM, acc, rg, WE + ((size_t)(32 + e) * 512 + nt * 128) * 1024, 1024, 1024, smem);
    EPI_SWAP_BEGIN(mt * 128, nt * 128)
      const f32x4 a = acc[mi][ni];
      const uint2 g = sg[mi][ni];
      *(uint2*)(H + (size_t)row * 512 + col) = make_uint2(pack2(a[0] * lo2f(g.x), a[1] * hi2f(g.x)), pack2(a[2] * lo2f(g.y), a[3] * hi2f(g.y)));
    EPI_END
  }
  {
    const bf16_t* W = (const bf16_t*)(WSB + O_WS) + (size_t)l * WO_END;
    float* PRE = (float*)(WSB + O_PRE);
    for (int item = BIDX; item < 516 * 8; item += GDIM) {
      const int mt = item >> 3, nt = item & 7, m0 = mt * 128, n0 = nt * 128;
      f32x4 acc[4][4];
      uint2 gp[4][4];
      zero_acc(acc);
      RowLin rx{(const unsigned char*)(XB + (size_t)m0 * 1024), 2048};
      gemm_main<true>(TIDX, BIDX, GDIM, acc, rx, W + WO_PG + (size_t)n0 * 1024, 1024, 1024, smem);
#pragma unroll
      for (int i = 0; i < 4; ++i)
#pragma unroll
        for (int j = 0; j < 4; ++j) gp[i][j] = make_uint2(pack2(sigmoidf_(acc[i][j][0]), sigmoidf_(acc[i][j][1])), pack2(sigmoidf_(acc[i][j][2]), sigmoidf_(acc[i][j][3])));
      zero_acc(acc);
      RowLin rpl{(const unsigned char*)((const bf16_t*)(WSB + O_YM) + (size_t)m0 * 256), 512};
      gemm_main<true>(TIDX, BIDX, GDIM, acc, rpl, W + WO_PLE + (size_t)n0 * 256, 256, 256, smem);
      EPI_SWAP_BEGIN(m0, n0)
        const f32x4 x = *(const f32x4*)(OUTB + (size_t)row * 1024 + col);
        const f32x4 a = acc[mi][ni];
        const uint2 g = gp[mi][ni];
        f32x4 o;
        o[0] = x[0] * DN_ALPHA + a[0] * lo2f(g.x); o[1] = x[1] * DN_ALPHA + a[1] * hi2f(g.x);
        o[2] = x[2] * DN_ALPHA + a[2] * lo2f(g.y); o[3] = x[3] * DN_ALPHA + a[3] * hi2f(g.y);
        *(f32x4*)(PRE + (size_t)row * 1024 + col) = o;
      EPI_END
    }
  }
}

DEVI void phase_p9(const int TIDX, const int BIDX, const int GDIM, KAP KA, unsigned char* WSB, float* OUTB, int l, unsigned char* smem) {
  int* tstart = (int*)(smem + SMEM_GEMM + 1024 + 64);
  const int NT = moe_table(TIDX, BIDX, GDIM, KA, WSB, OUTB, l, tstart);
  const bf16_t* WE = (const bf16_t*)(WSB + O_WE) + 64ull * 524288;
  const bf16_t* H = (const bf16_t*)(WSB + O_H);
  bf16_t* YM = (bf16_t*)(WSB + O_YM);
  const int* cnt = (const int*)(WSB + O_CNT) + l * 32;
  const int* ltok = (const int*)(WSB + O_LTOK);
  const float* lw = (const float*)(WSB + O_LW);
  for (int item = BIDX; item < NT * 8; item += GDIM) {
    const int mt = item >> 3, nt = item & 7, e = moe_find(tstart, mt), lt = mt - tstart[e], ce = cnt[e];
    f32x4 acc[4][4];
    zero_acc(acc);
    RowLin rp{(const unsigned char*)(H + (size_t)mt * 128 * 512), 1024};
    gemm_main<true>(TIDX, BIDX, GDIM, acc, rp, WE + ((size_t)e * 1024 + nt * 128) * 512, 512, 512, smem);
    EPI_SWAP_BEGIN(0, nt * 128)
      const int pos = lt * 128 + row;
      if (pos < ce) {
        const int tk = ltok[(size_t)e * NTOK + pos];
        const float wt = lw[(size_t)e * NTOK + pos];
        const f32x4 a = acc[mi][ni] * wt;
        *(uint2*)(YM + (size_t)tk * 1024 + col) = make_uint2(pack2(a[0], a[1]), pack2(a[2], a[3]));
      }
    EPI_END
  }
}

DEVI void phase_p10(const int TIDX, const int BIDX, const int GDIM, KAP KA, unsigned char* WSB, float* OUTB, int l) {
  const int tid = TIDX, lane = tid & 63;
  const float* PRE = (const float*)(WSB + O_PRE);
  const bf16_t* YM = (const bf16_t*)(WSB + O_YM);
  bf16_t* XB = (bf16_t*)(WSB + O_XB);
  const float* g2 = PIN(I_LN2G) + l * 1024; const float* b2 = PIN(I_LN2B) + l * 1024;
  const int wid = BIDX * 4 + (tid >> 6), nw = GDIM * 4;
  for (int row = wid; row < NTOK; row += nw) {
    float4 v[4];
#pragma unroll
    for (int j = 0; j < 4; ++j) {
      v[j] = *(const float4*)(PRE + (size_t)row * 1024 + j * 256 + lane * 4);
      const uint2 y0 = *(const uint2*)(YM + (size_t)row * 2048 + j * 256 + lane * 4);
      const uint2 y1 = *(const uint2*)(YM + (size_t)row * 2048 + 1024 + j * 256 + lane * 4);
      v[j].x += lo2f(y0.x) + lo2f(y1.x); v[j].y += hi2f(y0.x) + hi2f(y1.x);
      v[j].z += lo2f(y0.y) + lo2f(y1.y); v[j].w += hi2f(y0.y) + hi2f(y1.y);
    }
    ln_inplace(v, g2, b2, lane);
    store_row(v, OUTB + (size_t)row * 1024, XB + (size_t)row * 1024, lane);
  }
}

DEVI void* launder_ptr(const void* q) {
  uint32_t lo = (uint32_t)(uintptr_t)q, hi = (uint32_t)((uintptr_t)q >> 32);
  asm volatile("" : "+v"(lo), "+v"(hi));
  lo = __builtin_amdgcn_readfirstlane(lo);
  hi = __builtin_amdgcn_readfirstlane(hi);
  return (void*)(((uintptr_t)hi << 32) | lo);
}
DEVI void grid_barrier(const int TIDX, unsigned* bar, unsigned target) {
  __syncthreads();
  if (TIDX == 0) {
    __threadfence();
    __hip_atomic_fetch_add(bar, 1u, __ATOMIC_RELAXED, __HIP_MEMORY_SCOPE_AGENT);
    unsigned spins = 0;
    while (__hip_atomic_load(bar, __ATOMIC_RELAXED, __HIP_MEMORY_SCOPE_AGENT) < target) {
      __builtin_amdgcn_s_sleep(2);
      if (++spins > (1u << 27)) break;
    }
    __threadfence();
  }
  __syncthreads();
}
__global__ void __launch_bounds__(256, 2) mega(Params p, int ph0, int ph1) {
  __shared__ __attribute__((aligned(16))) unsigned char smem[SMEM_TOTAL];
  const int wave_in_block = __builtin_amdgcn_readfirstlane((int)(__builtin_amdgcn_workitem_id_x() >> 6));
  for (int ph = ph0; ph < ph1; ++ph) {
    int wv_ = wave_in_block;
    asm volatile("" : "+s"(wv_));
    int TIDX = wv_ * 64 + (int)__lane_id();
    asm volatile("" : "+v"(TIDX));
    int BIDX = __builtin_amdgcn_workgroup_id_x(), GDIM = (int)gridDim.x;
    asm volatile("" : "+s"(BIDX), "+s"(GDIM));
    KAP KA;
    {
      uintptr_t q = (uintptr_t)__builtin_amdgcn_kernarg_segment_ptr();
      uint32_t lo = (uint32_t)q, hi = (uint32_t)(q >> 32);
      asm volatile("" : "+s"(lo), "+s"(hi));
      KA = (KAP)(((uintptr_t)hi << 32) | lo);
    }
    float* OUTB = (float*)PIN(31);
    unsigned char* WSB = (unsigned char*)PIN(32);
#ifndef PHSEL
#define PHSEL -1
#endif
    if (ph == 0) { if (PHSEL < 0 || PHSEL == 10) phase_prep(TIDX, BIDX, GDIM, KA, WSB, OUTB, smem); }
    else {
      const int l = (ph - 1) / 10, s = (ph - 1) % 10;
      switch (s) {
        case 0: if (PHSEL < 0 || PHSEL == 0) phase_p1(TIDX, BIDX, GDIM, KA, WSB, OUTB, l, smem); break;
        case 1: if (PHSEL < 0 || PHSEL == 1) phase_p2(TIDX, BIDX, GDIM, KA, WSB, OUTB, l, smem); break;
        case 2: if (PHSEL < 0 || PHSEL == 2) phase_p3(TIDX, BIDX, GDIM, KA, WSB, OUTB, l, smem); break;
        case 3: if (PHSEL < 0 || PHSEL == 3) phase_p4(TIDX, BIDX, GDIM, KA, WSB, OUTB, l, smem); break;
        case 4: if (PHSEL < 0 || PHSEL == 4) phase_p5(TIDX, BIDX, GDIM, KA, WSB, OUTB, l, smem); break;
        case 5: if (PHSEL < 0 || PHSEL == 5) phase_p6(TIDX, BIDX, GDIM, KA, WSB, OUTB, l, smem); break;
        case 6: if (PHSEL < 0 || PHSEL == 6) phase_p7(TIDX, BIDX, GDIM, KA, WSB, OUTB, l, smem); break;
        case 7: if (PHSEL < 0 || PHSEL == 7) phase_p8(TIDX, BIDX, GDIM, KA, WSB, OUTB, l, smem); break;
        case 8: if (PHSEL < 0 || PHSEL == 8) phase_p9(TIDX, BIDX, GDIM, KA, WSB, OUTB, l, smem); break;
        default: if (PHSEL < 0 || PHSEL == 9) phase_p10(TIDX, BIDX, GDIM, KA, WSB, OUTB, l); break;
      }
    }
#ifdef PROBE_DUP
    if (ph > 0 && (ph - 1) % 10 == PROBE_DUP) {
      cg::this_grid().sync();
      const int l = (ph - 1) / 10;
      switch (PROBE_DUP) {
        case 0: phase_p1(TIDX, BIDX, GDIM, KA, WSB, OUTB, l, smem); break;
        case 1: phase_p2(TIDX, BIDX, GDIM, KA, WSB, OUTB, l, smem); break;
        case 2: phase_p3(TIDX, BIDX, GDIM, KA, WSB, OUTB, l, smem); break;
        case 3: phase_p4(TIDX, BIDX, GDIM, KA, WSB, OUTB, l, smem, 1); break;
        case 4: phase_p5(TIDX, BIDX, GDIM, KA, WSB, OUTB, l, smem); break;
        case 5: phase_p6(TIDX, BIDX, GDIM, KA, WSB, OUTB, l, smem); break;
        case 7: phase_p8(TIDX, BIDX, GDIM, KA, WSB, OUTB, l, smem); break;
        case 8: phase_p9(TIDX, BIDX, GDIM, KA, WSB, OUTB, l, smem); break;
        case 9: phase_p10(TIDX, BIDX, GDIM, KA, WSB, OUTB, l); break;
        default: break;
      }
    }
#endif
    if (ph + 1 < ph1) {
      if (ph == ph0) cg::this_grid().sync();
      else grid_barrier(TIDX, (unsigned*)(WSB + O_CNT + 2048), (unsigned)(ph - ph0) * (unsigned)GDIM);
    }
  }
}

#ifndef MK_MULTI
#define MK_MULTI 0
#endif

extern "C" void kernel_launch(void* const* d_in, const int* in_sizes, int n_in, void* d_out, int out_size, void* d_ws, size_t ws_size,
                              hipStream_t stream) {
  static int grid_blocks = 0;
  if (!grid_blocks) {
    int dev = 0, cus = 0, per_cu = 0;
    hipGetDevice(&dev);
    hipDeviceGetAttribute(&cus, hipDeviceAttributeMultiprocessorCount, dev);
    hipOccupancyMaxActiveBlocksPerMultiprocessor(&per_cu, mega, 256, 0);
    if (per_cu > 2) per_cu = 2;
    if (per_cu < 1) per_cu = 1;
    grid_blocks = cus * per_cu;
  }
  Params p{};
  for (int i = 0; i < 31; ++i) p.in[i] = (const float*)d_in[i];
  p.out_ = (float*)d_out;
  p.ws_ = (unsigned char*)d_ws;
  if (ws_size < WS_END) fprintf(stderr, "workspace too small: %zu < %zu\n", ws_size, (size_t)WS_END);
#if MK_MULTI
  for (int ph = 0; ph < 21; ++ph) mega<<<dim3(grid_blocks), dim3(256), 0, stream>>>(p, ph, ph + 1);
#else
  (void)hipMemsetAsync((unsigned char*)d_ws + O_CNT + 2048, 0, 256, stream);
  int ph0 = 0, ph1 = 21;
  void* args[] = {&p, &ph0, &ph1};
  hipError_t e = hipLaunchCooperativeKernel((void*)mega, dim3(grid_blocks), dim3(256), args, 0, stream);
  if (e != hipSuccess) fprintf(stderr, "cooperative launch failed: %s (grid %d)\n", hipGetErrorString(e), grid_blocks);
#endif
}
```

```cpp
#include <hip/hip_runtime.h>
#include <hip/hip_cooperative_groups.h>
#include <stdint.h>
#include <stdio.h>
namespace cg = cooperative_groups;

#define DEVI __device__ __forceinline__
typedef unsigned short bf16_t;
typedef short bf16x8 __attribute__((ext_vector_type(8)));
typedef float f32x4 __attribute__((ext_vector_type(4)));
typedef float f32x16 __attribute__((ext_vector_type(16)));

constexpr int NTOK = 66048, TP = 65536, TS = 512;
constexpr int NCH = NTOK / 32;
constexpr int KPAD = 4160;
constexpr float DN_ALPHA = 1.4142135623730951f;
constexpr float EPS = 1e-6f;
constexpr float QSCALE = 0.10206207261596575f * 1.4426950408889634f;

constexpr size_t OUT_Y = 0;
constexpr size_t OUT_CKV_P = 67633152ull;
constexpr size_t OUT_KR_P = 101187584ull;
constexpr size_t OUT_ST_P = 105381888ull;
constexpr size_t OUT_CKV_S = 109576192ull;
constexpr size_t OUT_KR_S = 109838336ull;
constexpr size_t OUT_ST_S = 109871104ull;

constexpr size_t WO_IN = 0, WO_G = WO_IN + 2816ull * 1024, WO_UQ = WO_G + 2048ull * 1024, WO_KV = WO_UQ + 768ull * 384,
                 WO_BRA = WO_KV + 1024ull * 256, WO_BRB = WO_BRA + 1024ull * 512, WO_OUT = WO_BRB + 1024ull * 512,
                 WO_PG = WO_OUT + 1024ull * 1024, WO_PLE = WO_PG + 1024ull * 1024, WO_END = WO_PLE + 1024ull * 256;
static_assert(WO_END == 8945664ull, "small weights");

constexpr size_t al(size_t x) { return (x + 255) & ~size_t(255); }
constexpr size_t SZ_XB = (size_t)(NTOK + 1) * 1024 * 2, SZ_LIST = 32ull * NTOK * 4, SZ_KRS = 2ull * 16 * KPAD * 32 * 2,
                 SZ_G = (size_t)NTOK * 512 * 2, SZ_CQ = (size_t)NTOK * 384 * 2, SZ_CKR = (size_t)NTOK * 288 * 4,
                 SZ_FQ = (size_t)NTOK * 1024 * 2, SZ_CKVN = (size_t)NTOK * 256 * 2, SZ_KRB = (size_t)NTOK * 32 * 2,
                 SZ_QB = (size_t)NTOK * 768 * 2, SZ_AM = (size_t)NCH * 4 * 32 * 32 * 2, SZ_EB = (size_t)NCH * 4 * 128 * 4,
                 SZ_VT = 32ull * 8 * 64 * 2048 * 2, SZ_KNS = 16ull * KPAD * 512 * 2, SZ_VTS = 16ull * 8 * 64 * KPAD * 2,
                 SZ_PRE = (size_t)NTOK * 1024 * 4, SZ_WE = 3ull * 32 * 512 * 1024 * 2, SZ_H = 1064ull * 128 * 512 * 2,
                 SZ_YM = (size_t)NTOK * 2 * 1024 * 2;
constexpr size_t O_WS = 0;
constexpr size_t O_WR = O_WS + al(2 * WO_END * 2);
constexpr size_t O_ROPE = O_WR + al(2ull * 36 * 1024 * 4);
constexpr size_t O_CNT = O_ROPE + al(2080ull * 16 * 2 * 4);
constexpr size_t O_XB = O_CNT + 4096;
constexpr size_t O_LTOK = O_XB + al(SZ_XB);
constexpr size_t O_LW = O_LTOK + al(SZ_LIST);
constexpr size_t O_KRS = O_LW + al(SZ_LIST);
constexpr size_t O_G = O_KRS + al(SZ_KRS);
constexpr size_t O_VT2 = O_G + al(SZ_G);
constexpr size_t O_CQ = O_VT2 + al(SZ_G);
constexpr size_t O_CKR = O_CQ + al(SZ_CQ);
constexpr size_t O_FQ = O_CKR + al(SZ_CKR);
constexpr size_t O_CKVN = O_FQ + al(SZ_FQ);
constexpr size_t O_KRB = O_CKVN + al(SZ_CKVN);
constexpr size_t O_QB = O_KRB + al(SZ_KRB);
constexpr size_t O_QT = O_QB + al(SZ_QB);
constexpr size_t O_KHT = O_QT + al(SZ_G);
constexpr size_t O_AM = O_KHT + al(SZ_G);
constexpr size_t O_EB = O_AM + al(SZ_AM);
constexpr size_t O_KN = O_EB + al(SZ_EB);
constexpr size_t O_HO = O_KN + al(SZ_G);
constexpr size_t O_CCB = O_HO + al(SZ_G);
constexpr size_t WS_END = O_CCB + 16ull * 4096 * 256 * 2;
constexpr size_t O_VT = O_CQ;
constexpr size_t O_KNS = O_VT + al(SZ_VT);
constexpr size_t O_VTS = O_KNS + al(SZ_KNS);
constexpr size_t O_AO = O_VTS + al(SZ_VTS);
constexpr size_t O_MG = O_QB;
constexpr size_t O_PRE = O_G;
constexpr size_t O_WE = O_VTS;
constexpr size_t O_H = O_WE + al(SZ_WE);
constexpr size_t O_YM = O_H + al(SZ_H);
static_assert(O_AO + SZ_G <= O_KRB, "AO");
static_assert(O_AO >= O_VTS + SZ_VTS, "AO2");
static_assert(O_MG + SZ_XB <= O_KN, "MG");
static_assert(O_PRE + SZ_PRE <= O_WE, "PRE");
static_assert(O_YM + SZ_YM <= WS_END, "YM");
static_assert(WS_END <= (1ull << 30), "workspace");

struct Params { const float* in[31]; float* out_; unsigned char* ws_; };
typedef const __attribute__((address_space(4))) unsigned char* KAP;
#define PIN(i) (*(const float* const __attribute__((address_space(4)))*)(KA + 8 * (i)))

enum { I_XP = 0, I_XS, I_PP, I_PS, I_CCKV, I_CKR, I_ST, I_LN0G, I_LN0B, I_WIN, I_QN, I_WUQ, I_KVN, I_WUK, I_WUV, I_HGLB, I_HGN,
       I_WBRA, I_WBRB, I_WOUT, I_LN1G, I_LN1B, I_WRG, I_WRE, I_WE1, I_WE3, I_WE2, I_WPLE, I_WPG, I_LN2G, I_LN2B };

DEVI float bf2f(bf16_t h) { return __uint_as_float(((uint32_t)h) << 16); }
DEVI bf16_t f2bf(float f) { uint32_t u = __float_as_uint(f); u += 0x7fffu + ((u >> 16) & 1u); return (bf16_t)(u >> 16); }
typedef float f32x2_t __attribute__((ext_vector_type(2)));
typedef __bf16 bf16x2_t __attribute__((ext_vector_type(2)));
DEVI uint32_t pack2(float lo, float hi) { f32x2_t v = {lo, hi}; bf16x2_t b = __builtin_convertvector(v, bf16x2_t); return __builtin_bit_cast(uint32_t, b); }
DEVI float lo2f(uint32_t u) { return __uint_as_float(u << 16); }
DEVI float hi2f(uint32_t u) { return __uint_as_float(u & 0xffff0000u); }
DEVI float wave_sum(float v) {
#pragma unroll
  for (int o = 32; o; o >>= 1) v += __shfl_xor(v, o);
  return v;
}
DEVI float sigmoidf_(float x) { return 1.f / (1.f + __expf(-x)); }
DEVI float siluf_(float x) { return x / (1.f + __expf(-x)); }
DEVI f32x4 mfma16(bf16x8 a, bf16x8 b, f32x4 c) { return __builtin_amdgcn_mfma_f32_16x16x32_bf16(a, b, c, 0, 0, 0); }
DEVI f32x16 mfma32(bf16x8 a, bf16x8 b, f32x16 c) { return __builtin_amdgcn_mfma_f32_32x32x16_bf16(a, b, c, 0, 0, 0); }
DEVI bf16x8 mk8(uint32_t a, uint32_t b, uint32_t c, uint32_t d) { uint4 u = make_uint4(a, b, c, d); return *(bf16x8*)&u; }
DEVI bf16x8 mk8(uint2 lo, uint2 hi) { uint4 u = make_uint4(lo.x, lo.y, hi.x, hi.y); return *(bf16x8*)&u; }

constexpr int SMEM_GEMM = 2 * 2 * 128 * 72 * 2;
constexpr int SMEM_TOTAL = SMEM_GEMM + 2048;

template <bool SWAP, class RP>
DEVI void gemm_main(const int TIDX, const int BIDX, const int GDIM, f32x4 (&acc)[4][4], RP rowoff, const bf16_t* __restrict__ Bt, int ldb, int K, unsigned char* smem) {
  const int tid = TIDX;
  const int lane = tid & 63, w = tid >> 6, wr = w >> 1, wc = w & 1, li = lane & 15, lg = lane >> 4;
  const unsigned char* abase = rowoff.base;
  const unsigned char* bbase = (const unsigned char*)Bt;
  const uint32_t schunk = (uint32_t)((lane & 7) ^ (((lane >> 4) + 4 * (w & 1)) & 7)) * 16u;
  uint32_t ao0, ao1, ao2, ao3;
  const int rsub = w * 8 + (lane >> 3);
  ao0 = rowoff(rsub) + schunk; ao1 = rowoff(rsub + 32) + schunk; ao2 = rowoff(rsub + 64) + schunk; ao3 = rowoff(rsub + 96) + schunk;
  const uint32_t bo = (uint32_t)(rsub * ldb) * 2u + schunk, bstep = (uint32_t)(32 * ldb) * 2u;
  unsigned char* sbase = smem + w * 1024;
#define GM_STAGE(kt_, buf_)                                                                                                       \
  {                                                                                                                              \
    unsigned char* da_ = sbase + (buf_) * 32768;                                                                                 \
    unsigned char* db_ = da_ + 16384;                                                                                            \
    const uint32_t ko_ = (uint32_t)(kt_) * 128u;                                                                                 \
    __builtin_amdgcn_global_load_lds((const unsigned*)(abase + ao0 + ko_), (unsigned*)(da_), 16, 0, 0);                         \
    __builtin_amdgcn_global_load_lds((const unsigned*)(abase + ao1 + ko_), (unsigned*)(da_ + 4096), 16, 0, 0);                  \
    __builtin_amdgcn_global_load_lds((const unsigned*)(abase + ao2 + ko_), (unsigned*)(da_ + 8192), 16, 0, 0);                  \
    __builtin_amdgcn_global_load_lds((const unsigned*)(abase + ao3 + ko_), (unsigned*)(da_ + 12288), 16, 0, 0);                 \
    __builtin_amdgcn_global_load_lds((const unsigned*)(bbase + bo + ko_), (unsigned*)(db_), 16, 0, 0);                          \
    __builtin_amdgcn_global_load_lds((const unsigned*)(bbase + bo + bstep + ko_), (unsigned*)(db_ + 4096), 16, 0, 0);           \
    __builtin_amdgcn_global_load_lds((const unsigned*)(bbase + bo + 2u * bstep + ko_), (unsigned*)(db_ + 8192), 16, 0, 0);      \
    __builtin_amdgcn_global_load_lds((const unsigned*)(bbase + bo + 3u * bstep + ko_), (unsigned*)(db_ + 12288), 16, 0, 0);     \
  }
  const int nk = K >> 6;
  const int px = lg ^ (li >> 1);
  GM_STAGE(0, 0);
  for (int kt = 0; kt < nk; ++kt) {
    const int buf = kt & 1;
    asm volatile("s_waitcnt vmcnt(0)" ::: "memory");
    __syncthreads();
    if (kt + 1 < nk) GM_STAGE(kt + 1, buf ^ 1);
    const unsigned char* A = smem + buf * 32768 + (wr * 64 + li) * 128;
    const unsigned char* B = smem + buf * 32768 + 16384 + (wc * 64 + li) * 128;
#pragma unroll
    for (int ks = 0; ks < 2; ++ks) {
      const int po = (px ^ (ks * 4)) * 16;
      bf16x8 af[4], bfr[4];
#pragma unroll
      for (int i = 0; i < 4; ++i) {
        af[i] = *(const bf16x8*)(A + i * 2048 + po);
        bfr[i] = *(const bf16x8*)(B + i * 2048 + po);
      }
#pragma unroll
      for (int mi = 0; mi < 4; ++mi)
#pragma unroll
        for (int ni = 0; ni < 4; ++ni)
          acc[mi][ni] = SWAP ? mfma16(bfr[ni], af[mi], acc[mi][ni]) : mfma16(af[mi], bfr[ni], acc[mi][ni]);
    }
  }
  __syncthreads();
}
DEVI float zero_f() { float z = 0.f; asm volatile("" : "+v"(z)); return z; }
DEVI void zero_acc(f32x4 (&acc)[4][4]) {
  const float z = zero_f();
#pragma unroll
  for (int i = 0; i < 4; ++i)
#pragma unroll
    for (int j = 0; j < 4; ++j) acc[i][j] = (f32x4){z, z, z, z};
}
#define EPI_SWAP_BEGIN(m0, n0)                                                                     \
  {                                                                                                \
    const int _lane = TIDX & 63, _w = TIDX >> 6;                                     \
    const int _rb = (m0) + (_w >> 1) * 64 + (_lane & 15), _cb = (n0) + (_w & 1) * 64 + 4 * (_lane >> 4); \
    _Pragma("unroll") for (int mi = 0; mi < 4; ++mi) {                                             \
      const int row = _rb + mi * 16;                                                               \
      _Pragma("unroll") for (int ni = 0; ni < 4; ++ni) {                                           \
        const int col = _cb + ni * 16;
#define EPI_END } __builtin_amdgcn_sched_barrier(0); } }

struct RowLin {
  const unsigned char* base; uint32_t stride;
  DEVI uint32_t operator()(int r) const { return (uint32_t)r * stride; }
};

struct CMap {
  int mode;
  DEVI int operator()(int n) const {
    if (mode == 0) return n;
    if (mode == 1) return n < 672 ? n : (n < 768 ? -1 : n - 96);
    if (mode == 2) return n + 2720;
    if (n < 512) return (n >> 6) * 96 + (n & 63);
    const int m = n - 512, h = m >> 5, w = m & 31;
    return h * 96 + (w < 16 ? 64 + w : 80 + (w - 16));
  }
};
DEVI void transpose_tile(const int TIDX, const int BIDX, const int GDIM, const float* __restrict__ src, int ld, int K, bf16_t* __restrict__ dst, int k0, int n0, CMap cm,
                         const float* kscale, float* tile) {
  const int t = TIDX;
  {
    const int n4 = (t & 15) * 4, kr = t >> 4;
    const int sc = cm(n0 + n4);
#pragma unroll
    for (int p = 0; p < 4; ++p) {
      const int k = kr + 16 * p;
      float4 v = make_float4(0.f, 0.f, 0.f, 0.f);
      if (sc >= 0) {
        v = *(const float4*)(src + (size_t)(k0 + k) * ld + sc);
        if (kscale) { const float sck = kscale[k0 + k]; v.x *= sck; v.y *= sck; v.z *= sck; v.w *= sck; }
      }
      float* d = tile + k * 65 + n4;
      d[0] = v.x; d[1] = v.y; d[2] = v.z; d[3] = v.w;
    }
  }
  __syncthreads();
  {
    const int kc = (t & 7) * 8, nr = t >> 3;
#pragma unroll
    for (int q = 0; q < 2; ++q) {
      const int n = nr + 32 * q;
      const float* sp = tile + kc * 65 + n;
      const uint4 o = make_uint4(pack2(sp[0], sp[65]), pack2(sp[130], sp[195]), pack2(sp[260], sp[325]), pack2(sp[390], sp[455]));
      *(uint4*)(dst + (size_t)(n0 + n) * K + k0 + kc) = o;
    }
  }
  __syncthreads();
}
DEVI void run_transpose(const int TIDX, const int BIDX, const int GDIM, const float* src, int ld, int K, int N, bf16_t* dst, int mode, const float* kscale, float* tile) {
  const int nkt = K >> 6, tiles = nkt * (N >> 6);
  CMap cm{mode};
  for (int t = BIDX; t < tiles; t += GDIM) transpose_tile(TIDX, BIDX, GDIM, src, ld, K, dst, (t % nkt) * 64, (t / nkt) * 64, cm, kscale, tile);
}

DEVI void ln_inplace(float4 (&v)[4], const float* __restrict__ g, const float* __restrict__ b, int lane) {
  float s = 0.f;
#pragma unroll
  for (int j = 0; j < 4; ++j) s += v[j].x + v[j].y + v[j].z + v[j].w;
  s = wave_sum(s);
  const float mu = s * (1.f / 1024.f);
  float q = 0.f;
#pragma unroll
  for (int j = 0; j < 4; ++j) {
    float a = v[j].x - mu, bq = v[j].y - mu, cq = v[j].z - mu, d = v[j].w - mu;
    q += a * a + bq * bq + cq * cq + d * d;
  }
  q = wave_sum(q);
  const float rs = rsqrtf(q * (1.f / 1024.f) + EPS);
#pragma unroll
  for (int j = 0; j < 4; ++j) {
    const float4 gg = *(const float4*)(g + j * 256 + lane * 4), bb = *(const float4*)(b + j * 256 + lane * 4);
    v[j].x = (v[j].x - mu) * rs * gg.x + bb.x;
    v[j].y = (v[j].y - mu) * rs * gg.y + bb.y;
    v[j].z = (v[j].z - mu) * rs * gg.z + bb.z;
    v[j].w = (v[j].w - mu) * rs * gg.w + bb.w;
  }
}
DEVI void store_row(const float4 (&v)[4], float* x32, bf16_t* x16, int lane) {
#pragma unroll
  for (int j = 0; j < 4; ++j) {
    *(float4*)(x32 + j * 256 + lane * 4) = v[j];
    *(uint2*)(x16 + j * 256 + lane * 4) = make_uint2(pack2(v[j].x, v[j].y), pack2(v[j].z, v[j].w));
  }
}
DEVI int pos_index(int row) { return row < TP ? (row & 2047) : 2048 + ((row - TP) & 31); }

DEVI void phase_prep(const int TIDX, const int BIDX, const int GDIM, KAP KA, unsigned char* WSB, float* OUTB, unsigned char* smem) {
  float* tile = (float*)smem;
  bf16_t* WS = (bf16_t*)(WSB + O_WS);
  const int tid = TIDX, gtid = BIDX * 256 + tid, gsz = GDIM * 256;
  if (gtid < 512) ((int*)(WSB + O_CNT))[gtid] = 0;
  if (gtid < 512) ((uint32_t*)(WSB + O_XB + (size_t)NTOK * 2048))[gtid] = 0u;
  for (int i = gtid; i < 2080 * 16; i += gsz) {
    const int pi = i >> 4, k = i & 15;
    const int pos = pi < 2048 ? pi : 4096 + (pi - 2048);
    const float inv = exp2f(-(float)k * (13.287712379549449f / 16.f));
    const float ang = (float)pos * inv;
    double rev = (double)ang * 0.15915494309189535;
    rev -= __builtin_rint(rev);
    const float fr = (float)rev;
    float2 cs = make_float2(__builtin_amdgcn_cosf(fr), __builtin_amdgcn_sinf(fr));
    ((float2*)(WSB + O_ROPE))[i] = cs;
  }
  for (int i = gtid; i < 2 * 36 * 1024; i += gsz) {
    const int l = i / (36 * 1024), r = i % (36 * 1024), c = r >> 10, k = r & 1023;
    float v = c < 4 ? PIN(I_WRG)[((size_t)l * 1024 + k) * 4 + c] : PIN(I_WRE)[((size_t)l * 1024 + k) * 32 + (c - 4)];
    ((float*)(WSB + O_WR))[i] = v;
  }
  for (int i = gtid; i < 2 * 16 * 4096 * 8; i += gsz) {
    const int e = i * 4, lb = e / (4096 * 32), r = e % (4096 * 32);
    const float4 v = *(const float4*)(PIN(I_CKR) + (size_t)e);
    *(uint2*)((bf16_t*)(WSB + O_KRS) + (size_t)lb * KPAD * 32 + r) = make_uint2(pack2(v.x, v.y), pack2(v.z, v.w));
  }
  {
    const int lane = tid & 63, wid = BIDX * 4 + (tid >> 6), nw = GDIM * 4;
    for (int row = wid; row < NTOK; row += nw) {
      const float* src = row < TP ? PIN(I_XP) + (size_t)row * 1024 : PIN(I_XS) + (size_t)(row - TP) * 1024;
      float4 v[4];
#pragma unroll
      for (int j = 0; j < 4; ++j) v[j] = *(const float4*)(src + j * 256 + lane * 4);
      ln_inplace(v, PIN(I_LN0G), PIN(I_LN0B), lane);
      store_row(v, OUTB + (size_t)row * 1024, (bf16_t*)(WSB + O_XB) + (size_t)row * 1024, lane);
    }
  }
  for (int l = 0; l < 2; ++l) {
    bf16_t* W = WS + (size_t)l * WO_END;
    run_transpose(TIDX, BIDX, GDIM, PIN(I_WIN) + (size_t)l * 1024 * 4768, 4768, 1024, 2816, W + WO_IN, 1, nullptr, tile);
    run_transpose(TIDX, BIDX, GDIM, PIN(I_WIN) + (size_t)l * 1024 * 4768, 4768, 1024, 2048, W + WO_G, 2, nullptr, tile);
    run_transpose(TIDX, BIDX, GDIM, PIN(I_WUQ) + (size_t)l * 384 * 768, 768, 384, 768, W + WO_UQ, 3, PIN(I_QN) + l * 384, tile);
    run_transpose(TIDX, BIDX, GDIM, PIN(I_WUK) + (size_t)l * 256 * 512, 512, 256, 512, W + WO_KV, 0, nullptr, tile);
    run_transpose(TIDX, BIDX, GDIM, PIN(I_WUV) + (size_t)l * 256 * 512, 512, 256, 512, W + WO_KV + 512 * 256, 0, nullptr, tile);
    run_transpose(TIDX, BIDX, GDIM, PIN(I_WBRA) + (size_t)l * 512 * 1024, 1024, 512, 1024, W + WO_BRA, 0, nullptr, tile);
    run_transpose(TIDX, BIDX, GDIM, PIN(I_WBRB) + (size_t)l * 512 * 1024, 1024, 512, 1024, W + WO_BRB, 0, nullptr, tile);
    run_transpose(TIDX, BIDX, GDIM, PIN(I_WOUT) + (size_t)l * 1024 * 1024, 1024, 1024, 1024, W + WO_OUT, 0, nullptr, tile);
    run_transpose(TIDX, BIDX, GDIM, PIN(I_WPG) + (size_t)l * 1024 * 1024, 1024, 1024, 1024, W + WO_PG, 0, nullptr, tile);
    run_transpose(TIDX, BIDX, GDIM, PIN(I_WPLE) + (size_t)l * 256 * 1024, 1024, 256, 1024, W + WO_PLE, 0, nullptr, tile);
  }
}

DEVI void phase_p1(const int TIDX, const int BIDX, const int GDIM, KAP KA, unsigned char* WSB, float* OUTB, int l, unsigned char* smem) {
  const bf16_t* XB = (const bf16_t*)(WSB + O_XB);
  const bf16_t* W = (const bf16_t*)(WSB + O_WS) + (size_t)l * WO_END + WO_IN;
  bf16_t* CQ = (bf16_t*)(WSB + O_CQ);
  float* CKR = (float*)(WSB + O_CKR);
  bf16_t* FQ = (bf16_t*)(WSB + O_FQ);
  bf16_t* VT2 = (bf16_t*)(WSB + O_VT2);
  bf16_t* G = (bf16_t*)(WSB + O_G);
  for (int item = (BIDX & 7) * (GDIM >> 3) + (BIDX >> 3); item < 516 * 22; item += GDIM) {
    const int mt = item / 22, nt = item % 22, m0 = mt * 128;
    f32x4 acc[4][4];
    zero_acc(acc);
    RowLin rp{(const unsigned char*)(XB + (size_t)m0 * 1024), 2048};
    if (nt >= 14 && nt < 18) {
      gemm_main<false>(TIDX, BIDX, GDIM, acc, rp, W + (size_t)nt * 128 * 1024, 1024, 1024, smem);
      const int h = nt - 14, lane = TIDX & 63, w = TIDX >> 6;
      const int rb = m0 + (w >> 1) * 64 + 4 * (lane >> 4), cb = (w & 1) * 64 + (lane & 15);
#pragma unroll
      for (int mi = 0; mi < 4; ++mi) {
        const int row = rb + mi * 16, ch = row >> 5, s = row & 31;
#pragma unroll
        for (int ni = 0; ni < 4; ++ni) {
          const int dv = cb + ni * 16;
          const f32x4 a = acc[mi][ni];
          *(uint2*)(VT2 + ((size_t)(ch * 4 + h) * 128 + dv) * 32 + s) = make_uint2(pack2(a[0], a[1]), pack2(a[2], a[3]));
        }
      }
    } else {
      gemm_main<true>(TIDX, BIDX, GDIM, acc, rp, W + (size_t)nt * 128 * 1024, 1024, 1024, smem);
      EPI_SWAP_BEGIN(m0, 0)
        const f32x4 a = acc[mi][ni];
        if (nt < 3) {
          *(uint2*)(CQ + (size_t)row * 384 + nt * 128 + col) = make_uint2(pack2(a[0], a[1]), pack2(a[2], a[3]));
        } else if (nt < 5) {
          *(f32x4*)(CKR + (size_t)row * 288 + (nt - 3) * 128 + col) = a;
        } else if (nt == 5) {
          if (col < 32) *(f32x4*)(CKR + (size_t)row * 288 + 256 + col) = a;
        } else if (nt < 14) {
          *(uint2*)(FQ + (size_t)row * 1024 + (nt - 6) * 128 + col) = make_uint2(pack2(a[0], a[1]), pack2(a[2], a[3]));
        } else {
          *(uint2*)(G + (size_t)row * 512 + (nt - 18) * 128 + col) = make_uint2(pack2(a[0], a[1]), pack2(a[2], a[3]));
        }
      EPI_END
    }
  }
}

DEVI void phase_p2(const int TIDX, const int BIDX, const int GDIM, KAP KA, unsigned char* WSB, float* OUTB, int l, unsigned char* smem) {
  const int tid = TIDX, lane = tid & 63;
  const float2* ROPE = (const float2*)(WSB + O_ROPE);
  {
    const bf16_t* CQ = (const bf16_t*)(WSB + O_CQ);
    const bf16_t* W = (const bf16_t*)(WSB + O_WS) + (size_t)l * WO_END + WO_UQ;
    bf16_t* QB = (bf16_t*)(WSB + O_QB);
    float* srow = (float*)(smem + SMEM_GEMM);
    for (int item = (BIDX & 7) * (GDIM >> 3) + (BIDX >> 3); item < 516 * 6; item += GDIM) {
      const int mt = item / 6, nt = item % 6, m0 = mt * 128;
      {
        const int r = tid >> 1, hf = tid & 1;
        const uint4* s = (const uint4*)(CQ + (size_t)(m0 + r) * 384 + hf * 192);
        float ss = 0.f;
#pragma unroll 4
        for (int j = 0; j < 24; ++j) {
          const uint4 u = s[j];
          float a;
          a = lo2f(u.x); ss += a * a; a = hi2f(u.x); ss += a * a;
          a = lo2f(u.y); ss += a * a; a = hi2f(u.y); ss += a * a;
          a = lo2f(u.z); ss += a * a; a = hi2f(u.z); ss += a * a;
          a = lo2f(u.w); ss += a * a; a = hi2f(u.w); ss += a * a;
        }
        ss += __shfl_xor(ss, 1);
        if (hf == 0) srow[r] = rsqrtf(ss * (1.f / 384.f) + EPS) * QSCALE;
      }
      f32x4 acc[4][4];
      zero_acc(acc);
      RowLin rp{(const unsigned char*)(CQ + (size_t)m0 * 384), 768};
      gemm_main<true>(TIDX, BIDX, GDIM, acc, rp, W + (size_t)nt * 128 * 384, 384, 384, smem);
      if (nt < 4) {
        EPI_SWAP_BEGIN(m0, nt * 128)
          const float sc = srow[row - m0];
          const f32x4 a = acc[mi][ni] * sc;
          const int hh = col >> 6, d = col & 63;
          *(uint2*)(QB + (size_t)row * 768 + hh * 96 + d) = make_uint2(pack2(a[0], a[1]), pack2(a[2], a[3]));
        EPI_END
      } else {
        const int w = tid >> 6;
        const int rb = m0 + (w >> 1) * 64 + (lane & 15), i0 = 4 * (lane >> 4);
#pragma unroll
        for (int mi = 0; mi < 4; ++mi) {
          const int row = rb + mi * 16;
          const float sc = srow[row - m0];
          const float2* rt = ROPE + (size_t)pos_index(row) * 16 + i0;
#pragma unroll
          for (int pr = 0; pr < 2; ++pr) {
            const int hh = (nt - 4) * 4 + (w & 1) * 2 + pr;
            const f32x4 x1 = acc[mi][2 * pr] * sc, x2 = acc[mi][2 * pr + 1] * sc;
            float o1[4], o2[4];
#pragma unroll
            for (int r = 0; r < 4; ++r) {
              const float2 cs = rt[r];
              o1[r] = x1[r] * cs.x - x2[r] * cs.y;
              o2[r] = x2[r] * cs.x + x1[r] * cs.y;
            }
            *(uint2*)(QB + (size_t)row * 768 + hh * 96 + 64 + i0) = make_uint2(pack2(o1[0], o1[1]), pack2(o1[2], o1[3]));
            *(uint2*)(QB + (size_t)row * 768 + hh * 96 + 80 + i0) = make_uint2(pack2(o2[0], o2[1]), pack2(o2[2], o2[3]));
          }
        }
      }
      __syncthreads();
    }
  }
  {
    const bf16_t* FQ = (const bf16_t*)(WSB + O_FQ);
    bf16_t* QT = (bf16_t*)(WSB + O_QT);
    bf16_t* KHT = (bf16_t*)(WSB + O_KHT);
    bf16_t* AM = (bf16_t*)(WSB + O_AM);
    float* EBp = (float*)(WSB + O_EB);
    bf16_t* sQ = (bf16_t*)smem;
    bf16_t* sK = sQ + 32 * 136;
    for (int item = BIDX; item < NCH * 4; item += GDIM) {
      const int ch = item >> 2, h = item & 3, cid = item;
      {
        const int k = tid & 127, half = tid >> 7, colh = h * 128 + k;
        float* sB = (float*)(smem + 2 * 32 * 136 * 2);
        float lb = 0.f;
        if (l == 1) { const float a0 = PIN(I_HGLB)[colh], a1 = PIN(I_HGLB)[512 + colh]; lb = 1.f / (1.f + expf(a0 - a1)); }
        const float oml = 1.f - lb;
        float bt[16], kk[16], qv[16];
        float bl = 0.f;
#pragma unroll
        for (int j = 0; j < 16; ++j) {
          const size_t row = (size_t)ch * 32 + half * 16 + j;
          const float z = bf2f(FQ[row * 1024 + colh]);
          qv[j] = bf2f(FQ[row * 1024 + 512 + colh]);
          const float e = __expf(-z);
          const float inv = __builtin_amdgcn_rcpf(1.f + e);
          const float f = lb + oml * inv;
          kk[j] = oml * e * inv;
          bl += __logf(f);
          bt[j] = bl;
        }
        sB[half * 128 + k] = bl;
        __syncthreads();
        const float b0 = sB[k], b1 = sB[128 + k];
        const float off = half ? b0 : 0.f, bend = b0 + b1;
        uint32_t pk[8];
#pragma unroll
        for (int j = 0; j < 16; ++j) {
          const int t = half * 16 + j;
          const float b = bt[j] + off;
          const float qs = qv[j] * __builtin_amdgcn_rcpf(1.f + __expf(-qv[j]));
          const bf16_t qt = f2bf(qs * __expf(b));
          QT[((size_t)cid * 32 + t) * 128 + k] = qt;
          sQ[t * 136 + k] = qt;
          sK[t * 136 + k] = f2bf(kk[j] * __expf(fminf(-b, 80.f)));
          bt[j] = kk[j] * __expf(bend - b);
        }
#pragma unroll
        for (int j = 0; j < 8; ++j) pk[j] = pack2(bt[2 * j], bt[2 * j + 1]);
        if (half == 0) EBp[(size_t)cid * 128 + k] = __expf(bend);
        uint4* dst = (uint4*)(KHT + ((size_t)cid * 128 + k) * 32 + half * 16);
        dst[0] = make_uint4(pk[0], pk[1], pk[2], pk[3]);
        dst[1] = make_uint4(pk[4], pk[5], pk[6], pk[7]);
      }
      __syncthreads();
      if (tid < 64) {
        const int c = lane & 31, hh = lane >> 5;
        f32x16 am;
        const float zf = zero_f();
#pragma unroll
        for (int r = 0; r < 16; ++r) am[r] = zf;
#pragma unroll
        for (int st = 0; st < 8; ++st) {
          const bf16x8 a = *(const bf16x8*)(sQ + c * 136 + st * 16 + hh * 8);
          const bf16x8 bb = *(const bf16x8*)(sK + c * 136 + st * 16 + hh * 8);
          am = mfma32(a, bb, am);
        }
#pragma unroll
        for (int r = 0; r < 16; ++r) {
          const int t = (r & 3) + 8 * (r >> 2) + 4 * hh;
          AM[((size_t)cid * 32 + t) * 32 + c] = f2bf(c <= t ? am[r] : 0.f);
        }
      }
      __syncthreads();
    }
  }
  {
    const float* src = PIN(I_CCKV) + (size_t)l * 16 * 4096 * 256;
    bf16_t* CCB = (bf16_t*)(WSB + O_CCB);
    for (size_t i = (size_t)BIDX * 256 + tid; i < 16ull * 4096 * 64; i += (size_t)GDIM * 256) {
      const float4 v = *(const float4*)(src + i * 4);
      *(uint2*)(CCB + i * 4) = make_uint2(pack2(v.x, v.y), pack2(v.z, v.w));
    }
  }
  {
    const float* CKR = (const float*)(WSB + O_CKR);
    bf16_t* CKVN = (bf16_t*)(WSB + O_CKVN);
    bf16_t* KRB = (bf16_t*)(WSB + O_KRB);
    bf16_t* KRS = (bf16_t*)(WSB + O_KRS) + (size_t)l * 16 * KPAD * 32;
    const float* kvn = PIN(I_KVN) + l * 256;
    const int wid = BIDX * 4 + (tid >> 6), nw = GDIM * 4;
    for (int row = wid; row < NTOK; row += nw) {
      const float* src = CKR + (size_t)row * 288;
      const float4 v = *(const float4*)(src + lane * 4);
      float ss = wave_sum(v.x * v.x + v.y * v.y + v.z * v.z + v.w * v.w);
      const float rs = rsqrtf(ss * (1.f / 256.f) + EPS);
      const float4 g = *(const float4*)(kvn + lane * 4);
      const float4 o = make_float4(v.x * rs * g.x, v.y * rs * g.y, v.z * rs * g.z, v.w * rs * g.w);
      float* oc = row < TP ? OUTB + OUT_CKV_P + ((size_t)l * TP + row) * 256 : OUTB + OUT_CKV_S + ((size_t)l * TS + (row - TP)) * 256;
      *(float4*)(oc + lane * 4) = o;
      *(uint2*)(CKVN + (size_t)row * 256 + lane * 4) = make_uint2(pack2(o.x, o.y), pack2(o.z, o.w));
      if (lane < 16) {
        const float x1 = src[256 + lane], x2 = src[272 + lane];
        const float2 cs = ROPE[(size_t)pos_index(row) * 16 + lane];
        const float o1 = x1 * cs.x - x2 * cs.y, o2 = x2 * cs.x + x1 * cs.y;
        float* ok = row < TP ? OUTB + OUT_KR_P + ((size_t)l * TP + row) * 32 : OUTB + OUT_KR_S + ((size_t)l * TS + (row - TP)) * 32;
        ok[lane] = o1;
        ok[16 + lane] = o2;
        bf16_t* kb = row < TP ? KRB + (size_t)row * 32 : KRS + ((size_t)((row - TP) >> 5) * KPAD + 4096 + ((row - TP) & 31)) * 32;
        kb[lane] = f2bf(o1);
        kb[16 + lane] = f2bf(o2);
      }
    }
  }
}

DEVI void phase_p3(const int TIDX, const int BIDX, const int GDIM, KAP KA, unsigned char* WSB, float* OUTB, int l, unsigned char* smem) {
  const bf16_t* W = (const bf16_t*)(WSB + O_WS) + (size_t)l * WO_END + WO_KV;
  const bf16_t* CKVN = (const bf16_t*)(WSB + O_CKVN);
  bf16_t* KN = (bf16_t*)(WSB + O_KN);
  bf16_t* VT = (bf16_t*)(WSB + O_VT);
  bf16_t* KNS = (bf16_t*)(WSB + O_KNS);
  bf16_t* VTS = (bf16_t*)(WSB + O_VTS);
  const bf16_t* cache = (const bf16_t*)(WSB + O_CCB);
  for (int i = BIDX * 256 + TIDX; i < 16 * 8 * 64 * 4; i += GDIM * 256) {
    const uint32_t z = __float_as_uint(zero_f());
    *(uint4*)(VTS + (size_t)(i >> 2) * KPAD + 4128 + (i & 3) * 8) = make_uint4(z, z, z, z);
  }
  for (int item = (BIDX & 7) * (GDIM >> 3) + (BIDX >> 3); item < (516 + 512) * 8; item += GDIM) {
    const int mt = item >> 3, nt = item & 7;
    const bool is_cache = mt >= 516;
    const int m0 = is_cache ? (mt - 516) * 128 : mt * 128;
    f32x4 acc[4][4];
    zero_acc(acc);
    bf16_t* kdst; bf16_t* vdst; size_t ldv; int key0;
    if (is_cache) { const int b = m0 >> 12; key0 = m0 & 4095; kdst = KNS + ((size_t)b * KPAD + key0) * 512; vdst = VTS + (size_t)b * 8 * 64 * KPAD; ldv = KPAD; }
    else if (m0 >= TP) { kdst = nullptr; vdst = nullptr; ldv = KPAD; key0 = 0; }
    else { const int b = m0 >> 11; key0 = m0 & 2047; kdst = KN + (size_t)m0 * 512; vdst = VT + (size_t)b * 8 * 64 * 2048; ldv = 2048; }
    if (nt < 4) {
      if (is_cache) { RowLin rp{(const unsigned char*)(cache + (size_t)m0 * 256), 512}; gemm_main<true>(TIDX, BIDX, GDIM, acc, rp, W + (size_t)nt * 128 * 256, 256, 256, smem); }
      else { RowLin rp{(const unsigned char*)(CKVN + (size_t)m0 * 256), 512}; gemm_main<true>(TIDX, BIDX, GDIM, acc, rp, W + (size_t)nt * 128 * 256, 256, 256, smem); }
      EPI_SWAP_BEGIN(0, nt * 128)
        const f32x4 a = acc[mi][ni];
        bf16_t* d;
        if (kdst) d = kdst + (size_t)row * 512 + col;
        else { const int sr = m0 - TP + row; d = KNS + ((size_t)(sr >> 5) * KPAD + 4096 + (sr & 31)) * 512 + col; }
        *(uint2*)d = make_uint2(pack2(a[0], a[1]), pack2(a[2], a[3]));
      EPI_END
    } else {
      if (is_cache) { RowLin rp{(const unsigned char*)(cache + (size_t)m0 * 256), 512}; gemm_main<false>(TIDX, BIDX, GDIM, acc, rp, W + (size_t)nt * 128 * 256, 256, 256, smem); }
      else { RowLin rp{(const unsigned char*)(CKVN + (size_t)m0 * 256), 512}; gemm_main<false>(TIDX, BIDX, GDIM, acc, rp, W + (size_t)nt * 128 * 256, 256, 256, smem); }
      const int lane = TIDX & 63, w = TIDX >> 6;
      const int rb = (w >> 1) * 64 + 4 * (lane >> 4), cb = (nt - 4) * 128 + (w & 1) * 64 + (lane & 15);
#pragma unroll
      for (int mi = 0; mi < 4; ++mi) {
        const int row = rb + mi * 16;
#pragma unroll
        for (int ni = 0; ni < 4; ++ni) {
          const int hv = cb + ni * 16;
          const f32x4 a = acc[mi][ni];
          bf16_t* d;
          if (vdst) d = vdst + (size_t)hv * ldv + key0 + row;
          else { const int sr = m0 - TP + row; d = VTS + ((size_t)(sr >> 5) * 512 + hv) * KPAD + 4096 + (sr & 31); }
          *(uint2*)d = make_uint2(pack2(a[0], a[1]), pack2(a[2], a[3]));
        }
      }
    }
  }
}

DEVI void attn_item(const int TIDX, const int BIDX, const int GDIM, const bf16_t* __restrict__ Q, int qrow0, int nq, int ng, const bf16_t* __restrict__ Kn, const bf16_t* __restrict__ Kr,
                    const bf16_t* __restrict__ VT, size_t ldv, int nkeys, bf16_t* __restrict__ O, unsigned char* smem) {
  const int tid = TIDX, lane = tid & 63, w = tid >> 6, li = lane & 15, lg = lane >> 4;
  const int ql = 16 * w + li;
  bf16x8 qf[2][3];
  f32x4 oT[2][4];
  float mrun[2], lrun[2];
  const float zf = zero_f();
#pragma unroll
  for (int g = 0; g < 2; ++g) {
    const int qr = qrow0 + (g == 0 ? (ql < nq ? ql : nq - 1) : 64 + ql);
    const int qrc = (g == 1 && ng < 2) ? qrow0 : qr;
#pragma unroll
    for (int ds = 0; ds < 3; ++ds) qf[g][ds] = *(const bf16x8*)(Q + (size_t)qrc * 768 + ds * 32 + lg * 8);
#pragma unroll
    for (int i = 0; i < 4; ++i) oT[g][i] = (f32x4){zf, zf, zf, zf};
    mrun[g] = -INFINITY; lrun[g] = 0.f;
  }
  const int nt = (nkeys + 63) >> 6;
  const int r8 = lane >> 3;
  const uint32_t sch = (uint32_t)((lane & 7) ^ (((lane >> 4) + 4 * (w & 1)) & 7)) * 16u;
  const unsigned char* kn0 = (const unsigned char*)Kn + (size_t)(w * 8 + r8) * 1024 + sch;
  const unsigned char* kr0 = (const unsigned char*)Kr + (size_t)(w * 16 + (lane >> 2)) * 64 + (uint32_t)((lane & 3) ^ (((lane >> 5) & 1) << 1)) * 16u;
  const unsigned char* v0 = (const unsigned char*)VT + (size_t)(w * 8 + r8) * ldv * 2 + sch;
  const size_t v32 = (size_t)32 * ldv * 2;
  unsigned char* sw = smem + w * 1024;
#define ATT_STAGE(kt_)                                                                                                  \
  {                                                                                                                     \
    unsigned char* st_ = sw + ((kt_) % 3) * 20480;                                                                      \
    const size_t kb_ = (size_t)(kt_) * 64;                                                                              \
    __builtin_amdgcn_global_load_lds((const unsigned*)(kn0 + kb_ * 1024), (unsigned*)(st_), 16, 0, 0);                  \
    __builtin_amdgcn_global_load_lds((const unsigned*)(kn0 + kb_ * 1024 + 32768), (unsigned*)(st_ + 4096), 16, 0, 0);   \
    __builtin_amdgcn_global_load_lds((const unsigned*)(kr0 + kb_ * 64), (unsigned*)(st_ + 8192), 16, 0, 0);             \
    __builtin_amdgcn_global_load_lds((const unsigned*)(v0 + kb_ * 2), (unsigned*)(st_ + 12288), 16, 0, 0);              \
    __builtin_amdgcn_global_load_lds((const unsigned*)(v0 + v32 + kb_ * 2), (unsigned*)(st_ + 12288 + 4096), 16, 0, 0); \
  }
  ATT_STAGE(0);
  if (nt > 1) ATT_STAGE(1);
  const int pk0 = (lg ^ (li >> 1)) * 16;
  const int pkr = (lg ^ (((li >> 3) & 1) << 1)) * 16;
  const int pv0 = ((lg >> 1) ^ (li >> 1)) * 16 + (lg & 1) * 8;
  for (int kt = 0; kt < nt; ++kt) {
    if (kt + 1 < nt) asm volatile("s_waitcnt vmcnt(5)" ::: "memory");
    else asm volatile("s_waitcnt vmcnt(0)" ::: "memory");
    __builtin_amdgcn_s_barrier();
    asm volatile("" ::: "memory");
    if (kt + 2 < nt) ATT_STAGE(kt + 2);
    const unsigned char* st = smem + (kt % 3) * 20480;
    const bool tail = (kt == nt - 1) && (nkeys & 63);
    const bool two = (ng == 2);
    const bool g0on = !(two && kt == nt - 1);
    f32x4 sT[2][4];
#pragma unroll
    for (int kb = 0; kb < 4; ++kb) {
      const unsigned char* kr_ = st + (kb * 16 + li) * 128;
      const bf16x8 k0 = *(const bf16x8*)(kr_ + pk0), k1 = *(const bf16x8*)(kr_ + (pk0 ^ 64)), k2 = *(const bf16x8*)(st + 8192 + (kb * 16 + li) * 64 + pkr);
      sT[0][kb] = (f32x4){zf, zf, zf, zf};
      sT[1][kb] = (f32x4){zf, zf, zf, zf};
      if (g0on) {
        sT[0][kb] = mfma16(k0, qf[0][0], sT[0][kb]);
        sT[0][kb] = mfma16(k1, qf[0][1], sT[0][kb]);
        sT[0][kb] = mfma16(k2, qf[0][2], sT[0][kb]);
      }
      if (two) {
        sT[1][kb] = mfma16(k0, qf[1][0], sT[1][kb]);
        sT[1][kb] = mfma16(k1, qf[1][1], sT[1][kb]);
        sT[1][kb] = mfma16(k2, qf[1][2], sT[1][kb]);
      }
    }
    bf16x8 pf[2][2];
#pragma unroll
    for (int g = 0; g < 2; ++g) {
      if (g == 0 ? g0on : two) {
        if (tail) {
#pragma unroll
          for (int kb = 0; kb < 4; ++kb)
#pragma unroll
            for (int r = 0; r < 4; ++r)
              if (kt * 64 + kb * 16 + 4 * lg + r >= nkeys) sT[g][kb][r] = -INFINITY;
        }
        float mx = sT[g][0][0];
#pragma unroll
        for (int kb = 0; kb < 4; ++kb)
#pragma unroll
          for (int r = 0; r < 4; ++r) mx = fmaxf(mx, sT[g][kb][r]);
        mx = fmaxf(mx, __shfl_xor(mx, 16));
        mx = fmaxf(mx, __shfl_xor(mx, 32));
        const float mnew = fmaxf(mrun[g], mx);
        const float alpha = __builtin_amdgcn_exp2f(mrun[g] - mnew);
        mrun[g] = mnew;
        float ps = 0.f;
#pragma unroll
        for (int kb = 0; kb < 4; ++kb)
#pragma unroll
          for (int r = 0; r < 4; ++r) { const float pv = __builtin_amdgcn_exp2f(sT[g][kb][r] - mnew); sT[g][kb][r] = pv; ps += pv; }
        lrun[g] = lrun[g] * alpha + ps;
#pragma unroll
        for (int vb = 0; vb < 4; ++vb) oT[g][vb] *= alpha;
      }
#pragma unroll
      for (int s2 = 0; s2 < 2; ++s2)
        pf[g][s2] = mk8(pack2(sT[g][2 * s2][0], sT[g][2 * s2][1]), pack2(sT[g][2 * s2][2], sT[g][2 * s2][3]),
                        pack2(sT[g][2 * s2 + 1][0], sT[g][2 * s2 + 1][1]), pack2(sT[g][2 * s2 + 1][2], sT[g][2 * s2 + 1][3]));
    }
#pragma unroll
    for (int s2 = 0; s2 < 2; ++s2) {
#pragma unroll
      for (int vb = 0; vb < 4; ++vb) {
        const unsigned char* vr_ = st + 12288 + (vb * 16 + li) * 128;
        const uint2 lo = *(const uint2*)(vr_ + (pv0 ^ (s2 * 64)));
        const uint2 hi = *(const uint2*)(vr_ + (pv0 ^ (s2 * 64) ^ 32));
        const bf16x8 vfr = mk8(lo, hi);
        if (g0on) oT[0][vb] = mfma16(vfr, pf[0][s2], oT[0][vb]);
        if (two) oT[1][vb] = mfma16(vfr, pf[1][s2], oT[1][vb]);
      }
    }
  }
#pragma unroll
  for (int g = 0; g < 2; ++g) {
    float lr = lrun[g];
    lr += __shfl_xor(lr, 16);
    lr += __shfl_xor(lr, 32);
    const float inv = 1.f / lr;
    const bool st_ok = g == 0 ? (ql < nq) : (ng == 2);
    if (st_ok) {
#pragma unroll
      for (int vb = 0; vb < 4; ++vb) {
        const f32x4 o = oT[g][vb] * inv;
        *(uint2*)(O + (size_t)(qrow0 + g * 64 + ql) * 512 + vb * 16 + 4 * lg) = make_uint2(pack2(o[0], o[1]), pack2(o[2], o[3]));
      }
    }
  }
  __syncthreads();
}

DEVI void hgrn_item(const int TIDX, const int BIDX, const int GDIM, KAP KA, unsigned char* WSB, float* OUTB, int l, int g0, int nchunks, int h, const float* __restrict__ S0, float* __restrict__ Sout, int rowbase,
                    unsigned char* smem) {
  constexpr int STG = 35840;
  const unsigned char* QT = WSB + O_QT;
  const unsigned char* KHT = WSB + O_KHT;
  const unsigned char* AM = WSB + O_AM;
  const unsigned char* EBp = WSB + O_EB;
  const unsigned char* VT2 = WSB + O_VT2;
  const unsigned char* G = WSB + O_G;
  bf16_t* HO = (bf16_t*)(WSB + O_HO);
  const float* hgn = PIN(I_HGN) + l * 512 + h * 128;
  float* sred = (float*)(smem + SMEM_GEMM);
  const int tid = TIDX, lane = tid & 63, w = tid >> 6, c = lane & 31, hh = lane >> 5;
  const int dvg = 32 * w + c;
  f32x16 S[4];
#pragma unroll
  for (int kt = 0; kt < 4; ++kt)
#pragma unroll
    for (int r = 0; r < 16; ++r) S[kt][r] = S0 ? S0[(size_t)(32 * kt + (r & 3) + 8 * (r >> 2) + 4 * hh) * 128 + dvg] : 0.f;
  float4 gn[4];
#pragma unroll
  for (int q = 0; q < 4; ++q) gn[q] = *(const float4*)(hgn + 32 * w + 8 * q + 4 * hh);
  const uint32_t lo16 = (uint32_t)lane * 16u;
  const uint32_t goff = (uint32_t)(w * 4 + (lane >> 4)) * 1024u + (uint32_t)h * 256u + (uint32_t)(lane & 15) * 16u;
#define HG_STAGE(ch_)                                                                                                                  \
  {                                                                                                                                    \
    unsigned char* st_ = smem + ((ch_) & 1) * STG + w * 1024;                                                                          \
    const size_t cid_ = (size_t)(g0 + (ch_)) * 4 + h;                                                                                  \
    const size_t grow_ = ((size_t)rowbase + (size_t)(ch_) * 32) * 1024;                                                                \
    __builtin_amdgcn_global_load_lds((const unsigned*)(QT + cid_ * 8192 + w * 1024 + lo16), (unsigned*)(st_), 16, 0, 0);              \
    __builtin_amdgcn_global_load_lds((const unsigned*)(QT + cid_ * 8192 + 4096 + w * 1024 + lo16), (unsigned*)(st_ + 4096), 16, 0, 0); \
    __builtin_amdgcn_global_load_lds((const unsigned*)(KHT + cid_ * 8192 + w * 1024 + lo16), (unsigned*)(st_ + 8192), 16, 0, 0);       \
    __builtin_amdgcn_global_load_lds((const unsigned*)(KHT + cid_ * 8192 + 4096 + w * 1024 + lo16), (unsigned*)(st_ + 12288), 16, 0, 0); \
    __builtin_amdgcn_global_load_lds((const unsigned*)(VT2 + cid_ * 8192 + w * 1024 + lo16), (unsigned*)(st_ + 16384), 16, 0, 0);      \
    __builtin_amdgcn_global_load_lds((const unsigned*)(VT2 + cid_ * 8192 + 4096 + w * 1024 + lo16), (unsigned*)(st_ + 20480), 16, 0, 0); \
    __builtin_amdgcn_global_load_lds((const unsigned*)(G + grow_ + goff), (unsigned*)(st_ + 24576), 16, 0, 0);                         \
    __builtin_amdgcn_global_load_lds((const unsigned*)(G + grow_ + 16384 + goff), (unsigned*)(st_ + 28672), 16, 0, 0);                 \
    if (w < 2) __builtin_amdgcn_global_load_lds((const unsigned*)(AM + cid_ * 2048 + w * 1024 + lo16), (unsigned*)(st_ + 32768), 16, 0, 0); \
    else if (w == 2) __builtin_amdgcn_global_load_lds((const unsigned*)(EBp + cid_ * 512 + lo16), (unsigned*)(smem + ((ch_) & 1) * STG + 34816), 16, 0, 0); \
  }
  HG_STAGE(0);
  for (int ch = 0; ch < nchunks; ++ch) {
    asm volatile("s_waitcnt vmcnt(0)" ::: "memory");
    __builtin_amdgcn_s_barrier();
    asm volatile("" ::: "memory");
    if (ch + 1 < nchunks) HG_STAGE(ch + 1);
    const unsigned char* st = smem + (ch & 1) * STG;
    bf16x8 vf[2], af[2];
#pragma unroll
    for (int s2 = 0; s2 < 2; ++s2) {
      vf[s2] = *(const bf16x8*)(st + 16384 + dvg * 64 + 32 * s2 + 16 * hh);
      af[s2] = *(const bf16x8*)(st + 32768 + c * 64 + 32 * s2 + 16 * hh);
    }
    f32x16 oT;
    const float zf = zero_f();
#pragma unroll
    for (int r = 0; r < 16; ++r) oT[r] = zf;
#pragma unroll
    for (int kt = 0; kt < 4; ++kt) {
#pragma unroll
      for (int s2 = 0; s2 < 2; ++s2) {
        const uint2 lo = *(const uint2*)(st + c * 256 + 64 * kt + 32 * s2 + 8 * hh);
        const uint2 hi = *(const uint2*)(st + c * 256 + 64 * kt + 32 * s2 + 16 + 8 * hh);
        const bf16x8 sa = mk8(pack2(S[kt][8 * s2 + 0], S[kt][8 * s2 + 1]), pack2(S[kt][8 * s2 + 2], S[kt][8 * s2 + 3]),
                              pack2(S[kt][8 * s2 + 4], S[kt][8 * s2 + 5]), pack2(S[kt][8 * s2 + 6], S[kt][8 * s2 + 7]));
        oT = mfma32(sa, mk8(lo, hi), oT);
      }
    }
#pragma unroll
    for (int s2 = 0; s2 < 2; ++s2) oT = mfma32(vf[s2], af[s2], oT);
#pragma unroll
    for (int kt = 0; kt < 4; ++kt) {
#pragma unroll
      for (int q = 0; q < 4; ++q) {
        const float4 e = *(const float4*)(st + 34816 + (32 * kt + 8 * q + 4 * hh) * 4);
        S[kt][4 * q + 0] *= e.x; S[kt][4 * q + 1] *= e.y; S[kt][4 * q + 2] *= e.z; S[kt][4 * q + 3] *= e.w;
      }
#pragma unroll
      for (int s2 = 0; s2 < 2; ++s2) {
        const bf16x8 kf = *(const bf16x8*)(st + 8192 + (32 * kt + c) * 64 + 32 * s2 + 16 * hh);
        S[kt] = mfma32(kf, vf[s2], S[kt]);
      }
    }
    float ss = 0.f;
#pragma unroll
    for (int r = 0; r < 16; ++r) ss += oT[r] * oT[r];
    ss += __shfl_xor(ss, 32);
    float* sr = sred + (ch & 1) * 128;
    if (lane < 32) sr[w * 32 + c] = ss;
    asm volatile("s_waitcnt lgkmcnt(0)" ::: "memory");
    __builtin_amdgcn_s_barrier();
    asm volatile("" ::: "memory");
    const float tot = sr[c] + sr[32 + c] + sr[64 + c] + sr[96 + c];
    const float rs = rsqrtf(tot * (1.f / 128.f) + EPS);
    const size_t row = (size_t)rowbase + ch * 32 + c;
#pragma unroll
    for (int q = 0; q < 4; ++q) {
      const int dv0 = 32 * w + 8 * q + 4 * hh;
      const uint2 gp = *(const uint2*)(st + 24576 + c * 256 + dv0 * 2);
      const float o0 = oT[4 * q + 0] * rs * gn[q].x * siluf_(lo2f(gp.x));
      const float o1 = oT[4 * q + 1] * rs * gn[q].y * siluf_(hi2f(gp.x));
      const float o2 = oT[4 * q + 2] * rs * gn[q].z * siluf_(lo2f(gp.y));
      const float o3 = oT[4 * q + 3] * rs * gn[q].w * siluf_(hi2f(gp.y));
      *(uint2*)(HO + row * 512 + h * 128 + dv0) = make_uint2(pack2(o0, o1), pack2(o2, o3));
    }
  }
#pragma unroll
  for (int kt = 0; kt < 4; ++kt)
#pragma unroll
    for (int r = 0; r < 16; ++r) Sout[(size_t)(32 * kt + (r & 3) + 8 * (r >> 2) + 4 * hh) * 128 + dvg] = S[kt][r];
  __syncthreads();
}

DEVI void phase_p4(const int TIDX, const int BIDX, const int GDIM, KAP KA, unsigned char* WSB, float* OUTB, int l, unsigned char* smem, int dup = 0) {
  const int q = BIDX & 7;
  int* qctr = (int*)(WSB + O_CNT) + 128 + l * 8 + q + 16 * dup;
  int* sitem = (int*)(smem + SMEM_GEMM + 1024);
  const bf16_t* QB = (const bf16_t*)(WSB + O_QB);
  bf16_t* AO = (bf16_t*)(WSB + O_AO);
  const int total = 16 + 16 + 512 + 8;
  for (;;) {
    if (TIDX == 0) *sitem = atomicAdd(qctr, 1);
    __syncthreads();
    const int it = *sitem;
    __syncthreads();
    if (it >= total) break;
    if (it < 16) {
      const int i2 = q * 16 + it, b = i2 >> 2, h = i2 & 3;
      hgrn_item(TIDX, BIDX, GDIM, KA, WSB, OUTB, l, b * 64, 64, h, nullptr, OUTB + OUT_ST_P + ((size_t)(l * 32 + b) * 4 + h) * 16384, b * 2048, smem);
    } else if (it < 32) {
      const int b = it - 16, h = q;
      attn_item(TIDX, BIDX, GDIM, QB + h * 96, TP + b * 32, 32, 1, (const bf16_t*)(WSB + O_KNS) + (size_t)b * KPAD * 512 + h * 64,
                (const bf16_t*)(WSB + O_KRS) + ((size_t)l * 16 + b) * KPAD * 32,
                (const bf16_t*)(WSB + O_VTS) + (size_t)(b * 8 + h) * 64 * KPAD, KPAD, 4128, AO + h * 64, smem);
    } else if (it < 32 + 512) {
      const int jj = it - 32, b = jj >> 4, cp = 15 - (jj & 15), h = q;
      attn_item(TIDX, BIDX, GDIM, QB + h * 96, b * 2048 + cp * 128, 64, 2, (const bf16_t*)(WSB + O_KN) + (size_t)b * 2048 * 512 + h * 64,
                (const bf16_t*)(WSB + O_KRB) + (size_t)b * 2048 * 32,
                (const bf16_t*)(WSB + O_VT) + (size_t)(b * 8 + h) * 64 * 2048, 2048, 128 * (cp + 1), AO + h * 64, smem);
    } else {
      const int i2 = q * 8 + (it - 32 - 512), b = i2 >> 2, h = i2 & 3;
      hgrn_item(TIDX, BIDX, GDIM, KA, WSB, OUTB, l, 2048 + b, 1, h, PIN(I_ST) + ((size_t)(l * 16 + b) * 4 + h) * 16384,
                OUTB + OUT_ST_S + ((size_t)(l * 16 + b) * 4 + h) * 16384, TP + b * 32, smem);
    }
  }
}

DEVI void phase_p5(const int TIDX, const int BIDX, const int GDIM, KAP KA, unsigned char* WSB, float* OUTB, int l, unsigned char* smem) {
  const bf16_t* XB = (const bf16_t*)(WSB + O_XB);
  const bf16_t* AO = (const bf16_t*)(WSB + O_AO);
  const bf16_t* HO = (const bf16_t*)(WSB + O_HO);
  const bf16_t* W = (const bf16_t*)(WSB + O_WS) + (size_t)l * WO_END;
  bf16_t* MG = (bf16_t*)(WSB + O_MG);
  for (int item = (BIDX & 7) * (GDIM >> 3) + (BIDX >> 3); item < 516 * 8; item += GDIM) {
    const int mt = item >> 3, nt = item & 7, m0 = mt * 128, n0 = nt * 128;
    f32x4 acc[4][4];
    bf16_t* TMP = (bf16_t*)(WSB + O_G);
    RowLin rx{(const unsigned char*)(XB + (size_t)m0 * 1024), 2048};
    RowLin ra{(const unsigned char*)(AO + (size_t)m0 * 512), 1024};
    RowLin ro{(const unsigned char*)(HO + (size_t)m0 * 512), 1024};
    zero_acc(acc);
    gemm_main<true>(TIDX, BIDX, GDIM, acc, rx, W + WO_G + (size_t)n0 * 1024, 1024, 1024, smem);
    EPI_SWAP_BEGIN(m0, n0)
      const f32x4 a = acc[mi][ni];
      *(uint2*)(MG + (size_t)row * 1024 + col) = make_uint2(pack2(sigmoidf_(a[0]), sigmoidf_(a[1])), pack2(sigmoidf_(a[2]), sigmoidf_(a[3])));
    EPI_END
    zero_acc(acc);
    gemm_main<true>(TIDX, BIDX, GDIM, acc, rx, W + WO_G + (size_t)(1024 + n0) * 1024, 1024, 1024, smem);
    EPI_SWAP_BEGIN(m0, n0)
      const f32x4 a = acc[mi][ni];
      *(uint2*)(TMP + (size_t)row * 1024 + col) = make_uint2(pack2(sigmoidf_(a[0]), sigmoidf_(a[1])), pack2(sigmoidf_(a[2]), sigmoidf_(a[3])));
    EPI_END
    zero_acc(acc);
    gemm_main<true>(TIDX, BIDX, GDIM, acc, ra, W + WO_BRA + (size_t)n0 * 512, 512, 512, smem);
    EPI_SWAP_BEGIN(m0, n0)
      const f32x4 a = acc[mi][ni];
      const uint2 g = *(const uint2*)(MG + (size_t)row * 1024 + col);
      *(uint2*)(MG + (size_t)row * 1024 + col) = make_uint2(pack2(a[0] * lo2f(g.x), a[1] * hi2f(g.x)), pack2(a[2] * lo2f(g.y), a[3] * hi2f(g.y)));
    EPI_END
    zero_acc(acc);
    gemm_main<true>(TIDX, BIDX, GDIM, acc, ro, W + WO_BRB + (size_t)n0 * 512, 512, 512, smem);
    EPI_SWAP_BEGIN(m0, n0)
      const f32x4 a = acc[mi][ni];
      const uint2 g = *(const uint2*)(TMP + (size_t)row * 1024 + col), m = *(const uint2*)(MG + (size_t)row * 1024 + col);
      const float o0 = lo2f(m.x) + a[0] * lo2f(g.x), o1 = hi2f(m.x) + a[1] * hi2f(g.x), o2 = lo2f(m.y) + a[2] * lo2f(g.y), o3 = hi2f(m.y) + a[3] * hi2f(g.y);
      *(uint2*)(MG + (size_t)row * 1024 + col) = make_uint2(pack2(o0, o1), pack2(o2, o3));
    EPI_END
  }
}

DEVI void phase_p6(const int TIDX, const int BIDX, const int GDIM, KAP KA, unsigned char* WSB, float* OUTB, int l, unsigned char* smem) {
  const bf16_t* MG = (const bf16_t*)(WSB + O_MG);
  const bf16_t* W = (const bf16_t*)(WSB + O_WS) + (size_t)l * WO_END + WO_OUT;
  float* PRE = (float*)(WSB + O_PRE);
  for (int item = (BIDX & 7) * (GDIM >> 3) + (BIDX >> 3); item < 516 * 8; item += GDIM) {
    const int mt = item >> 3, nt = item & 7, m0 = mt * 128, n0 = nt * 128;
    f32x4 acc[4][4];
    zero_acc(acc);
    RowLin rp{(const unsigned char*)(MG + (size_t)m0 * 1024), 2048};
    gemm_main<true>(TIDX, BIDX, GDIM, acc, rp, W + (size_t)n0 * 1024, 1024, 1024, smem);
    EPI_SWAP_BEGIN(m0, n0)
      const f32x4 x = *(const f32x4*)(OUTB + (size_t)row * 1024 + col);
      *(f32x4*)(PRE + (size_t)row * 1024 + col) = x * DN_ALPHA + acc[mi][ni];
    EPI_END
  }
}

DEVI void phase_p7(const int TIDX, const int BIDX, const int GDIM, KAP KA, unsigned char* WSB, float* OUTB, int l, unsigned char* smem) {
  const int tid = TIDX, lane = tid & 63;
  {
    const float* PRE = (const float*)(WSB + O_PRE);
    bf16_t* XB = (bf16_t*)(WSB + O_XB);
    const float* WR = (const float*)(WSB + O_WR) + (size_t)l * 36 * 1024;
    int* cnt = (int*)(WSB + O_CNT) + l * 32;
    int* ltok = (int*)(WSB + O_LTOK);
    float* lw = (float*)(WSB + O_LW);
    const float* g1 = PIN(I_LN1G) + l * 1024; const float* b1 = PIN(I_LN1B) + l * 1024;
    const int wid = BIDX * 4 + (tid >> 6), nw = GDIM * 4;
    for (int r4 = wid; r4 < NTOK / 4; r4 += nw) {
      float4 v[4][4];
#pragma unroll
      for (int t = 0; t < 4; ++t) {
        const size_t row = (size_t)r4 * 4 + t;
#pragma unroll
        for (int j = 0; j < 4; ++j) v[t][j] = *(const float4*)(PRE + row * 1024 + j * 256 + lane * 4);
        ln_inplace(v[t], g1, b1, lane);
        store_row(v[t], OUTB + row * 1024, XB + row * 1024, lane);
      }
      float mine[4] = {0.f, 0.f, 0.f, 0.f};
      for (int c = 0; c < 36; ++c) {
        float4 wv[4];
#pragma unroll
        for (int j = 0; j < 4; ++j) wv[j] = *(const float4*)(WR + c * 1024 + j * 256 + lane * 4);
#pragma unroll
        for (int t = 0; t < 4; ++t) {
          float s = 0.f;
#pragma unroll
          for (int j = 0; j < 4; ++j) s += v[t][j].x * wv[j].x + v[t][j].y * wv[j].y + v[t][j].z * wv[j].z + v[t][j].w * wv[j].w;
          s = wave_sum(s);
          if (lane == c) mine[t] = s;
        }
      }
#pragma unroll
      for (int t = 0; t < 4; ++t) {
        const int tok = r4 * 4 + t;
        float gl[4];
#pragma unroll
        for (int j = 0; j < 4; ++j) gl[j] = __shfl(mine[t], j);
        int gi = 0; float gm = gl[0];
#pragma unroll
        for (int j = 1; j < 4; ++j) if (gl[j] > gm) { gm = gl[j]; gi = j; }
        float gs = 0.f;
#pragma unroll
        for (int j = 0; j < 4; ++j) gs += expf(gl[j] - gm);
        const float gtop = 1.f / gs;
        float el[8];
#pragma unroll
        for (int j = 0; j < 8; ++j) el[j] = __shfl(mine[t], 4 + gi * 8 + j);
        float em = el[0];
#pragma unroll
        for (int j = 1; j < 8; ++j) em = fmaxf(em, el[j]);
        float pe[8], es = 0.f;
#pragma unroll
        for (int j = 0; j < 8; ++j) { pe[j] = expf(el[j] - em); es += pe[j]; }
#pragma unroll
        for (int j = 0; j < 8; ++j) pe[j] = pe[j] / es;
        int i1 = 0; float p1 = pe[0];
#pragma unroll
        for (int j = 1; j < 8; ++j) if (pe[j] > p1) { p1 = pe[j]; i1 = j; }
        int i2 = -1; float p2 = -1.f;
#pragma unroll
        for (int j = 0; j < 8; ++j) if (j != i1 && pe[j] > p2) { p2 = pe[j]; i2 = j; }
        const float den = p1 + p2;
        if (lane == 0) {
          const int e1 = gi * 8 + i1, e2 = gi * 8 + i2;
          const int s1 = atomicAdd(cnt + e1, 1);
          ltok[(size_t)e1 * NTOK + s1] = tok * 2;
          lw[(size_t)e1 * NTOK + s1] = gtop * (p1 / den);
          const int s2 = atomicAdd(cnt + e2, 1);
          ltok[(size_t)e2 * NTOK + s2] = tok * 2 + 1;
          lw[(size_t)e2 * NTOK + s2] = gtop * (p2 / den);
        }
      }
    }
  }
  {
    bf16_t* PLEB = (bf16_t*)(WSB + O_YM);
    const float* pp = PIN(I_PP) + (size_t)l * TP * 256;
    const float* ps = PIN(I_PS) + (size_t)l * TS * 256;
    for (size_t i = (size_t)BIDX * 256 + tid; i < (size_t)NTOK * 64; i += (size_t)GDIM * 256) {
      const size_t e = i * 4;
      const float4 v = e < (size_t)TP * 256 ? *(const float4*)(pp + e) : *(const float4*)(ps + (e - (size_t)TP * 256));
      *(uint2*)(PLEB + e) = make_uint2(pack2(v.x, v.y), pack2(v.z, v.w));
    }
  }
  {
    float* tile = (float*)smem;
    bf16_t* WE = (bf16_t*)(WSB + O_WE);
    CMap cm{0};
    for (int t = BIDX; t < 96 * 128; t += GDIM) {
      const int mat = t >> 7, tt = t & 127, kind = mat >> 5, e = mat & 31;
      const float* src = PIN(kind == 0 ? I_WE1 : (kind == 1 ? I_WE3 : I_WE2)) + ((size_t)l * 32 + e) * 524288;
      bf16_t* dst = WE + ((size_t)kind * 32 + e) * 524288;
      if (kind < 2) transpose_tile(TIDX, BIDX, GDIM, src, 512, 1024, dst, (tt & 15) * 64, (tt >> 4) * 64, cm, nullptr, tile);
      else transpose_tile(TIDX, BIDX, GDIM, src, 1024, 512, dst, (tt & 7) * 64, (tt >> 3) * 64, cm, nullptr, tile);
    }
  }
}

DEVI int moe_table(const int TIDX, const int BIDX, const int GDIM, KAP KA, unsigned char* WSB, float* OUTB, int l, int* tstart  ) {
  if (TIDX == 0) {
    const int* cnt = (const int*)(WSB + O_CNT) + l * 32;
    int acc = 0;
    for (int e = 0; e < 32; ++e) { tstart[e] = acc; acc += (cnt[e] + 127) >> 7; }
    tstart[32] = acc;
  }
  __syncthreads();
  return tstart[32];
}
DEVI int moe_find(const int* tstart, int mt) {
  int e = 0;
  for (int i = 1; i < 32; ++i) if (mt >= tstart[i]) e = i;
  return e;
}
struct RowGather {
  const unsigned char* base; const int* ltok; int pos0; int cnt;
  DEVI uint32_t operator()(int r) const {
    const int pos = pos0 + r;
    return pos < cnt ? (uint32_t)(ltok[pos] >> 1) * 2048u : (uint32_t)NTOK * 2048u;
  }
};

DEVI void phase_p8(const int TIDX, const int BIDX, const int GDIM, KAP KA, unsigned char* WSB, float* OUTB, int l, unsigned char* smem) {
  int* tstart = (int*)(smem + SMEM_GEMM + 1024 + 64);
  const int NT = moe_table(TIDX, BIDX, GDIM, KA, WSB, OUTB, l, tstart);
  const bf16_t* XB = (const bf16_t*)(WSB + O_XB);
  const bf16_t* WE = (const bf16_t*)(WSB + O_WE);
  bf16_t* H = (bf16_t*)(WSB + O_H);
  const int* cnt = (const int*)(WSB + O_CNT) + l * 32;
  const int* ltok = (const int*)(WSB + O_LTOK);
  for (int item = (BIDX & 7) * (GDIM >> 3) + (BIDX >> 3); item < NT * 4; item += GDIM) {
    const int mt = item >> 2, nt = item & 3, e = moe_find(tstart, mt), lt = mt - tstart[e];
    RowGather rg{(const unsigned char*)XB, ltok + (size_t)e * NTOK, lt * 128, cnt[e]};
    f32x4 acc[4][4];
    uint2 sg[4][4];
    zero_acc(acc);
    gemm_main<true>(TIDX, BIDX, GDIM, acc, rg, WE + ((size_t)e * 512 + nt * 128) * 1024, 1024, 1024, smem);
#pragma unroll
    for (int i = 0; i < 4; ++i)
#pragma unroll
      for (int j = 0; j < 4; ++j) sg[i][j] = make_uint2(pack2(siluf_(acc[i][j][0]), siluf_(acc[i][j][1])), pack2(siluf_(acc[i][j][2]), siluf_(acc[i][j][3])));
    zero_acc(acc);
    gemm_main<true>(TIDX, BIDX, GDIM, acc, rg, WE + ((size_t)(32 + e) * 512 + nt * 128) * 1024, 1024, 1024, smem);
    EPI_SWAP_BEGIN(mt * 128, nt * 128)
      const f32x4 a = acc[mi][ni];
      const uint2 g = sg[mi][ni];
      *(uint2*)(H + (size_t)row * 512 + col) = make_uint2(pack2(a[0] * lo2f(g.x), a[1] * hi2f(g.x)), pack2(a[2] * lo2f(g.y), a[3] * hi2f(g.y)));
    EPI_END
  }
  {
    const bf16_t* W = (const bf16_t*)(WSB + O_WS) + (size_t)l * WO_END;
    float* PRE = (float*)(WSB + O_PRE);
    for (int item = (BIDX & 7) * (GDIM >> 3) + (BIDX >> 3); item < 516 * 8; item += GDIM) {
      const int mt = item >> 3, nt = item & 7, m0 = mt * 128, n0 = nt * 128;
      f32x4 acc[4][4];
      uint2 gp[4][4];
      zero_acc(acc);
      RowLin rx{(const unsigned char*)(XB + (size_t)m0 * 1024), 2048};
      gemm_main<true>(TIDX, BIDX, GDIM, acc, rx, W + WO_PG + (size_t)n0 * 1024, 1024, 1024, smem);
#pragma unroll
      for (int i = 0; i < 4; ++i)
#pragma unroll
        for (int j = 0; j < 4; ++j) gp[i][j] = make_uint2(pack2(sigmoidf_(acc[i][j][0]), sigmoidf_(acc[i][j][1])), pack2(sigmoidf_(acc[i][j][2]), sigmoidf_(acc[i][j][3])));
      zero_acc(acc);
      RowLin rpl{(const unsigned char*)((const bf16_t*)(WSB + O_YM) + (size_t)m0 * 256), 512};
      gemm_main<true>(TIDX, BIDX, GDIM, acc, rpl, W + WO_PLE + (size_t)n0 * 256, 256, 256, smem);
      EPI_SWAP_BEGIN(m0, n0)
        const f32x4 x = *(const f32x4*)(OUTB + (size_t)row * 1024 + col);
        const f32x4 a = acc[mi][ni];
        const uint2 g = gp[mi][ni];
        f32x4 o;
        o[0] = x[0] * DN_ALPHA + a[0] * lo2f(g.x); o[1] = x[1] * DN_ALPHA + a[1] * hi2f(g.x);
        o[2] = x[2] * DN_ALPHA + a[2] * lo2f(g.y); o[3] = x[3] * DN_ALPHA + a[3] * hi2f(g.y);
        *(f32x4*)(PRE + (size_t)row * 1024 + col) = o;
      EPI_END
    }
  }
}

DEVI void phase_p9(const int TIDX, const int BIDX, const int GDIM, KAP KA, unsigned char* WSB, float* OUTB, int l, unsigned char* smem) {
  int* tstart = (int*)(smem + SMEM_GEMM + 1024 + 64);
  const int NT = moe_table(TIDX, BIDX, GDIM, KA, WSB, OUTB, l, tstart);
  const bf16_t* WE = (const bf16_t*)(WSB + O_WE) + 64ull * 524288;
  const bf16_t* H = (const bf16_t*)(WSB + O_H);
  bf16_t* YM = (bf16_t*)(WSB + O_YM);
  const int* cnt = (const int*)(WSB + O_CNT) + l * 32;
  const int* ltok = (const int*)(WSB + O_LTOK);
  const float* lw = (const float*)(WSB + O_LW);
  for (int item = (BIDX & 7) * (GDIM >> 3) + (BIDX >> 3); item < NT * 8; item += GDIM) {
    const int mt = item >> 3, nt = item & 7, e = moe_find(tstart, mt), lt = mt - tstart[e], ce = cnt[e];
    f32x4 acc[4][4];
    zero_acc(acc);
    RowLin rp{(const unsigned char*)(H + (size_t)mt * 128 * 512), 1024};
    gemm_main<true>(TIDX, BIDX, GDIM, acc, rp, WE + ((size_t)e * 1024 + nt * 128) * 512, 512, 512, smem);
    EPI_SWAP_BEGIN(0, nt * 128)
      const int pos = lt * 128 + row;
      if (pos < ce) {
        const int tk = ltok[(size_t)e * NTOK + pos];
        const float wt = lw[(size_t)e * NTOK + pos];
        const f32x4 a = acc[mi][ni] * wt;
        *(uint2*)(YM + (size_t)tk * 1024 + col) = make_uint2(pack2(a[0], a[1]), pack2(a[2], a[3]));
      }
    EPI_END
  }
}

DEVI void phase_p10(const int TIDX, const int BIDX, const int GDIM, KAP KA, unsigned char* WSB, float* OUTB, int l) {
  const int tid = TIDX, lane = tid & 63;
  const float* PRE = (const float*)(WSB + O_PRE);
  const bf16_t* YM = (const bf16_t*)(WSB + O_YM);
  bf16_t* XB = (bf16_t*)(WSB + O_XB);
  const float* g2 = PIN(I_LN2G) + l * 1024; const float* b2 = PIN(I_LN2B) + l * 1024;
  const int wid = BIDX * 4 + (tid >> 6), nw = GDIM * 4;
  for (int row = wid; row < NTOK; row += nw) {
    float4 v[4];
#pragma unroll
    for (int j = 0; j < 4; ++j) {
      v[j] = *(const float4*)(PRE + (size_t)row * 1024 + j * 256 + lane * 4);
      const uint2 y0 = *(const uint2*)(YM + (size_t)row * 2048 + j * 256 + lane * 4);
      const uint2 y1 = *(const uint2*)(YM + (size_t)row * 2048 + 1024 + j * 256 + lane * 4);
      v[j].x += lo2f(y0.x) + lo2f(y1.x); v[j].y += hi2f(y0.x) + hi2f(y1.x);
      v[j].z += lo2f(y0.y) + lo2f(y1.y); v[j].w += hi2f(y0.y) + hi2f(y1.y);
    }
    ln_inplace(v, g2, b2, lane);
    if (l == 0) store_row(v, OUTB + (size_t)row * 1024, XB + (size_t)row * 1024, lane);
    else {
#pragma unroll
      for (int j = 0; j < 4; ++j) *(float4*)(OUTB + (size_t)row * 1024 + j * 256 + lane * 4) = v[j];
    }
  }
}

DEVI void* launder_ptr(const void* q) {
  uint32_t lo = (uint32_t)(uintptr_t)q, hi = (uint32_t)((uintptr_t)q >> 32);
  asm volatile("" : "+v"(lo), "+v"(hi));
  lo = __builtin_amdgcn_readfirstlane(lo);
  hi = __builtin_amdgcn_readfirstlane(hi);
  return (void*)(((uintptr_t)hi << 32) | lo);
}
DEVI void grid_barrier(const int TIDX, unsigned* bar, unsigned target) {
  __syncthreads();
  if (TIDX == 0) {
    __threadfence();
    __hip_atomic_fetch_add(bar, 1u, __ATOMIC_RELAXED, __HIP_MEMORY_SCOPE_AGENT);
    unsigned spins = 0;
    while (__hip_atomic_load(bar, __ATOMIC_RELAXED, __HIP_MEMORY_SCOPE_AGENT) < target) {
      __builtin_amdgcn_s_sleep(2);
      if (++spins > (1u << 27)) break;
    }
    __threadfence();
  }
  __syncthreads();
}
__global__ void __launch_bounds__(256, 2) mega(Params p, int ph0, int ph1) {
  __shared__ __attribute__((aligned(16))) unsigned char smem[SMEM_TOTAL];
  const int wave_in_block = __builtin_amdgcn_readfirstlane((int)(__builtin_amdgcn_workitem_id_x() >> 6));
  for (int ph = ph0; ph < ph1; ++ph) {
    int wv_ = wave_in_block;
    asm volatile("" : "+s"(wv_));
    int TIDX = wv_ * 64 + (int)__lane_id();
    asm volatile("" : "+v"(TIDX));
    int BIDX = __builtin_amdgcn_workgroup_id_x(), GDIM = (int)gridDim.x;
    asm volatile("" : "+s"(BIDX), "+s"(GDIM));
    KAP KA;
    {
      uintptr_t q = (uintptr_t)__builtin_amdgcn_kernarg_segment_ptr();
      uint32_t lo = (uint32_t)q, hi = (uint32_t)(q >> 32);
      asm volatile("" : "+s"(lo), "+s"(hi));
      KA = (KAP)(((uintptr_t)hi << 32) | lo);
    }
    float* OUTB = (float*)PIN(31);
    unsigned char* WSB = (unsigned char*)PIN(32);
#ifndef PHSEL
#define PHSEL -1
#endif
    if (ph == 0) { if (PHSEL < 0 || PHSEL == 10) phase_prep(TIDX, BIDX, GDIM, KA, WSB, OUTB, smem); }
    else {
      const int l = (ph - 1) / 10, s = (ph - 1) % 10;
      switch (s) {
        case 0: if (PHSEL < 0 || PHSEL == 0) phase_p1(TIDX, BIDX, GDIM, KA, WSB, OUTB, l, smem); break;
        case 1: if (PHSEL < 0 || PHSEL == 1) phase_p2(TIDX, BIDX, GDIM, KA, WSB, OUTB, l, smem); break;
        case 2: if (PHSEL < 0 || PHSEL == 2) phase_p3(TIDX, BIDX, GDIM, KA, WSB, OUTB, l, smem); break;
        case 3: if (PHSEL < 0 || PHSEL == 3) phase_p4(TIDX, BIDX, GDIM, KA, WSB, OUTB, l, smem); break;
        case 4: if (PHSEL < 0 || PHSEL == 4) phase_p5(TIDX, BIDX, GDIM, KA, WSB, OUTB, l, smem); break;
        case 5: if (PHSEL < 0 || PHSEL == 5) phase_p6(TIDX, BIDX, GDIM, KA, WSB, OUTB, l, smem); break;
        case 6: if (PHSEL < 0 || PHSEL == 6) phase_p7(TIDX, BIDX, GDIM, KA, WSB, OUTB, l, smem); break;
        case 7: if (PHSEL < 0 || PHSEL == 7) phase_p8(TIDX, BIDX, GDIM, KA, WSB, OUTB, l, smem); break;
        case 8: if (PHSEL < 0 || PHSEL == 8) phase_p9(TIDX, BIDX, GDIM, KA, WSB, OUTB, l, smem); break;
        default: if (PHSEL < 0 || PHSEL == 9) phase_p10(TIDX, BIDX, GDIM, KA, WSB, OUTB, l); break;
      }
    }
#ifdef PROBE_DUP
    if (ph > 0 && (ph - 1) % 10 == PROBE_DUP) {
      cg::this_grid().sync();
      const int l = (ph - 1) / 10;
      switch (PROBE_DUP) {
        case 0: phase_p1(TIDX, BIDX, GDIM, KA, WSB, OUTB, l, smem); break;
        case 1: phase_p2(TIDX, BIDX, GDIM, KA, WSB, OUTB, l, smem); break;
        case 2: phase_p3(TIDX, BIDX, GDIM, KA, WSB, OUTB, l, smem); break;
        case 3: phase_p4(TIDX, BIDX, GDIM, KA, WSB, OUTB, l, smem, 1); break;
        case 4: phase_p5(TIDX, BIDX, GDIM, KA, WSB, OUTB, l, smem); break;
        case 5: phase_p6(TIDX, BIDX, GDIM, KA, WSB, OUTB, l, smem); break;
        case 7: phase_p8(TIDX, BIDX, GDIM, KA, WSB, OUTB, l, smem); break;
        case 8: phase_p9(TIDX, BIDX, GDIM, KA, WSB, OUTB, l, smem); break;
        case 9: phase_p10(TIDX, BIDX, GDIM, KA, WSB, OUTB, l); break;
        default: break;
      }
    }
#endif
    if (ph + 1 < ph1) {
      if (ph == ph0) cg::this_grid().sync();
      else grid_barrier(TIDX, (unsigned*)(WSB + O_CNT + 2048), (unsigned)(ph - ph0) * (unsigned)GDIM);
    }
  }
}

#ifndef MK_MULTI
#define MK_MULTI 0
#endif

extern "C" void kernel_launch(void* const* d_in, const int* in_sizes, int n_in, void* d_out, int out_size, void* d_ws, size_t ws_size,
                              hipStream_t stream) {
  static int grid_blocks = 0;
  if (!grid_blocks) {
    int dev = 0, cus = 0, per_cu = 0;
    hipGetDevice(&dev);
    hipDeviceGetAttribute(&cus, hipDeviceAttributeMultiprocessorCount, dev);
    hipOccupancyMaxActiveBlocksPerMultiprocessor(&per_cu, mega, 256, 0);
    if (per_cu > 2) per_cu = 2;
    if (per_cu < 1) per_cu = 1;
    grid_blocks = cus * per_cu;
  }
  Params p{};
  for (int i = 0; i < 31; ++i) p.in[i] = (const float*)d_in[i];
  p.out_ = (float*)d_out;
  p.ws_ = (unsigned char*)d_ws;
  if (ws_size < WS_END) fprintf(stderr, "workspace too small: %zu < %zu\n", ws_size, (size_t)WS_END);
#if MK_MULTI
  for (int ph = 0; ph < 21; ++ph) mega<<<dim3(grid_blocks), dim3(256), 0, stream>>>(p, ph, ph + 1);
#else
  (void)hipMemsetAsync((unsigned char*)d_ws + O_CNT + 2048, 0, 256, stream);
  int ph0 = 0, ph1 = 21;
  void* args[] = {&p, &ph0, &ph1};
  hipError_t e = hipLaunchCooperativeKernel((void*)mega, dim3(grid_blocks), dim3(256), args, 0, stream);
  if (e != hipSuccess) fprintf(stderr, "cooperative launch failed: %s (grid %d)\n", hipGetErrorString(e), grid_blocks);
#endif
}
```

```cpp
#include <hip/hip_runtime.h>
#include <hip/hip_cooperative_groups.h>
#include <stdint.h>
#include <stdio.h>
namespace cg = cooperative_groups;

#define DEVI __device__ __forceinline__
typedef unsigned short bf16_t;
typedef short bf16x8 __attribute__((ext_vector_type(8)));
typedef float f32x4 __attribute__((ext_vector_type(4)));
typedef float f32x16 __attribute__((ext_vector_type(16)));

constexpr int NTOK = 66048, TP = 65536, TS = 512;
constexpr int NCH = NTOK / 32;
constexpr int KPAD = 4160;
constexpr float DN_ALPHA = 1.4142135623730951f;
constexpr float EPS = 1e-6f;
constexpr float QSCALE = 0.10206207261596575f * 1.4426950408889634f;

constexpr size_t OUT_Y = 0;
constexpr size_t OUT_CKV_P = 67633152ull;
constexpr size_t OUT_KR_P = 101187584ull;
constexpr size_t OUT_ST_P = 105381888ull;
constexpr size_t OUT_CKV_S = 109576192ull;
constexpr size_t OUT_KR_S = 109838336ull;
constexpr size_t OUT_ST_S = 109871104ull;

constexpr size_t WO_IN = 0, WO_G = WO_IN + 2816ull * 1024, WO_UQ = WO_G + 2048ull * 1024, WO_KV = WO_UQ + 768ull * 384,
                 WO_BRA = WO_KV + 1024ull * 256, WO_BRB = WO_BRA + 1024ull * 512, WO_OUT = WO_BRB + 1024ull * 512,
                 WO_PG = WO_OUT + 1024ull * 1024, WO_PLE = WO_PG + 1024ull * 1024, WO_END = WO_PLE + 1024ull * 256;
static_assert(WO_END == 8945664ull, "small weights");

constexpr size_t al(size_t x) { return (x + 255) & ~size_t(255); }
constexpr size_t SZ_XB = (size_t)(NTOK + 1) * 1024 * 2, SZ_LIST = 32ull * NTOK * 4, SZ_KRS = 2ull * 16 * KPAD * 32 * 2,
                 SZ_G = (size_t)NTOK * 512 * 2, SZ_CQ = (size_t)NTOK * 384 * 2, SZ_CKR = (size_t)NTOK * 288 * 4,
                 SZ_FQ = (size_t)NTOK * 1024 * 2, SZ_CKVN = (size_t)NTOK * 256 * 2, SZ_KRB = (size_t)NTOK * 32 * 2,
                 SZ_QB = (size_t)NTOK * 768 * 2, SZ_AM = (size_t)NCH * 4 * 32 * 32 * 2, SZ_EB = (size_t)NCH * 4 * 128 * 4,
                 SZ_VT = 32ull * 8 * 64 * 2048 * 2, SZ_KNS = 16ull * KPAD * 512 * 2, SZ_VTS = 16ull * 8 * 64 * KPAD * 2,
                 SZ_PRE = (size_t)NTOK * 1024 * 4, SZ_WE = 3ull * 32 * 512 * 1024 * 2, SZ_H = 1064ull * 128 * 512 * 2,
                 SZ_YM = (size_t)NTOK * 2 * 1024 * 2;
constexpr size_t O_WS = 0;
constexpr size_t O_WR = O_WS + al(2 * WO_END * 2);
constexpr size_t O_ROPE = O_WR + al(2ull * 36 * 1024 * 4);
constexpr size_t O_CNT = O_ROPE + al(2080ull * 16 * 2 * 4);
constexpr size_t O_XB = O_CNT + 4096;
constexpr size_t O_LTOK = O_XB + al(SZ_XB);
constexpr size_t O_LW = O_LTOK + al(SZ_LIST);
constexpr size_t O_KRS = O_LW + al(SZ_LIST);
constexpr size_t O_G = O_KRS + al(SZ_KRS);
constexpr size_t O_VT2 = O_G + al(SZ_G);
constexpr size_t O_CQ = O_VT2 + al(SZ_G);
constexpr size_t O_CKR = O_CQ + al(SZ_CQ);
constexpr size_t O_FQ = O_CKR + al(SZ_CKR);
constexpr size_t O_CKVN = O_FQ + al(SZ_FQ);
constexpr size_t O_KRB = O_CKVN + al(SZ_CKVN);
constexpr size_t O_QB = O_KRB + al(SZ_KRB);
constexpr size_t O_QT = O_QB + al(SZ_QB);
constexpr size_t O_KHT = O_QT + al(SZ_G);
constexpr size_t O_AM = O_KHT + al(SZ_G);
constexpr size_t O_EB = O_AM + al(SZ_AM);
constexpr size_t O_KN = O_EB + al(SZ_EB);
constexpr size_t O_HO = O_KN + al(SZ_G);
constexpr size_t O_CCB = O_HO + al(SZ_G);
constexpr size_t WS_END = O_CCB + 16ull * 4096 * 256 * 2;
constexpr size_t O_VT = O_CQ;
constexpr size_t O_KNS = O_VT + al(SZ_VT);
constexpr size_t O_VTS = O_KNS + al(SZ_KNS);
constexpr size_t O_AO = O_VTS + al(SZ_VTS);
constexpr size_t O_MG = O_QB;
constexpr size_t O_PRE = O_G;
constexpr size_t O_WE = O_VTS;
constexpr size_t O_H = O_WE + al(SZ_WE);
constexpr size_t O_YM = O_H + al(SZ_H);
static_assert(O_AO + SZ_G <= O_KRB, "AO");
static_assert(O_AO >= O_VTS + SZ_VTS, "AO2");
static_assert(O_MG + SZ_XB <= O_KN, "MG");
static_assert(O_PRE + SZ_PRE <= O_WE, "PRE");
static_assert(O_YM + SZ_YM <= WS_END, "YM");
static_assert(WS_END <= (1ull << 30), "workspace");

struct Params { const float* in[31]; float* out_; unsigned char* ws_; };
typedef const __attribute__((address_space(4))) unsigned char* KAP;
#define PIN(i) (*(const float* const __attribute__((address_space(4)))*)(KA + 8 * (i)))

enum { I_XP = 0, I_XS, I_PP, I_PS, I_CCKV, I_CKR, I_ST, I_LN0G, I_LN0B, I_WIN, I_QN, I_WUQ, I_KVN, I_WUK, I_WUV, I_HGLB, I_HGN,
       I_WBRA, I_WBRB, I_WOUT, I_LN1G, I_LN1B, I_WRG, I_WRE, I_WE1, I_WE3, I_WE2, I_WPLE, I_WPG, I_LN2G, I_LN2B };

DEVI float bf2f(bf16_t h) { return __uint_as_float(((uint32_t)h) << 16); }
DEVI bf16_t f2bf(float f) { uint32_t u = __float_as_uint(f); u += 0x7fffu + ((u >> 16) & 1u); return (bf16_t)(u >> 16); }
typedef float f32x2_t __attribute__((ext_vector_type(2)));
typedef __bf16 bf16x2_t __attribute__((ext_vector_type(2)));
DEVI uint32_t pack2(float lo, float hi) { f32x2_t v = {lo, hi}; bf16x2_t b = __builtin_convertvector(v, bf16x2_t); return __builtin_bit_cast(uint32_t, b); }
DEVI float lo2f(uint32_t u) { return __uint_as_float(u << 16); }
DEVI float hi2f(uint32_t u) { return __uint_as_float(u & 0xffff0000u); }
DEVI float dpp_add_(float v, const int ctrl_sel) {
  const int iv = __float_as_int(v);
  int o;
  if (ctrl_sel == 0) o = __builtin_amdgcn_update_dpp(0, iv, 0xB1, 0xf, 0xf, true);
  else if (ctrl_sel == 1) o = __builtin_amdgcn_update_dpp(0, iv, 0x4E, 0xf, 0xf, true);
  else if (ctrl_sel == 2) o = __builtin_amdgcn_update_dpp(0, iv, 0x141, 0xf, 0xf, true);
  else o = __builtin_amdgcn_update_dpp(0, iv, 0x140, 0xf, 0xf, true);
  return v + __int_as_float(o);
}
DEVI float wave_sum(float v) {
  v = dpp_add_(v, 0);
  v = dpp_add_(v, 1);
  v = dpp_add_(v, 2);
  v = dpp_add_(v, 3);
  const int iv = __float_as_int(v);
  const float r0 = __int_as_float(__builtin_amdgcn_readlane(iv, 0)), r1 = __int_as_float(__builtin_amdgcn_readlane(iv, 16));
  const float r2 = __int_as_float(__builtin_amdgcn_readlane(iv, 32)), r3 = __int_as_float(__builtin_amdgcn_readlane(iv, 48));
  return (r0 + r1) + (r2 + r3);
}
DEVI float sigmoidf_(float x) { return 1.f / (1.f + __expf(-x)); }
DEVI float siluf_(float x) { return x / (1.f + __expf(-x)); }
DEVI f32x4 mfma16(bf16x8 a, bf16x8 b, f32x4 c) { return __builtin_amdgcn_mfma_f32_16x16x32_bf16(a, b, c, 0, 0, 0); }
DEVI f32x16 mfma32(bf16x8 a, bf16x8 b, f32x16 c) { return __builtin_amdgcn_mfma_f32_32x32x16_bf16(a, b, c, 0, 0, 0); }
DEVI bf16x8 mk8(uint32_t a, uint32_t b, uint32_t c, uint32_t d) { uint4 u = make_uint4(a, b, c, d); return *(bf16x8*)&u; }
DEVI bf16x8 mk8(uint2 lo, uint2 hi) { uint4 u = make_uint4(lo.x, lo.y, hi.x, hi.y); return *(bf16x8*)&u; }

constexpr int SMEM_GEMM = 2 * 2 * 128 * 72 * 2;
constexpr int SMEM_TOTAL = SMEM_GEMM + 2048;

template <bool SWAP, class RP>
DEVI void gemm_main(const int TIDX, const int BIDX, const int GDIM, f32x4 (&acc)[4][4], RP rowoff, const bf16_t* __restrict__ Bt, int ldb, int K, unsigned char* smem) {
  const int tid = TIDX;
  const int lane = tid & 63, w = tid >> 6, wr = w >> 1, wc = w & 1, li = lane & 15, lg = lane >> 4;
  const unsigned char* abase = rowoff.base;
  const unsigned char* bbase = (const unsigned char*)Bt;
  const uint32_t schunk = (uint32_t)((lane & 7) ^ (((lane >> 4) + 4 * (w & 1)) & 7)) * 16u;
  uint32_t ao0, ao1, ao2, ao3;
  const int rsub = w * 8 + (lane >> 3);
  ao0 = rowoff(rsub) + schunk; ao1 = rowoff(rsub + 32) + schunk; ao2 = rowoff(rsub + 64) + schunk; ao3 = rowoff(rsub + 96) + schunk;
  const uint32_t bo = (uint32_t)(rsub * ldb) * 2u + schunk, bstep = (uint32_t)(32 * ldb) * 2u;
  unsigned char* sbase = smem + w * 1024;
#define GM_STAGE(kt_, buf_)                                                                                                       \
  {                                                                                                                              \
    unsigned char* da_ = sbase + (buf_) * 32768;                                                                                 \
    unsigned char* db_ = da_ + 16384;                                                                                            \
    const uint32_t ko_ = (uint32_t)(kt_) * 128u;                                                                                 \
    __builtin_amdgcn_global_load_lds((const unsigned*)(abase + ao0 + ko_), (unsigned*)(da_), 16, 0, 0);                         \
    __builtin_amdgcn_global_load_lds((const unsigned*)(abase + ao1 + ko_), (unsigned*)(da_ + 4096), 16, 0, 0);                  \
    __builtin_amdgcn_global_load_lds((const unsigned*)(abase + ao2 + ko_), (unsigned*)(da_ + 8192), 16, 0, 0);                  \
    __builtin_amdgcn_global_load_lds((const unsigned*)(abase + ao3 + ko_), (unsigned*)(da_ + 12288), 16, 0, 0);                 \
    __builtin_amdgcn_global_load_lds((const unsigned*)(bbase + bo + ko_), (unsigned*)(db_), 16, 0, 0);                          \
    __builtin_amdgcn_global_load_lds((const unsigned*)(bbase + bo + bstep + ko_), (unsigned*)(db_ + 4096), 16, 0, 0);           \
    __builtin_amdgcn_global_load_lds((const unsigned*)(bbase + bo + 2u * bstep + ko_), (unsigned*)(db_ + 8192), 16, 0, 0);      \
    __builtin_amdgcn_global_load_lds((const unsigned*)(bbase + bo + 3u * bstep + ko_), (unsigned*)(db_ + 12288), 16, 0, 0);     \
  }
  const int nk = K >> 6;
  const int px = lg ^ (li >> 1);
  GM_STAGE(0, 0);
  for (int kt = 0; kt < nk; ++kt) {
    const int buf = kt & 1;
    asm volatile("s_waitcnt vmcnt(0)" ::: "memory");
    __syncthreads();
    if (kt + 1 < nk) GM_STAGE(kt + 1, buf ^ 1);
    const unsigned char* A = smem + buf * 32768 + (wr * 64 + li) * 128;
    const unsigned char* B = smem + buf * 32768 + 16384 + (wc * 64 + li) * 128;
#pragma unroll
    for (int ks = 0; ks < 2; ++ks) {
      const int po = (px ^ (ks * 4)) * 16;
      bf16x8 af[4], bfr[4];
#pragma unroll
      for (int i = 0; i < 4; ++i) {
        af[i] = *(const bf16x8*)(A + i * 2048 + po);
        bfr[i] = *(const bf16x8*)(B + i * 2048 + po);
      }
#pragma unroll
      for (int mi = 0; mi < 4; ++mi)
#pragma unroll
        for (int ni = 0; ni < 4; ++ni)
          acc[mi][ni] = SWAP ? mfma16(bfr[ni], af[mi], acc[mi][ni]) : mfma16(af[mi], bfr[ni], acc[mi][ni]);
    }
  }
  __syncthreads();
}
DEVI float zero_f() { float z = 0.f; asm volatile("" : "+v"(z)); return z; }
DEVI void zero_acc(f32x4 (&acc)[4][4]) {
  const float z = zero_f();
#pragma unroll
  for (int i = 0; i < 4; ++i)
#pragma unroll
    for (int j = 0; j < 4; ++j) acc[i][j] = (f32x4){z, z, z, z};
}
#define EPI_SWAP_BEGIN(m0, n0)                                                                     \
  {                                                                                                \
    const int _lane = TIDX & 63, _w = TIDX >> 6;                                     \
    const int _rb = (m0) + (_w >> 1) * 64 + (_lane & 15), _cb = (n0) + (_w & 1) * 64 + 4 * (_lane >> 4); \
    _Pragma("unroll") for (int mi = 0; mi < 4; ++mi) {                                             \
      const int row = _rb + mi * 16;                                                               \
      _Pragma("unroll") for (int ni = 0; ni < 4; ++ni) {                                           \
        const int col = _cb + ni * 16;
#define EPI_END } __builtin_amdgcn_sched_barrier(0); } }

struct RowLin {
  const unsigned char* base; uint32_t stride;
  DEVI uint32_t operator()(int r) const { return (uint32_t)r * stride; }
};

struct CMap {
  int mode;
  DEVI int operator()(int n) const {
    if (mode == 0) return n;
    if (mode == 1) return n < 672 ? n : (n < 768 ? -1 : n - 96);
    if (mode == 2) return n + 2720;
    if (n < 512) return (n >> 6) * 96 + (n & 63);
    const int m = n - 512, h = m >> 5, w = m & 31;
    return h * 96 + (w < 16 ? 64 + w : 80 + (w - 16));
  }
};
DEVI void transpose_tile(const int TIDX, const int BIDX, const int GDIM, const float* __restrict__ src, int ld, int K, bf16_t* __restrict__ dst, int k0, int n0, CMap cm,
                         const float* kscale, float* tile) {
  const int t = TIDX;
  {
    const int n4 = (t & 15) * 4, kr = t >> 4;
    const int sc = cm(n0 + n4);
#pragma unroll
    for (int p = 0; p < 4; ++p) {
      const int k = kr + 16 * p;
      float4 v = make_float4(0.f, 0.f, 0.f, 0.f);
      if (sc >= 0) {
        v = *(const float4*)(src + (size_t)(k0 + k) * ld + sc);
        if (kscale) { const float sck = kscale[k0 + k]; v.x *= sck; v.y *= sck; v.z *= sck; v.w *= sck; }
      }
      float* d = tile + k * 65 + n4;
      d[0] = v.x; d[1] = v.y; d[2] = v.z; d[3] = v.w;
    }
  }
  __syncthreads();
  {
    const int kc = (t & 7) * 8, nr = t >> 3;
#pragma unroll
    for (int q = 0; q < 2; ++q) {
      const int n = nr + 32 * q;
      const float* sp = tile + kc * 65 + n;
      const uint4 o = make_uint4(pack2(sp[0], sp[65]), pack2(sp[130], sp[195]), pack2(sp[260], sp[325]), pack2(sp[390], sp[455]));
      *(uint4*)(dst + (size_t)(n0 + n) * K + k0 + kc) = o;
    }
  }
  __syncthreads();
}
DEVI void run_transpose(const int TIDX, const int BIDX, const int GDIM, const float* src, int ld, int K, int N, bf16_t* dst, int mode, const float* kscale, float* tile) {
  const int nkt = K >> 6, tiles = nkt * (N >> 6);
  CMap cm{mode};
  for (int t = BIDX; t < tiles; t += GDIM) transpose_tile(TIDX, BIDX, GDIM, src, ld, K, dst, (t % nkt) * 64, (t / nkt) * 64, cm, kscale, tile);
}

DEVI void ln_inplace(float4 (&v)[4], const float* __restrict__ g, const float* __restrict__ b, int lane) {
  float s = 0.f;
#pragma unroll
  for (int j = 0; j < 4; ++j) s += v[j].x + v[j].y + v[j].z + v[j].w;
  s = wave_sum(s);
  const float mu = s * (1.f / 1024.f);
  float q = 0.f;
#pragma unroll
  for (int j = 0; j < 4; ++j) {
    float a = v[j].x - mu, bq = v[j].y - mu, cq = v[j].z - mu, d = v[j].w - mu;
    q += a * a + bq * bq + cq * cq + d * d;
  }
  q = wave_sum(q);
  const float rs = rsqrtf(q * (1.f / 1024.f) + EPS);
#pragma unroll
  for (int j = 0; j < 4; ++j) {
    const float4 gg = *(const float4*)(g + j * 256 + lane * 4), bb = *(const float4*)(b + j * 256 + lane * 4);
    v[j].x = (v[j].x - mu) * rs * gg.x + bb.x;
    v[j].y = (v[j].y - mu) * rs * gg.y + bb.y;
    v[j].z = (v[j].z - mu) * rs * gg.z + bb.z;
    v[j].w = (v[j].w - mu) * rs * gg.w + bb.w;
  }
}
DEVI void store_row(const float4 (&v)[4], float* x32, bf16_t* x16, int lane) {
#pragma unroll
  for (int j = 0; j < 4; ++j) {
    *(float4*)(x32 + j * 256 + lane * 4) = v[j];
    *(uint2*)(x16 + j * 256 + lane * 4) = make_uint2(pack2(v[j].x, v[j].y), pack2(v[j].z, v[j].w));
  }
}
DEVI int pos_index(int row) { return row < TP ? (row & 2047) : 2048 + ((row - TP) & 31); }

DEVI void phase_prep(const int TIDX, const int BIDX, const int GDIM, KAP KA, unsigned char* WSB, float* OUTB, unsigned char* smem) {
  float* tile = (float*)smem;
  bf16_t* WS = (bf16_t*)(WSB + O_WS);
  const int tid = TIDX, gtid = BIDX * 256 + tid, gsz = GDIM * 256;
  if (gtid < 512) ((int*)(WSB + O_CNT))[gtid] = 0;
  if (gtid < 512) ((uint32_t*)(WSB + O_XB + (size_t)NTOK * 2048))[gtid] = 0u;
  for (int i = gtid; i < 2080 * 16; i += gsz) {
    const int pi = i >> 4, k = i & 15;
    const int pos = pi < 2048 ? pi : 4096 + (pi - 2048);
    const float inv = exp2f(-(float)k * (13.287712379549449f / 16.f));
    const float ang = (float)pos * inv;
    double rev = (double)ang * 0.15915494309189535;
    rev -= __builtin_rint(rev);
    const float fr = (float)rev;
    float2 cs = make_float2(__builtin_amdgcn_cosf(fr), __builtin_amdgcn_sinf(fr));
    ((float2*)(WSB + O_ROPE))[i] = cs;
  }
  for (int i = gtid; i < 2 * 36 * 1024; i += gsz) {
    const int l = i / (36 * 1024), r = i % (36 * 1024), c = r >> 10, k = r & 1023;
    float v = c < 4 ? PIN(I_WRG)[((size_t)l * 1024 + k) * 4 + c] : PIN(I_WRE)[((size_t)l * 1024 + k) * 32 + (c - 4)];
    ((float*)(WSB + O_WR))[i] = v;
  }
  for (int i = gtid; i < 2 * 16 * 4096 * 8; i += gsz) {
    const int e = i * 4, lb = e / (4096 * 32), r = e % (4096 * 32);
    const float4 v = *(const float4*)(PIN(I_CKR) + (size_t)e);
    *(uint2*)((bf16_t*)(WSB + O_KRS) + (size_t)lb * KPAD * 32 + r) = make_uint2(pack2(v.x, v.y), pack2(v.z, v.w));
  }
  {
    const int lane = tid & 63, wid = BIDX * 4 + (tid >> 6), nw = GDIM * 4;
    for (int row = wid; row < NTOK; row += 2 * nw) {
      const bool hb = row + nw < NTOK;
      const int rws[2] = {row, hb ? row + nw : row};
      float4 v[2][4];
#pragma unroll
      for (int k = 0; k < 2; ++k) {
        const float* src = rws[k] < TP ? PIN(I_XP) + (size_t)rws[k] * 1024 : PIN(I_XS) + (size_t)(rws[k] - TP) * 1024;
#pragma unroll
        for (int j = 0; j < 4; ++j) v[k][j] = *(const float4*)(src + j * 256 + lane * 4);
      }
#pragma unroll
      for (int k = 0; k < 2; ++k) {
        if (k == 0 || hb) {
          ln_inplace(v[k], PIN(I_LN0G), PIN(I_LN0B), lane);
          store_row(v[k], OUTB + (size_t)rws[k] * 1024, (bf16_t*)(WSB + O_XB) + (size_t)rws[k] * 1024, lane);
        }
      }
    }
  }
  for (int l = 0; l < 2; ++l) {
    bf16_t* W = WS + (size_t)l * WO_END;
    run_transpose(TIDX, BIDX, GDIM, PIN(I_WIN) + (size_t)l * 1024 * 4768, 4768, 1024, 2816, W + WO_IN, 1, nullptr, tile);
    run_transpose(TIDX, BIDX, GDIM, PIN(I_WIN) + (size_t)l * 1024 * 4768, 4768, 1024, 2048, W + WO_G, 2, nullptr, tile);
    run_transpose(TIDX, BIDX, GDIM, PIN(I_WUQ) + (size_t)l * 384 * 768, 768, 384, 768, W + WO_UQ, 3, PIN(I_QN) + l * 384, tile);
    run_transpose(TIDX, BIDX, GDIM, PIN(I_WUK) + (size_t)l * 256 * 512, 512, 256, 512, W + WO_KV, 0, nullptr, tile);
    run_transpose(TIDX, BIDX, GDIM, PIN(I_WUV) + (size_t)l * 256 * 512, 512, 256, 512, W + WO_KV + 512 * 256, 0, nullptr, tile);
    run_transpose(TIDX, BIDX, GDIM, PIN(I_WBRA) + (size_t)l * 512 * 1024, 1024, 512, 1024, W + WO_BRA, 0, nullptr, tile);
    run_transpose(TIDX, BIDX, GDIM, PIN(I_WBRB) + (size_t)l * 512 * 1024, 1024, 512, 1024, W + WO_BRB, 0, nullptr, tile);
    run_transpose(TIDX, BIDX, GDIM, PIN(I_WOUT) + (size_t)l * 1024 * 1024, 1024, 1024, 1024, W + WO_OUT, 0, nullptr, tile);
    run_transpose(TIDX, BIDX, GDIM, PIN(I_WPG) + (size_t)l * 1024 * 1024, 1024, 1024, 1024, W + WO_PG, 0, nullptr, tile);
    run_transpose(TIDX, BIDX, GDIM, PIN(I_WPLE) + (size_t)l * 256 * 1024, 1024, 256, 1024, W + WO_PLE, 0, nullptr, tile);
  }
}

DEVI void phase_p1(const int TIDX, const int BIDX, const int GDIM, KAP KA, unsigned char* WSB, float* OUTB, int l, unsigned char* smem) {
  const bf16_t* XB = (const bf16_t*)(WSB + O_XB);
  const bf16_t* W = (const bf16_t*)(WSB + O_WS) + (size_t)l * WO_END + WO_IN;
  bf16_t* CQ = (bf16_t*)(WSB + O_CQ);
  float* CKR = (float*)(WSB + O_CKR);
  bf16_t* FQ = (bf16_t*)(WSB + O_FQ);
  bf16_t* VT2 = (bf16_t*)(WSB + O_VT2);
  bf16_t* G = (bf16_t*)(WSB + O_G);
  for (int item = (BIDX & 7) * (GDIM >> 3) + (BIDX >> 3); item < 516 * 22; item += GDIM) {
    const int mt = item / 22, nt = item % 22, m0 = mt * 128;
    f32x4 acc[4][4];
    zero_acc(acc);
    RowLin rp{(const unsigned char*)(XB + (size_t)m0 * 1024), 2048};
    if (nt >= 14 && nt < 18) {
      gemm_main<false>(TIDX, BIDX, GDIM, acc, rp, W + (size_t)nt * 128 * 1024, 1024, 1024, smem);
      const int h = nt - 14, lane = TIDX & 63, w = TIDX >> 6;
      const int rb = m0 + (w >> 1) * 64 + 4 * (lane >> 4), cb = (w & 1) * 64 + (lane & 15);
#pragma unroll
      for (int mi = 0; mi < 4; ++mi) {
        const int row = rb + mi * 16, ch = row >> 5, s = row & 31;
#pragma unroll
        for (int ni = 0; ni < 4; ++ni) {
          const int dv = cb + ni * 16;
          const f32x4 a = acc[mi][ni];
          *(uint2*)(VT2 + ((size_t)(ch * 4 + h) * 128 + dv) * 32 + s) = make_uint2(pack2(a[0], a[1]), pack2(a[2], a[3]));
        }
      }
    } else {
      gemm_main<true>(TIDX, BIDX, GDIM, acc, rp, W + (size_t)nt * 128 * 1024, 1024, 1024, smem);
      EPI_SWAP_BEGIN(m0, 0)
        const f32x4 a = acc[mi][ni];
        if (nt < 3) {
          *(uint2*)(CQ + (size_t)row * 384 + nt * 128 + col) = make_uint2(pack2(a[0], a[1]), pack2(a[2], a[3]));
        } else if (nt < 5) {
          *(f32x4*)(CKR + (size_t)row * 288 + (nt - 3) * 128 + col) = a;
        } else if (nt == 5) {
          if (col < 32) *(f32x4*)(CKR + (size_t)row * 288 + 256 + col) = a;
        } else if (nt < 14) {
          *(uint2*)(FQ + (size_t)row * 1024 + (nt - 6) * 128 + col) = make_uint2(pack2(a[0], a[1]), pack2(a[2], a[3]));
        } else {
          *(uint2*)(G + (size_t)row * 512 + (nt - 18) * 128 + col) = make_uint2(pack2(a[0], a[1]), pack2(a[2], a[3]));
        }
      EPI_END
    }
  }
}

DEVI void phase_p2(const int TIDX, const int BIDX, const int GDIM, KAP KA, unsigned char* WSB, float* OUTB, int l, unsigned char* smem) {
  const int tid = TIDX, lane = tid & 63;
  const float2* ROPE = (const float2*)(WSB + O_ROPE);
  {
    const bf16_t* CQ = (const bf16_t*)(WSB + O_CQ);
    const bf16_t* W = (const bf16_t*)(WSB + O_WS) + (size_t)l * WO_END + WO_UQ;
    bf16_t* QB = (bf16_t*)(WSB + O_QB);
    float* srow = (float*)(smem + SMEM_GEMM);
    for (int item = (BIDX & 7) * (GDIM >> 3) + (BIDX >> 3); item < 516 * 6; item += GDIM) {
      const int mt = item / 6, nt = item % 6, m0 = mt * 128;
      {
        const int r = tid >> 1, hf = tid & 1;
        const uint4* s = (const uint4*)(CQ + (size_t)(m0 + r) * 384 + hf * 192);
        float ss = 0.f;
#pragma unroll 4
        for (int j = 0; j < 24; ++j) {
          const uint4 u = s[j];
          float a;
          a = lo2f(u.x); ss += a * a; a = hi2f(u.x); ss += a * a;
          a = lo2f(u.y); ss += a * a; a = hi2f(u.y); ss += a * a;
          a = lo2f(u.z); ss += a * a; a = hi2f(u.z); ss += a * a;
          a = lo2f(u.w); ss += a * a; a = hi2f(u.w); ss += a * a;
        }
        ss += __shfl_xor(ss, 1);
        if (hf == 0) srow[r] = rsqrtf(ss * (1.f / 384.f) + EPS) * QSCALE;
      }
      f32x4 acc[4][4];
      zero_acc(acc);
      RowLin rp{(const unsigned char*)(CQ + (size_t)m0 * 384), 768};
      gemm_main<true>(TIDX, BIDX, GDIM, acc, rp, W + (size_t)nt * 128 * 384, 384, 384, smem);
      if (nt < 4) {
        EPI_SWAP_BEGIN(m0, nt * 128)
          const float sc = srow[row - m0];
          const f32x4 a = acc[mi][ni] * sc;
          const int hh = col >> 6, d = col & 63;
          *(uint2*)(QB + (size_t)row * 768 + hh * 96 + d) = make_uint2(pack2(a[0], a[1]), pack2(a[2], a[3]));
        EPI_END
      } else {
        const int w = tid >> 6;
        const int rb = m0 + (w >> 1) * 64 + (lane & 15), i0 = 4 * (lane >> 4);
#pragma unroll
        for (int mi = 0; mi < 4; ++mi) {
          const int row = rb + mi * 16;
          const float sc = srow[row - m0];
          const float2* rt = ROPE + (size_t)pos_index(row) * 16 + i0;
#pragma unroll
          for (int pr = 0; pr < 2; ++pr) {
            const int hh = (nt - 4) * 4 + (w & 1) * 2 + pr;
            const f32x4 x1 = acc[mi][2 * pr] * sc, x2 = acc[mi][2 * pr + 1] * sc;
            float o1[4], o2[4];
#pragma unroll
            for (int r = 0; r < 4; ++r) {
              const float2 cs = rt[r];
              o1[r] = x1[r] * cs.x - x2[r] * cs.y;
              o2[r] = x2[r] * cs.x + x1[r] * cs.y;
            }
            *(uint2*)(QB + (size_t)row * 768 + hh * 96 + 64 + i0) = make_uint2(pack2(o1[0], o1[1]), pack2(o1[2], o1[3]));
            *(uint2*)(QB + (size_t)row * 768 + hh * 96 + 80 + i0) = make_uint2(pack2(o2[0], o2[1]), pack2(o2[2], o2[3]));
          }
        }
      }
      __syncthreads();
    }
  }
  {
    const bf16_t* FQ = (const bf16_t*)(WSB + O_FQ);
    bf16_t* QT = (bf16_t*)(WSB + O_QT);
    bf16_t* KHT = (bf16_t*)(WSB + O_KHT);
    bf16_t* AM = (bf16_t*)(WSB + O_AM);
    float* EBp = (float*)(WSB + O_EB);
    bf16_t* sQ = (bf16_t*)smem;
    bf16_t* sK = sQ + 32 * 136;
    for (int item = BIDX; item < NCH * 4; item += GDIM) {
      const int ch = item >> 2, h = item & 3, cid = item;
      {
        const int k = tid & 127, half = tid >> 7, colh = h * 128 + k;
        float* sB = (float*)(smem + 2 * 32 * 136 * 2);
        float lb = 0.f;
        if (l == 1) { const float a0 = PIN(I_HGLB)[colh], a1 = PIN(I_HGLB)[512 + colh]; lb = 1.f / (1.f + expf(a0 - a1)); }
        const float oml = 1.f - lb;
        float bt[16], kk[16], qv[16];
        float bl = 0.f;
#pragma unroll
        for (int j = 0; j < 16; ++j) {
          const size_t row = (size_t)ch * 32 + half * 16 + j;
          const float z = bf2f(FQ[row * 1024 + colh]);
          qv[j] = bf2f(FQ[row * 1024 + 512 + colh]);
          const float e = __expf(-z);
          const float inv = __builtin_amdgcn_rcpf(1.f + e);
          const float f = lb + oml * inv;
          kk[j] = oml * e * inv;
          bl += __logf(f);
          bt[j] = bl;
        }
        sB[half * 128 + k] = bl;
        __syncthreads();
        const float b0 = sB[k], b1 = sB[128 + k];
        const float off = half ? b0 : 0.f, bend = b0 + b1;
        uint32_t pk[8];
#pragma unroll
        for (int j = 0; j < 16; ++j) {
          const int t = half * 16 + j;
          const float b = bt[j] + off;
          const float qs = qv[j] * __builtin_amdgcn_rcpf(1.f + __expf(-qv[j]));
          const bf16_t qt = f2bf(qs * __expf(b));
          QT[((size_t)cid * 32 + t) * 128 + k] = qt;
          sQ[t * 136 + k] = qt;
          sK[t * 136 + k] = f2bf(kk[j] * __expf(fminf(-b, 80.f)));
          bt[j] = kk[j] * __expf(bend - b);
        }
#pragma unroll
        for (int j = 0; j < 8; ++j) pk[j] = pack2(bt[2 * j], bt[2 * j + 1]);
        if (half == 0) EBp[(size_t)cid * 128 + k] = __expf(bend);
        uint4* dst = (uint4*)(KHT + ((size_t)cid * 128 + k) * 32 + half * 16);
        dst[0] = make_uint4(pk[0], pk[1], pk[2], pk[3]);
        dst[1] = make_uint4(pk[4], pk[5], pk[6], pk[7]);
      }
      __syncthreads();
      if (tid < 64) {
        const int c = lane & 31, hh = lane >> 5;
        f32x16 am;
        const float zf = zero_f();
#pragma unroll
        for (int r = 0; r < 16; ++r) am[r] = zf;
#pragma unroll
        for (int st = 0; st < 8; ++st) {
          const bf16x8 a = *(const bf16x8*)(sQ + c * 136 + st * 16 + hh * 8);
          const bf16x8 bb = *(const bf16x8*)(sK + c * 136 + st * 16 + hh * 8);
          am = mfma32(a, bb, am);
        }
#pragma unroll
        for (int r = 0; r < 16; ++r) {
          const int t = (r & 3) + 8 * (r >> 2) + 4 * hh;
          AM[((size_t)cid * 32 + t) * 32 + c] = f2bf(c <= t ? am[r] : 0.f);
        }
      }
      __syncthreads();
    }
  }
  {
    const float* src = PIN(I_CCKV) + (size_t)l * 16 * 4096 * 256;
    bf16_t* CCB = (bf16_t*)(WSB + O_CCB);
    const size_t str_ = (size_t)GDIM * 256;
    for (size_t i = (size_t)BIDX * 256 + tid; i < 16ull * 4096 * 64; i += 4 * str_) {
      float4 v4[4];
#pragma unroll
      for (int k = 0; k < 4; ++k) { const size_t ii = i + k * str_ < 16ull * 4096 * 64 ? i + k * str_ : i; v4[k] = *(const float4*)(src + ii * 4); }
#pragma unroll
      for (int k = 0; k < 4; ++k) if (i + k * str_ < 16ull * 4096 * 64) *(uint2*)(CCB + (i + k * str_) * 4) = make_uint2(pack2(v4[k].x, v4[k].y), pack2(v4[k].z, v4[k].w));
    }
  }
  {
    const float* CKR = (const float*)(WSB + O_CKR);
    bf16_t* CKVN = (bf16_t*)(WSB + O_CKVN);
    bf16_t* KRB = (bf16_t*)(WSB + O_KRB);
    bf16_t* KRS = (bf16_t*)(WSB + O_KRS) + (size_t)l * 16 * KPAD * 32;
    const float* kvn = PIN(I_KVN) + l * 256;
    const int wid = BIDX * 4 + (tid >> 6), nw = GDIM * 4;
    const float4 g = *(const float4*)(kvn + lane * 4);
    for (int row0 = wid; row0 < NTOK; row0 += 4 * nw) {
      int rws[4]; bool ok4[4];
      float4 v[4]; float x1[4], x2[4]; float2 cs[4];
#pragma unroll
      for (int k = 0; k < 4; ++k) {
        ok4[k] = row0 + k * nw < NTOK;
        rws[k] = ok4[k] ? row0 + k * nw : row0;
        const float* src = CKR + (size_t)rws[k] * 288;
        v[k] = *(const float4*)(src + lane * 4);
        x1[k] = src[256 + (lane & 15)]; x2[k] = src[272 + (lane & 15)];
        cs[k] = ROPE[(size_t)pos_index(rws[k]) * 16 + (lane & 15)];
      }
#pragma unroll
      for (int k = 0; k < 4; ++k) {
        if (ok4[k]) {
          const int row = rws[k];
          float ss = wave_sum(v[k].x * v[k].x + v[k].y * v[k].y + v[k].z * v[k].z + v[k].w * v[k].w);
          const float rs = rsqrtf(ss * (1.f / 256.f) + EPS);
          const float4 o = make_float4(v[k].x * rs * g.x, v[k].y * rs * g.y, v[k].z * rs * g.z, v[k].w * rs * g.w);
          float* oc = row < TP ? OUTB + OUT_CKV_P + ((size_t)l * TP + row) * 256 : OUTB + OUT_CKV_S + ((size_t)l * TS + (row - TP)) * 256;
          *(float4*)(oc + lane * 4) = o;
          *(uint2*)(CKVN + (size_t)row * 256 + lane * 4) = make_uint2(pack2(o.x, o.y), pack2(o.z, o.w));
          if (lane < 16) {
            const float o1 = x1[k] * cs[k].x - x2[k] * cs[k].y, o2 = x2[k] * cs[k].x + x1[k] * cs[k].y;
            float* okp = row < TP ? OUTB + OUT_KR_P + ((size_t)l * TP + row) * 32 : OUTB + OUT_KR_S + ((size_t)l * TS + (row - TP)) * 32;
            okp[lane] = o1;
            okp[16 + lane] = o2;
            bf16_t* kb = row < TP ? KRB + (size_t)row * 32 : KRS + ((size_t)((row - TP) >> 5) * KPAD + 4096 + ((row - TP) & 31)) * 32;
            kb[lane] = f2bf(o1);
            kb[16 + lane] = f2bf(o2);
          }
        }
      }
    }
  }
}

DEVI void phase_p3(const int TIDX, const int BIDX, const int GDIM, KAP KA, unsigned char* WSB, float* OUTB, int l, unsigned char* smem) {
  const bf16_t* W = (const bf16_t*)(WSB + O_WS) + (size_t)l * WO_END + WO_KV;
  const bf16_t* CKVN = (const bf16_t*)(WSB + O_CKVN);
  bf16_t* KN = (bf16_t*)(WSB + O_KN);
  bf16_t* VT = (bf16_t*)(WSB + O_VT);
  bf16_t* KNS = (bf16_t*)(WSB + O_KNS);
  bf16_t* VTS = (bf16_t*)(WSB + O_VTS);
  const bf16_t* cache = (const bf16_t*)(WSB + O_CCB);
  for (int i = BIDX * 256 + TIDX; i < 16 * 8 * 64 * 4; i += GDIM * 256) {
    const uint32_t z = __float_as_uint(zero_f());
    *(uint4*)(VTS + (size_t)(i >> 2) * KPAD + 4128 + (i & 3) * 8) = make_uint4(z, z, z, z);
  }
  for (int item = (BIDX & 7) * (GDIM >> 3) + (BIDX >> 3); item < (516 + 512) * 8; item += GDIM) {
    const int mt = item >> 3, nt = item & 7;
    const bool is_cache = mt >= 516;
    const int m0 = is_cache ? (mt - 516) * 128 : mt * 128;
    f32x4 acc[4][4];
    zero_acc(acc);
    bf16_t* kdst; bf16_t* vdst; size_t ldv; int key0;
    if (is_cache) { const int b = m0 >> 12; key0 = m0 & 4095; kdst = KNS + ((size_t)b * KPAD + key0) * 512; vdst = VTS + (size_t)b * 8 * 64 * KPAD; ldv = KPAD; }
    else if (m0 >= TP) { kdst = nullptr; vdst = nullptr; ldv = KPAD; key0 = 0; }
    else { const int b = m0 >> 11; key0 = m0 & 2047; kdst = KN + (size_t)m0 * 512; vdst = VT + (size_t)b * 8 * 64 * 2048; ldv = 2048; }
    if (nt < 4) {
      if (is_cache) { RowLin rp{(const unsigned char*)(cache + (size_t)m0 * 256), 512}; gemm_main<true>(TIDX, BIDX, GDIM, acc, rp, W + (size_t)nt * 128 * 256, 256, 256, smem); }
      else { RowLin rp{(const unsigned char*)(CKVN + (size_t)m0 * 256), 512}; gemm_main<true>(TIDX, BIDX, GDIM, acc, rp, W + (size_t)nt * 128 * 256, 256, 256, smem); }
      EPI_SWAP_BEGIN(0, nt * 128)
        const f32x4 a = acc[mi][ni];
        bf16_t* d;
        if (kdst) d = kdst + (size_t)row * 512 + col;
        else { const int sr = m0 - TP + row; d = KNS + ((size_t)(sr >> 5) * KPAD + 4096 + (sr & 31)) * 512 + col; }
        *(uint2*)d = make_uint2(pack2(a[0], a[1]), pack2(a[2], a[3]));
      EPI_END
    } else {
      if (is_cache) { RowLin rp{(const unsigned char*)(cache + (size_t)m0 * 256), 512}; gemm_main<false>(TIDX, BIDX, GDIM, acc, rp, W + (size_t)nt * 128 * 256, 256, 256, smem); }
      else { RowLin rp{(const unsigned char*)(CKVN + (size_t)m0 * 256), 512}; gemm_main<false>(TIDX, BIDX, GDIM, acc, rp, W + (size_t)nt * 128 * 256, 256, 256, smem); }
      const int lane = TIDX & 63, w = TIDX >> 6;
      const int rb = (w >> 1) * 64 + 4 * (lane >> 4), cb = (nt - 4) * 128 + (w & 1) * 64 + (lane & 15);
#pragma unroll
      for (int mi = 0; mi < 4; ++mi) {
        const int row = rb + mi * 16;
#pragma unroll
        for (int ni = 0; ni < 4; ++ni) {
          const int hv = cb + ni * 16;
          const f32x4 a = acc[mi][ni];
          bf16_t* d;
          if (vdst) d = vdst + (size_t)hv * ldv + key0 + row;
          else { const int sr = m0 - TP + row; d = VTS + ((size_t)(sr >> 5) * 512 + hv) * KPAD + 4096 + (sr & 31); }
          *(uint2*)d = make_uint2(pack2(a[0], a[1]), pack2(a[2], a[3]));
        }
      }
    }
  }
}

DEVI void attn_item(const int TIDX, const int BIDX, const int GDIM, const bf16_t* __restrict__ Q, int qrow0, int nq, int ng, const bf16_t* __restrict__ Kn, const bf16_t* __restrict__ Kr,
                    const bf16_t* __restrict__ VT, size_t ldv, int nkeys, bf16_t* __restrict__ O, unsigned char* smem) {
  const int tid = TIDX, lane = tid & 63, w = tid >> 6, li = lane & 15, lg = lane >> 4;
  const int ql = 16 * w + li;
  bf16x8 qf[2][3];
  f32x4 oT[2][4];
  float mrun[2], lrun[2];
  const float zf = zero_f();
#pragma unroll
  for (int g = 0; g < 2; ++g) {
    const int qr = qrow0 + (g == 0 ? (ql < nq ? ql : nq - 1) : 64 + ql);
    const int qrc = (g == 1 && ng < 2) ? qrow0 : qr;
#pragma unroll
    for (int ds = 0; ds < 3; ++ds) qf[g][ds] = *(const bf16x8*)(Q + (size_t)qrc * 768 + ds * 32 + lg * 8);
#pragma unroll
    for (int i = 0; i < 4; ++i) oT[g][i] = (f32x4){zf, zf, zf, zf};
    mrun[g] = -INFINITY; lrun[g] = 0.f;
  }
  const int nt = (nkeys + 63) >> 6;
  const int r8 = lane >> 3;
  const uint32_t sch = (uint32_t)((lane & 7) ^ (((lane >> 4) + 4 * (w & 1)) & 7)) * 16u;
  const unsigned char* kn0 = (const unsigned char*)Kn + (size_t)(w * 8 + r8) * 1024 + sch;
  const unsigned char* kr0 = (const unsigned char*)Kr + (size_t)(w * 16 + (lane >> 2)) * 64 + (uint32_t)((lane & 3) ^ (((lane >> 5) & 1) << 1)) * 16u;
  const unsigned char* v0 = (const unsigned char*)VT + (size_t)(w * 8 + r8) * ldv * 2 + sch;
  const size_t v32 = (size_t)32 * ldv * 2;
  unsigned char* sw = smem + w * 1024;
#define ATT_STAGE(kt_)                                                                                                  \
  {                                                                                                                     \
    unsigned char* st_ = sw + ((kt_) % 3) * 20480;                                                                      \
    const size_t kb_ = (size_t)(kt_) * 64;                                                                              \
    __builtin_amdgcn_global_load_lds((const unsigned*)(kn0 + kb_ * 1024), (unsigned*)(st_), 16, 0, 0);                  \
    __builtin_amdgcn_global_load_lds((const unsigned*)(kn0 + kb_ * 1024 + 32768), (unsigned*)(st_ + 4096), 16, 0, 0);   \
    __builtin_amdgcn_global_load_lds((const unsigned*)(kr0 + kb_ * 64), (unsigned*)(st_ + 8192), 16, 0, 0);             \
    __builtin_amdgcn_global_load_lds((const unsigned*)(v0 + kb_ * 2), (unsigned*)(st_ + 12288), 16, 0, 0);              \
    __builtin_amdgcn_global_load_lds((const unsigned*)(v0 + v32 + kb_ * 2), (unsigned*)(st_ + 12288 + 4096), 16, 0, 0); \
  }
  ATT_STAGE(0);
  if (nt > 1) ATT_STAGE(1);
  const int pk0 = (lg ^ (li >> 1)) * 16;
  const int pkr = (lg ^ (((li >> 3) & 1) << 1)) * 16;
  const int pv0 = ((lg >> 1) ^ (li >> 1)) * 16 + (lg & 1) * 8;
  for (int kt = 0; kt < nt; ++kt) {
    if (kt + 1 < nt) asm volatile("s_waitcnt vmcnt(5)" ::: "memory");
    else asm volatile("s_waitcnt vmcnt(0)" ::: "memory");
    __builtin_amdgcn_s_barrier();
    asm volatile("" ::: "memory");
    if (kt + 2 < nt) ATT_STAGE(kt + 2);
    const unsigned char* st = smem + (kt % 3) * 20480;
    const bool tail = (kt == nt - 1) && (nkeys & 63);
    const bool two = (ng == 2);
    const bool g0on = !(two && kt == nt - 1);
    f32x4 sT[2][4];
#pragma unroll
    for (int kb = 0; kb < 4; ++kb) {
      const unsigned char* kr_ = st + (kb * 16 + li) * 128;
      const bf16x8 k0 = *(const bf16x8*)(kr_ + pk0), k1 = *(const bf16x8*)(kr_ + (pk0 ^ 64)), k2 = *(const bf16x8*)(st + 8192 + (kb * 16 + li) * 64 + pkr);
      sT[0][kb] = (f32x4){zf, zf, zf, zf};
      sT[1][kb] = (f32x4){zf, zf, zf, zf};
      if (g0on) {
        sT[0][kb] = mfma16(k0, qf[0][0], sT[0][kb]);
        sT[0][kb] = mfma16(k1, qf[0][1], sT[0][kb]);
        sT[0][kb] = mfma16(k2, qf[0][2], sT[0][kb]);
      }
      if (two) {
        sT[1][kb] = mfma16(k0, qf[1][0], sT[1][kb]);
        sT[1][kb] = mfma16(k1, qf[1][1], sT[1][kb]);
        sT[1][kb] = mfma16(k2, qf[1][2], sT[1][kb]);
      }
    }
    bf16x8 pf[2][2];
#pragma unroll
    for (int g = 0; g < 2; ++g) {
      if (g == 0 ? g0on : two) {
        if (tail) {
#pragma unroll
          for (int kb = 0; kb < 4; ++kb)
#pragma unroll
            for (int r = 0; r < 4; ++r)
              if (kt * 64 + kb * 16 + 4 * lg + r >= nkeys) sT[g][kb][r] = -INFINITY;
        }
        float mx = sT[g][0][0];
#pragma unroll
        for (int kb = 0; kb < 4; ++kb)
#pragma unroll
          for (int r = 0; r < 4; ++r) mx = fmaxf(mx, sT[g][kb][r]);
        mx = fmaxf(mx, __shfl_xor(mx, 16));
        mx = fmaxf(mx, __shfl_xor(mx, 32));
        const float mnew = fmaxf(mrun[g], mx);
        const float alpha = __builtin_amdgcn_exp2f(mrun[g] - mnew);
        mrun[g] = mnew;
        float ps = 0.f;
#pragma unroll
        for (int kb = 0; kb < 4; ++kb)
#pragma unroll
          for (int r = 0; r < 4; ++r) { const float pv = __builtin_amdgcn_exp2f(sT[g][kb][r] - mnew); sT[g][kb][r] = pv; ps += pv; }
        lrun[g] = lrun[g] * alpha + ps;
#pragma unroll
        for (int vb = 0; vb < 4; ++vb) oT[g][vb] *= alpha;
      }
#pragma unroll
      for (int s2 = 0; s2 < 2; ++s2)
        pf[g][s2] = mk8(pack2(sT[g][2 * s2][0], sT[g][2 * s2][1]), pack2(sT[g][2 * s2][2], sT[g][2 * s2][3]),
                        pack2(sT[g][2 * s2 + 1][0], sT[g][2 * s2 + 1][1]), pack2(sT[g][2 * s2 + 1][2], sT[g][2 * s2 + 1][3]));
    }
#pragma unroll
    for (int s2 = 0; s2 < 2; ++s2) {
#pragma unroll
      for (int vb = 0; vb < 4; ++vb) {
        const unsigned char* vr_ = st + 12288 + (vb * 16 + li) * 128;
        const uint2 lo = *(const uint2*)(vr_ + (pv0 ^ (s2 * 64)));
        const uint2 hi = *(const uint2*)(vr_ + (pv0 ^ (s2 * 64) ^ 32));
        const bf16x8 vfr = mk8(lo, hi);
        if (g0on) oT[0][vb] = mfma16(vfr, pf[0][s2], oT[0][vb]);
        if (two) oT[1][vb] = mfma16(vfr, pf[1][s2], oT[1][vb]);
      }
    }
  }
#pragma unroll
  for (int g = 0; g < 2; ++g) {
    float lr = lrun[g];
    lr += __shfl_xor(lr, 16);
    lr += __shfl_xor(lr, 32);
    const float inv = 1.f / lr;
    const bool st_ok = g == 0 ? (ql < nq) : (ng == 2);
    if (st_ok) {
#pragma unroll
      for (int vb = 0; vb < 4; ++vb) {
        const f32x4 o = oT[g][vb] * inv;
        *(uint2*)(O + (size_t)(qrow0 + g * 64 + ql) * 512 + vb * 16 + 4 * lg) = make_uint2(pack2(o[0], o[1]), pack2(o[2], o[3]));
      }
    }
  }
  __syncthreads();
}

DEVI void hgrn_item(const int TIDX, const int BIDX, const int GDIM, KAP KA, unsigned char* WSB, float* OUTB, int l, int g0, int nchunks, int h, const float* __restrict__ S0, float* __restrict__ Sout, int rowbase,
                    unsigned char* smem) {
  constexpr int STG = 35840;
  const unsigned char* QT = WSB + O_QT;
  const unsigned char* KHT = WSB + O_KHT;
  const unsigned char* AM = WSB + O_AM;
  const unsigned char* EBp = WSB + O_EB;
  const unsigned char* VT2 = WSB + O_VT2;
  const unsigned char* G = WSB + O_G;
  bf16_t* HO = (bf16_t*)(WSB + O_HO);
  const float* hgn = PIN(I_HGN) + l * 512 + h * 128;
  float* sred = (float*)(smem + SMEM_GEMM);
  const int tid = TIDX, lane = tid & 63, w = tid >> 6, c = lane & 31, hh = lane >> 5;
  const int dvg = 32 * w + c;
  f32x16 S[4];
#pragma unroll
  for (int kt = 0; kt < 4; ++kt)
#pragma unroll
    for (int r = 0; r < 16; ++r) S[kt][r] = S0 ? S0[(size_t)(32 * kt + (r & 3) + 8 * (r >> 2) + 4 * hh) * 128 + dvg] : 0.f;
  float4 gn[4];
#pragma unroll
  for (int q = 0; q < 4; ++q) gn[q] = *(const float4*)(hgn + 32 * w + 8 * q + 4 * hh);
  const uint32_t lo16 = (uint32_t)lane * 16u;
  const uint32_t goff = (uint32_t)(w * 4 + (lane >> 4)) * 1024u + (uint32_t)h * 256u + (uint32_t)(lane & 15) * 16u;
#define HG_STAGE(ch_)                                                                                                                  \
  {                                                                                                                                    \
    unsigned char* st_ = smem + ((ch_) & 1) * STG + w * 1024;                                                                          \
    const size_t cid_ = (size_t)(g0 + (ch_)) * 4 + h;                                                                                  \
    const size_t grow_ = ((size_t)rowbase + (size_t)(ch_) * 32) * 1024;                                                                \
    __builtin_amdgcn_global_load_lds((const unsigned*)(QT + cid_ * 8192 + w * 1024 + lo16), (unsigned*)(st_), 16, 0, 0);              \
    __builtin_amdgcn_global_load_lds((const unsigned*)(QT + cid_ * 8192 + 4096 + w * 1024 + lo16), (unsigned*)(st_ + 4096), 16, 0, 0); \
    __builtin_amdgcn_global_load_lds((const unsigned*)(KHT + cid_ * 8192 + w * 1024 + lo16), (unsigned*)(st_ + 8192), 16, 0, 0);       \
    __builtin_amdgcn_global_load_lds((const unsigned*)(KHT + cid_ * 8192 + 4096 + w * 1024 + lo16), (unsigned*)(st_ + 12288), 16, 0, 0); \
    __builtin_amdgcn_global_load_lds((const unsigned*)(VT2 + cid_ * 8192 + w * 1024 + lo16), (unsigned*)(st_ + 16384), 16, 0, 0);      \
    __builtin_amdgcn_global_load_lds((const unsigned*)(VT2 + cid_ * 8192 + 4096 + w * 1024 + lo16), (unsigned*)(st_ + 20480), 16, 0, 0); \
    __builtin_amdgcn_global_load_lds((const unsigned*)(G + grow_ + goff), (unsigned*)(st_ + 24576), 16, 0, 0);                         \
    __builtin_amdgcn_global_load_lds((const unsigned*)(G + grow_ + 16384 + goff), (unsigned*)(st_ + 28672), 16, 0, 0);                 \
    if (w < 2) __builtin_amdgcn_global_load_lds((const unsigned*)(AM + cid_ * 2048 + w * 1024 + lo16), (unsigned*)(st_ + 32768), 16, 0, 0); \
    else if (w == 2) __builtin_amdgcn_global_load_lds((const unsigned*)(EBp + cid_ * 512 + lo16), (unsigned*)(smem + ((ch_) & 1) * STG + 34816), 16, 0, 0); \
  }
  HG_STAGE(0);
  for (int ch = 0; ch < nchunks; ++ch) {
    asm volatile("s_waitcnt vmcnt(0)" ::: "memory");
    __builtin_amdgcn_s_barrier();
    asm volatile("" ::: "memory");
    if (ch + 1 < nchunks) HG_STAGE(ch + 1);
    const unsigned char* st = smem + (ch & 1) * STG;
    bf16x8 vf[2], af[2];
#pragma unroll
    for (int s2 = 0; s2 < 2; ++s2) {
      vf[s2] = *(const bf16x8*)(st + 16384 + dvg * 64 + 32 * s2 + 16 * hh);
      af[s2] = *(const bf16x8*)(st + 32768 + c * 64 + 32 * s2 + 16 * hh);
    }
    f32x16 oT;
    const float zf = zero_f();
#pragma unroll
    for (int r = 0; r < 16; ++r) oT[r] = zf;
#pragma unroll
    for (int kt = 0; kt < 4; ++kt) {
#pragma unroll
      for (int s2 = 0; s2 < 2; ++s2) {
        const uint2 lo = *(const uint2*)(st + c * 256 + 64 * kt + 32 * s2 + 8 * hh);
        const uint2 hi = *(const uint2*)(st + c * 256 + 64 * kt + 32 * s2 + 16 + 8 * hh);
        const bf16x8 sa = mk8(pack2(S[kt][8 * s2 + 0], S[kt][8 * s2 + 1]), pack2(S[kt][8 * s2 + 2], S[kt][8 * s2 + 3]),
                              pack2(S[kt][8 * s2 + 4], S[kt][8 * s2 + 5]), pack2(S[kt][8 * s2 + 6], S[kt][8 * s2 + 7]));
        oT = mfma32(sa, mk8(lo, hi), oT);
      }
    }
#pragma unroll
    for (int s2 = 0; s2 < 2; ++s2) oT = mfma32(vf[s2], af[s2], oT);
#pragma unroll
    for (int kt = 0; kt < 4; ++kt) {
#pragma unroll
      for (int q = 0; q < 4; ++q) {
        const float4 e = *(const float4*)(st + 34816 + (32 * kt + 8 * q + 4 * hh) * 4);
        S[kt][4 * q + 0] *= e.x; S[kt][4 * q + 1] *= e.y; S[kt][4 * q + 2] *= e.z; S[kt][4 * q + 3] *= e.w;
      }
#pragma unroll
      for (int s2 = 0; s2 < 2; ++s2) {
        const bf16x8 kf = *(const bf16x8*)(st + 8192 + (32 * kt + c) * 64 + 32 * s2 + 16 * hh);
        S[kt] = mfma32(kf, vf[s2], S[kt]);
      }
    }
    float ss = 0.f;
#pragma unroll
    for (int r = 0; r < 16; ++r) ss += oT[r] * oT[r];
    ss += __shfl_xor(ss, 32);
    float* sr = sred + (ch & 1) * 128;
    if (lane < 32) sr[w * 32 + c] = ss;
    asm volatile("s_waitcnt lgkmcnt(0)" ::: "memory");
    __builtin_amdgcn_s_barrier();
    asm volatile("" ::: "memory");
    const float tot = sr[c] + sr[32 + c] + sr[64 + c] + sr[96 + c];
    const float rs = rsqrtf(tot * (1.f / 128.f) + EPS);
    const size_t row = (size_t)rowbase + ch * 32 + c;
#pragma unroll
    for (int q = 0; q < 4; ++q) {
      const int dv0 = 32 * w + 8 * q + 4 * hh;
      const uint2 gp = *(const uint2*)(st + 24576 + c * 256 + dv0 * 2);
      const float o0 = oT[4 * q + 0] * rs * gn[q].x * siluf_(lo2f(gp.x));
      const float o1 = oT[4 * q + 1] * rs * gn[q].y * siluf_(hi2f(gp.x));
      const float o2 = oT[4 * q + 2] * rs * gn[q].z * siluf_(lo2f(gp.y));
      const float o3 = oT[4 * q + 3] * rs * gn[q].w * siluf_(hi2f(gp.y));
      *(uint2*)(HO + row * 512 + h * 128 + dv0) = make_uint2(pack2(o0, o1), pack2(o2, o3));
    }
  }
#pragma unroll
  for (int kt = 0; kt < 4; ++kt)
#pragma unroll
    for (int r = 0; r < 16; ++r) Sout[(size_t)(32 * kt + (r & 3) + 8 * (r >> 2) + 4 * hh) * 128 + dvg] = S[kt][r];
  __syncthreads();
}

DEVI void phase_p4(const int TIDX, const int BIDX, const int GDIM, KAP KA, unsigned char* WSB, float* OUTB, int l, unsigned char* smem, int dup = 0) {
  const int q = BIDX & 7;
  int* qctr = (int*)(WSB + O_CNT) + 128 + l * 8 + q + 16 * dup;
  int* sitem = (int*)(smem + SMEM_GEMM + 1024);
  const bf16_t* QB = (const bf16_t*)(WSB + O_QB);
  bf16_t* AO = (bf16_t*)(WSB + O_AO);
  const int total = 16 + 16 + 512 + 8;
  for (;;) {
    if (TIDX == 0) *sitem = atomicAdd(qctr, 1);
    __syncthreads();
    const int it = *sitem;
    __syncthreads();
    if (it >= total) break;
    if (it < 16) {
      const int i2 = q * 16 + it, b = i2 >> 2, h = i2 & 3;
      hgrn_item(TIDX, BIDX, GDIM, KA, WSB, OUTB, l, b * 64, 64, h, nullptr, OUTB + OUT_ST_P + ((size_t)(l * 32 + b) * 4 + h) * 16384, b * 2048, smem);
    } else if (it < 32) {
      const int b = it - 16, h = q;
      attn_item(TIDX, BIDX, GDIM, QB + h * 96, TP + b * 32, 32, 1, (const bf16_t*)(WSB + O_KNS) + (size_t)b * KPAD * 512 + h * 64,
                (const bf16_t*)(WSB + O_KRS) + ((size_t)l * 16 + b) * KPAD * 32,
                (const bf16_t*)(WSB + O_VTS) + (size_t)(b * 8 + h) * 64 * KPAD, KPAD, 4128, AO + h * 64, smem);
    } else if (it < 32 + 512) {
      const int jj = it - 32, b = jj >> 4, cp = 15 - (jj & 15), h = q;
      attn_item(TIDX, BIDX, GDIM, QB + h * 96, b * 2048 + cp * 128, 64, 2, (const bf16_t*)(WSB + O_KN) + (size_t)b * 2048 * 512 + h * 64,
                (const bf16_t*)(WSB + O_KRB) + (size_t)b * 2048 * 32,
                (const bf16_t*)(WSB + O_VT) + (size_t)(b * 8 + h) * 64 * 2048, 2048, 128 * (cp + 1), AO + h * 64, smem);
    } else {
      const int i2 = q * 8 + (it - 32 - 512), b = i2 >> 2, h = i2 & 3;
      hgrn_item(TIDX, BIDX, GDIM, KA, WSB, OUTB, l, 2048 + b, 1, h, PIN(I_ST) + ((size_t)(l * 16 + b) * 4 + h) * 16384,
                OUTB + OUT_ST_S + ((size_t)(l * 16 + b) * 4 + h) * 16384, TP + b * 32, smem);
    }
  }
}

DEVI void phase_p5(const int TIDX, const int BIDX, const int GDIM, KAP KA, unsigned char* WSB, float* OUTB, int l, unsigned char* smem) {
  const bf16_t* XB = (const bf16_t*)(WSB + O_XB);
  const bf16_t* AO = (const bf16_t*)(WSB + O_AO);
  const bf16_t* HO = (const bf16_t*)(WSB + O_HO);
  const bf16_t* W = (const bf16_t*)(WSB + O_WS) + (size_t)l * WO_END;
  bf16_t* MG = (bf16_t*)(WSB + O_MG);
  for (int item = (BIDX & 7) * (GDIM >> 3) + (BIDX >> 3); item < 516 * 8; item += GDIM) {
    const int mt = item >> 3, nt = item & 7, m0 = mt * 128, n0 = nt * 128;
    f32x4 acc[4][4];
    bf16_t* TMP = (bf16_t*)(WSB + O_G);
    RowLin rx{(const unsigned char*)(XB + (size_t)m0 * 1024), 2048};
    RowLin ra{(const unsigned char*)(AO + (size_t)m0 * 512), 1024};
    RowLin ro{(const unsigned char*)(HO + (size_t)m0 * 512), 1024};
    zero_acc(acc);
    gemm_main<true>(TIDX, BIDX, GDIM, acc, rx, W + WO_G + (size_t)n0 * 1024, 1024, 1024, smem);
    EPI_SWAP_BEGIN(m0, n0)
      const f32x4 a = acc[mi][ni];
      *(uint2*)(MG + (size_t)row * 1024 + col) = make_uint2(pack2(sigmoidf_(a[0]), sigmoidf_(a[1])), pack2(sigmoidf_(a[2]), sigmoidf_(a[3])));
    EPI_END
    zero_acc(acc);
    gemm_main<true>(TIDX, BIDX, GDIM, acc, rx, W + WO_G + (size_t)(1024 + n0) * 1024, 1024, 1024, smem);
    EPI_SWAP_BEGIN(m0, n0)
      const f32x4 a = acc[mi][ni];
      *(uint2*)(TMP + (size_t)row * 1024 + col) = make_uint2(pack2(sigmoidf_(a[0]), sigmoidf_(a[1])), pack2(sigmoidf_(a[2]), sigmoidf_(a[3])));
    EPI_END
    zero_acc(acc);
    gemm_main<true>(TIDX, BIDX, GDIM, acc, ra, W + WO_BRA + (size_t)n0 * 512, 512, 512, smem);
    EPI_SWAP_BEGIN(m0, n0)
      const f32x4 a = acc[mi][ni];
      const uint2 g = *(const uint2*)(MG + (size_t)row * 1024 + col);
      *(uint2*)(MG + (size_t)row * 1024 + col) = make_uint2(pack2(a[0] * lo2f(g.x), a[1] * hi2f(g.x)), pack2(a[2] * lo2f(g.y), a[3] * hi2f(g.y)));
    EPI_END
    zero_acc(acc);
    gemm_main<true>(TIDX, BIDX, GDIM, acc, ro, W + WO_BRB + (size_t)n0 * 512, 512, 512, smem);
    EPI_SWAP_BEGIN(m0, n0)
      const f32x4 a = acc[mi][ni];
      const uint2 g = *(const uint2*)(TMP + (size_t)row * 1024 + col), m = *(const uint2*)(MG + (size_t)row * 1024 + col);
      const float o0 = lo2f(m.x) + a[0] * lo2f(g.x), o1 = hi2f(m.x) + a[1] * hi2f(g.x), o2 = lo2f(m.y) + a[2] * lo2f(g.y), o3 = hi2f(m.y) + a[3] * hi2f(g.y);
      *(uint2*)(MG + (size_t)row * 1024 + col) = make_uint2(pack2(o0, o1), pack2(o2, o3));
    EPI_END
  }
}

DEVI void phase_p6(const int TIDX, const int BIDX, const int GDIM, KAP KA, unsigned char* WSB, float* OUTB, int l, unsigned char* smem) {
  const bf16_t* MG = (const bf16_t*)(WSB + O_MG);
  const bf16_t* W = (const bf16_t*)(WSB + O_WS) + (size_t)l * WO_END + WO_OUT;
  float* PRE = (float*)(WSB + O_PRE);
  for (int item = (BIDX & 7) * (GDIM >> 3) + (BIDX >> 3); item < 516 * 8; item += GDIM) {
    const int mt = item >> 3, nt = item & 7, m0 = mt * 128, n0 = nt * 128;
    f32x4 acc[4][4];
    zero_acc(acc);
    RowLin rp{(const unsigned char*)(MG + (size_t)m0 * 1024), 2048};
    gemm_main<true>(TIDX, BIDX, GDIM, acc, rp, W + (size_t)n0 * 1024, 1024, 1024, smem);
    EPI_SWAP_BEGIN(m0, n0)
      const f32x4 x = *(const f32x4*)(OUTB + (size_t)row * 1024 + col);
      *(f32x4*)(PRE + (size_t)row * 1024 + col) = x * DN_ALPHA + acc[mi][ni];
    EPI_END
  }
}

DEVI void phase_p7(const int TIDX, const int BIDX, const int GDIM, KAP KA, unsigned char* WSB, float* OUTB, int l, unsigned char* smem) {
  const int tid = TIDX, lane = tid & 63;
  {
    const float* PRE = (const float*)(WSB + O_PRE);
    bf16_t* XB = (bf16_t*)(WSB + O_XB);
    const float* WR = (const float*)(WSB + O_WR) + (size_t)l * 36 * 1024;
    int* cnt = (int*)(WSB + O_CNT) + l * 32;
    int* ltok = (int*)(WSB + O_LTOK);
    float* lw = (float*)(WSB + O_LW);
    const float* g1 = PIN(I_LN1G) + l * 1024; const float* b1 = PIN(I_LN1B) + l * 1024;
    const int wid = BIDX * 4 + (tid >> 6), nw = GDIM * 4;
    for (int r4 = wid; r4 < NTOK / 4; r4 += nw) {
      float4 v[4][4];
#pragma unroll
      for (int t = 0; t < 4; ++t) {
        const size_t row = (size_t)r4 * 4 + t;
#pragma unroll
        for (int j = 0; j < 4; ++j) v[t][j] = *(const float4*)(PRE + row * 1024 + j * 256 + lane * 4);
        ln_inplace(v[t], g1, b1, lane);
        store_row(v[t], OUTB + row * 1024, XB + row * 1024, lane);
      }
      float mine[4] = {0.f, 0.f, 0.f, 0.f};
#pragma unroll 4
      for (int c = 0; c < 36; ++c) {
        float4 wv[4];
#pragma unroll
        for (int j = 0; j < 4; ++j) wv[j] = *(const float4*)(WR + c * 1024 + j * 256 + lane * 4);
#pragma unroll
        for (int t = 0; t < 4; ++t) {
          float s = 0.f;
#pragma unroll
          for (int j = 0; j < 4; ++j) s += v[t][j].x * wv[j].x + v[t][j].y * wv[j].y + v[t][j].z * wv[j].z + v[t][j].w * wv[j].w;
          s = wave_sum(s);
          if (lane == c) mine[t] = s;
        }
      }
#pragma unroll
      for (int t = 0; t < 4; ++t) {
        const int tok = r4 * 4 + t;
        float gl[4];
#pragma unroll
        for (int j = 0; j < 4; ++j) gl[j] = __shfl(mine[t], j);
        int gi = 0; float gm = gl[0];
#pragma unroll
        for (int j = 1; j < 4; ++j) if (gl[j] > gm) { gm = gl[j]; gi = j; }
        float gs = 0.f;
#pragma unroll
        for (int j = 0; j < 4; ++j) gs += expf(gl[j] - gm);
        const float gtop = 1.f / gs;
        float el[8];
#pragma unroll
        for (int j = 0; j < 8; ++j) el[j] = __shfl(mine[t], 4 + gi * 8 + j);
        float em = el[0];
#pragma unroll
        for (int j = 1; j < 8; ++j) em = fmaxf(em, el[j]);
        float pe[8], es = 0.f;
#pragma unroll
        for (int j = 0; j < 8; ++j) { pe[j] = expf(el[j] - em); es += pe[j]; }
#pragma unroll
        for (int j = 0; j < 8; ++j) pe[j] = pe[j] / es;
        int i1 = 0; float p1 = pe[0];
#pragma unroll
        for (int j = 1; j < 8; ++j) if (pe[j] > p1) { p1 = pe[j]; i1 = j; }
        int i2 = -1; float p2 = -1.f;
#pragma unroll
        for (int j = 0; j < 8; ++j) if (j != i1 && pe[j] > p2) { p2 = pe[j]; i2 = j; }
        const float den = p1 + p2;
        if (lane == 0) {
          const int e1 = gi * 8 + i1, e2 = gi * 8 + i2;
          const int s1 = atomicAdd(cnt + e1, 1);
          ltok[(size_t)e1 * NTOK + s1] = tok * 2;
          lw[(size_t)e1 * NTOK + s1] = gtop * (p1 / den);
          const int s2 = atomicAdd(cnt + e2, 1);
          ltok[(size_t)e2 * NTOK + s2] = tok * 2 + 1;
          lw[(size_t)e2 * NTOK + s2] = gtop * (p2 / den);
        }
      }
    }
  }
  {
    bf16_t* PLEB = (bf16_t*)(WSB + O_YM);
    const float* pp = PIN(I_PP) + (size_t)l * TP * 256;
    const float* ps = PIN(I_PS) + (size_t)l * TS * 256;
    const size_t tot_ = (size_t)NTOK * 64, str_ = (size_t)GDIM * 256;
    for (size_t i = (size_t)BIDX * 256 + tid; i < tot_; i += 4 * str_) {
      float4 v4[4];
#pragma unroll
      for (int k = 0; k < 4; ++k) {
        const size_t ii = i + k * str_ < tot_ ? i + k * str_ : i, e = ii * 4;
        v4[k] = e < (size_t)TP * 256 ? *(const float4*)(pp + e) : *(const float4*)(ps + (e - (size_t)TP * 256));
      }
#pragma unroll
      for (int k = 0; k < 4; ++k)
        if (i + k * str_ < tot_) *(uint2*)(PLEB + (i + k * str_) * 4) = make_uint2(pack2(v4[k].x, v4[k].y), pack2(v4[k].z, v4[k].w));
    }
  }
  {
    float* tile = (float*)smem;
    bf16_t* WE = (bf16_t*)(WSB + O_WE);
    CMap cm{0};
    for (int t = BIDX; t < 96 * 128; t += GDIM) {
      const int mat = t >> 7, tt = t & 127, kind = mat >> 5, e = mat & 31;
      const float* src = PIN(kind == 0 ? I_WE1 : (kind == 1 ? I_WE3 : I_WE2)) + ((size_t)l * 32 + e) * 524288;
      bf16_t* dst = WE + ((size_t)kind * 32 + e) * 524288;
      if (kind < 2) transpose_tile(TIDX, BIDX, GDIM, src, 512, 1024, dst, (tt & 15) * 64, (tt >> 4) * 64, cm, nullptr, tile);
      else transpose_tile(TIDX, BIDX, GDIM, src, 1024, 512, dst, (tt & 7) * 64, (tt >> 3) * 64, cm, nullptr, tile);
    }
  }
}

DEVI int moe_table(const int TIDX, const int BIDX, const int GDIM, KAP KA, unsigned char* WSB, float* OUTB, int l, int* tstart  ) {
  if (TIDX == 0) {
    const int* cnt = (const int*)(WSB + O_CNT) + l * 32;
    int acc = 0;
    for (int e = 0; e < 32; ++e) { tstart[e] = acc; acc += (cnt[e] + 127) >> 7; }
    tstart[32] = acc;
  }
  __syncthreads();
  return tstart[32];
}
DEVI int moe_find(const int* tstart, int mt) {
  int e = 0;
  for (int i = 1; i < 32; ++i) if (mt >= tstart[i]) e = i;
  return e;
}
struct RowGather {
  const unsigned char* base; const int* ltok; int pos0; int cnt;
  DEVI uint32_t operator()(int r) const {
    const int pos = pos0 + r;
    return pos < cnt ? (uint32_t)(ltok[pos] >> 1) * 2048u : (uint32_t)NTOK * 2048u;
  }
};

DEVI void phase_p8(const int TIDX, const int BIDX, const int GDIM, KAP KA, unsigned char* WSB, float* OUTB, int l, unsigned char* smem) {
  int* tstart = (int*)(smem + SMEM_GEMM + 1024 + 64);
  const int NT = moe_table(TIDX, BIDX, GDIM, KA, WSB, OUTB, l, tstart);
  const bf16_t* XB = (const bf16_t*)(WSB + O_XB);
  const bf16_t* WE = (const bf16_t*)(WSB + O_WE);
  bf16_t* H = (bf16_t*)(WSB + O_H);
  const int* cnt = (const int*)(WSB + O_CNT) + l * 32;
  const int* ltok = (const int*)(WSB + O_LTOK);
  for (int item = (BIDX & 7) * (GDIM >> 3) + (BIDX >> 3); item < NT * 4; item += GDIM) {
    const int mt = item >> 2, nt = item & 3, e = moe_find(tstart, mt), lt = mt - tstart[e];
    RowGather rg{(const unsigned char*)XB, ltok + (size_t)e * NTOK, lt * 128, cnt[e]};
    f32x4 acc[4][4];
    uint2 sg[4][4];
    zero_acc(acc);
    gemm_main<true>(TIDX, BIDX, GDIM, acc, rg, WE + ((size_t)e * 512 + nt * 128) * 1024, 1024, 1024, smem);
#pragma unroll
    for (int i = 0; i < 4; ++i)
#pragma unroll
      for (int j = 0; j < 4; ++j) sg[i][j] = make_uint2(pack2(siluf_(acc[i][j][0]), siluf_(acc[i][j][1])), pack2(siluf_(acc[i][j][2]), siluf_(acc[i][j][3])));
    zero_acc(acc);
    gemm_main<true>(TIDX, BIDX, GDIM, acc, rg, WE + ((size_t)(32 + e) * 512 + nt * 128) * 1024, 1024, 1024, smem);
    EPI_SWAP_BEGIN(mt * 128, nt * 128)
      const f32x4 a = acc[mi][ni];
      const uint2 g = sg[mi][ni];
      *(uint2*)(H + (size_t)row * 512 + col) = make_uint2(pack2(a[0] * lo2f(g.x), a[1] * hi2f(g.x)), pack2(a[2] * lo2f(g.y), a[3] * hi2f(g.y)));
    EPI_END
  }
  {
    const bf16_t* W = (const bf16_t*)(WSB + O_WS) + (size_t)l * WO_END;
    float* PRE = (float*)(WSB + O_PRE);
    for (int item = (BIDX & 7) * (GDIM >> 3) + (BIDX >> 3); item < 516 * 8; item += GDIM) {
      const int mt = item >> 3, nt = item & 7, m0 = mt * 128, n0 = nt * 128;
      f32x4 acc[4][4];
      uint2 gp[4][4];
      zero_acc(acc);
      RowLin rx{(const unsigned char*)(XB + (size_t)m0 * 1024), 2048};
      gemm_main<true>(TIDX, BIDX, GDIM, acc, rx, W + WO_PG + (size_t)n0 * 1024, 1024, 1024, smem);
#pragma unroll
      for (int i = 0; i < 4; ++i)
#pragma unroll
        for (int j = 0; j < 4; ++j) gp[i][j] = make_uint2(pack2(sigmoidf_(acc[i][j][0]), sigmoidf_(acc[i][j][1])), pack2(sigmoidf_(acc[i][j][2]), sigmoidf_(acc[i][j][3])));
      zero_acc(acc);
      RowLin rpl{(const unsigned char*)((const bf16_t*)(WSB + O_YM) + (size_t)m0 * 256), 512};
      gemm_main<true>(TIDX, BIDX, GDIM, acc, rpl, W + WO_PLE + (size_t)n0 * 256, 256, 256, smem);
      EPI_SWAP_BEGIN(m0, n0)
        const f32x4 x = *(const f32x4*)(OUTB + (size_t)row * 1024 + col);
        const f32x4 a = acc[mi][ni];
        const uint2 g = gp[mi][ni];
        f32x4 o;
        o[0] = x[0] * DN_ALPHA + a[0] * lo2f(g.x); o[1] = x[1] * DN_ALPHA + a[1] * hi2f(g.x);
        o[2] = x[2] * DN_ALPHA + a[2] * lo2f(g.y); o[3] = x[3] * DN_ALPHA + a[3] * hi2f(g.y);
        *(f32x4*)(PRE + (size_t)row * 1024 + col) = o;
      EPI_END
    }
  }
}

DEVI void phase_p9(const int TIDX, const int BIDX, const int GDIM, KAP KA, unsigned char* WSB, float* OUTB, int l, unsigned char* smem) {
  int* tstart = (int*)(smem + SMEM_GEMM + 1024 + 64);
  const int NT = moe_table(TIDX, BIDX, GDIM, KA, WSB, OUTB, l, tstart);
  const bf16_t* WE = (const bf16_t*)(WSB + O_WE) + 64ull * 524288;
  const bf16_t* H = (const bf16_t*)(WSB + O_H);
  bf16_t* YM = (bf16_t*)(WSB + O_YM);
  const int* cnt = (const int*)(WSB + O_CNT) + l * 32;
  const int* ltok = (const int*)(WSB + O_LTOK);
  const float* lw = (const float*)(WSB + O_LW);
  for (int item = (BIDX & 7) * (GDIM >> 3) + (BIDX >> 3); item < NT * 8; item += GDIM) {
    const int mt = item >> 3, nt = item & 7, e = moe_find(tstart, mt), lt = mt - tstart[e], ce = cnt[e];
    f32x4 acc[4][4];
    zero_acc(acc);
    RowLin rp{(const unsigned char*)(H + (size_t)mt * 128 * 512), 1024};
    gemm_main<true>(TIDX, BIDX, GDIM, acc, rp, WE + ((size_t)e * 1024 + nt * 128) * 512, 512, 512, smem);
    EPI_SWAP_BEGIN(0, nt * 128)
      const int pos = lt * 128 + row;
      if (pos < ce) {
        const int tk = ltok[(size_t)e * NTOK + pos];
        const float wt = lw[(size_t)e * NTOK + pos];
        const f32x4 a = acc[mi][ni] * wt;
        *(uint2*)(YM + (size_t)tk * 1024 + col) = make_uint2(pack2(a[0], a[1]), pack2(a[2], a[3]));
      }
    EPI_END
  }
}

DEVI void phase_p10(const int TIDX, const int BIDX, const int GDIM, KAP KA, unsigned char* WSB, float* OUTB, int l) {
  const int tid = TIDX, lane = tid & 63;
  const float* PRE = (const float*)(WSB + O_PRE);
  const bf16_t* YM = (const bf16_t*)(WSB + O_YM);
  bf16_t* XB = (bf16_t*)(WSB + O_XB);
  const float* g2 = PIN(I_LN2G) + l * 1024; const float* b2 = PIN(I_LN2B) + l * 1024;
  const int wid = BIDX * 4 + (tid >> 6), nw = GDIM * 4;
  for (int row = wid; row < NTOK; row += 2 * nw) {
    const bool hb = row + nw < NTOK;
    const int rws[2] = {row, hb ? row + nw : row};
    float4 v[2][4];
    uint2 y0[2][4], y1[2][4];
#pragma unroll
    for (int k = 0; k < 2; ++k)
#pragma unroll
      for (int j = 0; j < 4; ++j) {
        v[k][j] = *(const float4*)(PRE + (size_t)rws[k] * 1024 + j * 256 + lane * 4);
        y0[k][j] = *(const uint2*)(YM + (size_t)rws[k] * 2048 + j * 256 + lane * 4);
        y1[k][j] = *(const uint2*)(YM + (size_t)rws[k] * 2048 + 1024 + j * 256 + lane * 4);
      }
#pragma unroll
    for (int k = 0; k < 2; ++k) {
      if (k == 0 || hb) {
#pragma unroll
        for (int j = 0; j < 4; ++j) {
          v[k][j].x += lo2f(y0[k][j].x) + lo2f(y1[k][j].x); v[k][j].y += hi2f(y0[k][j].x) + hi2f(y1[k][j].x);
          v[k][j].z += lo2f(y0[k][j].y) + lo2f(y1[k][j].y); v[k][j].w += hi2f(y0[k][j].y) + hi2f(y1[k][j].y);
        }
        ln_inplace(v[k], g2, b2, lane);
        const size_t r = (size_t)rws[k];
        if (l == 0) store_row(v[k], OUTB + r * 1024, XB + r * 1024, lane);
        else {
#pragma unroll
          for (int j = 0; j < 4; ++j) *(float4*)(OUTB + r * 1024 + j * 256 + lane * 4) = v[k][j];
        }
      }
    }
  }
}

DEVI void* launder_ptr(const void* q) {
  uint32_t lo = (uint32_t)(uintptr_t)q, hi = (uint32_t)((uintptr_t)q >> 32);
  asm volatile("" : "+v"(lo), "+v"(hi));
  lo = __builtin_amdgcn_readfirstlane(lo);
  hi = __builtin_amdgcn_readfirstlane(hi);
  return (void*)(((uintptr_t)hi << 32) | lo);
}
DEVI void grid_barrier(const int TIDX, const int BIDX, const int GDIM, unsigned* bar, unsigned k) {
  __syncthreads();
  if (TIDX == 0) {
    __threadfence();
    const unsigned g = (unsigned)BIDX & 7u, gs = (unsigned)GDIM >> 3;
    const unsigned old = __hip_atomic_fetch_add(bar + 32 * (1 + g), 1u, __ATOMIC_RELAXED, __HIP_MEMORY_SCOPE_AGENT);
    if (old + 1u == gs * k) {
      __threadfence();
      __hip_atomic_fetch_add(bar, 1u, __ATOMIC_RELAXED, __HIP_MEMORY_SCOPE_AGENT);
    }
    unsigned spins = 0;
    while (__hip_atomic_load(bar, __ATOMIC_RELAXED, __HIP_MEMORY_SCOPE_AGENT) < 8u * k) {
      __builtin_amdgcn_s_sleep(1);
      if (++spins > (1u << 27)) break;
    }
    __threadfence();
  }
  __syncthreads();
}
__global__ void __launch_bounds__(256, 2) mega(Params p, int ph0, int ph1) {
  __shared__ __attribute__((aligned(16))) unsigned char smem[SMEM_TOTAL];
  const int wave_in_block = __builtin_amdgcn_readfirstlane((int)(__builtin_amdgcn_workitem_id_x() >> 6));
  for (int ph = ph0; ph < ph1; ++ph) {
    int wv_ = wave_in_block;
    asm volatile("" : "+s"(wv_));
    int TIDX = wv_ * 64 + (int)__lane_id();
    asm volatile("" : "+v"(TIDX));
    int BIDX = __builtin_amdgcn_workgroup_id_x(), GDIM = (int)gridDim.x;
    asm volatile("" : "+s"(BIDX), "+s"(GDIM));
    KAP KA;
    {
      uintptr_t q = (uintptr_t)__builtin_amdgcn_kernarg_segment_ptr();
      uint32_t lo = (uint32_t)q, hi = (uint32_t)(q >> 32);
      asm volatile("" : "+s"(lo), "+s"(hi));
      KA = (KAP)(((uintptr_t)hi << 32) | lo);
    }
    float* OUTB = (float*)PIN(31);
    unsigned char* WSB = (unsigned char*)PIN(32);
#ifndef PHSEL
#define PHSEL -1
#endif
    if (ph == 0) { if (PHSEL < 0 || PHSEL == 10) phase_prep(TIDX, BIDX, GDIM, KA, WSB, OUTB, smem); }
    else {
      const int l = (ph - 1) / 10, s = (ph - 1) % 10;
      switch (s) {
        case 0: if (PHSEL < 0 || PHSEL == 0) phase_p1(TIDX, BIDX, GDIM, KA, WSB, OUTB, l, smem); break;
        case 1: if (PHSEL < 0 || PHSEL == 1) phase_p2(TIDX, BIDX, GDIM, KA, WSB, OUTB, l, smem); break;
        case 2: if (PHSEL < 0 || PHSEL == 2) phase_p3(TIDX, BIDX, GDIM, KA, WSB, OUTB, l, smem); break;
        case 3: if (PHSEL < 0 || PHSEL == 3) phase_p4(TIDX, BIDX, GDIM, KA, WSB, OUTB, l, smem); break;
        case 4: if (PHSEL < 0 || PHSEL == 4) phase_p5(TIDX, BIDX, GDIM, KA, WSB, OUTB, l, smem); break;
        case 5: if (PHSEL < 0 || PHSEL == 5) phase_p6(TIDX, BIDX, GDIM, KA, WSB, OUTB, l, smem); break;
        case 6: if (PHSEL < 0 || PHSEL == 6) phase_p7(TIDX, BIDX, GDIM, KA, WSB, OUTB, l, smem); break;
        case 7: if (PHSEL < 0 || PHSEL == 7) phase_p8(TIDX, BIDX, GDIM, KA, WSB, OUTB, l, smem); break;
        case 8: if (PHSEL < 0 || PHSEL == 8) phase_p9(TIDX, BIDX, GDIM, KA, WSB, OUTB, l, smem); break;
        default: if (PHSEL < 0 || PHSEL == 9) phase_p10(TIDX, BIDX, GDIM, KA, WSB, OUTB, l); break;
      }
    }
#ifdef PROBE_DUP
    if (ph > 0 && (ph - 1) % 10 == PROBE_DUP) {
      cg::this_grid().sync();
      const int l = (ph - 1) / 10;
      switch (PROBE_DUP) {
        case 0: phase_p1(TIDX, BIDX, GDIM, KA, WSB, OUTB, l, smem); break;
        case 1: phase_p2(TIDX, BIDX, GDIM, KA, WSB, OUTB, l, smem); break;
        case 2: phase_p3(TIDX, BIDX, GDIM, KA, WSB, OUTB, l, smem); break;
        case 3: phase_p4(TIDX, BIDX, GDIM, KA, WSB, OUTB, l, smem, 1); break;
        case 4: phase_p5(TIDX, BIDX, GDIM, KA, WSB, OUTB, l, smem); break;
        case 5: phase_p6(TIDX, BIDX, GDIM, KA, WSB, OUTB, l, smem); break;
        case 7: phase_p8(TIDX, BIDX, GDIM, KA, WSB, OUTB, l, smem); break;
        case 8: phase_p9(TIDX, BIDX, GDIM, KA, WSB, OUTB, l, smem); break;
        case 9: phase_p10(TIDX, BIDX, GDIM, KA, WSB, OUTB, l); break;
        default: break;
      }
    }
#endif
    if (ph + 1 < ph1) {
      if (ph == ph0) cg::this_grid().sync();
      else grid_barrier(TIDX, BIDX, GDIM, (unsigned*)(WSB + O_CNT + 2048), (unsigned)(ph - ph0));
    }
  }
}

#ifndef MK_MULTI
#define MK_MULTI 0
#endif

extern "C" void kernel_launch(void* const* d_in, const int* in_sizes, int n_in, void* d_out, int out_size, void* d_ws, size_t ws_size,
                              hipStream_t stream) {
  static int grid_blocks = 0;
  if (!grid_blocks) {
    int dev = 0, cus = 0, per_cu = 0;
    hipGetDevice(&dev);
    hipDeviceGetAttribute(&cus, hipDeviceAttributeMultiprocessorCount, dev);
    hipOccupancyMaxActiveBlocksPerMultiprocessor(&per_cu, mega, 256, 0);
    if (per_cu > 2) per_cu = 2;
    if (per_cu < 1) per_cu = 1;
    grid_blocks = cus * per_cu;
  }
  Params p{};
  for (int i = 0; i < 31; ++i) p.in[i] = (const float*)d_in[i];
  p.out_ = (float*)d_out;
  p.ws_ = (unsigned char*)d_ws;
  if (ws_size < WS_END) fprintf(stderr, "workspace too small: %zu < %zu\n", ws_size, (size_t)WS_END);
#if MK_MULTI
  for (int ph = 0; ph < 21; ++ph) mega<<<dim3(grid_blocks), dim3(256), 0, stream>>>(p, ph, ph + 1);
#else
  (void)hipMemsetAsync((unsigned char*)d_ws + O_CNT + 2048, 0, 2048, stream);
  int ph0 = 0, ph1 = 21;
  void* args[] = {&p, &ph0, &ph1};
  hipError_t e = hipLaunchCooperativeKernel((void*)mega, dim3(grid_blocks), dim3(256), args, 0, stream);
  if (e != hipSuccess) fprintf(stderr, "cooperative launch failed: %s (grid %d)\n", hipGetErrorString(e), grid_blocks);
#endif
}
```

```cpp
#include <hip/hip_runtime.h>
#include <hip/hip_cooperative_groups.h>
#include <stdint.h>
#include <stdio.h>
namespace cg = cooperative_groups;

#define DEVI __device__ __forceinline__
typedef unsigned short bf16_t;
typedef short bf16x8 __attribute__((ext_vector_type(8)));
typedef float f32x4 __attribute__((ext_vector_type(4)));
typedef float f32x16 __attribute__((ext_vector_type(16)));

constexpr int NTOK = 66048, TP = 65536, TS = 512;
constexpr int NCH = NTOK / 32;
constexpr int KPAD = 4160;
constexpr float DN_ALPHA = 1.4142135623730951f;
constexpr float EPS = 1e-6f;
constexpr float QSCALE = 0.10206207261596575f * 1.4426950408889634f;

constexpr size_t OUT_Y = 0;
constexpr size_t OUT_CKV_P = 67633152ull;
constexpr size_t OUT_KR_P = 101187584ull;
constexpr size_t OUT_ST_P = 105381888ull;
constexpr size_t OUT_CKV_S = 109576192ull;
constexpr size_t OUT_KR_S = 109838336ull;
constexpr size_t OUT_ST_S = 109871104ull;

constexpr size_t WO_IN = 0, WO_G = WO_IN + 2816ull * 1024, WO_UQ = WO_G + 2048ull * 1024, WO_KV = WO_UQ + 768ull * 384,
                 WO_BRA = WO_KV + 1024ull * 256, WO_BRB = WO_BRA + 1024ull * 512, WO_OUT = WO_BRB + 1024ull * 512,
                 WO_PG = WO_OUT + 1024ull * 1024, WO_PLE = WO_PG + 1024ull * 1024, WO_END = WO_PLE + 1024ull * 256;
static_assert(WO_END == 8945664ull, "small weights");

constexpr size_t al(size_t x) { return (x + 255) & ~size_t(255); }
constexpr size_t SZ_XB = (size_t)(NTOK + 1) * 1024 * 2, SZ_LIST = 32ull * NTOK * 4, SZ_KRS = 2ull * 16 * KPAD * 32 * 2,
                 SZ_G = (size_t)NTOK * 512 * 2, SZ_CQ = (size_t)NTOK * 384 * 2, SZ_CKR = (size_t)NTOK * 288 * 4,
                 SZ_FQ = (size_t)NTOK * 1024 * 2, SZ_CKVN = (size_t)NTOK * 256 * 2, SZ_KRB = (size_t)NTOK * 32 * 2,
                 SZ_QB = (size_t)NTOK * 768 * 2, SZ_AM = (size_t)NCH * 4 * 32 * 32 * 2, SZ_EB = (size_t)NCH * 4 * 128 * 4,
                 SZ_VT = 32ull * 8 * 64 * 2048 * 2, SZ_KNS = 16ull * KPAD * 512 * 2, SZ_VTS = 16ull * 8 * 64 * KPAD * 2,
                 SZ_PRE = (size_t)NTOK * 1024 * 4, SZ_WE = 3ull * 32 * 512 * 1024 * 2, SZ_H = 1064ull * 128 * 512 * 2,
                 SZ_YM = (size_t)NTOK * 2 * 1024 * 2;
constexpr size_t O_WS = 0;
constexpr size_t O_WR = O_WS + al(2 * WO_END * 2);
constexpr size_t O_ROPE = O_WR + al(2ull * 36 * 1024 * 4);
constexpr size_t O_CNT = O_ROPE + al(2080ull * 16 * 2 * 4);
constexpr size_t O_XB = O_CNT + 4096;
constexpr size_t O_LTOK = O_XB + al(SZ_XB);
constexpr size_t O_LW = O_LTOK + al(SZ_LIST);
constexpr size_t O_KRS = O_LW + al(SZ_LIST);
constexpr size_t O_G = O_KRS + al(SZ_KRS);
constexpr size_t O_VT2 = O_G + al(SZ_G);
constexpr size_t O_CQ = O_VT2 + al(SZ_G);
constexpr size_t O_CKR = O_CQ + al(SZ_CQ);
constexpr size_t O_FQ = O_CKR + al(SZ_CKR);
constexpr size_t O_CKVN = O_FQ + al(SZ_FQ);
constexpr size_t O_KRB = O_CKVN + al(SZ_CKVN);
constexpr size_t O_QB = O_KRB + al(SZ_KRB);
constexpr size_t O_QT = O_QB + al(SZ_QB);
constexpr size_t O_KHT = O_QT + al(SZ_G);
constexpr size_t O_AM = O_KHT + al(SZ_G);
constexpr size_t O_EB = O_AM + al(SZ_AM);
constexpr size_t O_KN = O_EB + al(SZ_EB);
constexpr size_t O_HO = O_KN + al(SZ_G);
constexpr size_t O_CCB = O_HO + al(SZ_G);
constexpr size_t WS_END = O_CCB + 16ull * 4096 * 256 * 2;
constexpr size_t O_VT = O_CQ;
constexpr size_t O_KNS = O_VT + al(SZ_VT);
constexpr size_t O_VTS = O_KNS + al(SZ_KNS);
constexpr size_t O_AO = O_VTS + al(SZ_VTS);
constexpr size_t O_MG = O_QB;
constexpr size_t O_PRE = O_G;
constexpr size_t O_WE = O_VTS;
constexpr size_t O_H = O_WE + al(SZ_WE);
constexpr size_t O_YM = O_H + al(SZ_H);
static_assert(O_AO + SZ_G <= O_KRB, "AO");
static_assert(O_AO >= O_VTS + SZ_VTS, "AO2");
static_assert(O_MG + SZ_XB <= O_KN, "MG");
static_assert(O_PRE + SZ_PRE <= O_WE, "PRE");
static_assert(O_YM + SZ_YM <= WS_END, "YM");
static_assert(WS_END <= (1ull << 30), "workspace");

struct Params { const float* in[31]; float* out_; unsigned char* ws_; };
typedef const __attribute__((address_space(4))) unsigned char* KAP;
#define PIN(i) (*(const float* const __attribute__((address_space(4)))*)(KA + 8 * (i)))

enum { I_XP = 0, I_XS, I_PP, I_PS, I_CCKV, I_CKR, I_ST, I_LN0G, I_LN0B, I_WIN, I_QN, I_WUQ, I_KVN, I_WUK, I_WUV, I_HGLB, I_HGN,
       I_WBRA, I_WBRB, I_WOUT, I_LN1G, I_LN1B, I_WRG, I_WRE, I_WE1, I_WE3, I_WE2, I_WPLE, I_WPG, I_LN2G, I_LN2B };

DEVI float bf2f(bf16_t h) { return __uint_as_float(((uint32_t)h) << 16); }
DEVI bf16_t f2bf(float f) { uint32_t u = __float_as_uint(f); u += 0x7fffu + ((u >> 16) & 1u); return (bf16_t)(u >> 16); }
typedef float f32x2_t __attribute__((ext_vector_type(2)));
typedef __bf16 bf16x2_t __attribute__((ext_vector_type(2)));
DEVI uint32_t pack2(float lo, float hi) { f32x2_t v = {lo, hi}; bf16x2_t b = __builtin_convertvector(v, bf16x2_t); return __builtin_bit_cast(uint32_t, b); }
DEVI float lo2f(uint32_t u) { return __uint_as_float(u << 16); }
DEVI float hi2f(uint32_t u) { return __uint_as_float(u & 0xffff0000u); }
DEVI float dpp_add_(float v, const int ctrl_sel) {
  const int iv = __float_as_int(v);
  int o;
  if (ctrl_sel == 0) o = __builtin_amdgcn_update_dpp(0, iv, 0xB1, 0xf, 0xf, true);
  else if (ctrl_sel == 1) o = __builtin_amdgcn_update_dpp(0, iv, 0x4E, 0xf, 0xf, true);
  else if (ctrl_sel == 2) o = __builtin_amdgcn_update_dpp(0, iv, 0x141, 0xf, 0xf, true);
  else o = __builtin_amdgcn_update_dpp(0, iv, 0x140, 0xf, 0xf, true);
  return v + __int_as_float(o);
}
DEVI float wave_sum(float v) {
  v = dpp_add_(v, 0);
  v = dpp_add_(v, 1);
  v = dpp_add_(v, 2);
  v = dpp_add_(v, 3);
  const int iv = __float_as_int(v);
  const float r0 = __int_as_float(__builtin_amdgcn_readlane(iv, 0)), r1 = __int_as_float(__builtin_amdgcn_readlane(iv, 16));
  const float r2 = __int_as_float(__builtin_amdgcn_readlane(iv, 32)), r3 = __int_as_float(__builtin_amdgcn_readlane(iv, 48));
  return (r0 + r1) + (r2 + r3);
}
DEVI float sigmoidf_(float x) { return 1.f / (1.f + __expf(-x)); }
DEVI float siluf_(float x) { return x / (1.f + __expf(-x)); }
DEVI f32x4 mfma16(bf16x8 a, bf16x8 b, f32x4 c) { return __builtin_amdgcn_mfma_f32_16x16x32_bf16(a, b, c, 0, 0, 0); }
DEVI f32x16 mfma32(bf16x8 a, bf16x8 b, f32x16 c) { return __builtin_amdgcn_mfma_f32_32x32x16_bf16(a, b, c, 0, 0, 0); }
DEVI bf16x8 mk8(uint32_t a, uint32_t b, uint32_t c, uint32_t d) { uint4 u = make_uint4(a, b, c, d); return *(bf16x8*)&u; }
DEVI bf16x8 mk8(uint2 lo, uint2 hi) { uint4 u = make_uint4(lo.x, lo.y, hi.x, hi.y); return *(bf16x8*)&u; }

constexpr int SMEM_GEMM = 2 * 2 * 128 * 72 * 2;
constexpr int SMEM_TOTAL = SMEM_GEMM + 2048;

template <bool SWAP, class RP>
DEVI void gemm_main(const int TIDX, const int BIDX, const int GDIM, f32x4 (&acc)[4][4], RP rowoff, const bf16_t* __restrict__ Bt, int ldb, int K, unsigned char* smem) {
  const int tid = TIDX;
  const int lane = tid & 63, w = tid >> 6, wr = w >> 1, wc = w & 1, li = lane & 15, lg = lane >> 4;
  const unsigned char* abase = rowoff.base;
  const unsigned char* bbase = (const unsigned char*)Bt;
  const uint32_t schunk = (uint32_t)((lane & 7) ^ (((lane >> 4) + 4 * (w & 1)) & 7)) * 16u;
  uint32_t ao0, ao1, ao2, ao3;
  const int rsub = w * 8 + (lane >> 3);
  ao0 = rowoff(rsub) + schunk; ao1 = rowoff(rsub + 32) + schunk; ao2 = rowoff(rsub + 64) + schunk; ao3 = rowoff(rsub + 96) + schunk;
  const uint32_t bo = (uint32_t)(rsub * ldb) * 2u + schunk, bstep = (uint32_t)(32 * ldb) * 2u;
  unsigned char* sbase = smem + w * 1024;
#define GM_STAGE(kt_, buf_)                                                                                                       \
  {                                                                                                                              \
    unsigned char* da_ = sbase + (buf_) * 32768;                                                                                 \
    unsigned char* db_ = da_ + 16384;                                                                                            \
    const uint32_t ko_ = (uint32_t)(kt_) * 128u;                                                                                 \
    __builtin_amdgcn_global_load_lds((const unsigned*)(abase + ao0 + ko_), (unsigned*)(da_), 16, 0, 0);                         \
    __builtin_amdgcn_global_load_lds((const unsigned*)(abase + ao1 + ko_), (unsigned*)(da_ + 4096), 16, 0, 0);                  \
    __builtin_amdgcn_global_load_lds((const unsigned*)(abase + ao2 + ko_), (unsigned*)(da_ + 8192), 16, 0, 0);                  \
    __builtin_amdgcn_global_load_lds((const unsigned*)(abase + ao3 + ko_), (unsigned*)(da_ + 12288), 16, 0, 0);                 \
    __builtin_amdgcn_global_load_lds((const unsigned*)(bbase + bo + ko_), (unsigned*)(db_), 16, 0, 0);                          \
    __builtin_amdgcn_global_load_lds((const unsigned*)(bbase + bo + bstep + ko_), (unsigned*)(db_ + 4096), 16, 0, 0);           \
    __builtin_amdgcn_global_load_lds((const unsigned*)(bbase + bo + 2u * bstep + ko_), (unsigned*)(db_ + 8192), 16, 0, 0);      \
    __builtin_amdgcn_global_load_lds((const unsigned*)(bbase + bo + 3u * bstep + ko_), (unsigned*)(db_ + 12288), 16, 0, 0);     \
  }
  const int nk = K >> 6;
  const int px = lg ^ (li >> 1);
  GM_STAGE(0, 0);
  for (int kt = 0; kt < nk; ++kt) {
    const int buf = kt & 1;
    asm volatile("s_waitcnt vmcnt(0)" ::: "memory");
    __syncthreads();
    if (kt + 1 < nk) GM_STAGE(kt + 1, buf ^ 1);
    const unsigned char* A = smem + buf * 32768 + (wr * 64 + li) * 128;
    const unsigned char* B = smem + buf * 32768 + 16384 + (wc * 64 + li) * 128;
#pragma unroll
    for (int ks = 0; ks < 2; ++ks) {
      const int po = (px ^ (ks * 4)) * 16;
      bf16x8 af[4], bfr[4];
#pragma unroll
      for (int i = 0; i < 4; ++i) {
        af[i] = *(const bf16x8*)(A + i * 2048 + po);
        bfr[i] = *(const bf16x8*)(B + i * 2048 + po);
      }
#pragma unroll
      for (int mi = 0; mi < 4; ++mi)
#pragma unroll
        for (int ni = 0; ni < 4; ++ni)
          acc[mi][ni] = SWAP ? mfma16(bfr[ni], af[mi], acc[mi][ni]) : mfma16(af[mi], bfr[ni], acc[mi][ni]);
    }
  }
  __syncthreads();
}
DEVI float zero_f() { float z = 0.f; asm volatile("" : "+v"(z)); return z; }
DEVI void zero_acc(f32x4 (&acc)[4][4]) {
  const float z = zero_f();
#pragma unroll
  for (int i = 0; i < 4; ++i)
#pragma unroll
    for (int j = 0; j < 4; ++j) acc[i][j] = (f32x4){z, z, z, z};
}
#define EPI_SWAP_BEGIN(m0, n0)                                                                     \
  {                                                                                                \
    const int _lane = TIDX & 63, _w = TIDX >> 6;                                     \
    const int _rb = (m0) + (_w >> 1) * 64 + (_lane & 15), _cb = (n0) + (_w & 1) * 64 + 4 * (_lane >> 4); \
    _Pragma("unroll") for (int mi = 0; mi < 4; ++mi) {                                             \
      const int row = _rb + mi * 16;                                                               \
      _Pragma("unroll") for (int ni = 0; ni < 4; ++ni) {                                           \
        const int col = _cb + ni * 16;
#define EPI_END } __builtin_amdgcn_sched_barrier(0); } }

struct RowLin {
  const unsigned char* base; uint32_t stride;
  DEVI uint32_t operator()(int r) const { return (uint32_t)r * stride; }
};

struct CMap {
  int mode;
  DEVI int operator()(int n) const {
    if (mode == 0) return n;
    if (mode == 1) return n < 672 ? n : (n < 768 ? -1 : n - 96);
    if (mode == 2) return n + 2720;
    if (n < 512) return (n >> 6) * 96 + (n & 63);
    const int m = n - 512, h = m >> 5, w = m & 31;
    return h * 96 + (w < 16 ? 64 + w : 80 + (w - 16));
  }
};
DEVI void transpose_tile(const int TIDX, const int BIDX, const int GDIM, const float* __restrict__ src, int ld, int K, bf16_t* __restrict__ dst, int k0, int n0, CMap cm,
                         const float* kscale, float* tile) {
  const int t = TIDX;
  {
    const int n4 = (t & 15) * 4, kr = t >> 4;
    const int sc = cm(n0 + n4);
#pragma unroll
    for (int p = 0; p < 4; ++p) {
      const int k = kr + 16 * p;
      float4 v = make_float4(0.f, 0.f, 0.f, 0.f);
      if (sc >= 0) {
        v = *(const float4*)(src + (size_t)(k0 + k) * ld + sc);
        if (kscale) { const float sck = kscale[k0 + k]; v.x *= sck; v.y *= sck; v.z *= sck; v.w *= sck; }
      }
      float* d = tile + k * 65 + n4;
      d[0] = v.x; d[1] = v.y; d[2] = v.z; d[3] = v.w;
    }
  }
  __syncthreads();
  {
    const int kc = (t & 7) * 8, nr = t >> 3;
#pragma unroll
    for (int q = 0; q < 2; ++q) {
      const int n = nr + 32 * q;
      const float* sp = tile + kc * 65 + n;
      const uint4 o = make_uint4(pack2(sp[0], sp[65]), pack2(sp[130], sp[195]), pack2(sp[260], sp[325]), pack2(sp[390], sp[455]));
      *(uint4*)(dst + (size_t)(n0 + n) * K + k0 + kc) = o;
    }
  }
  __syncthreads();
}
DEVI void run_transpose(const int TIDX, const int BIDX, const int GDIM, const float* src, int ld, int K, int N, bf16_t* dst, int mode, const float* kscale, float* tile) {
  const int nkt = K >> 6, tiles = nkt * (N >> 6);
  CMap cm{mode};
  for (int t = BIDX; t < tiles; t += GDIM) transpose_tile(TIDX, BIDX, GDIM, src, ld, K, dst, (t % nkt) * 64, (t / nkt) * 64, cm, kscale, tile);
}

DEVI void ln_inplace(float4 (&v)[4], const float* __restrict__ g, const float* __restrict__ b, int lane) {
  float s = 0.f;
#pragma unroll
  for (int j = 0; j < 4; ++j) s += v[j].x + v[j].y + v[j].z + v[j].w;
  s = wave_sum(s);
  const float mu = s * (1.f / 1024.f);
  float q = 0.f;
#pragma unroll
  for (int j = 0; j < 4; ++j) {
    float a = v[j].x - mu, bq = v[j].y - mu, cq = v[j].z - mu, d = v[j].w - mu;
    q += a * a + bq * bq + cq * cq + d * d;
  }
  q = wave_sum(q);
  const float rs = rsqrtf(q * (1.f / 1024.f) + EPS);
#pragma unroll
  for (int j = 0; j < 4; ++j) {
    const float4 gg = *(const float4*)(g + j * 256 + lane * 4), bb = *(const float4*)(b + j * 256 + lane * 4);
    v[j].x = (v[j].x - mu) * rs * gg.x + bb.x;
    v[j].y = (v[j].y - mu) * rs * gg.y + bb.y;
    v[j].z = (v[j].z - mu) * rs * gg.z + bb.z;
    v[j].w = (v[j].w - mu) * rs * gg.w + bb.w;
  }
}
DEVI void store_row(const float4 (&v)[4], float* x32, bf16_t* x16, int lane) {
#pragma unroll
  for (int j = 0; j < 4; ++j) {
    *(float4*)(x32 + j * 256 + lane * 4) = v[j];
    *(uint2*)(x16 + j * 256 + lane * 4) = make_uint2(pack2(v[j].x, v[j].y), pack2(v[j].z, v[j].w));
  }
}
DEVI int pos_index(int row) { return row < TP ? (row & 2047) : 2048 + ((row - TP) & 31); }

DEVI void phase_prep(const int TIDX, const int BIDX, const int GDIM, KAP KA, unsigned char* WSB, float* OUTB, unsigned char* smem) {
  float* tile = (float*)smem;
  bf16_t* WS = (bf16_t*)(WSB + O_WS);
  const int tid = TIDX, gtid = BIDX * 256 + tid, gsz = GDIM * 256;
  if (gtid < 512) ((int*)(WSB + O_CNT))[gtid] = 0;
  if (gtid < 512) ((uint32_t*)(WSB + O_XB + (size_t)NTOK * 2048))[gtid] = 0u;
  for (int i = gtid; i < 2080 * 16; i += gsz) {
    const int pi = i >> 4, k = i & 15;
    const int pos = pi < 2048 ? pi : 4096 + (pi - 2048);
    const float inv = exp2f(-(float)k * (13.287712379549449f / 16.f));
    const float ang = (float)pos * inv;
    double rev = (double)ang * 0.15915494309189535;
    rev -= __builtin_rint(rev);
    const float fr = (float)rev;
    float2 cs = make_float2(__builtin_amdgcn_cosf(fr), __builtin_amdgcn_sinf(fr));
    ((float2*)(WSB + O_ROPE))[i] = cs;
  }
  for (int i = gtid; i < 2 * 36 * 1024; i += gsz) {
    const int l = i / (36 * 1024), r = i % (36 * 1024), c = r >> 10, k = r & 1023;
    float v = c < 4 ? PIN(I_WRG)[((size_t)l * 1024 + k) * 4 + c] : PIN(I_WRE)[((size_t)l * 1024 + k) * 32 + (c - 4)];
    ((float*)(WSB + O_WR))[i] = v;
  }
  for (int i = gtid; i < 2 * 16 * 4096 * 8; i += gsz) {
    const int e = i * 4, lb = e / (4096 * 32), r = e % (4096 * 32);
    const float4 v = *(const float4*)(PIN(I_CKR) + (size_t)e);
    *(uint2*)((bf16_t*)(WSB + O_KRS) + (size_t)lb * KPAD * 32 + r) = make_uint2(pack2(v.x, v.y), pack2(v.z, v.w));
  }
  {
    const int lane = tid & 63, wid = BIDX * 4 + (tid >> 6), nw = GDIM * 4;
    for (int row = wid; row < NTOK; row += 2 * nw) {
      const bool hb = row + nw < NTOK;
      const int rws[2] = {row, hb ? row + nw : row};
      float4 v[2][4];
#pragma unroll
      for (int k = 0; k < 2; ++k) {
        const float* src = rws[k] < TP ? PIN(I_XP) + (size_t)rws[k] * 1024 : PIN(I_XS) + (size_t)(rws[k] - TP) * 1024;
#pragma unroll
        for (int j = 0; j < 4; ++j) v[k][j] = *(const float4*)(src + j * 256 + lane * 4);
      }
#pragma unroll
      for (int k = 0; k < 2; ++k) {
        if (k == 0 || hb) {
          ln_inplace(v[k], PIN(I_LN0G), PIN(I_LN0B), lane);
          store_row(v[k], OUTB + (size_t)rws[k] * 1024, (bf16_t*)(WSB + O_XB) + (size_t)rws[k] * 1024, lane);
        }
      }
    }
  }
  for (int l = 0; l < 2; ++l) {
    bf16_t* W = WS + (size_t)l * WO_END;
    run_transpose(TIDX, BIDX, GDIM, PIN(I_WIN) + (size_t)l * 1024 * 4768, 4768, 1024, 2816, W + WO_IN, 1, nullptr, tile);
    run_transpose(TIDX, BIDX, GDIM, PIN(I_WIN) + (size_t)l * 1024 * 4768, 4768, 1024, 2048, W + WO_G, 2, nullptr, tile);
    run_transpose(TIDX, BIDX, GDIM, PIN(I_WUQ) + (size_t)l * 384 * 768, 768, 384, 768, W + WO_UQ, 3, PIN(I_QN) + l * 384, tile);
    run_transpose(TIDX, BIDX, GDIM, PIN(I_WUK) + (size_t)l * 256 * 512, 512, 256, 512, W + WO_KV, 0, nullptr, tile);
    run_transpose(TIDX, BIDX, GDIM, PIN(I_WUV) + (size_t)l * 256 * 512, 512, 256, 512, W + WO_KV + 512 * 256, 0, nullptr, tile);
    run_transpose(TIDX, BIDX, GDIM, PIN(I_WBRA) + (size_t)l * 512 * 1024, 1024, 512, 1024, W + WO_BRA, 0, nullptr, tile);
    run_transpose(TIDX, BIDX, GDIM, PIN(I_WBRB) + (size_t)l * 512 * 1024, 1024, 512, 1024, W + WO_BRB, 0, nullptr, tile);
    run_transpose(TIDX, BIDX, GDIM, PIN(I_WOUT) + (size_t)l * 1024 * 1024, 1024, 1024, 1024, W + WO_OUT, 0, nullptr, tile);
    run_transpose(TIDX, BIDX, GDIM, PIN(I_WPG) + (size_t)l * 1024 * 1024, 1024, 1024, 1024, W + WO_PG, 0, nullptr, tile);
    run_transpose(TIDX, BIDX, GDIM, PIN(I_WPLE) + (size_t)l * 256 * 1024, 1024, 256, 1024, W + WO_PLE, 0, nullptr, tile);
  }
}

DEVI void phase_p1(const int TIDX, const int BIDX, const int GDIM, KAP KA, unsigned char* WSB, float* OUTB, int l, unsigned char* smem) {
  const bf16_t* XB = (const bf16_t*)(WSB + O_XB);
  const bf16_t* W = (const bf16_t*)(WSB + O_WS) + (size_t)l * WO_END + WO_IN;
  bf16_t* CQ = (bf16_t*)(WSB + O_CQ);
  float* CKR = (float*)(WSB + O_CKR);
  bf16_t* FQ = (bf16_t*)(WSB + O_FQ);
  bf16_t* VT2 = (bf16_t*)(WSB + O_VT2);
  bf16_t* G = (bf16_t*)(WSB + O_G);
  for (int item = (BIDX & 7) * (GDIM >> 3) + (BIDX >> 3); item < 516 * 22; item += GDIM) {
    const int mt = item / 22, nt = item % 22, m0 = mt * 128;
    f32x4 acc[4][4];
    zero_acc(acc);
    RowLin rp{(const unsigned char*)(XB + (size_t)m0 * 1024), 2048};
    if (nt >= 14 && nt < 18) {
      gemm_main<false>(TIDX, BIDX, GDIM, acc, rp, W + (size_t)nt * 128 * 1024, 1024, 1024, smem);
      const int h = nt - 14, lane = TIDX & 63, w = TIDX >> 6;
      const int rb = m0 + (w >> 1) * 64 + 4 * (lane >> 4), cb = (w & 1) * 64 + (lane & 15);
#pragma unroll
      for (int mi = 0; mi < 4; ++mi) {
        const int row = rb + mi * 16, ch = row >> 5, s = row & 31;
#pragma unroll
        for (int ni = 0; ni < 4; ++ni) {
          const int dv = cb + ni * 16;
          const f32x4 a = acc[mi][ni];
          *(uint2*)(VT2 + ((size_t)(ch * 4 + h) * 128 + dv) * 32 + s) = make_uint2(pack2(a[0], a[1]), pack2(a[2], a[3]));
        }
      }
    } else {
      gemm_main<true>(TIDX, BIDX, GDIM, acc, rp, W + (size_t)nt * 128 * 1024, 1024, 1024, smem);
      EPI_SWAP_BEGIN(m0, 0)
        const f32x4 a = acc[mi][ni];
        if (nt < 3) {
          *(uint2*)(CQ + (size_t)row * 384 + nt * 128 + col) = make_uint2(pack2(a[0], a[1]), pack2(a[2], a[3]));
        } else if (nt < 5) {
          *(f32x4*)(CKR + (size_t)row * 288 + (nt - 3) * 128 + col) = a;
        } else if (nt == 5) {
          if (col < 32) *(f32x4*)(CKR + (size_t)row * 288 + 256 + col) = a;
        } else if (nt < 14) {
          *(uint2*)(FQ + (size_t)row * 1024 + (nt - 6) * 128 + col) = make_uint2(pack2(a[0], a[1]), pack2(a[2], a[3]));
        } else {
          *(uint2*)(G + (size_t)row * 512 + (nt - 18) * 128 + col) = make_uint2(pack2(a[0], a[1]), pack2(a[2], a[3]));
        }
      EPI_END
    }
  }
}

DEVI void phase_p2(const int TIDX, const int BIDX, const int GDIM, KAP KA, unsigned char* WSB, float* OUTB, int l, unsigned char* smem) {
  const int tid = TIDX, lane = tid & 63;
  const float2* ROPE = (const float2*)(WSB + O_ROPE);
  {
    const bf16_t* CQ = (const bf16_t*)(WSB + O_CQ);
    const bf16_t* W = (const bf16_t*)(WSB + O_WS) + (size_t)l * WO_END + WO_UQ;
    bf16_t* QB = (bf16_t*)(WSB + O_QB);
    float* srow = (float*)(smem + SMEM_GEMM);
    for (int item = (BIDX & 7) * (GDIM >> 3) + (BIDX >> 3); item < 516 * 6; item += GDIM) {
      const int mt = item / 6, nt = item % 6, m0 = mt * 128;
      {
        const int r = tid >> 1, hf = tid & 1;
        const uint4* s = (const uint4*)(CQ + (size_t)(m0 + r) * 384 + hf * 192);
        float ss = 0.f;
#pragma unroll 4
        for (int j = 0; j < 24; ++j) {
          const uint4 u = s[j];
          float a;
          a = lo2f(u.x); ss += a * a; a = hi2f(u.x); ss += a * a;
          a = lo2f(u.y); ss += a * a; a = hi2f(u.y); ss += a * a;
          a = lo2f(u.z); ss += a * a; a = hi2f(u.z); ss += a * a;
          a = lo2f(u.w); ss += a * a; a = hi2f(u.w); ss += a * a;
        }
        ss += __shfl_xor(ss, 1);
        if (hf == 0) srow[r] = rsqrtf(ss * (1.f / 384.f) + EPS) * QSCALE;
      }
      f32x4 acc[4][4];
      zero_acc(acc);
      RowLin rp{(const unsigned char*)(CQ + (size_t)m0 * 384), 768};
      gemm_main<true>(TIDX, BIDX, GDIM, acc, rp, W + (size_t)nt * 128 * 384, 384, 384, smem);
      if (nt < 4) {
        EPI_SWAP_BEGIN(m0, nt * 128)
          const float sc = srow[row - m0];
          const f32x4 a = acc[mi][ni] * sc;
          const int hh = col >> 6, d = col & 63;
          *(uint2*)(QB + (size_t)row * 768 + hh * 96 + d) = make_uint2(pack2(a[0], a[1]), pack2(a[2], a[3]));
        EPI_END
      } else {
        const int w = tid >> 6;
        const int rb = m0 + (w >> 1) * 64 + (lane & 15), i0 = 4 * (lane >> 4);
#pragma unroll
        for (int mi = 0; mi < 4; ++mi) {
          const int row = rb + mi * 16;
          const float sc = srow[row - m0];
          const float2* rt = ROPE + (size_t)pos_index(row) * 16 + i0;
#pragma unroll
          for (int pr = 0; pr < 2; ++pr) {
            const int hh = (nt - 4) * 4 + (w & 1) * 2 + pr;
            const f32x4 x1 = acc[mi][2 * pr] * sc, x2 = acc[mi][2 * pr + 1] * sc;
            float o1[4], o2[4];
#pragma unroll
            for (int r = 0; r < 4; ++r) {
              const float2 cs = rt[r];
              o1[r] = x1[r] * cs.x - x2[r] * cs.y;
              o2[r] = x2[r] * cs.x + x1[r] * cs.y;
            }
            *(uint2*)(QB + (size_t)row * 768 + hh * 96 + 64 + i0) = make_uint2(pack2(o1[0], o1[1]), pack2(o1[2], o1[3]));
            *(uint2*)(QB + (size_t)row * 768 + hh * 96 + 80 + i0) = make_uint2(pack2(o2[0], o2[1]), pack2(o2[2], o2[3]));
          }
        }
      }
      __syncthreads();
    }
  }
  {
    const bf16_t* FQ = (const bf16_t*)(WSB + O_FQ);
    bf16_t* QT = (bf16_t*)(WSB + O_QT);
    bf16_t* KHT = (bf16_t*)(WSB + O_KHT);
    bf16_t* AM = (bf16_t*)(WSB + O_AM);
    float* EBp = (float*)(WSB + O_EB);
    bf16_t* sQ = (bf16_t*)smem;
    bf16_t* sK = sQ + 32 * 136;
    for (int item = BIDX; item < NCH * 4; item += GDIM) {
      const int ch = item >> 2, h = item & 3, cid = item;
      {
        const int k = tid & 127, half = tid >> 7, colh = h * 128 + k;
        float* sB = (float*)(smem + 2 * 32 * 136 * 2);
        float lb = 0.f;
        if (l == 1) { const float a0 = PIN(I_HGLB)[colh], a1 = PIN(I_HGLB)[512 + colh]; lb = 1.f / (1.f + expf(a0 - a1)); }
        const float oml = 1.f - lb;
        float bt[16], kk[16], qv[16];
        float bl = 0.f;
#pragma unroll
        for (int j = 0; j < 16; ++j) {
          const size_t row = (size_t)ch * 32 + half * 16 + j;
          const float z = bf2f(FQ[row * 1024 + colh]);
          qv[j] = bf2f(FQ[row * 1024 + 512 + colh]);
          const float e = __expf(-z);
          const float inv = __builtin_amdgcn_rcpf(1.f + e);
          const float f = lb + oml * inv;
          kk[j] = oml * e * inv;
          bl += __logf(f);
          bt[j] = bl;
        }
        sB[half * 128 + k] = bl;
        __syncthreads();
        const float b0 = sB[k], b1 = sB[128 + k];
        const float off = half ? b0 : 0.f, bend = b0 + b1;
        uint32_t pk[8];
#pragma unroll
        for (int j = 0; j < 16; ++j) {
          const int t = half * 16 + j;
          const float b = bt[j] + off;
          const float qs = qv[j] * __builtin_amdgcn_rcpf(1.f + __expf(-qv[j]));
          const bf16_t qt = f2bf(qs * __expf(b));
          QT[((size_t)cid * 32 + t) * 128 + k] = qt;
          sQ[t * 136 + k] = qt;
          sK[t * 136 + k] = f2bf(kk[j] * __expf(fminf(-b, 80.f)));
          bt[j] = kk[j] * __expf(bend - b);
        }
#pragma unroll
        for (int j = 0; j < 8; ++j) pk[j] = pack2(bt[2 * j], bt[2 * j + 1]);
        if (half == 0) EBp[(size_t)cid * 128 + k] = __expf(bend);
        uint4* dst = (uint4*)(KHT + ((size_t)cid * 128 + k) * 32 + half * 16);
        dst[0] = make_uint4(pk[0], pk[1], pk[2], pk[3]);
        dst[1] = make_uint4(pk[4], pk[5], pk[6], pk[7]);
      }
      __syncthreads();
      if (tid < 64) {
        const int c = lane & 31, hh = lane >> 5;
        f32x16 am;
        const float zf = zero_f();
#pragma unroll
        for (int r = 0; r < 16; ++r) am[r] = zf;
#pragma unroll
        for (int st = 0; st < 8; ++st) {
          const bf16x8 a = *(const bf16x8*)(sQ + c * 136 + st * 16 + hh * 8);
          const bf16x8 bb = *(const bf16x8*)(sK + c * 136 + st * 16 + hh * 8);
          am = mfma32(a, bb, am);
        }
#pragma unroll
        for (int r = 0; r < 16; ++r) {
          const int t = (r & 3) + 8 * (r >> 2) + 4 * hh;
          AM[((size_t)cid * 32 + t) * 32 + c] = f2bf(c <= t ? am[r] : 0.f);
        }
      }
      __syncthreads();
    }
  }
  {
    const float* src = PIN(I_CCKV) + (size_t)l * 16 * 4096 * 256;
    bf16_t* CCB = (bf16_t*)(WSB + O_CCB);
    const size_t str_ = (size_t)GDIM * 256;
    for (size_t i = (size_t)BIDX * 256 + tid; i < 16ull * 4096 * 64; i += 4 * str_) {
      float4 v4[4];
#pragma unroll
      for (int k = 0; k < 4; ++k) { const size_t ii = i + k * str_ < 16ull * 4096 * 64 ? i + k * str_ : i; v4[k] = *(const float4*)(src + ii * 4); }
#pragma unroll
      for (int k = 0; k < 4; ++k) if (i + k * str_ < 16ull * 4096 * 64) *(uint2*)(CCB + (i + k * str_) * 4) = make_uint2(pack2(v4[k].x, v4[k].y), pack2(v4[k].z, v4[k].w));
    }
  }
  {
    const float* CKR = (const float*)(WSB + O_CKR);
    bf16_t* CKVN = (bf16_t*)(WSB + O_CKVN);
    bf16_t* KRB = (bf16_t*)(WSB + O_KRB);
    bf16_t* KRS = (bf16_t*)(WSB + O_KRS) + (size_t)l * 16 * KPAD * 32;
    const float* kvn = PIN(I_KVN) + l * 256;
    const int wid = BIDX * 4 + (tid >> 6), nw = GDIM * 4;
    const float4 g = *(const float4*)(kvn + lane * 4);
    for (int row0 = wid; row0 < NTOK; row0 += 4 * nw) {
      int rws[4]; bool ok4[4];
      float4 v[4]; float x1[4], x2[4]; float2 cs[4];
#pragma unroll
      for (int k = 0; k < 4; ++k) {
        ok4[k] = row0 + k * nw < NTOK;
        rws[k] = ok4[k] ? row0 + k * nw : row0;
        const float* src = CKR + (size_t)rws[k] * 288;
        v[k] = *(const float4*)(src + lane * 4);
        x1[k] = src[256 + (lane & 15)]; x2[k] = src[272 + (lane & 15)];
        cs[k] = ROPE[(size_t)pos_index(rws[k]) * 16 + (lane & 15)];
      }
#pragma unroll
      for (int k = 0; k < 4; ++k) {
        if (ok4[k]) {
          const int row = rws[k];
          float ss = wave_sum(v[k].x * v[k].x + v[k].y * v[k].y + v[k].z * v[k].z + v[k].w * v[k].w);
          const float rs = rsqrtf(ss * (1.f / 256.f) + EPS);
          const float4 o = make_float4(v[k].x * rs * g.x, v[k].y * rs * g.y, v[k].z * rs * g.z, v[k].w * rs * g.w);
          float* oc = row < TP ? OUTB + OUT_CKV_P + ((size_t)l * TP + row) * 256 : OUTB + OUT_CKV_S + ((size_t)l * TS + (row - TP)) * 256;
          *(float4*)(oc + lane * 4) = o;
          *(uint2*)(CKVN + (size_t)row * 256 + lane * 4) = make_uint2(pack2(o.x, o.y), pack2(o.z, o.w));
          if (lane < 16) {
            const float o1 = x1[k] * cs[k].x - x2[k] * cs[k].y, o2 = x2[k] * cs[k].x + x1[k] * cs[k].y;
            float* okp = row < TP ? OUTB + OUT_KR_P + ((size_t)l * TP + row) * 32 : OUTB + OUT_KR_S + ((size_t)l * TS + (row - TP)) * 32;
            okp[lane] = o1;
            okp[16 + lane] = o2;
            bf16_t* kb = row < TP ? KRB + (size_t)row * 32 : KRS + ((size_t)((row - TP) >> 5) * KPAD + 4096 + ((row - TP) & 31)) * 32;
            kb[lane] = f2bf(o1);
            kb[16 + lane] = f2bf(o2);
          }
        }
      }
    }
  }
}

DEVI void phase_p3(const int TIDX, const int BIDX, const int GDIM, KAP KA, unsigned char* WSB, float* OUTB, int l, unsigned char* smem) {
  const bf16_t* W = (const bf16_t*)(WSB + O_WS) + (size_t)l * WO_END + WO_KV;
  const bf16_t* CKVN = (const bf16_t*)(WSB + O_CKVN);
  bf16_t* KN = (bf16_t*)(WSB + O_KN);
  bf16_t* VT = (bf16_t*)(WSB + O_VT);
  bf16_t* KNS = (bf16_t*)(WSB + O_KNS);
  bf16_t* VTS = (bf16_t*)(WSB + O_VTS);
  const bf16_t* cache = (const bf16_t*)(WSB + O_CCB);
  for (int i = BIDX * 256 + TIDX; i < 16 * 8 * 64 * 4; i += GDIM * 256) {
    const uint32_t z = __float_as_uint(zero_f());
    *(uint4*)(VTS + (size_t)(i >> 2) * KPAD + 4128 + (i & 3) * 8) = make_uint4(z, z, z, z);
  }
  for (int item = (BIDX & 7) * (GDIM >> 3) + (BIDX >> 3); item < (516 + 512) * 8; item += GDIM) {
    const int mt = item >> 3, nt = item & 7;
    const bool is_cache = mt >= 516;
    const int m0 = is_cache ? (mt - 516) * 128 : mt * 128;
    f32x4 acc[4][4];
    zero_acc(acc);
    bf16_t* kdst; bf16_t* vdst; size_t ldv; int key0;
    if (is_cache) { const int b = m0 >> 12; key0 = m0 & 4095; kdst = KNS + ((size_t)b * KPAD + key0) * 512; vdst = VTS + (size_t)b * 8 * 64 * KPAD; ldv = KPAD; }
    else if (m0 >= TP) { kdst = nullptr; vdst = nullptr; ldv = KPAD; key0 = 0; }
    else { const int b = m0 >> 11; key0 = m0 & 2047; kdst = KN + (size_t)m0 * 512; vdst = VT + (size_t)b * 8 * 64 * 2048; ldv = 2048; }
    if (nt < 4) {
      if (is_cache) { RowLin rp{(const unsigned char*)(cache + (size_t)m0 * 256), 512}; gemm_main<true>(TIDX, BIDX, GDIM, acc, rp, W + (size_t)nt * 128 * 256, 256, 256, smem); }
      else { RowLin rp{(const unsigned char*)(CKVN + (size_t)m0 * 256), 512}; gemm_main<true>(TIDX, BIDX, GDIM, acc, rp, W + (size_t)nt * 128 * 256, 256, 256, smem); }
      EPI_SWAP_BEGIN(0, nt * 128)
        const f32x4 a = acc[mi][ni];
        bf16_t* d;
        if (kdst) d = kdst + (size_t)row * 512 + col;
        else { const int sr = m0 - TP + row; d = KNS + ((size_t)(sr >> 5) * KPAD + 4096 + (sr & 31)) * 512 + col; }
        *(uint2*)d = make_uint2(pack2(a[0], a[1]), pack2(a[2], a[3]));
      EPI_END
    } else {
      if (is_cache) { RowLin rp{(const unsigned char*)(cache + (size_t)m0 * 256), 512}; gemm_main<false>(TIDX, BIDX, GDIM, acc, rp, W + (size_t)nt * 128 * 256, 256, 256, smem); }
      else { RowLin rp{(const unsigned char*)(CKVN + (size_t)m0 * 256), 512}; gemm_main<false>(TIDX, BIDX, GDIM, acc, rp, W + (size_t)nt * 128 * 256, 256, 256, smem); }
      const int lane = TIDX & 63, w = TIDX >> 6;
      const int rb = (w >> 1) * 64 + 4 * (lane >> 4), cb = (nt - 4) * 128 + (w & 1) * 64 + (lane & 15);
#pragma unroll
      for (int mi = 0; mi < 4; ++mi) {
        const int row = rb + mi * 16;
#pragma unroll
        for (int ni = 0; ni < 4; ++ni) {
          const int hv = cb + ni * 16;
          const f32x4 a = acc[mi][ni];
          bf16_t* d;
          if (vdst) d = vdst + (size_t)hv * ldv + key0 + row;
          else { const int sr = m0 - TP + row; d = VTS + ((size_t)(sr >> 5) * 512 + hv) * KPAD + 4096 + (sr & 31); }
          *(uint2*)d = make_uint2(pack2(a[0], a[1]), pack2(a[2], a[3]));
        }
      }
    }
  }
}

DEVI void attn_item(const int TIDX, const int BIDX, const int GDIM, const bf16_t* __restrict__ Q, int qrow0, int nq, int ng, const bf16_t* __restrict__ Kn, const bf16_t* __restrict__ Kr,
                    const bf16_t* __restrict__ VT, size_t ldv, int nkeys, bf16_t* __restrict__ O, unsigned char* smem) {
  const int tid = TIDX, lane = tid & 63, w = tid >> 6, li = lane & 15, lg = lane >> 4;
  const int ql = 16 * w + li;
  bf16x8 qf[2][3];
  f32x4 oT[2][4];
  float mrun[2], lrun[2];
  const float zf = zero_f();
#pragma unroll
  for (int g = 0; g < 2; ++g) {
    const int qr = qrow0 + (g == 0 ? (ql < nq ? ql : nq - 1) : 64 + ql);
    const int qrc = (g == 1 && ng < 2) ? qrow0 : qr;
#pragma unroll
    for (int ds = 0; ds < 3; ++ds) qf[g][ds] = *(const bf16x8*)(Q + (size_t)qrc * 768 + ds * 32 + lg * 8);
#pragma unroll
    for (int i = 0; i < 4; ++i) oT[g][i] = (f32x4){zf, zf, zf, zf};
    mrun[g] = -INFINITY; lrun[g] = 0.f;
  }
  const int nt = (nkeys + 63) >> 6;
  const int r8 = lane >> 3;
  const uint32_t sch = (uint32_t)((lane & 7) ^ (((lane >> 4) + 4 * (w & 1)) & 7)) * 16u;
  const unsigned char* kn0 = (const unsigned char*)Kn + (size_t)(w * 8 + r8) * 1024 + sch;
  const unsigned char* kr0 = (const unsigned char*)Kr + (size_t)(w * 16 + (lane >> 2)) * 64 + (uint32_t)((lane & 3) ^ (((lane >> 5) & 1) << 1)) * 16u;
  const unsigned char* v0 = (const unsigned char*)VT + (size_t)(w * 8 + r8) * ldv * 2 + sch;
  const size_t v32 = (size_t)32 * ldv * 2;
  unsigned char* sw = smem + w * 1024;
#define ATT_STAGE(kt_)                                                                                                  \
  {                                                                                                                     \
    unsigned char* st_ = sw + ((kt_) % 3) * 20480;                                                                      \
    const size_t kb_ = (size_t)(kt_) * 64;                                                                              \
    __builtin_amdgcn_global_load_lds((const unsigned*)(kn0 + kb_ * 1024), (unsigned*)(st_), 16, 0, 0);                  \
    __builtin_amdgcn_global_load_lds((const unsigned*)(kn0 + kb_ * 1024 + 32768), (unsigned*)(st_ + 4096), 16, 0, 0);   \
    __builtin_amdgcn_global_load_lds((const unsigned*)(kr0 + kb_ * 64), (unsigned*)(st_ + 8192), 16, 0, 0);             \
    __builtin_amdgcn_global_load_lds((const unsigned*)(v0 + kb_ * 2), (unsigned*)(st_ + 12288), 16, 0, 0);              \
    __builtin_amdgcn_global_load_lds((const unsigned*)(v0 + v32 + kb_ * 2), (unsigned*)(st_ + 12288 + 4096), 16, 0, 0); \
  }
  ATT_STAGE(0);
  if (nt > 1) ATT_STAGE(1);
  const int pk0 = (lg ^ (li >> 1)) * 16;
  const int pkr = (lg ^ (((li >> 3) & 1) << 1)) * 16;
  const int pv0 = ((lg >> 1) ^ (li >> 1)) * 16 + (lg & 1) * 8;
  for (int kt = 0; kt < nt; ++kt) {
    if (kt + 1 < nt) asm volatile("s_waitcnt vmcnt(5)" ::: "memory");
    else asm volatile("s_waitcnt vmcnt(0)" ::: "memory");
    __builtin_amdgcn_s_barrier();
    asm volatile("" ::: "memory");
    if (kt + 2 < nt) ATT_STAGE(kt + 2);
    const unsigned char* st = smem + (kt % 3) * 20480;
    const bool tail = (kt == nt - 1) && (nkeys & 63);
    const bool two = (ng == 2);
    const bool g0on = !(two && kt == nt - 1);
    f32x4 sT[2][4];
#pragma unroll
    for (int kb = 0; kb < 4; ++kb) {
      const unsigned char* kr_ = st + (kb * 16 + li) * 128;
      const bf16x8 k0 = *(const bf16x8*)(kr_ + pk0), k1 = *(const bf16x8*)(kr_ + (pk0 ^ 64)), k2 = *(const bf16x8*)(st + 8192 + (kb * 16 + li) * 64 + pkr);
      sT[0][kb] = (f32x4){zf, zf, zf, zf};
      sT[1][kb] = (f32x4){zf, zf, zf, zf};
      if (g0on) {
        sT[0][kb] = mfma16(k0, qf[0][0], sT[0][kb]);
        sT[0][kb] = mfma16(k1, qf[0][1], sT[0][kb]);
        sT[0][kb] = mfma16(k2, qf[0][2], sT[0][kb]);
      }
      if (two) {
        sT[1][kb] = mfma16(k0, qf[1][0], sT[1][kb]);
        sT[1][kb] = mfma16(k1, qf[1][1], sT[1][kb]);
        sT[1][kb] = mfma16(k2, qf[1][2], sT[1][kb]);
      }
    }
    bf16x8 pf[2][2];
#pragma unroll
    for (int g = 0; g < 2; ++g) {
      if (g == 0 ? g0on : two) {
        if (tail) {
#pragma unroll
          for (int kb = 0; kb < 4; ++kb)
#pragma unroll
            for (int r = 0; r < 4; ++r)
              if (kt * 64 + kb * 16 + 4 * lg + r >= nkeys) sT[g][kb][r] = -INFINITY;
        }
        float mx = sT[g][0][0];
#pragma unroll
        for (int kb = 0; kb < 4; ++kb)
#pragma unroll
          for (int r = 0; r < 4; ++r) mx = fmaxf(mx, sT[g][kb][r]);
        mx = fmaxf(mx, __shfl_xor(mx, 16));
        mx = fmaxf(mx, __shfl_xor(mx, 32));
        const float mnew = fmaxf(mrun[g], mx);
        const float alpha = __builtin_amdgcn_exp2f(mrun[g] - mnew);
        mrun[g] = mnew;
        float ps = 0.f;
#pragma unroll
        for (int kb = 0; kb < 4; ++kb)
#pragma unroll
          for (int r = 0; r < 4; ++r) { const float pv = __builtin_amdgcn_exp2f(sT[g][kb][r] - mnew); sT[g][kb][r] = pv; ps += pv; }
        lrun[g] = lrun[g] * alpha + ps;
#pragma unroll
        for (int vb = 0; vb < 4; ++vb) oT[g][vb] *= alpha;
      }
#pragma unroll
      for (int s2 = 0; s2 < 2; ++s2)
        pf[g][s2] = mk8(pack2(sT[g][2 * s2][0], sT[g][2 * s2][1]), pack2(sT[g][2 * s2][2], sT[g][2 * s2][3]),
                        pack2(sT[g][2 * s2 + 1][0], sT[g][2 * s2 + 1][1]), pack2(sT[g][2 * s2 + 1][2], sT[g][2 * s2 + 1][3]));
    }
#pragma unroll
    for (int s2 = 0; s2 < 2; ++s2) {
#pragma unroll
      for (int vb = 0; vb < 4; ++vb) {
        const unsigned char* vr_ = st + 12288 + (vb * 16 + li) * 128;
        const uint2 lo = *(const uint2*)(vr_ + (pv0 ^ (s2 * 64)));
        const uint2 hi = *(const uint2*)(vr_ + (pv0 ^ (s2 * 64) ^ 32));
        const bf16x8 vfr = mk8(lo, hi);
        if (g0on) oT[0][vb] = mfma16(vfr, pf[0][s2], oT[0][vb]);
        if (two) oT[1][vb] = mfma16(vfr, pf[1][s2], oT[1][vb]);
      }
    }
  }
#pragma unroll
  for (int g = 0; g < 2; ++g) {
    float lr = lrun[g];
    lr += __shfl_xor(lr, 16);
    lr += __shfl_xor(lr, 32);
    const float inv = 1.f / lr;
    const bool st_ok = g == 0 ? (ql < nq) : (ng == 2);
    if (st_ok) {
#pragma unroll
      for (int vb = 0; vb < 4; ++vb) {
        const f32x4 o = oT[g][vb] * inv;
        *(uint2*)(O + (size_t)(qrow0 + g * 64 + ql) * 512 + vb * 16 + 4 * lg) = make_uint2(pack2(o[0], o[1]), pack2(o[2], o[3]));
      }
    }
  }
  __syncthreads();
}

DEVI void hgrn_item(const int TIDX, const int BIDX, const int GDIM, KAP KA, unsigned char* WSB, float* OUTB, int l, int g0, int nchunks, int h, const float* __restrict__ S0, float* __restrict__ Sout, int rowbase,
                    unsigned char* smem) {
  constexpr int STG = 35840;
  const unsigned char* QT = WSB + O_QT;
  const unsigned char* KHT = WSB + O_KHT;
  const unsigned char* AM = WSB + O_AM;
  const unsigned char* EBp = WSB + O_EB;
  const unsigned char* VT2 = WSB + O_VT2;
  const unsigned char* G = WSB + O_G;
  bf16_t* HO = (bf16_t*)(WSB + O_HO);
  const float* hgn = PIN(I_HGN) + l * 512 + h * 128;
  float* sred = (float*)(smem + SMEM_GEMM);
  const int tid = TIDX, lane = tid & 63, w = tid >> 6, c = lane & 31, hh = lane >> 5;
  const int dvg = 32 * w + c;
  f32x16 S[4];
#pragma unroll
  for (int kt = 0; kt < 4; ++kt)
#pragma unroll
    for (int r = 0; r < 16; ++r) S[kt][r] = S0 ? S0[(size_t)(32 * kt + (r & 3) + 8 * (r >> 2) + 4 * hh) * 128 + dvg] : 0.f;
  float4 gn[4];
#pragma unroll
  for (int q = 0; q < 4; ++q) gn[q] = *(const float4*)(hgn + 32 * w + 8 * q + 4 * hh);
  const uint32_t lo16 = (uint32_t)lane * 16u;
  const uint32_t goff = (uint32_t)(w * 4 + (lane >> 4)) * 1024u + (uint32_t)h * 256u + (uint32_t)(lane & 15) * 16u;
#define HG_STAGE(ch_)                                                                                                                  \
  {                                                                                                                                    \
    unsigned char* st_ = smem + ((ch_) & 1) * STG + w * 1024;                                                                          \
    const size_t cid_ = (size_t)(g0 + (ch_)) * 4 + h;                                                                                  \
    const size_t grow_ = ((size_t)rowbase + (size_t)(ch_) * 32) * 1024;                                                                \
    __builtin_amdgcn_global_load_lds((const unsigned*)(QT + cid_ * 8192 + w * 1024 + lo16), (unsigned*)(st_), 16, 0, 0);              \
    __builtin_amdgcn_global_load_lds((const unsigned*)(QT + cid_ * 8192 + 4096 + w * 1024 + lo16), (unsigned*)(st_ + 4096), 16, 0, 0); \
    __builtin_amdgcn_global_load_lds((const unsigned*)(KHT + cid_ * 8192 + w * 1024 + lo16), (unsigned*)(st_ + 8192), 16, 0, 0);       \
    __builtin_amdgcn_global_load_lds((const unsigned*)(KHT + cid_ * 8192 + 4096 + w * 1024 + lo16), (unsigned*)(st_ + 12288), 16, 0, 0); \
    __builtin_amdgcn_global_load_lds((const unsigned*)(VT2 + cid_ * 8192 + w * 1024 + lo16), (unsigned*)(st_ + 16384), 16, 0, 0);      \
    __builtin_amdgcn_global_load_lds((const unsigned*)(VT2 + cid_ * 8192 + 4096 + w * 1024 + lo16), (unsigned*)(st_ + 20480), 16, 0, 0); \
    __builtin_amdgcn_global_load_lds((const unsigned*)(G + grow_ + goff), (unsigned*)(st_ + 24576), 16, 0, 0);                         \
    __builtin_amdgcn_global_load_lds((const unsigned*)(G + grow_ + 16384 + goff), (unsigned*)(st_ + 28672), 16, 0, 0);                 \
    if (w < 2) __builtin_amdgcn_global_load_lds((const unsigned*)(AM + cid_ * 2048 + w * 1024 + lo16), (unsigned*)(st_ + 32768), 16, 0, 0); \
    else if (w == 2) __builtin_amdgcn_global_load_lds((const unsigned*)(EBp + cid_ * 512 + lo16), (unsigned*)(smem + ((ch_) & 1) * STG + 34816), 16, 0, 0); \
  }
  HG_STAGE(0);
  for (int ch = 0; ch < nchunks; ++ch) {
    asm volatile("s_waitcnt vmcnt(0)" ::: "memory");
    __builtin_amdgcn_s_barrier();
    asm volatile("" ::: "memory");
    if (ch + 1 < nchunks) HG_STAGE(ch + 1);
    const unsigned char* st = smem + (ch & 1) * STG;
    bf16x8 vf[2], af[2];
#pragma unroll
    for (int s2 = 0; s2 < 2; ++s2) {
      vf[s2] = *(const bf16x8*)(st + 16384 + dvg * 64 + 32 * s2 + 16 * hh);
      af[s2] = *(const bf16x8*)(st + 32768 + c * 64 + 32 * s2 + 16 * hh);
    }
    f32x16 oT;
    const float zf = zero_f();
#pragma unroll
    for (int r = 0; r < 16; ++r) oT[r] = zf;
#pragma unroll
    for (int kt = 0; kt < 4; ++kt) {
#pragma unroll
      for (int s2 = 0; s2 < 2; ++s2) {
        const uint2 lo = *(const uint2*)(st + c * 256 + 64 * kt + 32 * s2 + 8 * hh);
        const uint2 hi = *(const uint2*)(st + c * 256 + 64 * kt + 32 * s2 + 16 + 8 * hh);
        const bf16x8 sa = mk8(pack2(S[kt][8 * s2 + 0], S[kt][8 * s2 + 1]), pack2(S[kt][8 * s2 + 2], S[kt][8 * s2 + 3]),
                              pack2(S[kt][8 * s2 + 4], S[kt][8 * s2 + 5]), pack2(S[kt][8 * s2 + 6], S[kt][8 * s2 + 7]));
        oT = mfma32(sa, mk8(lo, hi), oT);
      }
    }
#pragma unroll
    for (int s2 = 0; s2 < 2; ++s2) oT = mfma32(vf[s2], af[s2], oT);
#pragma unroll
    for (int kt = 0; kt < 4; ++kt) {
#pragma unroll
      for (int q = 0; q < 4; ++q) {
        const float4 e = *(const float4*)(st + 34816 + (32 * kt + 8 * q + 4 * hh) * 4);
        S[kt][4 * q + 0] *= e.x; S[kt][4 * q + 1] *= e.y; S[kt][4 * q + 2] *= e.z; S[kt][4 * q + 3] *= e.w;
      }
#pragma unroll
      for (int s2 = 0; s2 < 2; ++s2) {
        const bf16x8 kf = *(const bf16x8*)(st + 8192 + (32 * kt + c) * 64 + 32 * s2 + 16 * hh);
        S[kt] = mfma32(kf, vf[s2], S[kt]);
      }
    }
    float ss = 0.f;
#pragma unroll
    for (int r = 0; r < 16; ++r) ss += oT[r] * oT[r];
    ss += __shfl_xor(ss, 32);
    float* sr = sred + (ch & 1) * 128;
    if (lane < 32) sr[w * 32 + c] = ss;
    asm volatile("s_waitcnt lgkmcnt(0)" ::: "memory");
    __builtin_amdgcn_s_barrier();
    asm volatile("" ::: "memory");
    const float tot = sr[c] + sr[32 + c] + sr[64 + c] + sr[96 + c];
    const float rs = rsqrtf(tot * (1.f / 128.f) + EPS);
    const size_t row = (size_t)rowbase + ch * 32 + c;
#pragma unroll
    for (int q = 0; q < 4; ++q) {
      const int dv0 = 32 * w + 8 * q + 4 * hh;
      const uint2 gp = *(const uint2*)(st + 24576 + c * 256 + dv0 * 2);
      const float o0 = oT[4 * q + 0] * rs * gn[q].x * siluf_(lo2f(gp.x));
      const float o1 = oT[4 * q + 1] * rs * gn[q].y * siluf_(hi2f(gp.x));
      const float o2 = oT[4 * q + 2] * rs * gn[q].z * siluf_(lo2f(gp.y));
      const float o3 = oT[4 * q + 3] * rs * gn[q].w * siluf_(hi2f(gp.y));
      *(uint2*)(HO + row * 512 + h * 128 + dv0) = make_uint2(pack2(o0, o1), pack2(o2, o3));
    }
  }
#pragma unroll
  for (int kt = 0; kt < 4; ++kt)
#pragma unroll
    for (int r = 0; r < 16; ++r) Sout[(size_t)(32 * kt + (r & 3) + 8 * (r >> 2) + 4 * hh) * 128 + dvg] = S[kt][r];
  __syncthreads();
}

DEVI void phase_p4(const int TIDX, const int BIDX, const int GDIM, KAP KA, unsigned char* WSB, float* OUTB, int l, unsigned char* smem, int dup = 0) {
  const int q = BIDX & 7;
  int* qctr = (int*)(WSB + O_CNT) + 128 + l * 8 + q + 16 * dup;
  int* sitem = (int*)(smem + SMEM_GEMM + 1024);
  const bf16_t* QB = (const bf16_t*)(WSB + O_QB);
  bf16_t* AO = (bf16_t*)(WSB + O_AO);
  const int total = 16 + 16 + 512 + 8;
  for (;;) {
    if (TIDX == 0) *sitem = atomicAdd(qctr, 1);
    __syncthreads();
    const int it = *sitem;
    __syncthreads();
    if (it >= total) break;
    if (it < 16) {
      const int i2 = q * 16 + it, b = i2 >> 2, h = i2 & 3;
      hgrn_item(TIDX, BIDX, GDIM, KA, WSB, OUTB, l, b * 64, 64, h, nullptr, OUTB + OUT_ST_P + ((size_t)(l * 32 + b) * 4 + h) * 16384, b * 2048, smem);
    } else if (it < 32) {
      const int b = it - 16, h = q;
      attn_item(TIDX, BIDX, GDIM, QB + h * 96, TP + b * 32, 32, 1, (const bf16_t*)(WSB + O_KNS) + (size_t)b * KPAD * 512 + h * 64,
                (const bf16_t*)(WSB + O_KRS) + ((size_t)l * 16 + b) * KPAD * 32,
                (const bf16_t*)(WSB + O_VTS) + (size_t)(b * 8 + h) * 64 * KPAD, KPAD, 4128, AO + h * 64, smem);
    } else if (it < 32 + 512) {
      const int jj = it - 32, b = jj >> 4, cp = 15 - (jj & 15), h = q;
      attn_item(TIDX, BIDX, GDIM, QB + h * 96, b * 2048 + cp * 128, 64, 2, (const bf16_t*)(WSB + O_KN) + (size_t)b * 2048 * 512 + h * 64,
                (const bf16_t*)(WSB + O_KRB) + (size_t)b * 2048 * 32,
                (const bf16_t*)(WSB + O_VT) + (size_t)(b * 8 + h) * 64 * 2048, 2048, 128 * (cp + 1), AO + h * 64, smem);
    } else {
      const int i2 = q * 8 + (it - 32 - 512), b = i2 >> 2, h = i2 & 3;
      hgrn_item(TIDX, BIDX, GDIM, KA, WSB, OUTB, l, 2048 + b, 1, h, PIN(I_ST) + ((size_t)(l * 16 + b) * 4 + h) * 16384,
                OUTB + OUT_ST_S + ((size_t)(l * 16 + b) * 4 + h) * 16384, TP + b * 32, smem);
    }
  }
}

DEVI void phase_p5(const int TIDX, const int BIDX, const int GDIM, KAP KA, unsigned char* WSB, float* OUTB, int l, unsigned char* smem) {
  const bf16_t* XB = (const bf16_t*)(WSB + O_XB);
  const bf16_t* AO = (const bf16_t*)(WSB + O_AO);
  const bf16_t* HO = (const bf16_t*)(WSB + O_HO);
  const bf16_t* W = (const bf16_t*)(WSB + O_WS) + (size_t)l * WO_END;
  bf16_t* MG = (bf16_t*)(WSB + O_MG);
  for (int item = (BIDX & 7) * (GDIM >> 3) + (BIDX >> 3); item < 516 * 8; item += GDIM) {
    const int mt = item >> 3, nt = item & 7, m0 = mt * 128, n0 = nt * 128;
    f32x4 acc[4][4];
    bf16_t* TMP = (bf16_t*)(WSB + O_G);
    RowLin rx{(const unsigned char*)(XB + (size_t)m0 * 1024), 2048};
    RowLin ra{(const unsigned char*)(AO + (size_t)m0 * 512), 1024};
    RowLin ro{(const unsigned char*)(HO + (size_t)m0 * 512), 1024};
    zero_acc(acc);
    gemm_main<true>(TIDX, BIDX, GDIM, acc, rx, W + WO_G + (size_t)n0 * 1024, 1024, 1024, smem);
    EPI_SWAP_BEGIN(m0, n0)
      const f32x4 a = acc[mi][ni];
      *(uint2*)(MG + (size_t)row * 1024 + col) = make_uint2(pack2(sigmoidf_(a[0]), sigmoidf_(a[1])), pack2(sigmoidf_(a[2]), sigmoidf_(a[3])));
    EPI_END
    zero_acc(acc);
    gemm_main<true>(TIDX, BIDX, GDIM, acc, rx, W + WO_G + (size_t)(1024 + n0) * 1024, 1024, 1024, smem);
    EPI_SWAP_BEGIN(m0, n0)
      const f32x4 a = acc[mi][ni];
      *(uint2*)(TMP + (size_t)row * 1024 + col) = make_uint2(pack2(sigmoidf_(a[0]), sigmoidf_(a[1])), pack2(sigmoidf_(a[2]), sigmoidf_(a[3])));
    EPI_END
    zero_acc(acc);
    gemm_main<true>(TIDX, BIDX, GDIM, acc, ra, W + WO_BRA + (size_t)n0 * 512, 512, 512, smem);
    EPI_SWAP_BEGIN(m0, n0)
      const f32x4 a = acc[mi][ni];
      const uint2 g = *(const uint2*)(MG + (size_t)row * 1024 + col);
      *(uint2*)(MG + (size_t)row * 1024 + col) = make_uint2(pack2(a[0] * lo2f(g.x), a[1] * hi2f(g.x)), pack2(a[2] * lo2f(g.y), a[3] * hi2f(g.y)));
    EPI_END
    zero_acc(acc);
    gemm_main<true>(TIDX, BIDX, GDIM, acc, ro, W + WO_BRB + (size_t)n0 * 512, 512, 512, smem);
    EPI_SWAP_BEGIN(m0, n0)
      const f32x4 a = acc[mi][ni];
      const uint2 g = *(const uint2*)(TMP + (size_t)row * 1024 + col), m = *(const uint2*)(MG + (size_t)row * 1024 + col);
      const float o0 = lo2f(m.x) + a[0] * lo2f(g.x), o1 = hi2f(m.x) + a[1] * hi2f(g.x), o2 = lo2f(m.y) + a[2] * lo2f(g.y), o3 = hi2f(m.y) + a[3] * hi2f(g.y);
      *(uint2*)(MG + (size_t)row * 1024 + col) = make_uint2(pack2(o0, o1), pack2(o2, o3));
    EPI_END
  }
}

DEVI void phase_p6(const int TIDX, const int BIDX, const int GDIM, KAP KA, unsigned char* WSB, float* OUTB, int l, unsigned char* smem) {
  const bf16_t* MG = (const bf16_t*)(WSB + O_MG);
  const bf16_t* W = (const bf16_t*)(WSB + O_WS) + (size_t)l * WO_END + WO_OUT;
  float* PRE = (float*)(WSB + O_PRE);
  for (int item = (BIDX & 7) * (GDIM >> 3) + (BIDX >> 3); item < 516 * 8; item += GDIM) {
    const int mt = item >> 3, nt = item & 7, m0 = mt * 128, n0 = nt * 128;
    f32x4 acc[4][4];
    zero_acc(acc);
    RowLin rp{(const unsigned char*)(MG + (size_t)m0 * 1024), 2048};
    gemm_main<true>(TIDX, BIDX, GDIM, acc, rp, W + (size_t)n0 * 1024, 1024, 1024, smem);
    EPI_SWAP_BEGIN(m0, n0)
      const f32x4 x = *(const f32x4*)(OUTB + (size_t)row * 1024 + col);
      *(f32x4*)(PRE + (size_t)row * 1024 + col) = x * DN_ALPHA + acc[mi][ni];
    EPI_END
  }
}

DEVI void phase_p7(const int TIDX, const int BIDX, const int GDIM, KAP KA, unsigned char* WSB, float* OUTB, int l, unsigned char* smem) {
  const int tid = TIDX, lane = tid & 63;
  {
    const float* PRE = (const float*)(WSB + O_PRE);
    bf16_t* XB = (bf16_t*)(WSB + O_XB);
    const float* WR = (const float*)(WSB + O_WR) + (size_t)l * 36 * 1024;
    int* cnt = (int*)(WSB + O_CNT) + l * 32;
    int* ltok = (int*)(WSB + O_LTOK);
    float* lw = (float*)(WSB + O_LW);
    const float* g1 = PIN(I_LN1G) + l * 1024; const float* b1 = PIN(I_LN1B) + l * 1024;
    const int wid = BIDX * 4 + (tid >> 6), nw = GDIM * 4;
    for (int r4 = wid; r4 < NTOK / 4; r4 += nw) {
      float4 v[4][4];
#pragma unroll
      for (int t = 0; t < 4; ++t) {
        const size_t row = (size_t)r4 * 4 + t;
#pragma unroll
        for (int j = 0; j < 4; ++j) v[t][j] = *(const float4*)(PRE + row * 1024 + j * 256 + lane * 4);
        ln_inplace(v[t], g1, b1, lane);
        store_row(v[t], OUTB + row * 1024, XB + row * 1024, lane);
      }
      float mine[4] = {0.f, 0.f, 0.f, 0.f};
#pragma unroll 4
      for (int c = 0; c < 36; ++c) {
        float4 wv[4];
#pragma unroll
        for (int j = 0; j < 4; ++j) wv[j] = *(const float4*)(WR + c * 1024 + j * 256 + lane * 4);
#pragma unroll
        for (int t = 0; t < 4; ++t) {
          float s = 0.f;
#pragma unroll
          for (int j = 0; j < 4; ++j) s += v[t][j].x * wv[j].x + v[t][j].y * wv[j].y + v[t][j].z * wv[j].z + v[t][j].w * wv[j].w;
          s = wave_sum(s);
          if (lane == c) mine[t] = s;
        }
      }
      int my_e = 0, my_tk = 0; float my_w = 0.f;
#pragma unroll
      for (int t = 0; t < 4; ++t) {
        const int tok = r4 * 4 + t;
        float gl[4];
#pragma unroll
        for (int j = 0; j < 4; ++j) gl[j] = __shfl(mine[t], j);
        int gi = 0; float gm = gl[0];
#pragma unroll
        for (int j = 1; j < 4; ++j) if (gl[j] > gm) { gm = gl[j]; gi = j; }
        float gs = 0.f;
#pragma unroll
        for (int j = 0; j < 4; ++j) gs += expf(gl[j] - gm);
        const float gtop = 1.f / gs;
        float el[8];
#pragma unroll
        for (int j = 0; j < 8; ++j) el[j] = __shfl(mine[t], 4 + gi * 8 + j);
        float em = el[0];
#pragma unroll
        for (int j = 1; j < 8; ++j) em = fmaxf(em, el[j]);
        float pe[8], es = 0.f;
#pragma unroll
        for (int j = 0; j < 8; ++j) { pe[j] = expf(el[j] - em); es += pe[j]; }
#pragma unroll
        for (int j = 0; j < 8; ++j) pe[j] = pe[j] / es;
        int i1 = 0; float p1 = pe[0];
#pragma unroll
        for (int j = 1; j < 8; ++j) if (pe[j] > p1) { p1 = pe[j]; i1 = j; }
        int i2 = -1; float p2 = -1.f;
#pragma unroll
        for (int j = 0; j < 8; ++j) if (j != i1 && pe[j] > p2) { p2 = pe[j]; i2 = j; }
        const float den = p1 + p2;
        if (lane == 2 * t) { my_e = gi * 8 + i1; my_w = gtop * (p1 / den); my_tk = tok * 2; }
        if (lane == 2 * t + 1) { my_e = gi * 8 + i2; my_w = gtop * (p2 / den); my_tk = tok * 2 + 1; }
      }
      if (lane < 8) {
        const int sl = atomicAdd(cnt + my_e, 1);
        ltok[(size_t)my_e * NTOK + sl] = my_tk;
        lw[(size_t)my_e * NTOK + sl] = my_w;
      }
    }
  }
  {
    bf16_t* PLEB = (bf16_t*)(WSB + O_YM);
    const float* pp = PIN(I_PP) + (size_t)l * TP * 256;
    const float* ps = PIN(I_PS) + (size_t)l * TS * 256;
    const size_t tot_ = (size_t)NTOK * 64, str_ = (size_t)GDIM * 256;
    for (size_t i = (size_t)BIDX * 256 + tid; i < tot_; i += 4 * str_) {
      float4 v4[4];
#pragma unroll
      for (int k = 0; k < 4; ++k) {
        const size_t ii = i + k * str_ < tot_ ? i + k * str_ : i, e = ii * 4;
        v4[k] = e < (size_t)TP * 256 ? *(const float4*)(pp + e) : *(const float4*)(ps + (e - (size_t)TP * 256));
      }
#pragma unroll
      for (int k = 0; k < 4; ++k)
        if (i + k * str_ < tot_) *(uint2*)(PLEB + (i + k * str_) * 4) = make_uint2(pack2(v4[k].x, v4[k].y), pack2(v4[k].z, v4[k].w));
    }
  }
  {
    float* tile = (float*)smem;
    bf16_t* WE = (bf16_t*)(WSB + O_WE);
    CMap cm{0};
    for (int t = BIDX; t < 96 * 128; t += GDIM) {
      const int mat = t >> 7, tt = t & 127, kind = mat >> 5, e = mat & 31;
      const float* src = PIN(kind == 0 ? I_WE1 : (kind == 1 ? I_WE3 : I_WE2)) + ((size_t)l * 32 + e) * 524288;
      bf16_t* dst = WE + ((size_t)kind * 32 + e) * 524288;
      if (kind < 2) transpose_tile(TIDX, BIDX, GDIM, src, 512, 1024, dst, (tt & 15) * 64, (tt >> 4) * 64, cm, nullptr, tile);
      else transpose_tile(TIDX, BIDX, GDIM, src, 1024, 512, dst, (tt & 7) * 64, (tt >> 3) * 64, cm, nullptr, tile);
    }
  }
}

DEVI int moe_table(const int TIDX, const int BIDX, const int GDIM, KAP KA, unsigned char* WSB, float* OUTB, int l, int* tstart  ) {
  if (TIDX == 0) {
    const int* cnt = (const int*)(WSB + O_CNT) + l * 32;
    int acc = 0;
    for (int e = 0; e < 32; ++e) { tstart[e] = acc; acc += (cnt[e] + 127) >> 7; }
    tstart[32] = acc;
  }
  __syncthreads();
  return tstart[32];
}
DEVI int moe_find(const int* tstart, int mt) {
  int e = 0;
  for (int i = 1; i < 32; ++i) if (mt >= tstart[i]) e = i;
  return e;
}
struct RowGather {
  const unsigned char* base; const int* ltok; int pos0; int cnt;
  DEVI uint32_t operator()(int r) const {
    const int pos = pos0 + r;
    return pos < cnt ? (uint32_t)(ltok[pos] >> 1) * 2048u : (uint32_t)NTOK * 2048u;
  }
};

DEVI void phase_p8(const int TIDX, const int BIDX, const int GDIM, KAP KA, unsigned char* WSB, float* OUTB, int l, unsigned char* smem) {
  int* tstart = (int*)(smem + SMEM_GEMM + 1024 + 64);
  const int NT = moe_table(TIDX, BIDX, GDIM, KA, WSB, OUTB, l, tstart);
  const bf16_t* XB = (const bf16_t*)(WSB + O_XB);
  const bf16_t* WE = (const bf16_t*)(WSB + O_WE);
  bf16_t* H = (bf16_t*)(WSB + O_H);
  const int* cnt = (const int*)(WSB + O_CNT) + l * 32;
  const int* ltok = (const int*)(WSB + O_LTOK);
  for (int item = (BIDX & 7) * (GDIM >> 3) + (BIDX >> 3); item < NT * 4; item += GDIM) {
    const int mt = item >> 2, nt = item & 3, e = moe_find(tstart, mt), lt = mt - tstart[e];
    RowGather rg{(const unsigned char*)XB, ltok + (size_t)e * NTOK, lt * 128, cnt[e]};
    f32x4 acc[4][4];
    uint2 sg[4][4];
    zero_acc(acc);
    gemm_main<true>(TIDX, BIDX, GDIM, acc, rg, WE + ((size_t)e * 512 + nt * 128) * 1024, 1024, 1024, smem);
#pragma unroll
    for (int i = 0; i < 4; ++i)
#pragma unroll
      for (int j = 0; j < 4; ++j) sg[i][j] = make_uint2(pack2(siluf_(acc[i][j][0]), siluf_(acc[i][j][1])), pack2(siluf_(acc[i][j][2]), siluf_(acc[i][j][3])));
    zero_acc(acc);
    gemm_main<true>(TIDX, BIDX, GDIM, acc, rg, WE + ((size_t)(32 + e) * 512 + nt * 128) * 1024, 1024, 1024, smem);
    EPI_SWAP_BEGIN(mt * 128, nt * 128)
      const f32x4 a = acc[mi][ni];
      const uint2 g = sg[mi][ni];
      *(uint2*)(H + (size_t)row * 512 + col) = make_uint2(pack2(a[0] * lo2f(g.x), a[1] * hi2f(g.x)), pack2(a[2] * lo2f(g.y), a[3] * hi2f(g.y)));
    EPI_END
  }
  {
    const bf16_t* W = (const bf16_t*)(WSB + O_WS) + (size_t)l * WO_END;
    float* PRE = (float*)(WSB + O_PRE);
    for (int item = (BIDX & 7) * (GDIM >> 3) + (BIDX >> 3); item < 516 * 8; item += GDIM) {
      const int mt = item >> 3, nt = item & 7, m0 = mt * 128, n0 = nt * 128;
      f32x4 acc[4][4];
      uint2 gp[4][4];
      zero_acc(acc);
      RowLin rx{(const unsigned char*)(XB + (size_t)m0 * 1024), 2048};
      gemm_main<true>(TIDX, BIDX, GDIM, acc, rx, W + WO_PG + (size_t)n0 * 1024, 1024, 1024, smem);
#pragma unroll
      for (int i = 0; i < 4; ++i)
#pragma unroll
        for (int j = 0; j < 4; ++j) gp[i][j] = make_uint2(pack2(sigmoidf_(acc[i][j][0]), sigmoidf_(acc[i][j][1])), pack2(sigmoidf_(acc[i][j][2]), sigmoidf_(acc[i][j][3])));
      zero_acc(acc);
      RowLin rpl{(const unsigned char*)((const bf16_t*)(WSB + O_YM) + (size_t)m0 * 256), 512};
      gemm_main<true>(TIDX, BIDX, GDIM, acc, rpl, W + WO_PLE + (size_t)n0 * 256, 256, 256, smem);
      EPI_SWAP_BEGIN(m0, n0)
        const f32x4 x = *(const f32x4*)(OUTB + (size_t)row * 1024 + col);
        const f32x4 a = acc[mi][ni];
        const uint2 g = gp[mi][ni];
        f32x4 o;
        o[0] = x[0] * DN_ALPHA + a[0] * lo2f(g.x); o[1] = x[1] * DN_ALPHA + a[1] * hi2f(g.x);
        o[2] = x[2] * DN_ALPHA + a[2] * lo2f(g.y); o[3] = x[3] * DN_ALPHA + a[3] * hi2f(g.y);
        *(f32x4*)(PRE + (size_t)row * 1024 + col) = o;
      EPI_END
    }
  }
}

DEVI void phase_p9(const int TIDX, const int BIDX, const int GDIM, KAP KA, unsigned char* WSB, float* OUTB, int l, unsigned char* smem) {
  int* tstart = (int*)(smem + SMEM_GEMM + 1024 + 64);
  const int NT = moe_table(TIDX, BIDX, GDIM, KA, WSB, OUTB, l, tstart);
  const bf16_t* WE = (const bf16_t*)(WSB + O_WE) + 64ull * 524288;
  const bf16_t* H = (const bf16_t*)(WSB + O_H);
  bf16_t* YM = (bf16_t*)(WSB + O_YM);
  const int* cnt = (const int*)(WSB + O_CNT) + l * 32;
  const int* ltok = (const int*)(WSB + O_LTOK);
  const float* lw = (const float*)(WSB + O_LW);
  for (int item = (BIDX & 7) * (GDIM >> 3) + (BIDX >> 3); item < NT * 8; item += GDIM) {
    const int mt = item >> 3, nt = item & 7, e = moe_find(tstart, mt), lt = mt - tstart[e], ce = cnt[e];
    f32x4 acc[4][4];
    zero_acc(acc);
    RowLin rp{(const unsigned char*)(H + (size_t)mt * 128 * 512), 1024};
    gemm_main<true>(TIDX, BIDX, GDIM, acc, rp, WE + ((size_t)e * 1024 + nt * 128) * 512, 512, 512, smem);
    EPI_SWAP_BEGIN(0, nt * 128)
      const int pos = lt * 128 + row;
      if (pos < ce) {
        const int tk = ltok[(size_t)e * NTOK + pos];
        const float wt = lw[(size_t)e * NTOK + pos];
        const f32x4 a = acc[mi][ni] * wt;
        *(uint2*)(YM + (size_t)tk * 1024 + col) = make_uint2(pack2(a[0], a[1]), pack2(a[2], a[3]));
      }
    EPI_END
  }
}

DEVI void phase_p10(const int TIDX, const int BIDX, const int GDIM, KAP KA, unsigned char* WSB, float* OUTB, int l) {
  const int tid = TIDX, lane = tid & 63;
  const float* PRE = (const float*)(WSB + O_PRE);
  const bf16_t* YM = (const bf16_t*)(WSB + O_YM);
  bf16_t* XB = (bf16_t*)(WSB + O_XB);
  const float* g2 = PIN(I_LN2G) + l * 1024; const float* b2 = PIN(I_LN2B) + l * 1024;
  const int wid = BIDX * 4 + (tid >> 6), nw = GDIM * 4;
  for (int row = wid; row < NTOK; row += 2 * nw) {
    const bool hb = row + nw < NTOK;
    const int rws[2] = {row, hb ? row + nw : row};
    float4 v[2][4];
    uint2 y0[2][4], y1[2][4];
#pragma unroll
    for (int k = 0; k < 2; ++k)
#pragma unroll
      for (int j = 0; j < 4; ++j) {
        v[k][j] = *(const float4*)(PRE + (size_t)rws[k] * 1024 + j * 256 + lane * 4);
        y0[k][j] = *(const uint2*)(YM + (size_t)rws[k] * 2048 + j * 256 + lane * 4);
        y1[k][j] = *(const uint2*)(YM + (size_t)rws[k] * 2048 + 1024 + j * 256 + lane * 4);
      }
#pragma unroll
    for (int k = 0; k < 2; ++k) {
      if (k == 0 || hb) {
#pragma unroll
        for (int j = 0; j < 4; ++j) {
          v[k][j].x += lo2f(y0[k][j].x) + lo2f(y1[k][j].x); v[k][j].y += hi2f(y0[k][j].x) + hi2f(y1[k][j].x);
          v[k][j].z += lo2f(y0[k][j].y) + lo2f(y1[k][j].y); v[k][j].w += hi2f(y0[k][j].y) + hi2f(y1[k][j].y);
        }
        ln_inplace(v[k], g2, b2, lane);
        const size_t r = (size_t)rws[k];
        if (l == 0) store_row(v[k], OUTB + r * 1024, XB + r * 1024, lane);
        else {
#pragma unroll
          for (int j = 0; j < 4; ++j) *(float4*)(OUTB + r * 1024 + j * 256 + lane * 4) = v[k][j];
        }
      }
    }
  }
}

DEVI void* launder_ptr(const void* q) {
  uint32_t lo = (uint32_t)(uintptr_t)q, hi = (uint32_t)((uintptr_t)q >> 32);
  asm volatile("" : "+v"(lo), "+v"(hi));
  lo = __builtin_amdgcn_readfirstlane(lo);
  hi = __builtin_amdgcn_readfirstlane(hi);
  return (void*)(((uintptr_t)hi << 32) | lo);
}
DEVI void grid_barrier(const int TIDX, const int BIDX, const int GDIM, unsigned* bar, unsigned k) {
  __syncthreads();
  if (TIDX == 0) {
    __threadfence();
    const unsigned g = (unsigned)BIDX & 7u, gs = (unsigned)GDIM >> 3;
    const unsigned old = __hip_atomic_fetch_add(bar + 32 * (1 + g), 1u, __ATOMIC_RELAXED, __HIP_MEMORY_SCOPE_AGENT);
    if (old + 1u == gs * k) {
      __threadfence();
      __hip_atomic_fetch_add(bar, 1u, __ATOMIC_RELAXED, __HIP_MEMORY_SCOPE_AGENT);
    }
    unsigned spins = 0;
    while (__hip_atomic_load(bar, __ATOMIC_RELAXED, __HIP_MEMORY_SCOPE_AGENT) < 8u * k) {
      __builtin_amdgcn_s_sleep(1);
      if (++spins > (1u << 27)) break;
    }
    __threadfence();
  }
  __syncthreads();
}
__global__ void __launch_bounds__(256, 2) mega(Params p, int ph0, int ph1) {
  __shared__ __attribute__((aligned(16))) unsigned char smem[SMEM_TOTAL];
  const int wave_in_block = __builtin_amdgcn_readfirstlane((int)(__builtin_amdgcn_workitem_id_x() >> 6));
  for (int ph = ph0; ph < ph1; ++ph) {
    int wv_ = wave_in_block;
    asm volatile("" : "+s"(wv_));
    int TIDX = wv_ * 64 + (int)__lane_id();
    asm volatile("" : "+v"(TIDX));
    int BIDX = __builtin_amdgcn_workgroup_id_x(), GDIM = (int)gridDim.x;
    asm volatile("" : "+s"(BIDX), "+s"(GDIM));
    KAP KA;
    {
      uintptr_t q = (uintptr_t)__builtin_amdgcn_kernarg_segment_ptr();
      uint32_t lo = (uint32_t)q, hi = (uint32_t)(q >> 32);
      asm volatile("" : "+s"(lo), "+s"(hi));
      KA = (KAP)(((uintptr_t)hi << 32) | lo);
    }
    float* OUTB = (float*)PIN(31);
    unsigned char* WSB = (unsigned char*)PIN(32);
#ifndef PHSEL
#define PHSEL -1
#endif
    if (ph == 0) { if (PHSEL < 0 || PHSEL == 10) phase_prep(TIDX, BIDX, GDIM, KA, WSB, OUTB, smem); }
    else {
      const int l = (ph - 1) / 10, s = (ph - 1) % 10;
      switch (s) {
        case 0: if (PHSEL < 0 || PHSEL == 0) phase_p1(TIDX, BIDX, GDIM, KA, WSB, OUTB, l, smem); break;
        case 1: if (PHSEL < 0 || PHSEL == 1) phase_p2(TIDX, BIDX, GDIM, KA, WSB, OUTB, l, smem); break;
        case 2: if (PHSEL < 0 || PHSEL == 2) phase_p3(TIDX, BIDX, GDIM, KA, WSB, OUTB, l, smem); break;
        case 3: if (PHSEL < 0 || PHSEL == 3) phase_p4(TIDX, BIDX, GDIM, KA, WSB, OUTB, l, smem); break;
        case 4: if (PHSEL < 0 || PHSEL == 4) phase_p5(TIDX, BIDX, GDIM, KA, WSB, OUTB, l, smem); break;
        case 5: if (PHSEL < 0 || PHSEL == 5) phase_p6(TIDX, BIDX, GDIM, KA, WSB, OUTB, l, smem); break;
        case 6: if (PHSEL < 0 || PHSEL == 6) phase_p7(TIDX, BIDX, GDIM, KA, WSB, OUTB, l, smem); break;
        case 7: if (PHSEL < 0 || PHSEL == 7) phase_p8(TIDX, BIDX, GDIM, KA, WSB, OUTB, l, smem); break;
        case 8: if (PHSEL < 0 || PHSEL == 8) phase_p9(TIDX, BIDX, GDIM, KA, WSB, OUTB, l, smem); break;
        default: if (PHSEL < 0 || PHSEL == 9) phase_p10(TIDX, BIDX, GDIM, KA, WSB, OUTB, l); break;
      }
    }
#ifdef PROBE_DUP
    if (ph > 0 && (ph - 1) % 10 == PROBE_DUP) {
      cg::this_grid().sync();
      const int l = (ph - 1) / 10;
      switch (PROBE_DUP) {
        case 0: phase_p1(TIDX, BIDX, GDIM, KA, WSB, OUTB, l, smem); break;
        case 1: phase_p2(TIDX, BIDX, GDIM, KA, WSB, OUTB, l, smem); break;
        case 2: phase_p3(TIDX, BIDX, GDIM, KA, WSB, OUTB, l, smem); break;
        case 3: phase_p4(TIDX, BIDX, GDIM, KA, WSB, OUTB, l, smem, 1); break;
        case 4: phase_p5(TIDX, BIDX, GDIM, KA, WSB, OUTB, l, smem); break;
        case 5: phase_p6(TIDX, BIDX, GDIM, KA, WSB, OUTB, l, smem); break;
        case 7: phase_p8(TIDX, BIDX, GDIM, KA, WSB, OUTB, l, smem); break;
        case 8: phase_p9(TIDX, BIDX, GDIM, KA, WSB, OUTB, l, smem); break;
        case 9: phase_p10(TIDX, BIDX, GDIM, KA, WSB, OUTB, l); break;
        default: break;
      }
    }
#endif
    if (ph + 1 < ph1) {
      if (ph == ph0) cg::this_grid().sync();
      else grid_barrier(TIDX, BIDX, GDIM, (unsigned*)(WSB + O_CNT + 2048), (unsigned)(ph - ph0));
    }
  }
}

#ifndef MK_MULTI
#define MK_MULTI 0
#endif

extern "C" void kernel_launch(void* const* d_in, const int* in_sizes, int n_in, void* d_out, int out_size, void* d_ws, size_t ws_size,
                              hipStream_t stream) {
  static int grid_blocks = 0;
  if (!grid_blocks) {
    int dev = 0, cus = 0, per_cu = 0;
    hipGetDevice(&dev);
    hipDeviceGetAttribute(&cus, hipDeviceAttributeMultiprocessorCount, dev);
    hipOccupancyMaxActiveBlocksPerMultiprocessor(&per_cu, mega, 256, 0);
    if (per_cu > 2) per_cu = 2;
    if (per_cu < 1) per_cu = 1;
    grid_blocks = cus * per_cu;
  }
  Params p{};
  for (int i = 0; i < 31; ++i) p.in[i] = (const float*)d_in[i];
  p.out_ = (float*)d_out;
  p.ws_ = (unsigned char*)d_ws;
  if (ws_size < WS_END) fprintf(stderr, "workspace too small: %zu < %zu\n", ws_size, (size_t)WS_END);
#if MK_MULTI
  for (int ph = 0; ph < 21; ++ph) mega<<<dim3(grid_blocks), dim3(256), 0, stream>>>(p, ph, ph + 1);
#else
  (void)hipMemsetAsync((unsigned char*)d_ws + O_CNT + 2048, 0, 2048, stream);
  int ph0 = 0, ph1 = 21;
  void* args[] = {&p, &ph0, &ph1};
  hipError_t e = hipLaunchCooperativeKernel((void*)mega, dim3(grid_blocks), dim3(256), args, 0, stream);
  if (e != hipSuccess) fprintf(stderr, "cooperative launch failed: %s (grid %d)\n", hipGetErrorString(e), grid_blocks);
#endif
}
```

```cpp
#include <hip/hip_runtime.h>
#include <hip/hip_cooperative_groups.h>
#include <stdint.h>
#include <stdio.h>
namespace cg = cooperative_groups;

#define DEVI __device__ __forceinline__
typedef unsigned short bf16_t;
typedef short bf16x8 __attribute__((ext_vector_type(8)));
typedef float f32x4 __attribute__((ext_vector_type(4)));
typedef float f32x16 __attribute__((ext_vector_type(16)));

constexpr int NTOK = 66048, TP = 65536, TS = 512;
constexpr int NCH = NTOK / 32;
constexpr int KPAD = 4160;
constexpr float DN_ALPHA = 1.4142135623730951f;
constexpr float EPS = 1e-6f;
constexpr float QSCALE = 0.10206207261596575f * 1.4426950408889634f;

constexpr size_t OUT_Y = 0;
constexpr size_t OUT_CKV_P = 67633152ull;
constexpr size_t OUT_KR_P = 101187584ull;
constexpr size_t OUT_ST_P = 105381888ull;
constexpr size_t OUT_CKV_S = 109576192ull;
constexpr size_t OUT_KR_S = 109838336ull;
constexpr size_t OUT_ST_S = 109871104ull;

constexpr size_t WO_IN = 0, WO_G = WO_IN + 2816ull * 1024, WO_UQ = WO_G + 2048ull * 1024, WO_KV = WO_UQ + 768ull * 384,
                 WO_BRA = WO_KV + 1024ull * 256, WO_BRB = WO_BRA + 1024ull * 512, WO_OUT = WO_BRB + 1024ull * 512,
                 WO_PG = WO_OUT + 1024ull * 1024, WO_PLE = WO_PG + 1024ull * 1024, WO_END = WO_PLE + 1024ull * 256;
static_assert(WO_END == 8945664ull, "small weights");

constexpr size_t al(size_t x) { return (x + 255) & ~size_t(255); }
constexpr size_t SZ_XB = (size_t)(NTOK + 1) * 1024 * 2, SZ_LIST = 32ull * NTOK * 4, SZ_KRS = 2ull * 16 * KPAD * 32 * 2,
                 SZ_G = (size_t)NTOK * 512 * 2, SZ_CQ = (size_t)NTOK * 384 * 2, SZ_CKR = (size_t)NTOK * 288 * 4,
                 SZ_FQ = (size_t)NTOK * 1024 * 2, SZ_CKVN = (size_t)NTOK * 256 * 2, SZ_KRB = (size_t)NTOK * 32 * 2,
                 SZ_QB = (size_t)NTOK * 768 * 2, SZ_AM = (size_t)NCH * 4 * 32 * 32 * 2, SZ_EB = (size_t)NCH * 4 * 128 * 4,
                 SZ_VT = 32ull * 8 * 64 * 2048 * 2, SZ_KNS = 16ull * KPAD * 512 * 2, SZ_VTS = 16ull * 8 * 64 * KPAD * 2,
                 SZ_PRE = (size_t)NTOK * 1024 * 4, SZ_WE = 3ull * 32 * 512 * 1024 * 2, SZ_H = 1064ull * 128 * 512 * 2,
                 SZ_YM = (size_t)NTOK * 2 * 1024 * 2;
constexpr size_t O_WS = 0;
constexpr size_t O_WR = O_WS + al(2 * WO_END * 2);
constexpr size_t O_ROPE = O_WR + al(2ull * 36 * 1024 * 4);
constexpr size_t O_CNT = O_ROPE + al(2080ull * 16 * 2 * 4);
constexpr size_t O_XB = O_CNT + 16384;
constexpr size_t O_LTOK = O_XB + al(SZ_XB);
constexpr size_t O_LW = O_LTOK + al(SZ_LIST);
constexpr size_t O_KRS = O_LW + al(SZ_LIST);
constexpr size_t O_G = O_KRS + al(SZ_KRS);
constexpr size_t O_VT2 = O_G + al(SZ_G);
constexpr size_t O_CQ = O_VT2 + al(SZ_G);
constexpr size_t O_CKR = O_CQ + al(SZ_CQ);
constexpr size_t O_FQ = O_CKR + al(SZ_CKR);
constexpr size_t O_CKVN = O_FQ + al(SZ_FQ);
constexpr size_t O_KRB = O_CKVN + al(SZ_CKVN);
constexpr size_t O_QB = O_KRB + al(SZ_KRB);
constexpr size_t O_QT = O_QB + al(SZ_QB);
constexpr size_t O_KHT = O_QT + al(SZ_G);
constexpr size_t O_AM = O_KHT + al(SZ_G);
constexpr size_t O_EB = O_AM + al(SZ_AM);
constexpr size_t O_KN = O_EB + al(SZ_EB);
constexpr size_t O_HO = O_KN + al(SZ_G);
constexpr size_t O_CCB = O_HO + al(SZ_G);
constexpr size_t WS_END = O_CCB + 16ull * 4096 * 256 * 2;
constexpr size_t O_VT = O_CQ;
constexpr size_t O_KNS = O_VT + al(SZ_VT);
constexpr size_t O_VTS = O_KNS + al(SZ_KNS);
constexpr size_t O_AO = O_VTS + al(SZ_VTS);
constexpr size_t O_MG = O_QB;
constexpr size_t O_PRE = O_G;
constexpr size_t O_WE = O_VTS;
constexpr size_t O_H = O_WE + al(SZ_WE);
constexpr size_t O_YM = O_H + al(SZ_H);
static_assert(O_AO + SZ_G <= O_KRB, "AO");
static_assert(O_AO >= O_VTS + SZ_VTS, "AO2");
static_assert(O_MG + SZ_XB <= O_KN, "MG");
static_assert(O_PRE + SZ_PRE <= O_WE, "PRE");
static_assert(O_YM + SZ_YM <= WS_END, "YM");
static_assert(WS_END <= (1ull << 30), "workspace");

struct Params { const float* in[31]; float* out_; unsigned char* ws_; };
typedef const __attribute__((address_space(4))) unsigned char* KAP;
#define PIN(i) (*(const float* const __attribute__((address_space(4)))*)(KA + 8 * (i)))

enum { I_XP = 0, I_XS, I_PP, I_PS, I_CCKV, I_CKR, I_ST, I_LN0G, I_LN0B, I_WIN, I_QN, I_WUQ, I_KVN, I_WUK, I_WUV, I_HGLB, I_HGN,
       I_WBRA, I_WBRB, I_WOUT, I_LN1G, I_LN1B, I_WRG, I_WRE, I_WE1, I_WE3, I_WE2, I_WPLE, I_WPG, I_LN2G, I_LN2B };

DEVI float bf2f(bf16_t h) { return __uint_as_float(((uint32_t)h) << 16); }
DEVI bf16_t f2bf(float f) { uint32_t u = __float_as_uint(f); u += 0x7fffu + ((u >> 16) & 1u); return (bf16_t)(u >> 16); }
typedef float f32x2_t __attribute__((ext_vector_type(2)));
typedef __bf16 bf16x2_t __attribute__((ext_vector_type(2)));
DEVI uint32_t pack2(float lo, float hi) { f32x2_t v = {lo, hi}; bf16x2_t b = __builtin_convertvector(v, bf16x2_t); return __builtin_bit_cast(uint32_t, b); }
DEVI float lo2f(uint32_t u) { return __uint_as_float(u << 16); }
DEVI float hi2f(uint32_t u) { return __uint_as_float(u & 0xffff0000u); }
DEVI float dpp_add_(float v, const int ctrl_sel) {
  const int iv = __float_as_int(v);
  int o;
  if (ctrl_sel == 0) o = __builtin_amdgcn_update_dpp(0, iv, 0xB1, 0xf, 0xf, true);
  else if (ctrl_sel == 1) o = __builtin_amdgcn_update_dpp(0, iv, 0x4E, 0xf, 0xf, true);
  else if (ctrl_sel == 2) o = __builtin_amdgcn_update_dpp(0, iv, 0x141, 0xf, 0xf, true);
  else o = __builtin_amdgcn_update_dpp(0, iv, 0x140, 0xf, 0xf, true);
  return v + __int_as_float(o);
}
DEVI float wave_sum(float v) {
  v = dpp_add_(v, 0);
  v = dpp_add_(v, 1);
  v = dpp_add_(v, 2);
  v = dpp_add_(v, 3);
  const int iv = __float_as_int(v);
  const float r0 = __int_as_float(__builtin_amdgcn_readlane(iv, 0)), r1 = __int_as_float(__builtin_amdgcn_readlane(iv, 16));
  const float r2 = __int_as_float(__builtin_amdgcn_readlane(iv, 32)), r3 = __int_as_float(__builtin_amdgcn_readlane(iv, 48));
  return (r0 + r1) + (r2 + r3);
}
DEVI float sigmoidf_(float x) { return 1.f / (1.f + __expf(-x)); }
DEVI float siluf_(float x) { return x / (1.f + __expf(-x)); }
DEVI f32x4 mfma16(bf16x8 a, bf16x8 b, f32x4 c) { return __builtin_amdgcn_mfma_f32_16x16x32_bf16(a, b, c, 0, 0, 0); }
DEVI f32x16 mfma32(bf16x8 a, bf16x8 b, f32x16 c) { return __builtin_amdgcn_mfma_f32_32x32x16_bf16(a, b, c, 0, 0, 0); }
DEVI bf16x8 mk8(uint32_t a, uint32_t b, uint32_t c, uint32_t d) { uint4 u = make_uint4(a, b, c, d); return *(bf16x8*)&u; }
DEVI bf16x8 mk8(uint2 lo, uint2 hi) { uint4 u = make_uint4(lo.x, lo.y, hi.x, hi.y); return *(bf16x8*)&u; }

constexpr int SMEM_GEMM = 2 * 2 * 128 * 72 * 2;
constexpr int SMEM_TOTAL = SMEM_GEMM + 2048;

template <bool SWAP, class RP>
DEVI void gemm_main(const int TIDX, const int BIDX, const int GDIM, f32x4 (&acc)[4][4], RP rowoff, const bf16_t* __restrict__ Bt, int ldb, int K, unsigned char* smem) {
  const int tid = TIDX;
  const int lane = tid & 63, w = tid >> 6, wr = w >> 1, wc = w & 1, li = lane & 15, lg = lane >> 4;
  const unsigned char* abase = rowoff.base;
  const unsigned char* bbase = (const unsigned char*)Bt;
  const uint32_t schunk = (uint32_t)((lane & 7) ^ (((lane >> 4) + 4 * (w & 1)) & 7)) * 16u;
  uint32_t ao0, ao1, ao2, ao3;
  const int rsub = w * 8 + (lane >> 3);
  ao0 = rowoff(rsub) + schunk; ao1 = rowoff(rsub + 32) + schunk; ao2 = rowoff(rsub + 64) + schunk; ao3 = rowoff(rsub + 96) + schunk;
  const uint32_t bo = (uint32_t)(rsub * ldb) * 2u + schunk, bstep = (uint32_t)(32 * ldb) * 2u;
  unsigned char* sbase = smem + w * 1024;
#define GM_STAGE(kt_, buf_)                                                                                                       \
  {                                                                                                                              \
    unsigned char* da_ = sbase + (buf_) * 32768;                                                                                 \
    unsigned char* db_ = da_ + 16384;                                                                                            \
    const uint32_t ko_ = (uint32_t)(kt_) * 128u;                                                                                 \
    __builtin_amdgcn_global_load_lds((const unsigned*)(abase + ao0 + ko_), (unsigned*)(da_), 16, 0, 0);                         \
    __builtin_amdgcn_global_load_lds((const unsigned*)(abase + ao1 + ko_), (unsigned*)(da_ + 4096), 16, 0, 0);                  \
    __builtin_amdgcn_global_load_lds((const unsigned*)(abase + ao2 + ko_), (unsigned*)(da_ + 8192), 16, 0, 0);                  \
    __builtin_amdgcn_global_load_lds((const unsigned*)(abase + ao3 + ko_), (unsigned*)(da_ + 12288), 16, 0, 0);                 \
    __builtin_amdgcn_global_load_lds((const unsigned*)(bbase + bo + ko_), (unsigned*)(db_), 16, 0, 0);                          \
    __builtin_amdgcn_global_load_lds((const unsigned*)(bbase + bo + bstep + ko_), (unsigned*)(db_ + 4096), 16, 0, 0);           \
    __builtin_amdgcn_global_load_lds((const unsigned*)(bbase + bo + 2u * bstep + ko_), (unsigned*)(db_ + 8192), 16, 0, 0);      \
    __builtin_amdgcn_global_load_lds((const unsigned*)(bbase + bo + 3u * bstep + ko_), (unsigned*)(db_ + 12288), 16, 0, 0);     \
  }
  const int nk = K >> 6;
  const int px = lg ^ (li >> 1);
  GM_STAGE(0, 0);
  for (int kt = 0; kt < nk; ++kt) {
    const int buf = kt & 1;
    asm volatile("s_waitcnt vmcnt(0)" ::: "memory");
    __syncthreads();
    if (kt + 1 < nk) GM_STAGE(kt + 1, buf ^ 1);
    const unsigned char* A = smem + buf * 32768 + (wr * 64 + li) * 128;
    const unsigned char* B = smem + buf * 32768 + 16384 + (wc * 64 + li) * 128;
#pragma unroll
    for (int ks = 0; ks < 2; ++ks) {
      const int po = (px ^ (ks * 4)) * 16;
      bf16x8 af[4], bfr[4];
#pragma unroll
      for (int i = 0; i < 4; ++i) {
        af[i] = *(const bf16x8*)(A + i * 2048 + po);
        bfr[i] = *(const bf16x8*)(B + i * 2048 + po);
      }
#pragma unroll
      for (int mi = 0; mi < 4; ++mi)
#pragma unroll
        for (int ni = 0; ni < 4; ++ni)
          acc[mi][ni] = SWAP ? mfma16(bfr[ni], af[mi], acc[mi][ni]) : mfma16(af[mi], bfr[ni], acc[mi][ni]);
    }
  }
  __syncthreads();
}
DEVI float zero_f() { float z = 0.f; asm volatile("" : "+v"(z)); return z; }
DEVI void zero_acc(f32x4 (&acc)[4][4]) {
  const float z = zero_f();
#pragma unroll
  for (int i = 0; i < 4; ++i)
#pragma unroll
    for (int j = 0; j < 4; ++j) acc[i][j] = (f32x4){z, z, z, z};
}
#define EPI_SWAP_BEGIN(m0, n0)                                                                     \
  {                                                                                                \
    const int _lane = TIDX & 63, _w = TIDX >> 6;                                     \
    const int _rb = (m0) + (_w >> 1) * 64 + (_lane & 15), _cb = (n0) + (_w & 1) * 64 + 4 * (_lane >> 4); \
    _Pragma("unroll") for (int mi = 0; mi < 4; ++mi) {                                             \
      const int row = _rb + mi * 16;                                                               \
      _Pragma("unroll") for (int ni = 0; ni < 4; ++ni) {                                           \
        const int col = _cb + ni * 16;
#define EPI_END } __builtin_amdgcn_sched_barrier(0); } }

struct RowLin {
  const unsigned char* base; uint32_t stride;
  DEVI uint32_t operator()(int r) const { return (uint32_t)r * stride; }
};

struct CMap {
  int mode;
  DEVI int operator()(int n) const {
    if (mode == 0) return n;
    if (mode == 1) return n < 672 ? n : (n < 768 ? -1 : n - 96);
    if (mode == 2) return n + 2720;
    if (n < 512) return (n >> 6) * 96 + (n & 63);
    const int m = n - 512, h = m >> 5, w = m & 31;
    return h * 96 + (w < 16 ? 64 + w : 80 + (w - 16));
  }
};
DEVI void transpose_tile(const int TIDX, const int BIDX, const int GDIM, const float* __restrict__ src, int ld, int K, bf16_t* __restrict__ dst, int k0, int n0, CMap cm,
                         const float* kscale, float* tile) {
  const int t = TIDX;
  {
    const int n4 = (t & 15) * 4, kr = t >> 4;
    const int sc = cm(n0 + n4);
#pragma unroll
    for (int p = 0; p < 4; ++p) {
      const int k = kr + 16 * p;
      float4 v = make_float4(0.f, 0.f, 0.f, 0.f);
      if (sc >= 0) {
        v = *(const float4*)(src + (size_t)(k0 + k) * ld + sc);
        if (kscale) { const float sck = kscale[k0 + k]; v.x *= sck; v.y *= sck; v.z *= sck; v.w *= sck; }
      }
      float* d = tile + k * 65 + n4;
      d[0] = v.x; d[1] = v.y; d[2] = v.z; d[3] = v.w;
    }
  }
  __syncthreads();
  {
    const int kc = (t & 7) * 8, nr = t >> 3;
#pragma unroll
    for (int q = 0; q < 2; ++q) {
      const int n = nr + 32 * q;
      const float* sp = tile + kc * 65 + n;
      const uint4 o = make_uint4(pack2(sp[0], sp[65]), pack2(sp[130], sp[195]), pack2(sp[260], sp[325]), pack2(sp[390], sp[455]));
      *(uint4*)(dst + (size_t)(n0 + n) * K + k0 + kc) = o;
    }
  }
  __syncthreads();
}
DEVI void run_transpose(const int TIDX, const int BIDX, const int GDIM, const float* src, int ld, int K, int N, bf16_t* dst, int mode, const float* kscale, float* tile) {
  const int nkt = K >> 6, tiles = nkt * (N >> 6);
  CMap cm{mode};
  for (int t = BIDX; t < tiles; t += GDIM) transpose_tile(TIDX, BIDX, GDIM, src, ld, K, dst, (t % nkt) * 64, (t / nkt) * 64, cm, kscale, tile);
}

DEVI void ln_inplace(float4 (&v)[4], const float* __restrict__ g, const float* __restrict__ b, int lane) {
  float s = 0.f;
#pragma unroll
  for (int j = 0; j < 4; ++j) s += v[j].x + v[j].y + v[j].z + v[j].w;
  s = wave_sum(s);
  const float mu = s * (1.f / 1024.f);
  float q = 0.f;
#pragma unroll
  for (int j = 0; j < 4; ++j) {
    float a = v[j].x - mu, bq = v[j].y - mu, cq = v[j].z - mu, d = v[j].w - mu;
    q += a * a + bq * bq + cq * cq + d * d;
  }
  q = wave_sum(q);
  const float rs = rsqrtf(q * (1.f / 1024.f) + EPS);
#pragma unroll
  for (int j = 0; j < 4; ++j) {
    const float4 gg = *(const float4*)(g + j * 256 + lane * 4), bb = *(const float4*)(b + j * 256 + lane * 4);
    v[j].x = (v[j].x - mu) * rs * gg.x + bb.x;
    v[j].y = (v[j].y - mu) * rs * gg.y + bb.y;
    v[j].z = (v[j].z - mu) * rs * gg.z + bb.z;
    v[j].w = (v[j].w - mu) * rs * gg.w + bb.w;
  }
}
DEVI void store_row(const float4 (&v)[4], float* x32, bf16_t* x16, int lane) {
#pragma unroll
  for (int j = 0; j < 4; ++j) {
    *(float4*)(x32 + j * 256 + lane * 4) = v[j];
    *(uint2*)(x16 + j * 256 + lane * 4) = make_uint2(pack2(v[j].x, v[j].y), pack2(v[j].z, v[j].w));
  }
}
DEVI int pos_index(int row) { return row < TP ? (row & 2047) : 2048 + ((row - TP) & 31); }

DEVI void phase_prep(const int TIDX, const int BIDX, const int GDIM, KAP KA, unsigned char* WSB, float* OUTB, unsigned char* smem) {
  float* tile = (float*)smem;
  bf16_t* WS = (bf16_t*)(WSB + O_WS);
  const int tid = TIDX, gtid = BIDX * 256 + tid, gsz = GDIM * 256;
  if (gtid < 512) ((int*)(WSB + O_CNT))[gtid] = 0;
  if (gtid < 64) ((int*)(WSB + O_CNT))[1024 + gtid * 32] = 0;
  if (gtid < 32) ((int*)(WSB + O_CNT))[3072 + (gtid >> 1) * 32 + (gtid & 1) * 16] = 0;
  if (gtid < 512) ((uint32_t*)(WSB + O_XB + (size_t)NTOK * 2048))[gtid] = 0u;
  for (int i = gtid; i < 2080 * 16; i += gsz) {
    const int pi = i >> 4, k = i & 15;
    const int pos = pi < 2048 ? pi : 4096 + (pi - 2048);
    const float inv = exp2f(-(float)k * (13.287712379549449f / 16.f));
    const float ang = (float)pos * inv;
    double rev = (double)ang * 0.15915494309189535;
    rev -= __builtin_rint(rev);
    const float fr = (float)rev;
    float2 cs = make_float2(__builtin_amdgcn_cosf(fr), __builtin_amdgcn_sinf(fr));
    ((float2*)(WSB + O_ROPE))[i] = cs;
  }
  for (int i = gtid; i < 2 * 36 * 1024; i += gsz) {
    const int l = i / (36 * 1024), r = i % (36 * 1024), c = r >> 10, k = r & 1023;
    float v = c < 4 ? PIN(I_WRG)[((size_t)l * 1024 + k) * 4 + c] : PIN(I_WRE)[((size_t)l * 1024 + k) * 32 + (c - 4)];
    ((float*)(WSB + O_WR))[i] = v;
  }
  for (int i = gtid; i < 2 * 16 * 4096 * 8; i += gsz) {
    const int e = i * 4, lb = e / (4096 * 32), r = e % (4096 * 32);
    const float4 v = *(const float4*)(PIN(I_CKR) + (size_t)e);
    *(uint2*)((bf16_t*)(WSB + O_KRS) + (size_t)lb * KPAD * 32 + r) = make_uint2(pack2(v.x, v.y), pack2(v.z, v.w));
  }
  {
    const int lane = tid & 63, wid = BIDX * 4 + (tid >> 6), nw = GDIM * 4;
    for (int row = wid; row < NTOK; row += 2 * nw) {
      const bool hb = row + nw < NTOK;
      const int rws[2] = {row, hb ? row + nw : row};
      float4 v[2][4];
#pragma unroll
      for (int k = 0; k < 2; ++k) {
        const float* src = rws[k] < TP ? PIN(I_XP) + (size_t)rws[k] * 1024 : PIN(I_XS) + (size_t)(rws[k] - TP) * 1024;
#pragma unroll
        for (int j = 0; j < 4; ++j) v[k][j] = *(const float4*)(src + j * 256 + lane * 4);
      }
#pragma unroll
      for (int k = 0; k < 2; ++k) {
        if (k == 0 || hb) {
          ln_inplace(v[k], PIN(I_LN0G), PIN(I_LN0B), lane);
          store_row(v[k], OUTB + (size_t)rws[k] * 1024, (bf16_t*)(WSB + O_XB) + (size_t)rws[k] * 1024, lane);
        }
      }
    }
  }
  for (int l = 0; l < 2; ++l) {
    bf16_t* W = WS + (size_t)l * WO_END;
    run_transpose(TIDX, BIDX, GDIM, PIN(I_WIN) + (size_t)l * 1024 * 4768, 4768, 1024, 2816, W + WO_IN, 1, nullptr, tile);
    run_transpose(TIDX, BIDX, GDIM, PIN(I_WIN) + (size_t)l * 1024 * 4768, 4768, 1024, 2048, W + WO_G, 2, nullptr, tile);
    run_transpose(TIDX, BIDX, GDIM, PIN(I_WUQ) + (size_t)l * 384 * 768, 768, 384, 768, W + WO_UQ, 3, PIN(I_QN) + l * 384, tile);
    run_transpose(TIDX, BIDX, GDIM, PIN(I_WUK) + (size_t)l * 256 * 512, 512, 256, 512, W + WO_KV, 0, nullptr, tile);
    run_transpose(TIDX, BIDX, GDIM, PIN(I_WUV) + (size_t)l * 256 * 512, 512, 256, 512, W + WO_KV + 512 * 256, 0, nullptr, tile);
    run_transpose(TIDX, BIDX, GDIM, PIN(I_WBRA) + (size_t)l * 512 * 1024, 1024, 512, 1024, W + WO_BRA, 0, nullptr, tile);
    run_transpose(TIDX, BIDX, GDIM, PIN(I_WBRB) + (size_t)l * 512 * 1024, 1024, 512, 1024, W + WO_BRB, 0, nullptr, tile);
    run_transpose(TIDX, BIDX, GDIM, PIN(I_WOUT) + (size_t)l * 1024 * 1024, 1024, 1024, 1024, W + WO_OUT, 0, nullptr, tile);
    run_transpose(TIDX, BIDX, GDIM, PIN(I_WPG) + (size_t)l * 1024 * 1024, 1024, 1024, 1024, W + WO_PG, 0, nullptr, tile);
    run_transpose(TIDX, BIDX, GDIM, PIN(I_WPLE) + (size_t)l * 256 * 1024, 1024, 256, 1024, W + WO_PLE, 0, nullptr, tile);
  }
}

DEVI void phase_p1(const int TIDX, const int BIDX, const int GDIM, KAP KA, unsigned char* WSB, float* OUTB, int l, unsigned char* smem) {
  const bf16_t* XB = (const bf16_t*)(WSB + O_XB);
  const bf16_t* W = (const bf16_t*)(WSB + O_WS) + (size_t)l * WO_END + WO_IN;
  bf16_t* CQ = (bf16_t*)(WSB + O_CQ);
  float* CKR = (float*)(WSB + O_CKR);
  bf16_t* FQ = (bf16_t*)(WSB + O_FQ);
  bf16_t* VT2 = (bf16_t*)(WSB + O_VT2);
  bf16_t* G = (bf16_t*)(WSB + O_G);
  for (int item = (BIDX & 7) * (GDIM >> 3) + (BIDX >> 3); item < 516 * 22; item += GDIM) {
    const int mt = item / 22, nt = item % 22, m0 = mt * 128;
    f32x4 acc[4][4];
    zero_acc(acc);
    RowLin rp{(const unsigned char*)(XB + (size_t)m0 * 1024), 2048};
    if (nt >= 14 && nt < 18) {
      gemm_main<false>(TIDX, BIDX, GDIM, acc, rp, W + (size_t)nt * 128 * 1024, 1024, 1024, smem);
      const int h = nt - 14, lane = TIDX & 63, w = TIDX >> 6;
      const int rb = m0 + (w >> 1) * 64 + 4 * (lane >> 4), cb = (w & 1) * 64 + (lane & 15);
#pragma unroll
      for (int mi = 0; mi < 4; ++mi) {
        const int row = rb + mi * 16, ch = row >> 5, s = row & 31;
#pragma unroll
        for (int ni = 0; ni < 4; ++ni) {
          const int dv = cb + ni * 16;
          const f32x4 a = acc[mi][ni];
          *(uint2*)(VT2 + ((size_t)(ch * 4 + h) * 128 + dv) * 32 + s) = make_uint2(pack2(a[0], a[1]), pack2(a[2], a[3]));
        }
      }
    } else {
      gemm_main<true>(TIDX, BIDX, GDIM, acc, rp, W + (size_t)nt * 128 * 1024, 1024, 1024, smem);
      EPI_SWAP_BEGIN(m0, 0)
        const f32x4 a = acc[mi][ni];
        if (nt < 3) {
          *(uint2*)(CQ + (size_t)row * 384 + nt * 128 + col) = make_uint2(pack2(a[0], a[1]), pack2(a[2], a[3]));
        } else if (nt < 5) {
          *(f32x4*)(CKR + (size_t)row * 288 + (nt - 3) * 128 + col) = a;
        } else if (nt == 5) {
          if (col < 32) *(f32x4*)(CKR + (size_t)row * 288 + 256 + col) = a;
        } else if (nt < 14) {
          *(uint2*)(FQ + (size_t)row * 1024 + (nt - 6) * 128 + col) = make_uint2(pack2(a[0], a[1]), pack2(a[2], a[3]));
        } else {
          *(uint2*)(G + (size_t)row * 512 + (nt - 18) * 128 + col) = make_uint2(pack2(a[0], a[1]), pack2(a[2], a[3]));
        }
      EPI_END
    }
  }
}

DEVI void phase_p2(const int TIDX, const int BIDX, const int GDIM, KAP KA, unsigned char* WSB, float* OUTB, int l, unsigned char* smem) {
  const int tid = TIDX, lane = tid & 63;
  const float2* ROPE = (const float2*)(WSB + O_ROPE);
  {
    const bf16_t* CQ = (const bf16_t*)(WSB + O_CQ);
    const bf16_t* W = (const bf16_t*)(WSB + O_WS) + (size_t)l * WO_END + WO_UQ;
    bf16_t* QB = (bf16_t*)(WSB + O_QB);
    float* srow = (float*)(smem + SMEM_GEMM);
    for (int item = (BIDX & 7) * (GDIM >> 3) + (BIDX >> 3); item < 516 * 6; item += GDIM) {
      const int mt = item / 6, nt = item % 6, m0 = mt * 128;
      {
        const int r = tid >> 1, hf = tid & 1;
        const uint4* s = (const uint4*)(CQ + (size_t)(m0 + r) * 384 + hf * 192);
        float ss = 0.f;
#pragma unroll 4
        for (int j = 0; j < 24; ++j) {
          const uint4 u = s[j];
          float a;
          a = lo2f(u.x); ss += a * a; a = hi2f(u.x); ss += a * a;
          a = lo2f(u.y); ss += a * a; a = hi2f(u.y); ss += a * a;
          a = lo2f(u.z); ss += a * a; a = hi2f(u.z); ss += a * a;
          a = lo2f(u.w); ss += a * a; a = hi2f(u.w); ss += a * a;
        }
        ss += __shfl_xor(ss, 1);
        if (hf == 0) srow[r] = rsqrtf(ss * (1.f / 384.f) + EPS) * QSCALE;
      }
      f32x4 acc[4][4];
      zero_acc(acc);
      RowLin rp{(const unsigned char*)(CQ + (size_t)m0 * 384), 768};
      gemm_main<true>(TIDX, BIDX, GDIM, acc, rp, W + (size_t)nt * 128 * 384, 384, 384, smem);
      if (nt < 4) {
        EPI_SWAP_BEGIN(m0, nt * 128)
          const float sc = srow[row - m0];
          const f32x4 a = acc[mi][ni] * sc;
          const int hh = col >> 6, d = col & 63;
          *(uint2*)(QB + (size_t)row * 768 + hh * 96 + d) = make_uint2(pack2(a[0], a[1]), pack2(a[2], a[3]));
        EPI_END
      } else {
        const int w = tid >> 6;
        const int rb = m0 + (w >> 1) * 64 + (lane & 15), i0 = 4 * (lane >> 4);
#pragma unroll
        for (int mi = 0; mi < 4; ++mi) {
          const int row = rb + mi * 16;
          const float sc = srow[row - m0];
          const float2* rt = ROPE + (size_t)pos_index(row) * 16 + i0;
#pragma unroll
          for (int pr = 0; pr < 2; ++pr) {
            const int hh = (nt - 4) * 4 + (w & 1) * 2 + pr;
            const f32x4 x1 = acc[mi][2 * pr] * sc, x2 = acc[mi][2 * pr + 1] * sc;
            float o1[4], o2[4];
#pragma unroll
            for (int r = 0; r < 4; ++r) {
              const float2 cs = rt[r];
              o1[r] = x1[r] * cs.x - x2[r] * cs.y;
              o2[r] = x2[r] * cs.x + x1[r] * cs.y;
            }
            *(uint2*)(QB + (size_t)row * 768 + hh * 96 + 64 + i0) = make_uint2(pack2(o1[0], o1[1]), pack2(o1[2], o1[3]));
            *(uint2*)(QB + (size_t)row * 768 + hh * 96 + 80 + i0) = make_uint2(pack2(o2[0], o2[1]), pack2(o2[2], o2[3]));
          }
        }
      }
      __syncthreads();
    }
  }
  {
    const bf16_t* FQ = (const bf16_t*)(WSB + O_FQ);
    bf16_t* QT = (bf16_t*)(WSB + O_QT);
    bf16_t* KHT = (bf16_t*)(WSB + O_KHT);
    bf16_t* AM = (bf16_t*)(WSB + O_AM);
    float* EBp = (float*)(WSB + O_EB);
    bf16_t* sQ = (bf16_t*)smem;
    bf16_t* sK = sQ + 32 * 136;
    for (int item = BIDX; item < NCH * 4; item += GDIM) {
      const int ch = item >> 2, h = item & 3, cid = item;
      {
        const int k = tid & 127, half = tid >> 7, colh = h * 128 + k;
        float* sB = (float*)(smem + 2 * 32 * 136 * 2);
        float lb = 0.f;
        if (l == 1) { const float a0 = PIN(I_HGLB)[colh], a1 = PIN(I_HGLB)[512 + colh]; lb = 1.f / (1.f + expf(a0 - a1)); }
        const float oml = 1.f - lb;
        float bt[16], kk[16], qv[16];
        float bl = 0.f;
#pragma unroll
        for (int j = 0; j < 16; ++j) {
          const size_t row = (size_t)ch * 32 + half * 16 + j;
          const float z = bf2f(FQ[row * 1024 + colh]);
          qv[j] = bf2f(FQ[row * 1024 + 512 + colh]);
          const float e = __expf(-z);
          const float inv = __builtin_amdgcn_rcpf(1.f + e);
          const float f = lb + oml * inv;
          kk[j] = oml * e * inv;
          bl += __logf(f);
          bt[j] = bl;
        }
        sB[half * 128 + k] = bl;
        __syncthreads();
        const float b0 = sB[k], b1 = sB[128 + k];
        const float off = half ? b0 : 0.f, bend = b0 + b1;
        uint32_t pk[8];
#pragma unroll
        for (int j = 0; j < 16; ++j) {
          const int t = half * 16 + j;
          const float b = bt[j] + off;
          const float qs = qv[j] * __builtin_amdgcn_rcpf(1.f + __expf(-qv[j]));
          const bf16_t qt = f2bf(qs * __expf(b));
          QT[((size_t)cid * 32 + t) * 128 + k] = qt;
          sQ[t * 136 + k] = qt;
          sK[t * 136 + k] = f2bf(kk[j] * __expf(fminf(-b, 80.f)));
          bt[j] = kk[j] * __expf(bend - b);
        }
#pragma unroll
        for (int j = 0; j < 8; ++j) pk[j] = pack2(bt[2 * j], bt[2 * j + 1]);
        if (half == 0) EBp[(size_t)cid * 128 + k] = __expf(bend);
        uint4* dst = (uint4*)(KHT + ((size_t)cid * 128 + k) * 32 + half * 16);
        dst[0] = make_uint4(pk[0], pk[1], pk[2], pk[3]);
        dst[1] = make_uint4(pk[4], pk[5], pk[6], pk[7]);
      }
      __syncthreads();
      if (tid < 64) {
        const int c = lane & 31, hh = lane >> 5;
        f32x16 am;
        const float zf = zero_f();
#pragma unroll
        for (int r = 0; r < 16; ++r) am[r] = zf;
#pragma unroll
        for (int st = 0; st < 8; ++st) {
          const bf16x8 a = *(const bf16x8*)(sQ + c * 136 + st * 16 + hh * 8);
          const bf16x8 bb = *(const bf16x8*)(sK + c * 136 + st * 16 + hh * 8);
          am = mfma32(a, bb, am);
        }
#pragma unroll
        for (int r = 0; r < 16; ++r) {
          const int t = (r & 3) + 8 * (r >> 2) + 4 * hh;
          AM[((size_t)cid * 32 + t) * 32 + c] = f2bf(c <= t ? am[r] : 0.f);
        }
      }
      __syncthreads();
    }
  }
  {
    const float* src = PIN(I_CCKV) + (size_t)l * 16 * 4096 * 256;
    bf16_t* CCB = (bf16_t*)(WSB + O_CCB);
    const size_t str_ = (size_t)GDIM * 256;
    for (size_t i = (size_t)BIDX * 256 + tid; i < 16ull * 4096 * 64; i += 4 * str_) {
      float4 v4[4];
#pragma unroll
      for (int k = 0; k < 4; ++k) { const size_t ii = i + k * str_ < 16ull * 4096 * 64 ? i + k * str_ : i; v4[k] = *(const float4*)(src + ii * 4); }
#pragma unroll
      for (int k = 0; k < 4; ++k) if (i + k * str_ < 16ull * 4096 * 64) *(uint2*)(CCB + (i + k * str_) * 4) = make_uint2(pack2(v4[k].x, v4[k].y), pack2(v4[k].z, v4[k].w));
    }
  }
  {
    const float* CKR = (const float*)(WSB + O_CKR);
    bf16_t* CKVN = (bf16_t*)(WSB + O_CKVN);
    bf16_t* KRB = (bf16_t*)(WSB + O_KRB);
    bf16_t* KRS = (bf16_t*)(WSB + O_KRS) + (size_t)l * 16 * KPAD * 32;
    const float* kvn = PIN(I_KVN) + l * 256;
    const int wid = BIDX * 4 + (tid >> 6), nw = GDIM * 4;
    const float4 g = *(const float4*)(kvn + lane * 4);
    for (int row0 = wid; row0 < NTOK; row0 += 4 * nw) {
      int rws[4]; bool ok4[4];
      float4 v[4]; float x1[4], x2[4]; float2 cs[4];
#pragma unroll
      for (int k = 0; k < 4; ++k) {
        ok4[k] = row0 + k * nw < NTOK;
        rws[k] = ok4[k] ? row0 + k * nw : row0;
        const float* src = CKR + (size_t)rws[k] * 288;
        v[k] = *(const float4*)(src + lane * 4);
        x1[k] = src[256 + (lane & 15)]; x2[k] = src[272 + (lane & 15)];
        cs[k] = ROPE[(size_t)pos_index(rws[k]) * 16 + (lane & 15)];
      }
#pragma unroll
      for (int k = 0; k < 4; ++k) {
        if (ok4[k]) {
          const int row = rws[k];
          float ss = wave_sum(v[k].x * v[k].x + v[k].y * v[k].y + v[k].z * v[k].z + v[k].w * v[k].w);
          const float rs = rsqrtf(ss * (1.f / 256.f) + EPS);
          const float4 o = make_float4(v[k].x * rs * g.x, v[k].y * rs * g.y, v[k].z * rs * g.z, v[k].w * rs * g.w);
          float* oc = row < TP ? OUTB + OUT_CKV_P + ((size_t)l * TP + row) * 256 : OUTB + OUT_CKV_S + ((size_t)l * TS + (row - TP)) * 256;
          *(float4*)(oc + lane * 4) = o;
          *(uint2*)(CKVN + (size_t)row * 256 + lane * 4) = make_uint2(pack2(o.x, o.y), pack2(o.z, o.w));
          if (lane < 16) {
            const float o1 = x1[k] * cs[k].x - x2[k] * cs[k].y, o2 = x2[k] * cs[k].x + x1[k] * cs[k].y;
            float* okp = row < TP ? OUTB + OUT_KR_P + ((size_t)l * TP + row) * 32 : OUTB + OUT_KR_S + ((size_t)l * TS + (row - TP)) * 32;
            okp[lane] = o1;
            okp[16 + lane] = o2;
            bf16_t* kb = row < TP ? KRB + (size_t)row * 32 : KRS + ((size_t)((row - TP) >> 5) * KPAD + 4096 + ((row - TP) & 31)) * 32;
            kb[lane] = f2bf(o1);
            kb[16 + lane] = f2bf(o2);
          }
        }
      }
    }
  }
}

DEVI void phase_p3(const int TIDX, const int BIDX, const int GDIM, KAP KA, unsigned char* WSB, float* OUTB, int l, unsigned char* smem) {
  const bf16_t* W = (const bf16_t*)(WSB + O_WS) + (size_t)l * WO_END + WO_KV;
  const bf16_t* CKVN = (const bf16_t*)(WSB + O_CKVN);
  bf16_t* KN = (bf16_t*)(WSB + O_KN);
  bf16_t* VT = (bf16_t*)(WSB + O_VT);
  bf16_t* KNS = (bf16_t*)(WSB + O_KNS);
  bf16_t* VTS = (bf16_t*)(WSB + O_VTS);
  const bf16_t* cache = (const bf16_t*)(WSB + O_CCB);
  for (int i = BIDX * 256 + TIDX; i < 16 * 8 * 64 * 4; i += GDIM * 256) {
    const uint32_t z = __float_as_uint(zero_f());
    *(uint4*)(VTS + (size_t)(i >> 2) * KPAD + 4128 + (i & 3) * 8) = make_uint4(z, z, z, z);
  }
  for (int item = (BIDX & 7) * (GDIM >> 3) + (BIDX >> 3); item < (516 + 512) * 8; item += GDIM) {
    const int mt = item >> 3, nt = item & 7;
    const bool is_cache = mt >= 516;
    const int m0 = is_cache ? (mt - 516) * 128 : mt * 128;
    f32x4 acc[4][4];
    zero_acc(acc);
    bf16_t* kdst; bf16_t* vdst; size_t ldv; int key0;
    if (is_cache) { const int b = m0 >> 12; key0 = m0 & 4095; kdst = KNS + ((size_t)b * KPAD + key0) * 512; vdst = VTS + (size_t)b * 8 * 64 * KPAD; ldv = KPAD; }
    else if (m0 >= TP) { kdst = nullptr; vdst = nullptr; ldv = KPAD; key0 = 0; }
    else { const int b = m0 >> 11; key0 = m0 & 2047; kdst = KN + (size_t)m0 * 512; vdst = VT + (size_t)b * 8 * 64 * 2048; ldv = 2048; }
    if (nt < 4) {
      if (is_cache) { RowLin rp{(const unsigned char*)(cache + (size_t)m0 * 256), 512}; gemm_main<true>(TIDX, BIDX, GDIM, acc, rp, W + (size_t)nt * 128 * 256, 256, 256, smem); }
      else { RowLin rp{(const unsigned char*)(CKVN + (size_t)m0 * 256), 512}; gemm_main<true>(TIDX, BIDX, GDIM, acc, rp, W + (size_t)nt * 128 * 256, 256, 256, smem); }
      EPI_SWAP_BEGIN(0, nt * 128)
        const f32x4 a = acc[mi][ni];
        bf16_t* d;
        if (kdst) d = kdst + (size_t)row * 512 + col;
        else { const int sr = m0 - TP + row; d = KNS + ((size_t)(sr >> 5) * KPAD + 4096 + (sr & 31)) * 512 + col; }
        *(uint2*)d = make_uint2(pack2(a[0], a[1]), pack2(a[2], a[3]));
      EPI_END
    } else {
      if (is_cache) { RowLin rp{(const unsigned char*)(cache + (size_t)m0 * 256), 512}; gemm_main<false>(TIDX, BIDX, GDIM, acc, rp, W + (size_t)nt * 128 * 256, 256, 256, smem); }
      else { RowLin rp{(const unsigned char*)(CKVN + (size_t)m0 * 256), 512}; gemm_main<false>(TIDX, BIDX, GDIM, acc, rp, W + (size_t)nt * 128 * 256, 256, 256, smem); }
      const int lane = TIDX & 63, w = TIDX >> 6;
      const int rb = (w >> 1) * 64 + 4 * (lane >> 4), cb = (nt - 4) * 128 + (w & 1) * 64 + (lane & 15);
#pragma unroll
      for (int mi = 0; mi < 4; ++mi) {
        const int row = rb + mi * 16;
#pragma unroll
        for (int ni = 0; ni < 4; ++ni) {
          const int hv = cb + ni * 16;
          const f32x4 a = acc[mi][ni];
          bf16_t* d;
          if (vdst) d = vdst + (size_t)hv * ldv + key0 + row;
          else { const int sr = m0 - TP + row; d = VTS + ((size_t)(sr >> 5) * 512 + hv) * KPAD + 4096 + (sr & 31); }
          *(uint2*)d = make_uint2(pack2(a[0], a[1]), pack2(a[2], a[3]));
        }
      }
    }
  }
}

DEVI void attn_item(const int TIDX, const int BIDX, const int GDIM, const bf16_t* __restrict__ Q, int qrow0, int nq, int ng, const bf16_t* __restrict__ Kn, const bf16_t* __restrict__ Kr,
                    const bf16_t* __restrict__ VT, size_t ldv, int nkeys, bf16_t* __restrict__ O, unsigned char* smem) {
  const int tid = TIDX, lane = tid & 63, w = tid >> 6, li = lane & 15, lg = lane >> 4;
  const int ql = 16 * w + li;
  bf16x8 qf[2][3];
  f32x4 oT[2][4];
  float mrun[2], lrun[2];
  const float zf = zero_f();
#pragma unroll
  for (int g = 0; g < 2; ++g) {
    const int qr = qrow0 + (g == 0 ? (ql < nq ? ql : nq - 1) : 64 + ql);
    const int qrc = (g == 1 && ng < 2) ? qrow0 : qr;
#pragma unroll
    for (int ds = 0; ds < 3; ++ds) qf[g][ds] = *(const bf16x8*)(Q + (size_t)qrc * 768 + ds * 32 + lg * 8);
#pragma unroll
    for (int i = 0; i < 4; ++i) oT[g][i] = (f32x4){zf, zf, zf, zf};
    mrun[g] = -INFINITY; lrun[g] = 0.f;
  }
  const int nt = (nkeys + 63) >> 6;
  const int r8 = lane >> 3;
  const uint32_t sch = (uint32_t)((lane & 7) ^ (((lane >> 4) + 4 * (w & 1)) & 7)) * 16u;
  const unsigned char* kn0 = (const unsigned char*)Kn + (size_t)(w * 8 + r8) * 1024 + sch;
  const unsigned char* kr0 = (const unsigned char*)Kr + (size_t)(w * 16 + (lane >> 2)) * 64 + (uint32_t)((lane & 3) ^ (((lane >> 5) & 1) << 1)) * 16u;
  const unsigned char* v0 = (const unsigned char*)VT + (size_t)(w * 8 + r8) * ldv * 2 + sch;
  const size_t v32 = (size_t)32 * ldv * 2;
  unsigned char* sw = smem + w * 1024;
#define ATT_STAGE(kt_)                                                                                                  \
  {                                                                                                                     \
    unsigned char* st_ = sw + ((kt_) % 3) * 20480;                                                                      \
    const size_t kb_ = (size_t)(kt_) * 64;                                                                              \
    __builtin_amdgcn_global_load_lds((const unsigned*)(kn0 + kb_ * 1024), (unsigned*)(st_), 16, 0, 0);                  \
    __builtin_amdgcn_global_load_lds((const unsigned*)(kn0 + kb_ * 1024 + 32768), (unsigned*)(st_ + 4096), 16, 0, 0);   \
    __builtin_amdgcn_global_load_lds((const unsigned*)(kr0 + kb_ * 64), (unsigned*)(st_ + 8192), 16, 0, 0);             \
    __builtin_amdgcn_global_load_lds((const unsigned*)(v0 + kb_ * 2), (unsigned*)(st_ + 12288), 16, 0, 0);              \
    __builtin_amdgcn_global_load_lds((const unsigned*)(v0 + v32 + kb_ * 2), (unsigned*)(st_ + 12288 + 4096), 16, 0, 0); \
  }
  ATT_STAGE(0);
  if (nt > 1) ATT_STAGE(1);
  const int pk0 = (lg ^ (li >> 1)) * 16;
  const int pkr = (lg ^ (((li >> 3) & 1) << 1)) * 16;
  const int pv0 = ((lg >> 1) ^ (li >> 1)) * 16 + (lg & 1) * 8;
  for (int kt = 0; kt < nt; ++kt) {
    if (kt + 1 < nt) asm volatile("s_waitcnt vmcnt(5)" ::: "memory");
    else asm volatile("s_waitcnt vmcnt(0)" ::: "memory");
    __builtin_amdgcn_s_barrier();
    asm volatile("" ::: "memory");
    if (kt + 2 < nt) ATT_STAGE(kt + 2);
    const unsigned char* st = smem + (kt % 3) * 20480;
    const bool tail = (kt == nt - 1) && (nkeys & 63);
    const bool two = (ng == 2);
    const bool g0on = !(two && kt == nt - 1);
    f32x4 sT[2][4];
#pragma unroll
    for (int kb = 0; kb < 4; ++kb) {
      const unsigned char* kr_ = st + (kb * 16 + li) * 128;
      const bf16x8 k0 = *(const bf16x8*)(kr_ + pk0), k1 = *(const bf16x8*)(kr_ + (pk0 ^ 64)), k2 = *(const bf16x8*)(st + 8192 + (kb * 16 + li) * 64 + pkr);
      sT[0][kb] = (f32x4){zf, zf, zf, zf};
      sT[1][kb] = (f32x4){zf, zf, zf, zf};
      if (g0on) {
        sT[0][kb] = mfma16(k0, qf[0][0], sT[0][kb]);
        sT[0][kb] = mfma16(k1, qf[0][1], sT[0][kb]);
        sT[0][kb] = mfma16(k2, qf[0][2], sT[0][kb]);
      }
      if (two) {
        sT[1][kb] = mfma16(k0, qf[1][0], sT[1][kb]);
        sT[1][kb] = mfma16(k1, qf[1][1], sT[1][kb]);
        sT[1][kb] = mfma16(k2, qf[1][2], sT[1][kb]);
      }
    }
    bf16x8 pf[2][2];
#pragma unroll
    for (int g = 0; g < 2; ++g) {
      if (g == 0 ? g0on : two) {
        if (tail) {
#pragma unroll
          for (int kb = 0; kb < 4; ++kb)
#pragma unroll
            for (int r = 0; r < 4; ++r)
              if (kt * 64 + kb * 16 + 4 * lg + r >= nkeys) sT[g][kb][r] = -INFINITY;
        }
        float mx = sT[g][0][0];
#pragma unroll
        for (int kb = 0; kb < 4; ++kb)
#pragma unroll
          for (int r = 0; r < 4; ++r) mx = fmaxf(mx, sT[g][kb][r]);
        mx = fmaxf(mx, __shfl_xor(mx, 16));
        mx = fmaxf(mx, __shfl_xor(mx, 32));
        const float mnew = fmaxf(mrun[g], mx);
        const float alpha = __builtin_amdgcn_exp2f(mrun[g] - mnew);
        mrun[g] = mnew;
        float ps = 0.f;
#pragma unroll
        for (int kb = 0; kb < 4; ++kb)
#pragma unroll
          for (int r = 0; r < 4; ++r) { const float pv = __builtin_amdgcn_exp2f(sT[g][kb][r] - mnew); sT[g][kb][r] = pv; ps += pv; }
        lrun[g] = lrun[g] * alpha + ps;
#pragma unroll
        for (int vb = 0; vb < 4; ++vb) oT[g][vb] *= alpha;
      }
#pragma unroll
      for (int s2 = 0; s2 < 2; ++s2)
        pf[g][s2] = mk8(pack2(sT[g][2 * s2][0], sT[g][2 * s2][1]), pack2(sT[g][2 * s2][2], sT[g][2 * s2][3]),
                        pack2(sT[g][2 * s2 + 1][0], sT[g][2 * s2 + 1][1]), pack2(sT[g][2 * s2 + 1][2], sT[g][2 * s2 + 1][3]));
    }
#pragma unroll
    for (int s2 = 0; s2 < 2; ++s2) {
#pragma unroll
      for (int vb = 0; vb < 4; ++vb) {
        const unsigned char* vr_ = st + 12288 + (vb * 16 + li) * 128;
        const uint2 lo = *(const uint2*)(vr_ + (pv0 ^ (s2 * 64)));
        const uint2 hi = *(const uint2*)(vr_ + (pv0 ^ (s2 * 64) ^ 32));
        const bf16x8 vfr = mk8(lo, hi);
        if (g0on) oT[0][vb] = mfma16(vfr, pf[0][s2], oT[0][vb]);
        if (two) oT[1][vb] = mfma16(vfr, pf[1][s2], oT[1][vb]);
      }
    }
  }
#pragma unroll
  for (int g = 0; g < 2; ++g) {
    float lr = lrun[g];
    lr += __shfl_xor(lr, 16);
    lr += __shfl_xor(lr, 32);
    const float inv = 1.f / lr;
    const bool st_ok = g == 0 ? (ql < nq) : (ng == 2);
    if (st_ok) {
#pragma unroll
      for (int vb = 0; vb < 4; ++vb) {
        const f32x4 o = oT[g][vb] * inv;
        *(uint2*)(O + (size_t)(qrow0 + g * 64 + ql) * 512 + vb * 16 + 4 * lg) = make_uint2(pack2(o[0], o[1]), pack2(o[2], o[3]));
      }
    }
  }
  __syncthreads();
}

DEVI void hgrn_item(const int TIDX, const int BIDX, const int GDIM, KAP KA, unsigned char* WSB, float* OUTB, int l, int g0, int nchunks, int h, const float* __restrict__ S0, float* __restrict__ Sout, int rowbase,
                    unsigned char* smem) {
  constexpr int STG = 35840;
  const unsigned char* QT = WSB + O_QT;
  const unsigned char* KHT = WSB + O_KHT;
  const unsigned char* AM = WSB + O_AM;
  const unsigned char* EBp = WSB + O_EB;
  const unsigned char* VT2 = WSB + O_VT2;
  const unsigned char* G = WSB + O_G;
  bf16_t* HO = (bf16_t*)(WSB + O_HO);
  const float* hgn = PIN(I_HGN) + l * 512 + h * 128;
  float* sred = (float*)(smem + SMEM_GEMM);
  const int tid = TIDX, lane = tid & 63, w = tid >> 6, c = lane & 31, hh = lane >> 5;
  const int dvg = 32 * w + c;
  f32x16 S[4];
#pragma unroll
  for (int kt = 0; kt < 4; ++kt)
#pragma unroll
    for (int r = 0; r < 16; ++r) S[kt][r] = S0 ? S0[(size_t)(32 * kt + (r & 3) + 8 * (r >> 2) + 4 * hh) * 128 + dvg] : 0.f;
  float4 gn[4];
#pragma unroll
  for (int q = 0; q < 4; ++q) gn[q] = *(const float4*)(hgn + 32 * w + 8 * q + 4 * hh);
  const uint32_t lo16 = (uint32_t)lane * 16u;
  const uint32_t goff = (uint32_t)(w * 4 + (lane >> 4)) * 1024u + (uint32_t)h * 256u + (uint32_t)(lane & 15) * 16u;
#define HG_STAGE(ch_)                                                                                                                  \
  {                                                                                                                                    \
    unsigned char* st_ = smem + ((ch_) & 1) * STG + w * 1024;                                                                          \
    const size_t cid_ = (size_t)(g0 + (ch_)) * 4 + h;                                                                                  \
    const size_t grow_ = ((size_t)rowbase + (size_t)(ch_) * 32) * 1024;                                                                \
    __builtin_amdgcn_global_load_lds((const unsigned*)(QT + cid_ * 8192 + w * 1024 + lo16), (unsigned*)(st_), 16, 0, 0);              \
    __builtin_amdgcn_global_load_lds((const unsigned*)(QT + cid_ * 8192 + 4096 + w * 1024 + lo16), (unsigned*)(st_ + 4096), 16, 0, 0); \
    __builtin_amdgcn_global_load_lds((const unsigned*)(KHT + cid_ * 8192 + w * 1024 + lo16), (unsigned*)(st_ + 8192), 16, 0, 0);       \
    __builtin_amdgcn_global_load_lds((const unsigned*)(KHT + cid_ * 8192 + 4096 + w * 1024 + lo16), (unsigned*)(st_ + 12288), 16, 0, 0); \
    __builtin_amdgcn_global_load_lds((const unsigned*)(VT2 + cid_ * 8192 + w * 1024 + lo16), (unsigned*)(st_ + 16384), 16, 0, 0);      \
    __builtin_amdgcn_global_load_lds((const unsigned*)(VT2 + cid_ * 8192 + 4096 + w * 1024 + lo16), (unsigned*)(st_ + 20480), 16, 0, 0); \
    __builtin_amdgcn_global_load_lds((const unsigned*)(G + grow_ + goff), (unsigned*)(st_ + 24576), 16, 0, 0);                         \
    __builtin_amdgcn_global_load_lds((const unsigned*)(G + grow_ + 16384 + goff), (unsigned*)(st_ + 28672), 16, 0, 0);                 \
    if (w < 2) __builtin_amdgcn_global_load_lds((const unsigned*)(AM + cid_ * 2048 + w * 1024 + lo16), (unsigned*)(st_ + 32768), 16, 0, 0); \
    else if (w == 2) __builtin_amdgcn_global_load_lds((const unsigned*)(EBp + cid_ * 512 + lo16), (unsigned*)(smem + ((ch_) & 1) * STG + 34816), 16, 0, 0); \
  }
  HG_STAGE(0);
  for (int ch = 0; ch < nchunks; ++ch) {
    asm volatile("s_waitcnt vmcnt(0)" ::: "memory");
    __builtin_amdgcn_s_barrier();
    asm volatile("" ::: "memory");
    if (ch + 1 < nchunks) HG_STAGE(ch + 1);
    const unsigned char* st = smem + (ch & 1) * STG;
    bf16x8 vf[2], af[2];
#pragma unroll
    for (int s2 = 0; s2 < 2; ++s2) {
      vf[s2] = *(const bf16x8*)(st + 16384 + dvg * 64 + 32 * s2 + 16 * hh);
      af[s2] = *(const bf16x8*)(st + 32768 + c * 64 + 32 * s2 + 16 * hh);
    }
    f32x16 oT;
    const float zf = zero_f();
#pragma unroll
    for (int r = 0; r < 16; ++r) oT[r] = zf;
#pragma unroll
    for (int kt = 0; kt < 4; ++kt) {
#pragma unroll
      for (int s2 = 0; s2 < 2; ++s2) {
        const uint2 lo = *(const uint2*)(st + c * 256 + 64 * kt + 32 * s2 + 8 * hh);
        const uint2 hi = *(const uint2*)(st + c * 256 + 64 * kt + 32 * s2 + 16 + 8 * hh);
        const bf16x8 sa = mk8(pack2(S[kt][8 * s2 + 0], S[kt][8 * s2 + 1]), pack2(S[kt][8 * s2 + 2], S[kt][8 * s2 + 3]),
                              pack2(S[kt][8 * s2 + 4], S[kt][8 * s2 + 5]), pack2(S[kt][8 * s2 + 6], S[kt][8 * s2 + 7]));
        oT = mfma32(sa, mk8(lo, hi), oT);
      }
    }
#pragma unroll
    for (int s2 = 0; s2 < 2; ++s2) oT = mfma32(vf[s2], af[s2], oT);
#pragma unroll
    for (int kt = 0; kt < 4; ++kt) {
#pragma unroll
      for (int q = 0; q < 4; ++q) {
        const float4 e = *(const float4*)(st + 34816 + (32 * kt + 8 * q + 4 * hh) * 4);
        S[kt][4 * q + 0] *= e.x; S[kt][4 * q + 1] *= e.y; S[kt][4 * q + 2] *= e.z; S[kt][4 * q + 3] *= e.w;
      }
#pragma unroll
      for (int s2 = 0; s2 < 2; ++s2) {
        const bf16x8 kf = *(const bf16x8*)(st + 8192 + (32 * kt + c) * 64 + 32 * s2 + 16 * hh);
        S[kt] = mfma32(kf, vf[s2], S[kt]);
      }
    }
    float ss = 0.f;
#pragma unroll
    for (int r = 0; r < 16; ++r) ss += oT[r] * oT[r];
    ss += __shfl_xor(ss, 32);
    float* sr = sred + (ch & 1) * 128;
    if (lane < 32) sr[w * 32 + c] = ss;
    asm volatile("s_waitcnt lgkmcnt(0)" ::: "memory");
    __builtin_amdgcn_s_barrier();
    asm volatile("" ::: "memory");
    const float tot = sr[c] + sr[32 + c] + sr[64 + c] + sr[96 + c];
    const float rs = rsqrtf(tot * (1.f / 128.f) + EPS);
    const size_t row = (size_t)rowbase + ch * 32 + c;
#pragma unroll
    for (int q = 0; q < 4; ++q) {
      const int dv0 = 32 * w + 8 * q + 4 * hh;
      const uint2 gp = *(const uint2*)(st + 24576 + c * 256 + dv0 * 2);
      const float o0 = oT[4 * q + 0] * rs * gn[q].x * siluf_(lo2f(gp.x));
      const float o1 = oT[4 * q + 1] * rs * gn[q].y * siluf_(hi2f(gp.x));
      const float o2 = oT[4 * q + 2] * rs * gn[q].z * siluf_(lo2f(gp.y));
      const float o3 = oT[4 * q + 3] * rs * gn[q].w * siluf_(hi2f(gp.y));
      *(uint2*)(HO + row * 512 + h * 128 + dv0) = make_uint2(pack2(o0, o1), pack2(o2, o3));
    }
  }
#pragma unroll
  for (int kt = 0; kt < 4; ++kt)
#pragma unroll
    for (int r = 0; r < 16; ++r) Sout[(size_t)(32 * kt + (r & 3) + 8 * (r >> 2) + 4 * hh) * 128 + dvg] = S[kt][r];
  __syncthreads();
}

DEVI void phase_p4(const int TIDX, const int BIDX, const int GDIM, KAP KA, unsigned char* WSB, float* OUTB, int l, unsigned char* smem, int dup = 0) {
  const int q = BIDX & 7;
  int* qctr = (int*)(WSB + O_CNT) + 3072 + (l * 8 + q) * 32 + 16 * dup;
  int* sitem = (int*)(smem + SMEM_GEMM + 1024);
  const bf16_t* QB = (const bf16_t*)(WSB + O_QB);
  bf16_t* AO = (bf16_t*)(WSB + O_AO);
  const int total = 16 + 16 + 512 + 8;
  for (;;) {
    if (TIDX == 0) *sitem = atomicAdd(qctr, 1);
    __syncthreads();
    const int it = *sitem;
    __syncthreads();
    if (it >= total) break;
    if (it < 16) {
      const int i2 = q * 16 + it, b = i2 >> 2, h = i2 & 3;
      hgrn_item(TIDX, BIDX, GDIM, KA, WSB, OUTB, l, b * 64, 64, h, nullptr, OUTB + OUT_ST_P + ((size_t)(l * 32 + b) * 4 + h) * 16384, b * 2048, smem);
    } else if (it < 32) {
      const int b = it - 16, h = q;
      attn_item(TIDX, BIDX, GDIM, QB + h * 96, TP + b * 32, 32, 1, (const bf16_t*)(WSB + O_KNS) + (size_t)b * KPAD * 512 + h * 64,
                (const bf16_t*)(WSB + O_KRS) + ((size_t)l * 16 + b) * KPAD * 32,
                (const bf16_t*)(WSB + O_VTS) + (size_t)(b * 8 + h) * 64 * KPAD, KPAD, 4128, AO + h * 64, smem);
    } else if (it < 32 + 512) {
      const int jj = it - 32, b = jj >> 4, cp = 15 - (jj & 15), h = q;
      attn_item(TIDX, BIDX, GDIM, QB + h * 96, b * 2048 + cp * 128, 64, 2, (const bf16_t*)(WSB + O_KN) + (size_t)b * 2048 * 512 + h * 64,
                (const bf16_t*)(WSB + O_KRB) + (size_t)b * 2048 * 32,
                (const bf16_t*)(WSB + O_VT) + (size_t)(b * 8 + h) * 64 * 2048, 2048, 128 * (cp + 1), AO + h * 64, smem);
    } else {
      const int i2 = q * 8 + (it - 32 - 512), b = i2 >> 2, h = i2 & 3;
      hgrn_item(TIDX, BIDX, GDIM, KA, WSB, OUTB, l, 2048 + b, 1, h, PIN(I_ST) + ((size_t)(l * 16 + b) * 4 + h) * 16384,
                OUTB + OUT_ST_S + ((size_t)(l * 16 + b) * 4 + h) * 16384, TP + b * 32, smem);
    }
  }
}

DEVI void phase_p5(const int TIDX, const int BIDX, const int GDIM, KAP KA, unsigned char* WSB, float* OUTB, int l, unsigned char* smem) {
  const bf16_t* XB = (const bf16_t*)(WSB + O_XB);
  const bf16_t* AO = (const bf16_t*)(WSB + O_AO);
  const bf16_t* HO = (const bf16_t*)(WSB + O_HO);
  const bf16_t* W = (const bf16_t*)(WSB + O_WS) + (size_t)l * WO_END;
  bf16_t* MG = (bf16_t*)(WSB + O_MG);
  for (int item = (BIDX & 7) * (GDIM >> 3) + (BIDX >> 3); item < 516 * 8; item += GDIM) {
    const int mt = item >> 3, nt = item & 7, m0 = mt * 128, n0 = nt * 128;
    f32x4 acc[4][4];
    bf16_t* TMP = (bf16_t*)(WSB + O_G);
    RowLin rx{(const unsigned char*)(XB + (size_t)m0 * 1024), 2048};
    RowLin ra{(const unsigned char*)(AO + (size_t)m0 * 512), 1024};
    RowLin ro{(const unsigned char*)(HO + (size_t)m0 * 512), 1024};
    zero_acc(acc);
    gemm_main<true>(TIDX, BIDX, GDIM, acc, rx, W + WO_G + (size_t)n0 * 1024, 1024, 1024, smem);
    EPI_SWAP_BEGIN(m0, n0)
      const f32x4 a = acc[mi][ni];
      *(uint2*)(MG + (size_t)row * 1024 + col) = make_uint2(pack2(sigmoidf_(a[0]), sigmoidf_(a[1])), pack2(sigmoidf_(a[2]), sigmoidf_(a[3])));
    EPI_END
    zero_acc(acc);
    gemm_main<true>(TIDX, BIDX, GDIM, acc, rx, W + WO_G + (size_t)(1024 + n0) * 1024, 1024, 1024, smem);
    EPI_SWAP_BEGIN(m0, n0)
      const f32x4 a = acc[mi][ni];
      *(uint2*)(TMP + (size_t)row * 1024 + col) = make_uint2(pack2(sigmoidf_(a[0]), sigmoidf_(a[1])), pack2(sigmoidf_(a[2]), sigmoidf_(a[3])));
    EPI_END
    zero_acc(acc);
    gemm_main<true>(TIDX, BIDX, GDIM, acc, ra, W + WO_BRA + (size_t)n0 * 512, 512, 512, smem);
    EPI_SWAP_BEGIN(m0, n0)
      const f32x4 a = acc[mi][ni];
      const uint2 g = *(const uint2*)(MG + (size_t)row * 1024 + col);
      *(uint2*)(MG + (size_t)row * 1024 + col) = make_uint2(pack2(a[0] * lo2f(g.x), a[1] * hi2f(g.x)), pack2(a[2] * lo2f(g.y), a[3] * hi2f(g.y)));
    EPI_END
    zero_acc(acc);
    gemm_main<true>(TIDX, BIDX, GDIM, acc, ro, W + WO_BRB + (size_t)n0 * 512, 512, 512, smem);
    EPI_SWAP_BEGIN(m0, n0)
      const f32x4 a = acc[mi][ni];
      const uint2 g = *(const uint2*)(TMP + (size_t)row * 1024 + col), m = *(const uint2*)(MG + (size_t)row * 1024 + col);
      const float o0 = lo2f(m.x) + a[0] * lo2f(g.x), o1 = hi2f(m.x) + a[1] * hi2f(g.x), o2 = lo2f(m.y) + a[2] * lo2f(g.y), o3 = hi2f(m.y) + a[3] * hi2f(g.y);
      *(uint2*)(MG + (size_t)row * 1024 + col) = make_uint2(pack2(o0, o1), pack2(o2, o3));
    EPI_END
  }
}

DEVI void phase_p6(const int TIDX, const int BIDX, const int GDIM, KAP KA, unsigned char* WSB, float* OUTB, int l, unsigned char* smem) {
  const bf16_t* MG = (const bf16_t*)(WSB + O_MG);
  const bf16_t* W = (const bf16_t*)(WSB + O_WS) + (size_t)l * WO_END + WO_OUT;
  float* PRE = (float*)(WSB + O_PRE);
  for (int item = (BIDX & 7) * (GDIM >> 3) + (BIDX >> 3); item < 516 * 8; item += GDIM) {
    const int mt = item >> 3, nt = item & 7, m0 = mt * 128, n0 = nt * 128;
    f32x4 acc[4][4];
    zero_acc(acc);
    RowLin rp{(const unsigned char*)(MG + (size_t)m0 * 1024), 2048};
    gemm_main<true>(TIDX, BIDX, GDIM, acc, rp, W + (size_t)n0 * 1024, 1024, 1024, smem);
    EPI_SWAP_BEGIN(m0, n0)
      const f32x4 x = *(const f32x4*)(OUTB + (size_t)row * 1024 + col);
      *(f32x4*)(PRE + (size_t)row * 1024 + col) = x * DN_ALPHA + acc[mi][ni];
    EPI_END
  }
}

DEVI void phase_p7(const int TIDX, const int BIDX, const int GDIM, KAP KA, unsigned char* WSB, float* OUTB, int l, unsigned char* smem) {
  const int tid = TIDX, lane = tid & 63;
  {
    const float* PRE = (const float*)(WSB + O_PRE);
    bf16_t* XB = (bf16_t*)(WSB + O_XB);
    const float* WR = (const float*)(WSB + O_WR) + (size_t)l * 36 * 1024;
    int* cnt = (int*)(WSB + O_CNT) + 1024 + l * 1024;
    int* ltok = (int*)(WSB + O_LTOK);
    float* lw = (float*)(WSB + O_LW);
    const float* g1 = PIN(I_LN1G) + l * 1024; const float* b1 = PIN(I_LN1B) + l * 1024;
    const int wid = BIDX * 4 + (tid >> 6), nw = GDIM * 4;
    for (int r4 = wid; r4 < NTOK / 4; r4 += nw) {
      float4 v[4][4];
#pragma unroll
      for (int t = 0; t < 4; ++t) {
        const size_t row = (size_t)r4 * 4 + t;
#pragma unroll
        for (int j = 0; j < 4; ++j) v[t][j] = *(const float4*)(PRE + row * 1024 + j * 256 + lane * 4);
        ln_inplace(v[t], g1, b1, lane);
        store_row(v[t], OUTB + row * 1024, XB + row * 1024, lane);
      }
      float mine[4] = {0.f, 0.f, 0.f, 0.f};
#pragma unroll 4
      for (int c = 0; c < 36; ++c) {
        float4 wv[4];
#pragma unroll
        for (int j = 0; j < 4; ++j) wv[j] = *(const float4*)(WR + c * 1024 + j * 256 + lane * 4);
#pragma unroll
        for (int t = 0; t < 4; ++t) {
          float s = 0.f;
#pragma unroll
          for (int j = 0; j < 4; ++j) s += v[t][j].x * wv[j].x + v[t][j].y * wv[j].y + v[t][j].z * wv[j].z + v[t][j].w * wv[j].w;
          s = wave_sum(s);
          if (lane == c) mine[t] = s;
        }
      }
      int my_e = 0, my_tk = 0; float my_w = 0.f;
#pragma unroll
      for (int t = 0; t < 4; ++t) {
        const int tok = r4 * 4 + t;
        float gl[4];
#pragma unroll
        for (int j = 0; j < 4; ++j) gl[j] = __shfl(mine[t], j);
        int gi = 0; float gm = gl[0];
#pragma unroll
        for (int j = 1; j < 4; ++j) if (gl[j] > gm) { gm = gl[j]; gi = j; }
        float gs = 0.f;
#pragma unroll
        for (int j = 0; j < 4; ++j) gs += expf(gl[j] - gm);
        const float gtop = 1.f / gs;
        float el[8];
#pragma unroll
        for (int j = 0; j < 8; ++j) el[j] = __shfl(mine[t], 4 + gi * 8 + j);
        float em = el[0];
#pragma unroll
        for (int j = 1; j < 8; ++j) em = fmaxf(em, el[j]);
        float pe[8], es = 0.f;
#pragma unroll
        for (int j = 0; j < 8; ++j) { pe[j] = expf(el[j] - em); es += pe[j]; }
#pragma unroll
        for (int j = 0; j < 8; ++j) pe[j] = pe[j] / es;
        int i1 = 0; float p1 = pe[0];
#pragma unroll
        for (int j = 1; j < 8; ++j) if (pe[j] > p1) { p1 = pe[j]; i1 = j; }
        int i2 = -1; float p2 = -1.f;
#pragma unroll
        for (int j = 0; j < 8; ++j) if (j != i1 && pe[j] > p2) { p2 = pe[j]; i2 = j; }
        const float den = p1 + p2;
        if (lane == 2 * t) { my_e = gi * 8 + i1; my_w = gtop * (p1 / den); my_tk = tok * 2; }
        if (lane == 2 * t + 1) { my_e = gi * 8 + i2; my_w = gtop * (p2 / den); my_tk = tok * 2 + 1; }
      }
      if (lane < 8) {
        const int sl = atomicAdd(cnt + my_e * 32, 1);
        ltok[(size_t)my_e * NTOK + sl] = my_tk;
        lw[(size_t)my_e * NTOK + sl] = my_w;
      }
    }
  }
  {
    bf16_t* PLEB = (bf16_t*)(WSB + O_YM);
    const float* pp = PIN(I_PP) + (size_t)l * TP * 256;
    const float* ps = PIN(I_PS) + (size_t)l * TS * 256;
    const size_t tot_ = (size_t)NTOK * 64, str_ = (size_t)GDIM * 256;
    for (size_t i = (size_t)BIDX * 256 + tid; i < tot_; i += 4 * str_) {
      float4 v4[4];
#pragma unroll
      for (int k = 0; k < 4; ++k) {
        const size_t ii = i + k * str_ < tot_ ? i + k * str_ : i, e = ii * 4;
        v4[k] = e < (size_t)TP * 256 ? *(const float4*)(pp + e) : *(const float4*)(ps + (e - (size_t)TP * 256));
      }
#pragma unroll
      for (int k = 0; k < 4; ++k)
        if (i + k * str_ < tot_) *(uint2*)(PLEB + (i + k * str_) * 4) = make_uint2(pack2(v4[k].x, v4[k].y), pack2(v4[k].z, v4[k].w));
    }
  }
  {
    float* tile = (float*)smem;
    bf16_t* WE = (bf16_t*)(WSB + O_WE);
    CMap cm{0};
    for (int t = BIDX; t < 96 * 128; t += GDIM) {
      const int mat = t >> 7, tt = t & 127, kind = mat >> 5, e = mat & 31;
      const float* src = PIN(kind == 0 ? I_WE1 : (kind == 1 ? I_WE3 : I_WE2)) + ((size_t)l * 32 + e) * 524288;
      bf16_t* dst = WE + ((size_t)kind * 32 + e) * 524288;
      if (kind < 2) transpose_tile(TIDX, BIDX, GDIM, src, 512, 1024, dst, (tt & 15) * 64, (tt >> 4) * 64, cm, nullptr, tile);
      else transpose_tile(TIDX, BIDX, GDIM, src, 1024, 512, dst, (tt & 7) * 64, (tt >> 3) * 64, cm, nullptr, tile);
    }
  }
}

DEVI int moe_table(const int TIDX, const int BIDX, const int GDIM, KAP KA, unsigned char* WSB, float* OUTB, int l, int* tstart  ) {
  if (TIDX == 0) {
    const int* cnt = (const int*)(WSB + O_CNT) + 1024 + l * 1024;
    int acc = 0;
    for (int e = 0; e < 32; ++e) { tstart[e] = acc; acc += (cnt[e * 32] + 127) >> 7; }
    tstart[32] = acc;
  }
  __syncthreads();
  return tstart[32];
}
DEVI int moe_find(const int* tstart, int mt) {
  int e = 0;
  for (int i = 1; i < 32; ++i) if (mt >= tstart[i]) e = i;
  return e;
}
struct RowGather {
  const unsigned char* base; const int* ltok; int pos0; int cnt;
  DEVI uint32_t operator()(int r) const {
    const int pos = pos0 + r;
    return pos < cnt ? (uint32_t)(ltok[pos] >> 1) * 2048u : (uint32_t)NTOK * 2048u;
  }
};

DEVI void phase_p8(const int TIDX, const int BIDX, const int GDIM, KAP KA, unsigned char* WSB, float* OUTB, int l, unsigned char* smem) {
  int* tstart = (int*)(smem + SMEM_GEMM + 1024 + 64);
  const int NT = moe_table(TIDX, BIDX, GDIM, KA, WSB, OUTB, l, tstart);
  const bf16_t* XB = (const bf16_t*)(WSB + O_XB);
  const bf16_t* WE = (const bf16_t*)(WSB + O_WE);
  bf16_t* H = (bf16_t*)(WSB + O_H);
  const int* cnt = (const int*)(WSB + O_CNT) + 1024 + l * 1024;
  const int* ltok = (const int*)(WSB + O_LTOK);
  for (int item = (BIDX & 7) * (GDIM >> 3) + (BIDX >> 3); item < NT * 4; item += GDIM) {
    const int mt = item >> 2, nt = item & 3, e = moe_find(tstart, mt), lt = mt - tstart[e];
    RowGather rg{(const unsigned char*)XB, ltok + (size_t)e * NTOK, lt * 128, cnt[e * 32]};
    f32x4 acc[4][4];
    uint2 sg[4][4];
    zero_acc(acc);
    gemm_main<true>(TIDX, BIDX, GDIM, acc, rg, WE + ((size_t)e * 512 + nt * 128) * 1024, 1024, 1024, smem);
#pragma unroll
    for (int i = 0; i < 4; ++i)
#pragma unroll
      for (int j = 0; j < 4; ++j) sg[i][j] = make_uint2(pack2(siluf_(acc[i][j][0]), siluf_(acc[i][j][1])), pack2(siluf_(acc[i][j][2]), siluf_(acc[i][j][3])));
    zero_acc(acc);
    gemm_main<true>(TIDX, BIDX, GDIM, acc, rg, WE + ((size_t)(32 + e) * 512 + nt * 128) * 1024, 1024, 1024, smem);
    EPI_SWAP_BEGIN(mt * 128, nt * 128)
      const f32x4 a = acc[mi][ni];
      const uint2 g = sg[mi][ni];
      *(uint2*)(H + (size_t)row * 512 + col) = make_uint2(pack2(a[0] * lo2f(g.x), a[1] * hi2f(g.x)), pack2(a[2] * lo2f(g.y), a[3] * hi2f(g.y)));
    EPI_END
  }
  {
    const bf16_t* W = (const bf16_t*)(WSB + O_WS) + (size_t)l * WO_END;
    float* PRE = (float*)(WSB + O_PRE);
    for (int item = (BIDX & 7) * (GDIM >> 3) + (BIDX >> 3); item < 516 * 8; item += GDIM) {
      const int mt = item >> 3, nt = item & 7, m0 = mt * 128, n0 = nt * 128;
      f32x4 acc[4][4];
      uint2 gp[4][4];
      zero_acc(acc);
      RowLin rx{(const unsigned char*)(XB + (size_t)m0 * 1024), 2048};
      gemm_main<true>(TIDX, BIDX, GDIM, acc, rx, W + WO_PG + (size_t)n0 * 1024, 1024, 1024, smem);
#pragma unroll
      for (int i = 0; i < 4; ++i)
#pragma unroll
        for (int j = 0; j < 4; ++j) gp[i][j] = make_uint2(pack2(sigmoidf_(acc[i][j][0]), sigmoidf_(acc[i][j][1])), pack2(sigmoidf_(acc[i][j][2]), sigmoidf_(acc[i][j][3])));
      zero_acc(acc);
      RowLin rpl{(const unsigned char*)((const bf16_t*)(WSB + O_YM) + (size_t)m0 * 256), 512};
      gemm_main<true>(TIDX, BIDX, GDIM, acc, rpl, W + WO_PLE + (size_t)n0 * 256, 256, 256, smem);
      EPI_SWAP_BEGIN(m0, n0)
        const f32x4 x = *(const f32x4*)(OUTB + (size_t)row * 1024 + col);
        const f32x4 a = acc[mi][ni];
        const uint2 g = gp[mi][ni];
        f32x4 o;
        o[0] = x[0] * DN_ALPHA + a[0] * lo2f(g.x); o[1] = x[1] * DN_ALPHA + a[1] * hi2f(g.x);
        o[2] = x[2] * DN_ALPHA + a[2] * lo2f(g.y); o[3] = x[3] * DN_ALPHA + a[3] * hi2f(g.y);
        *(f32x4*)(PRE + (size_t)row * 1024 + col) = o;
      EPI_END
    }
  }
}

DEVI void phase_p9(const int TIDX, const int BIDX, const int GDIM, KAP KA, unsigned char* WSB, float* OUTB, int l, unsigned char* smem) {
  int* tstart = (int*)(smem + SMEM_GEMM + 1024 + 64);
  const int NT = moe_table(TIDX, BIDX, GDIM, KA, WSB, OUTB, l, tstart);
  const bf16_t* WE = (const bf16_t*)(WSB + O_WE) + 64ull * 524288;
  const bf16_t* H = (const bf16_t*)(WSB + O_H);
  bf16_t* YM = (bf16_t*)(WSB + O_YM);
  const int* cnt = (const int*)(WSB + O_CNT) + 1024 + l * 1024;
  const int* ltok = (const int*)(WSB + O_LTOK);
  const float* lw = (const float*)(WSB + O_LW);
  for (int item = (BIDX & 7) * (GDIM >> 3) + (BIDX >> 3); item < NT * 8; item += GDIM) {
    const int mt = item >> 3, nt = item & 7, e = moe_find(tstart, mt), lt = mt - tstart[e], ce = cnt[e * 32];
    f32x4 acc[4][4];
    zero_acc(acc);
    RowLin rp{(const unsigned char*)(H + (size_t)mt * 128 * 512), 1024};
    gemm_main<true>(TIDX, BIDX, GDIM, acc, rp, WE + ((size_t)e * 1024 + nt * 128) * 512, 512, 512, smem);
    EPI_SWAP_BEGIN(0, nt * 128)
      const int pos = lt * 128 + row;
      if (pos < ce) {
        const int tk = ltok[(size_t)e * NTOK + pos];
        const float wt = lw[(size_t)e * NTOK + pos];
        const f32x4 a = acc[mi][ni] * wt;
        *(uint2*)(YM + (size_t)tk * 1024 + col) = make_uint2(pack2(a[0], a[1]), pack2(a[2], a[3]));
      }
    EPI_END
  }
}

DEVI void phase_p10(const int TIDX, const int BIDX, const int GDIM, KAP KA, unsigned char* WSB, float* OUTB, int l) {
  const int tid = TIDX, lane = tid & 63;
  const float* PRE = (const float*)(WSB + O_PRE);
  const bf16_t* YM = (const bf16_t*)(WSB + O_YM);
  bf16_t* XB = (bf16_t*)(WSB + O_XB);
  const float* g2 = PIN(I_LN2G) + l * 1024; const float* b2 = PIN(I_LN2B) + l * 1024;
  const int wid = BIDX * 4 + (tid >> 6), nw = GDIM * 4;
  for (int row = wid; row < NTOK; row += 2 * nw) {
    const bool hb = row + nw < NTOK;
    const int rws[2] = {row, hb ? row + nw : row};
    float4 v[2][4];
    uint2 y0[2][4], y1[2][4];
#pragma unroll
    for (int k = 0; k < 2; ++k)
#pragma unroll
      for (int j = 0; j < 4; ++j) {
        v[k][j] = *(const float4*)(PRE + (size_t)rws[k] * 1024 + j * 256 + lane * 4);
        y0[k][j] = *(const uint2*)(YM + (size_t)rws[k] * 2048 + j * 256 + lane * 4);
        y1[k][j] = *(const uint2*)(YM + (size_t)rws[k] * 2048 + 1024 + j * 256 + lane * 4);
      }
#pragma unroll
    for (int k = 0; k < 2; ++k) {
      if (k == 0 || hb) {
#pragma unroll
        for (int j = 0; j < 4; ++j) {
          v[k][j].x += lo2f(y0[k][j].x) + lo2f(y1[k][j].x); v[k][j].y += hi2f(y0[k][j].x) + hi2f(y1[k][j].x);
          v[k][j].z += lo2f(y0[k][j].y) + lo2f(y1[k][j].y); v[k][j].w += hi2f(y0[k][j].y) + hi2f(y1[k][j].y);
        }
        ln_inplace(v[k], g2, b2, lane);
        const size_t r = (size_t)rws[k];
        if (l == 0) store_row(v[k], OUTB + r * 1024, XB + r * 1024, lane);
        else {
#pragma unroll
          for (int j = 0; j < 4; ++j) *(float4*)(OUTB + r * 1024 + j * 256 + lane * 4) = v[k][j];
        }
      }
    }
  }
}

DEVI void* launder_ptr(const void* q) {
  uint32_t lo = (uint32_t)(uintptr_t)q, hi = (uint32_t)((uintptr_t)q >> 32);
  asm volatile("" : "+v"(lo), "+v"(hi));
  lo = __builtin_amdgcn_readfirstlane(lo);
  hi = __builtin_amdgcn_readfirstlane(hi);
  return (void*)(((uintptr_t)hi << 32) | lo);
}
DEVI void grid_barrier(const int TIDX, const int BIDX, const int GDIM, unsigned* bar, unsigned k) {
  __syncthreads();
  if (TIDX == 0) {
    __threadfence();
    const unsigned g = (unsigned)BIDX & 7u, gs = (unsigned)GDIM >> 3;
    const unsigned old = __hip_atomic_fetch_add(bar + 32 * (1 + g), 1u, __ATOMIC_RELAXED, __HIP_MEMORY_SCOPE_AGENT);
    if (old + 1u == gs * k) {
      __threadfence();
      __hip_atomic_fetch_add(bar, 1u, __ATOMIC_RELAXED, __HIP_MEMORY_SCOPE_AGENT);
    }
    unsigned spins = 0;
    while (__hip_atomic_load(bar, __ATOMIC_RELAXED, __HIP_MEMORY_SCOPE_AGENT) < 8u * k) {
      __builtin_amdgcn_s_sleep(1);
      if (++spins > (1u << 27)) break;
    }
    __threadfence();
  }
  __syncthreads();
}
__global__ void __launch_bounds__(256, 2) mega(Params p, int ph0, int ph1) {
  __shared__ __attribute__((aligned(16))) unsigned char smem[SMEM_TOTAL];
  const int wave_in_block = __builtin_amdgcn_readfirstlane((int)(__builtin_amdgcn_workitem_id_x() >> 6));
  for (int ph = ph0; ph < ph1; ++ph) {
    int wv_ = wave_in_block;
    asm volatile("" : "+s"(wv_));
    int TIDX = wv_ * 64 + (int)__lane_id();
    asm volatile("" : "+v"(TIDX));
    int BIDX = __builtin_amdgcn_workgroup_id_x(), GDIM = (int)gridDim.x;
    asm volatile("" : "+s"(BIDX), "+s"(GDIM));
    KAP KA;
    {
      uintptr_t q = (uintptr_t)__builtin_amdgcn_kernarg_segment_ptr();
      uint32_t lo = (uint32_t)q, hi = (uint32_t)(q >> 32);
      asm volatile("" : "+s"(lo), "+s"(hi));
      KA = (KAP)(((uintptr_t)hi << 32) | lo);
    }
    float* OUTB = (float*)PIN(31);
    unsigned char* WSB = (unsigned char*)PIN(32);
#ifndef PHSEL
#define PHSEL -1
#endif
    if (ph == 0) { if (PHSEL < 0 || PHSEL == 10) phase_prep(TIDX, BIDX, GDIM, KA, WSB, OUTB, smem); }
    else {
      const int l = (ph - 1) / 10, s = (ph - 1) % 10;
      switch (s) {
        case 0: if (PHSEL < 0 || PHSEL == 0) phase_p1(TIDX, BIDX, GDIM, KA, WSB, OUTB, l, smem); break;
        case 1: if (PHSEL < 0 || PHSEL == 1) phase_p2(TIDX, BIDX, GDIM, KA, WSB, OUTB, l, smem); break;
        case 2: if (PHSEL < 0 || PHSEL == 2) phase_p3(TIDX, BIDX, GDIM, KA, WSB, OUTB, l, smem); break;
        case 3: if (PHSEL < 0 || PHSEL == 3) phase_p4(TIDX, BIDX, GDIM, KA, WSB, OUTB, l, smem); break;
        case 4: if (PHSEL < 0 || PHSEL == 4) phase_p5(TIDX, BIDX, GDIM, KA, WSB, OUTB, l, smem); break;
        case 5: if (PHSEL < 0 || PHSEL == 5) phase_p6(TIDX, BIDX, GDIM, KA, WSB, OUTB, l, smem); break;
        case 6: if (PHSEL < 0 || PHSEL == 6) phase_p7(TIDX, BIDX, GDIM, KA, WSB, OUTB, l, smem); break;
        case 7: if (PHSEL < 0 || PHSEL == 7) phase_p8(TIDX, BIDX, GDIM, KA, WSB, OUTB, l, smem); break;
        case 8: if (PHSEL < 0 || PHSEL == 8) phase_p9(TIDX, BIDX, GDIM, KA, WSB, OUTB, l, smem); break;
        default: if (PHSEL < 0 || PHSEL == 9) phase_p10(TIDX, BIDX, GDIM, KA, WSB, OUTB, l); break;
      }
    }
#ifdef PROBE_DUP
    if (ph > 0 && (ph - 1) % 10 == PROBE_DUP) {
      cg::this_grid().sync();
      const int l = (ph - 1) / 10;
      switch (PROBE_DUP) {
        case 0: phase_p1(TIDX, BIDX, GDIM, KA, WSB, OUTB, l, smem); break;
        case 1: phase_p2(TIDX, BIDX, GDIM, KA, WSB, OUTB, l, smem); break;
        case 2: phase_p3(TIDX, BIDX, GDIM, KA, WSB, OUTB, l, smem); break;
        case 3: phase_p4(TIDX, BIDX, GDIM, KA, WSB, OUTB, l, smem, 1); break;
        case 4: phase_p5(TIDX, BIDX, GDIM, KA, WSB, OUTB, l, smem); break;
        case 5: phase_p6(TIDX, BIDX, GDIM, KA, WSB, OUTB, l, smem); break;
        case 7: phase_p8(TIDX, BIDX, GDIM, KA, WSB, OUTB, l, smem); break;
        case 8: phase_p9(TIDX, BIDX, GDIM, KA, WSB, OUTB, l, smem); break;
        case 9: phase_p10(TIDX, BIDX, GDIM, KA, WSB, OUTB, l); break;
        default: break;
      }
    }
#endif
    if (ph + 1 < ph1) {
      if (ph == ph0) cg::this_grid().sync();
      else grid_barrier(TIDX, BIDX, GDIM, (unsigned*)(WSB + O_CNT + 2048), (unsigned)(ph - ph0));
    }
  }
}

#ifndef MK_MULTI
#define MK_MULTI 0
#endif

extern "C" void kernel_launch(void* const* d_in, const int* in_sizes, int n_in, void* d_out, int out_size, void* d_ws, size_t ws_size,
                              hipStream_t stream) {
  static int grid_blocks = 0;
  if (!grid_blocks) {
    int dev = 0, cus = 0, per_cu = 0;
    hipGetDevice(&dev);
    hipDeviceGetAttribute(&cus, hipDeviceAttributeMultiprocessorCount, dev);
    hipOccupancyMaxActiveBlocksPerMultiprocessor(&per_cu, mega, 256, 0);
    if (per_cu > 2) per_cu = 2;
    if (per_cu < 1) per_cu = 1;
    grid_blocks = cus * per_cu;
  }
  Params p{};
  for (int i = 0; i < 31; ++i) p.in[i] = (const float*)d_in[i];
  p.out_ = (float*)d_out;
  p.ws_ = (unsigned char*)d_ws;
  if (ws_size < WS_END) fprintf(stderr, "workspace too small: %zu < %zu\n", ws_size, (size_t)WS_END);
#if MK_MULTI
  for (int ph = 0; ph < 21; ++ph) mega<<<dim3(grid_blocks), dim3(256), 0, stream>>>(p, ph, ph + 1);
#else
  (void)hipMemsetAsync((unsigned char*)d_ws + O_CNT + 2048, 0, 2048, stream);
  int ph0 = 0, ph1 = 21;
  void* args[] = {&p, &ph0, &ph1};
  hipError_t e = hipLaunchCooperativeKernel((void*)mega, dim3(grid_blocks), dim3(256), args, 0, stream);
  if (e != hipSuccess) fprintf(stderr, "cooperative launch failed: %s (grid %d)\n", hipGetErrorString(e), grid_blocks);
#endif
}
```

```cpp
#include <hip/hip_runtime.h>
#include <hip/hip_cooperative_groups.h>
#include <stdint.h>
#include <stdio.h>
namespace cg = cooperative_groups;

#define DEVI __device__ __forceinline__
typedef unsigned short bf16_t;
typedef short bf16x8 __attribute__((ext_vector_type(8)));
typedef float f32x4 __attribute__((ext_vector_type(4)));
typedef float f32x16 __attribute__((ext_vector_type(16)));

constexpr int NTOK = 66048, TP = 65536, TS = 512;
constexpr int NCH = NTOK / 32;
constexpr int KPAD = 4160;
constexpr float DN_ALPHA = 1.4142135623730951f;
constexpr float EPS = 1e-6f;
constexpr float QSCALE = 0.10206207261596575f * 1.4426950408889634f;

constexpr size_t OUT_Y = 0;
constexpr size_t OUT_CKV_P = 67633152ull;
constexpr size_t OUT_KR_P = 101187584ull;
constexpr size_t OUT_ST_P = 105381888ull;
constexpr size_t OUT_CKV_S = 109576192ull;
constexpr size_t OUT_KR_S = 109838336ull;
constexpr size_t OUT_ST_S = 109871104ull;

constexpr size_t WO_IN = 0, WO_G = WO_IN + 2816ull * 1024, WO_UQ = WO_G + 2048ull * 1024, WO_KV = WO_UQ + 768ull * 384,
                 WO_BRA = WO_KV + 1024ull * 256, WO_BRB = WO_BRA + 1024ull * 512, WO_OUT = WO_BRB + 1024ull * 512,
                 WO_PG = WO_OUT + 1024ull * 1024, WO_PLE = WO_PG + 1024ull * 1024, WO_END = WO_PLE + 1024ull * 256;
static_assert(WO_END == 8945664ull, "small weights");

constexpr size_t al(size_t x) { return (x + 255) & ~size_t(255); }
constexpr size_t SZ_XB = (size_t)(NTOK + 1) * 1024 * 2, SZ_LIST = 32ull * NTOK * 4, SZ_KRS = 2ull * 16 * KPAD * 32 * 2,
                 SZ_G = (size_t)NTOK * 512 * 2, SZ_CQ = (size_t)NTOK * 384 * 2, SZ_CKR = (size_t)NTOK * 288 * 4,
                 SZ_FQ = (size_t)NTOK * 1024 * 2, SZ_CKVN = (size_t)NTOK * 256 * 2, SZ_KRB = (size_t)NTOK * 32 * 2,
                 SZ_QB = (size_t)NTOK * 768 * 2, SZ_AM = (size_t)NCH * 4 * 32 * 32 * 2, SZ_EB = (size_t)NCH * 4 * 128 * 4,
                 SZ_VT = 32ull * 8 * 64 * 2048 * 2, SZ_KNS = 16ull * KPAD * 512 * 2, SZ_VTS = 16ull * 8 * 64 * KPAD * 2,
                 SZ_PRE = (size_t)NTOK * 1024 * 4, SZ_WE = 3ull * 32 * 512 * 1024 * 2, SZ_H = 1064ull * 128 * 512 * 2,
                 SZ_YM = (size_t)NTOK * 2 * 1024 * 2;
constexpr size_t O_WS = 0;
constexpr size_t O_WR = O_WS + al(2 * WO_END * 2);
constexpr size_t O_ROPE = O_WR + al(2ull * 36 * 1024 * 4);
constexpr size_t O_CNT = O_ROPE + al(2080ull * 16 * 2 * 4);
constexpr size_t O_XB = O_CNT + 16384;
constexpr size_t O_LTOK = O_XB + al(SZ_XB);
constexpr size_t O_LW = O_LTOK + al(SZ_LIST);
constexpr size_t O_KRS = O_LW + al(SZ_LIST);
constexpr size_t O_G = O_KRS + al(SZ_KRS);
constexpr size_t O_VT2 = O_G + al(SZ_G);
constexpr size_t O_CQ = O_VT2 + al(SZ_G);
constexpr size_t O_CKR = O_CQ + al(SZ_CQ);
constexpr size_t O_FQ = O_CKR + al(SZ_CKR);
constexpr size_t O_CKVN = O_FQ + al(SZ_FQ);
constexpr size_t O_KRB = O_CKVN + al(SZ_CKVN);
constexpr size_t O_QB = O_KRB + al(SZ_KRB);
constexpr size_t O_QT = O_QB + al(SZ_QB);
constexpr size_t O_KHT = O_QT + al(SZ_G);
constexpr size_t O_AM = O_KHT + al(SZ_G);
constexpr size_t O_EB = O_AM + al(SZ_AM);
constexpr size_t O_KN = O_EB + al(SZ_EB);
constexpr size_t O_HO = O_KN + al(SZ_G);
constexpr size_t O_CCB = O_HO + al(SZ_G);
constexpr size_t WS_END = O_CCB + 16ull * 4096 * 256 * 2;
constexpr size_t O_VT = O_CQ;
constexpr size_t O_KNS = O_VT + al(SZ_VT);
constexpr size_t O_VTS = O_KNS + al(SZ_KNS);
constexpr size_t O_AO = O_VTS + al(SZ_VTS);
constexpr size_t O_MG = O_QB;
constexpr size_t O_PRE = O_G;
constexpr size_t O_WE = O_VTS;
constexpr size_t O_H = O_WE + al(SZ_WE);
constexpr size_t O_YM = O_H + al(SZ_H);
static_assert(O_AO + SZ_G <= O_KRB, "AO");
static_assert(O_AO >= O_VTS + SZ_VTS, "AO2");
static_assert(O_MG + SZ_XB <= O_KN, "MG");
static_assert(O_PRE + SZ_PRE <= O_WE, "PRE");
static_assert(O_YM + SZ_YM <= WS_END, "YM");
static_assert(WS_END <= (1ull << 30), "workspace");

struct Params { const float* in[31]; float* out_; unsigned char* ws_; };
typedef const __attribute__((address_space(4))) unsigned char* KAP;
#define PIN(i) (*(const float* const __attribute__((address_space(4)))*)(KA + 8 * (i)))

enum { I_XP = 0, I_XS, I_PP, I_PS, I_CCKV, I_CKR, I_ST, I_LN0G, I_LN0B, I_WIN, I_QN, I_WUQ, I_KVN, I_WUK, I_WUV, I_HGLB, I_HGN,
       I_WBRA, I_WBRB, I_WOUT, I_LN1G, I_LN1B, I_WRG, I_WRE, I_WE1, I_WE3, I_WE2, I_WPLE, I_WPG, I_LN2G, I_LN2B };

DEVI float bf2f(bf16_t h) { return __uint_as_float(((uint32_t)h) << 16); }
DEVI bf16_t f2bf(float f) { uint32_t u = __float_as_uint(f); u += 0x7fffu + ((u >> 16) & 1u); return (bf16_t)(u >> 16); }
typedef float f32x2_t __attribute__((ext_vector_type(2)));
typedef __bf16 bf16x2_t __attribute__((ext_vector_type(2)));
DEVI uint32_t pack2(float lo, float hi) { f32x2_t v = {lo, hi}; bf16x2_t b = __builtin_convertvector(v, bf16x2_t); return __builtin_bit_cast(uint32_t, b); }
DEVI float lo2f(uint32_t u) { return __uint_as_float(u << 16); }
DEVI float hi2f(uint32_t u) { return __uint_as_float(u & 0xffff0000u); }
DEVI float dpp_add_(float v, const int ctrl_sel) {
  const int iv = __float_as_int(v);
  int o;
  if (ctrl_sel == 0) o = __builtin_amdgcn_update_dpp(0, iv, 0xB1, 0xf, 0xf, true);
  else if (ctrl_sel == 1) o = __builtin_amdgcn_update_dpp(0, iv, 0x4E, 0xf, 0xf, true);
  else if (ctrl_sel == 2) o = __builtin_amdgcn_update_dpp(0, iv, 0x141, 0xf, 0xf, true);
  else o = __builtin_amdgcn_update_dpp(0, iv, 0x140, 0xf, 0xf, true);
  return v + __int_as_float(o);
}
DEVI float wave_sum(float v) {
  v = dpp_add_(v, 0);
  v = dpp_add_(v, 1);
  v = dpp_add_(v, 2);
  v = dpp_add_(v, 3);
  const int iv = __float_as_int(v);
  const float r0 = __int_as_float(__builtin_amdgcn_readlane(iv, 0)), r1 = __int_as_float(__builtin_amdgcn_readlane(iv, 16));
  const float r2 = __int_as_float(__builtin_amdgcn_readlane(iv, 32)), r3 = __int_as_float(__builtin_amdgcn_readlane(iv, 48));
  return (r0 + r1) + (r2 + r3);
}
DEVI float sigmoidf_(float x) { return 1.f / (1.f + __expf(-x)); }
DEVI float siluf_(float x) { return x / (1.f + __expf(-x)); }
DEVI f32x4 mfma16(bf16x8 a, bf16x8 b, f32x4 c) { return __builtin_amdgcn_mfma_f32_16x16x32_bf16(a, b, c, 0, 0, 0); }
DEVI f32x16 mfma32(bf16x8 a, bf16x8 b, f32x16 c) { return __builtin_amdgcn_mfma_f32_32x32x16_bf16(a, b, c, 0, 0, 0); }
DEVI bf16x8 mk8(uint32_t a, uint32_t b, uint32_t c, uint32_t d) { uint4 u = make_uint4(a, b, c, d); return *(bf16x8*)&u; }
DEVI bf16x8 mk8(uint2 lo, uint2 hi) { uint4 u = make_uint4(lo.x, lo.y, hi.x, hi.y); return *(bf16x8*)&u; }

constexpr int SMEM_GEMM = 2 * 2 * 128 * 72 * 2;
constexpr int SMEM_TOTAL = SMEM_GEMM + 2048;

template <bool SWAP, class RP>
DEVI void gemm_main(const int TIDX, const int BIDX, const int GDIM, f32x4 (&acc)[4][4], RP rowoff, const bf16_t* __restrict__ Bt, int ldb, int K, unsigned char* smem) {
  const int tid = TIDX;
  const int lane = tid & 63, w = tid >> 6, wr = w >> 1, wc = w & 1, li = lane & 15, lg = lane >> 4;
  const unsigned char* abase = rowoff.base;
  const unsigned char* bbase = (const unsigned char*)Bt;
  const uint32_t schunk = (uint32_t)((lane & 7) ^ (((lane >> 4) + 4 * (w & 1)) & 7)) * 16u;
  uint32_t ao0, ao1, ao2, ao3;
  const int rsub = w * 8 + (lane >> 3);
  ao0 = rowoff(rsub) + schunk; ao1 = rowoff(rsub + 32) + schunk; ao2 = rowoff(rsub + 64) + schunk; ao3 = rowoff(rsub + 96) + schunk;
  const uint32_t bo = (uint32_t)(rsub * ldb) * 2u + schunk, bstep = (uint32_t)(32 * ldb) * 2u;
  unsigned char* sbase = smem + w * 1024;
#define GM_STAGE(kt_, buf_)                                                                                                       \
  {                                                                                                                              \
    unsigned char* da_ = sbase + (buf_) * 32768;                                                                                 \
    unsigned char* db_ = da_ + 16384;                                                                                            \
    const uint32_t ko_ = (uint32_t)(kt_) * 128u;                                                                                 \
    __builtin_amdgcn_global_load_lds((const unsigned*)(abase + ao0 + ko_), (unsigned*)(da_), 16, 0, 0);                         \
    __builtin_amdgcn_global_load_lds((const unsigned*)(abase + ao1 + ko_), (unsigned*)(da_ + 4096), 16, 0, 0);                  \
    __builtin_amdgcn_global_load_lds((const unsigned*)(abase + ao2 + ko_), (unsigned*)(da_ + 8192), 16, 0, 0);                  \
    __builtin_amdgcn_global_load_lds((const unsigned*)(abase + ao3 + ko_), (unsigned*)(da_ + 12288), 16, 0, 0);                 \
    __builtin_amdgcn_global_load_lds((const unsigned*)(bbase + bo + ko_), (unsigned*)(db_), 16, 0, 0);                          \
    __builtin_amdgcn_global_load_lds((const unsigned*)(bbase + bo + bstep + ko_), (unsigned*)(db_ + 4096), 16, 0, 0);           \
    __builtin_amdgcn_global_load_lds((const unsigned*)(bbase + bo + 2u * bstep + ko_), (unsigned*)(db_ + 8192), 16, 0, 0);      \
    __builtin_amdgcn_global_load_lds((const unsigned*)(bbase + bo + 3u * bstep + ko_), (unsigned*)(db_ + 12288), 16, 0, 0);     \
  }
  const int nk = K >> 6;
  const int px = lg ^ (li >> 1);
  GM_STAGE(0, 0);
  for (int kt = 0; kt < nk; ++kt) {
    const int buf = kt & 1;
    asm volatile("s_waitcnt vmcnt(0)" ::: "memory");
    __syncthreads();
    if (kt + 1 < nk) GM_STAGE(kt + 1, buf ^ 1);
    const unsigned char* A = smem + buf * 32768 + (wr * 64 + li) * 128;
    const unsigned char* B = smem + buf * 32768 + 16384 + (wc * 64 + li) * 128;
#pragma unroll
    for (int ks = 0; ks < 2; ++ks) {
      const int po = (px ^ (ks * 4)) * 16;
      bf16x8 af[4], bfr[4];
#pragma unroll
      for (int i = 0; i < 4; ++i) {
        af[i] = *(const bf16x8*)(A + i * 2048 + po);
        bfr[i] = *(const bf16x8*)(B + i * 2048 + po);
      }
#pragma unroll
      for (int mi = 0; mi < 4; ++mi)
#pragma unroll
        for (int ni = 0; ni < 4; ++ni)
          acc[mi][ni] = SWAP ? mfma16(bfr[ni], af[mi], acc[mi][ni]) : mfma16(af[mi], bfr[ni], acc[mi][ni]);
    }
  }
  __syncthreads();
}
DEVI float zero_f() { float z = 0.f; asm volatile("" : "+v"(z)); return z; }
DEVI void zero_acc(f32x4 (&acc)[4][4]) {
  const float z = zero_f();
#pragma unroll
  for (int i = 0; i < 4; ++i)
#pragma unroll
    for (int j = 0; j < 4; ++j) acc[i][j] = (f32x4){z, z, z, z};
}
#define EPI_SWAP_BEGIN(m0, n0)                                                                     \
  {                                                                                                \
    const int _lane = TIDX & 63, _w = TIDX >> 6;                                     \
    const int _rb = (m0) + (_w >> 1) * 64 + (_lane & 15), _cb = (n0) + (_w & 1) * 64 + 4 * (_lane >> 4); \
    _Pragma("unroll") for (int mi = 0; mi < 4; ++mi) {                                             \
      const int row = _rb + mi * 16;                                                               \
      _Pragma("unroll") for (int ni = 0; ni < 4; ++ni) {                                           \
        const int col = _cb + ni * 16;
#define EPI_END } __builtin_amdgcn_sched_barrier(0); } }

struct RowLin {
  const unsigned char* base; uint32_t stride;
  DEVI uint32_t operator()(int r) const { return (uint32_t)r * stride; }
};

struct CMap {
  int mode;
  DEVI int operator()(int n) const {
    if (mode == 0) return n;
    if (mode == 1) return n < 672 ? n : (n < 768 ? -1 : n - 96);
    if (mode == 2) return n + 2720;
    if (n < 512) return (n >> 6) * 96 + (n & 63);
    const int m = n - 512, h = m >> 5, w = m & 31;
    return h * 96 + (w < 16 ? 64 + w : 80 + (w - 16));
  }
};
DEVI void transpose_tile(const int TIDX, const int BIDX, const int GDIM, const float* __restrict__ src, int ld, int K, bf16_t* __restrict__ dst, int k0, int n0, CMap cm,
                         const float* kscale, float* tile) {
  const int t = TIDX;
  {
    const int n4 = (t & 15) * 4, kr = t >> 4;
    const int sc = cm(n0 + n4);
#pragma unroll
    for (int p = 0; p < 4; ++p) {
      const int k = kr + 16 * p;
      float4 v = make_float4(0.f, 0.f, 0.f, 0.f);
      if (sc >= 0) {
        v = *(const float4*)(src + (size_t)(k0 + k) * ld + sc);
        if (kscale) { const float sck = kscale[k0 + k]; v.x *= sck; v.y *= sck; v.z *= sck; v.w *= sck; }
      }
      float* d = tile + k * 65 + n4;
      d[0] = v.x; d[1] = v.y; d[2] = v.z; d[3] = v.w;
    }
  }
  __syncthreads();
  {
    const int kc = (t & 7) * 8, nr = t >> 3;
#pragma unroll
    for (int q = 0; q < 2; ++q) {
      const int n = nr + 32 * q;
      const float* sp = tile + kc * 65 + n;
      const uint4 o = make_uint4(pack2(sp[0], sp[65]), pack2(sp[130], sp[195]), pack2(sp[260], sp[325]), pack2(sp[390], sp[455]));
      *(uint4*)(dst + (size_t)(n0 + n) * K + k0 + kc) = o;
    }
  }
  __syncthreads();
}
DEVI void run_transpose(const int TIDX, const int BIDX, const int GDIM, const float* src, int ld, int K, int N, bf16_t* dst, int mode, const float* kscale, float* tile) {
  const int nkt = K >> 6, tiles = nkt * (N >> 6);
  CMap cm{mode};
  for (int t = BIDX; t < tiles; t += GDIM) transpose_tile(TIDX, BIDX, GDIM, src, ld, K, dst, (t % nkt) * 64, (t / nkt) * 64, cm, kscale, tile);
}

DEVI void ln_inplace(float4 (&v)[4], const float* __restrict__ g, const float* __restrict__ b, int lane) {
  float s = 0.f;
#pragma unroll
  for (int j = 0; j < 4; ++j) s += v[j].x + v[j].y + v[j].z + v[j].w;
  s = wave_sum(s);
  const float mu = s * (1.f / 1024.f);
  float q = 0.f;
#pragma unroll
  for (int j = 0; j < 4; ++j) {
    float a = v[j].x - mu, bq = v[j].y - mu, cq = v[j].z - mu, d = v[j].w - mu;
    q += a * a + bq * bq + cq * cq + d * d;
  }
  q = wave_sum(q);
  const float rs = rsqrtf(q * (1.f / 1024.f) + EPS);
#pragma unroll
  for (int j = 0; j < 4; ++j) {
    const float4 gg = *(const float4*)(g + j * 256 + lane * 4), bb = *(const float4*)(b + j * 256 + lane * 4);
    v[j].x = (v[j].x - mu) * rs * gg.x + bb.x;
    v[j].y = (v[j].y - mu) * rs * gg.y + bb.y;
    v[j].z = (v[j].z - mu) * rs * gg.z + bb.z;
    v[j].w = (v[j].w - mu) * rs * gg.w + bb.w;
  }
}
DEVI void store_row(const float4 (&v)[4], float* x32, bf16_t* x16, int lane) {
#pragma unroll
  for (int j = 0; j < 4; ++j) {
    *(uint2*)(x16 + j * 256 + lane * 4) = make_uint2(pack2(v[j].x, v[j].y), pack2(v[j].z, v[j].w));
  }
}
DEVI float4 resid_plus(const uint2 xb, const uint2 mb) {
  return make_float4(lo2f(xb.x) * DN_ALPHA + lo2f(mb.x), hi2f(xb.x) * DN_ALPHA + hi2f(mb.x), lo2f(xb.y) * DN_ALPHA + lo2f(mb.y), hi2f(xb.y) * DN_ALPHA + hi2f(mb.y));
}
DEVI int pos_index(int row) { return row < TP ? (row & 2047) : 2048 + ((row - TP) & 31); }

DEVI void phase_prep(const int TIDX, const int BIDX, const int GDIM, KAP KA, unsigned char* WSB, float* OUTB, unsigned char* smem) {
  float* tile = (float*)smem;
  bf16_t* WS = (bf16_t*)(WSB + O_WS);
  const int tid = TIDX, gtid = BIDX * 256 + tid, gsz = GDIM * 256;
  if (gtid < 512) ((int*)(WSB + O_CNT))[gtid] = 0;
  if (gtid < 64) ((int*)(WSB + O_CNT))[1024 + gtid * 32] = 0;
  if (gtid < 32) ((int*)(WSB + O_CNT))[3072 + (gtid >> 1) * 32 + (gtid & 1) * 16] = 0;
  if (gtid < 512) ((uint32_t*)(WSB + O_XB + (size_t)NTOK * 2048))[gtid] = 0u;
  for (int i = gtid; i < 2080 * 16; i += gsz) {
    const int pi = i >> 4, k = i & 15;
    const int pos = pi < 2048 ? pi : 4096 + (pi - 2048);
    const float inv = exp2f(-(float)k * (13.287712379549449f / 16.f));
    const float ang = (float)pos * inv;
    double rev = (double)ang * 0.15915494309189535;
    rev -= __builtin_rint(rev);
    const float fr = (float)rev;
    float2 cs = make_float2(__builtin_amdgcn_cosf(fr), __builtin_amdgcn_sinf(fr));
    ((float2*)(WSB + O_ROPE))[i] = cs;
  }
  for (int i = gtid; i < 2 * 36 * 1024; i += gsz) {
    const int l = i / (36 * 1024), r = i % (36 * 1024), c = r >> 10, k = r & 1023;
    float v = c < 4 ? PIN(I_WRG)[((size_t)l * 1024 + k) * 4 + c] : PIN(I_WRE)[((size_t)l * 1024 + k) * 32 + (c - 4)];
    ((float*)(WSB + O_WR))[i] = v;
  }
  for (int i = gtid; i < 2 * 16 * 4096 * 8; i += gsz) {
    const int e = i * 4, lb = e / (4096 * 32), r = e % (4096 * 32);
    const float4 v = *(const float4*)(PIN(I_CKR) + (size_t)e);
    *(uint2*)((bf16_t*)(WSB + O_KRS) + (size_t)lb * KPAD * 32 + r) = make_uint2(pack2(v.x, v.y), pack2(v.z, v.w));
  }
  {
    const int lane = tid & 63, wid = BIDX * 4 + (tid >> 6), nw = GDIM * 4;
    for (int row = wid; row < NTOK; row += 2 * nw) {
      const bool hb = row + nw < NTOK;
      const int rws[2] = {row, hb ? row + nw : row};
      float4 v[2][4];
#pragma unroll
      for (int k = 0; k < 2; ++k) {
        const float* src = rws[k] < TP ? PIN(I_XP) + (size_t)rws[k] * 1024 : PIN(I_XS) + (size_t)(rws[k] - TP) * 1024;
#pragma unroll
        for (int j = 0; j < 4; ++j) v[k][j] = *(const float4*)(src + j * 256 + lane * 4);
      }
#pragma unroll
      for (int k = 0; k < 2; ++k) {
        if (k == 0 || hb) {
          ln_inplace(v[k], PIN(I_LN0G), PIN(I_LN0B), lane);
          store_row(v[k], OUTB + (size_t)rws[k] * 1024, (bf16_t*)(WSB + O_XB) + (size_t)rws[k] * 1024, lane);
        }
      }
    }
  }
  for (int l = 0; l < 2; ++l) {
    bf16_t* W = WS + (size_t)l * WO_END;
    run_transpose(TIDX, BIDX, GDIM, PIN(I_WIN) + (size_t)l * 1024 * 4768, 4768, 1024, 2816, W + WO_IN, 1, nullptr, tile);
    run_transpose(TIDX, BIDX, GDIM, PIN(I_WIN) + (size_t)l * 1024 * 4768, 4768, 1024, 2048, W + WO_G, 2, nullptr, tile);
    run_transpose(TIDX, BIDX, GDIM, PIN(I_WUQ) + (size_t)l * 384 * 768, 768, 384, 768, W + WO_UQ, 3, PIN(I_QN) + l * 384, tile);
    run_transpose(TIDX, BIDX, GDIM, PIN(I_WUK) + (size_t)l * 256 * 512, 512, 256, 512, W + WO_KV, 0, nullptr, tile);
    run_transpose(TIDX, BIDX, GDIM, PIN(I_WUV) + (size_t)l * 256 * 512, 512, 256, 512, W + WO_KV + 512 * 256, 0, nullptr, tile);
    run_transpose(TIDX, BIDX, GDIM, PIN(I_WBRA) + (size_t)l * 512 * 1024, 1024, 512, 1024, W + WO_BRA, 0, nullptr, tile);
    run_transpose(TIDX, BIDX, GDIM, PIN(I_WBRB) + (size_t)l * 512 * 1024, 1024, 512, 1024, W + WO_BRB, 0, nullptr, tile);
    run_transpose(TIDX, BIDX, GDIM, PIN(I_WOUT) + (size_t)l * 1024 * 1024, 1024, 1024, 1024, W + WO_OUT, 0, nullptr, tile);
    run_transpose(TIDX, BIDX, GDIM, PIN(I_WPG) + (size_t)l * 1024 * 1024, 1024, 1024, 1024, W + WO_PG, 0, nullptr, tile);
    run_transpose(TIDX, BIDX, GDIM, PIN(I_WPLE) + (size_t)l * 256 * 1024, 1024, 256, 1024, W + WO_PLE, 0, nullptr, tile);
  }
}

DEVI void phase_p1(const int TIDX, const int BIDX, const int GDIM, KAP KA, unsigned char* WSB, float* OUTB, int l, unsigned char* smem) {
  const bf16_t* XB = (const bf16_t*)(WSB + O_XB);
  const bf16_t* W = (const bf16_t*)(WSB + O_WS) + (size_t)l * WO_END + WO_IN;
  bf16_t* CQ = (bf16_t*)(WSB + O_CQ);
  float* CKR = (float*)(WSB + O_CKR);
  bf16_t* FQ = (bf16_t*)(WSB + O_FQ);
  bf16_t* VT2 = (bf16_t*)(WSB + O_VT2);
  bf16_t* G = (bf16_t*)(WSB + O_G);
  for (int item = (BIDX & 7) * (GDIM >> 3) + (BIDX >> 3); item < 516 * 22; item += GDIM) {
    const int mt = item / 22, nt = item % 22, m0 = mt * 128;
    f32x4 acc[4][4];
    zero_acc(acc);
    RowLin rp{(const unsigned char*)(XB + (size_t)m0 * 1024), 2048};
    if (nt >= 14 && nt < 18) {
      gemm_main<false>(TIDX, BIDX, GDIM, acc, rp, W + (size_t)nt * 128 * 1024, 1024, 1024, smem);
      const int h = nt - 14, lane = TIDX & 63, w = TIDX >> 6;
      const int rb = m0 + (w >> 1) * 64 + 4 * (lane >> 4), cb = (w & 1) * 64 + (lane & 15);
#pragma unroll
      for (int mi = 0; mi < 4; ++mi) {
        const int row = rb + mi * 16, ch = row >> 5, s = row & 31;
#pragma unroll
        for (int ni = 0; ni < 4; ++ni) {
          const int dv = cb + ni * 16;
          const f32x4 a = acc[mi][ni];
          *(uint2*)(VT2 + ((size_t)(ch * 4 + h) * 128 + dv) * 32 + s) = make_uint2(pack2(a[0], a[1]), pack2(a[2], a[3]));
        }
      }
    } else {
      gemm_main<true>(TIDX, BIDX, GDIM, acc, rp, W + (size_t)nt * 128 * 1024, 1024, 1024, smem);
      EPI_SWAP_BEGIN(m0, 0)
        const f32x4 a = acc[mi][ni];
        if (nt < 3) {
          *(uint2*)(CQ + (size_t)row * 384 + nt * 128 + col) = make_uint2(pack2(a[0], a[1]), pack2(a[2], a[3]));
        } else if (nt < 5) {
          *(f32x4*)(CKR + (size_t)row * 288 + (nt - 3) * 128 + col) = a;
        } else if (nt == 5) {
          if (col < 32) *(f32x4*)(CKR + (size_t)row * 288 + 256 + col) = a;
        } else if (nt < 14) {
          *(uint2*)(FQ + (size_t)row * 1024 + (nt - 6) * 128 + col) = make_uint2(pack2(a[0], a[1]), pack2(a[2], a[3]));
        } else {
          *(uint2*)(G + (size_t)row * 512 + (nt - 18) * 128 + col) = make_uint2(pack2(a[0], a[1]), pack2(a[2], a[3]));
        }
      EPI_END
    }
  }
}

DEVI void phase_p2(const int TIDX, const int BIDX, const int GDIM, KAP KA, unsigned char* WSB, float* OUTB, int l, unsigned char* smem) {
  const int tid = TIDX, lane = tid & 63;
  const float2* ROPE = (const float2*)(WSB + O_ROPE);
  {
    const bf16_t* CQ = (const bf16_t*)(WSB + O_CQ);
    const bf16_t* W = (const bf16_t*)(WSB + O_WS) + (size_t)l * WO_END + WO_UQ;
    bf16_t* QB = (bf16_t*)(WSB + O_QB);
    float* srow = (float*)(smem + SMEM_GEMM);
    for (int item = (BIDX & 7) * (GDIM >> 3) + (BIDX >> 3); item < 516 * 6; item += GDIM) {
      const int mt = item / 6, nt = item % 6, m0 = mt * 128;
      {
        const int r = tid >> 1, hf = tid & 1;
        const uint4* s = (const uint4*)(CQ + (size_t)(m0 + r) * 384 + hf * 192);
        float ss = 0.f;
#pragma unroll 4
        for (int j = 0; j < 24; ++j) {
          const uint4 u = s[j];
          float a;
          a = lo2f(u.x); ss += a * a; a = hi2f(u.x); ss += a * a;
          a = lo2f(u.y); ss += a * a; a = hi2f(u.y); ss += a * a;
          a = lo2f(u.z); ss += a * a; a = hi2f(u.z); ss += a * a;
          a = lo2f(u.w); ss += a * a; a = hi2f(u.w); ss += a * a;
        }
        ss += __shfl_xor(ss, 1);
        if (hf == 0) srow[r] = rsqrtf(ss * (1.f / 384.f) + EPS) * QSCALE;
      }
      f32x4 acc[4][4];
      zero_acc(acc);
      RowLin rp{(const unsigned char*)(CQ + (size_t)m0 * 384), 768};
      gemm_main<true>(TIDX, BIDX, GDIM, acc, rp, W + (size_t)nt * 128 * 384, 384, 384, smem);
      if (nt < 4) {
        EPI_SWAP_BEGIN(m0, nt * 128)
          const float sc = srow[row - m0];
          const f32x4 a = acc[mi][ni] * sc;
          const int hh = col >> 6, d = col & 63;
          *(uint2*)(QB + (size_t)row * 768 + hh * 96 + d) = make_uint2(pack2(a[0], a[1]), pack2(a[2], a[3]));
        EPI_END
      } else {
        const int w = tid >> 6;
        const int rb = m0 + (w >> 1) * 64 + (lane & 15), i0 = 4 * (lane >> 4);
#pragma unroll
        for (int mi = 0; mi < 4; ++mi) {
          const int row = rb + mi * 16;
          const float sc = srow[row - m0];
          const float2* rt = ROPE + (size_t)pos_index(row) * 16 + i0;
#pragma unroll
          for (int pr = 0; pr < 2; ++pr) {
            const int hh = (nt - 4) * 4 + (w & 1) * 2 + pr;
            const f32x4 x1 = acc[mi][2 * pr] * sc, x2 = acc[mi][2 * pr + 1] * sc;
            float o1[4], o2[4];
#pragma unroll
            for (int r = 0; r < 4; ++r) {
              const float2 cs = rt[r];
              o1[r] = x1[r] * cs.x - x2[r] * cs.y;
              o2[r] = x2[r] * cs.x + x1[r] * cs.y;
            }
            *(uint2*)(QB + (size_t)row * 768 + hh * 96 + 64 + i0) = make_uint2(pack2(o1[0], o1[1]), pack2(o1[2], o1[3]));
            *(uint2*)(QB + (size_t)row * 768 + hh * 96 + 80 + i0) = make_uint2(pack2(o2[0], o2[1]), pack2(o2[2], o2[3]));
          }
        }
      }
      __syncthreads();
    }
  }
  {
    const bf16_t* FQ = (const bf16_t*)(WSB + O_FQ);
    bf16_t* QT = (bf16_t*)(WSB + O_QT);
    bf16_t* KHT = (bf16_t*)(WSB + O_KHT);
    bf16_t* AM = (bf16_t*)(WSB + O_AM);
    float* EBp = (float*)(WSB + O_EB);
    bf16_t* sQ = (bf16_t*)smem;
    bf16_t* sK = sQ + 32 * 136;
    for (int item = BIDX; item < NCH * 4; item += GDIM) {
      const int ch = item >> 2, h = item & 3, cid = item;
      {
        const int k = tid & 127, half = tid >> 7, colh = h * 128 + k;
        float* sB = (float*)(smem + 2 * 32 * 136 * 2);
        float lb = 0.f;
        if (l == 1) { const float a0 = PIN(I_HGLB)[colh], a1 = PIN(I_HGLB)[512 + colh]; lb = 1.f / (1.f + expf(a0 - a1)); }
        const float oml = 1.f - lb;
        float bt[16], kk[16], qv[16];
        float bl = 0.f;
#pragma unroll
        for (int j = 0; j < 16; ++j) {
          const size_t row = (size_t)ch * 32 + half * 16 + j;
          const float z = bf2f(FQ[row * 1024 + colh]);
          qv[j] = bf2f(FQ[row * 1024 + 512 + colh]);
          const float e = __expf(-z);
          const float inv = __builtin_amdgcn_rcpf(1.f + e);
          const float f = lb + oml * inv;
          kk[j] = oml * e * inv;
          bl += __logf(f);
          bt[j] = bl;
        }
        sB[half * 128 + k] = bl;
        __syncthreads();
        const float b0 = sB[k], b1 = sB[128 + k];
        const float off = half ? b0 : 0.f, bend = b0 + b1;
        uint32_t pk[8];
#pragma unroll
        for (int j = 0; j < 16; ++j) {
          const int t = half * 16 + j;
          const float b = bt[j] + off;
          const float qs = qv[j] * __builtin_amdgcn_rcpf(1.f + __expf(-qv[j]));
          const bf16_t qt = f2bf(qs * __expf(b));
          QT[((size_t)cid * 32 + t) * 128 + k] = qt;
          sQ[t * 136 + k] = qt;
          sK[t * 136 + k] = f2bf(kk[j] * __expf(fminf(-b, 80.f)));
          bt[j] = kk[j] * __expf(bend - b);
        }
#pragma unroll
        for (int j = 0; j < 8; ++j) pk[j] = pack2(bt[2 * j], bt[2 * j + 1]);
        if (half == 0) EBp[(size_t)cid * 128 + k] = __expf(bend);
        uint4* dst = (uint4*)(KHT + ((size_t)cid * 128 + k) * 32 + half * 16);
        dst[0] = make_uint4(pk[0], pk[1], pk[2], pk[3]);
        dst[1] = make_uint4(pk[4], pk[5], pk[6], pk[7]);
      }
      __syncthreads();
      if (tid < 64) {
        const int c = lane & 31, hh = lane >> 5;
        f32x16 am;
        const float zf = zero_f();
#pragma unroll
        for (int r = 0; r < 16; ++r) am[r] = zf;
#pragma unroll
        for (int st = 0; st < 8; ++st) {
          const bf16x8 a = *(const bf16x8*)(sQ + c * 136 + st * 16 + hh * 8);
          const bf16x8 bb = *(const bf16x8*)(sK + c * 136 + st * 16 + hh * 8);
          am = mfma32(a, bb, am);
        }
#pragma unroll
        for (int r = 0; r < 16; ++r) {
          const int t = (r & 3) + 8 * (r >> 2) + 4 * hh;
          AM[((size_t)cid * 32 + t) * 32 + c] = f2bf(c <= t ? am[r] : 0.f);
        }
      }
      __syncthreads();
    }
  }
  {
    const float* src = PIN(I_CCKV) + (size_t)l * 16 * 4096 * 256;
    bf16_t* CCB = (bf16_t*)(WSB + O_CCB);
    const size_t str_ = (size_t)GDIM * 256;
    for (size_t i = (size_t)BIDX * 256 + tid; i < 16ull * 4096 * 64; i += 4 * str_) {
      float4 v4[4];
#pragma unroll
      for (int k = 0; k < 4; ++k) { const size_t ii = i + k * str_ < 16ull * 4096 * 64 ? i + k * str_ : i; v4[k] = *(const float4*)(src + ii * 4); }
#pragma unroll
      for (int k = 0; k < 4; ++k) if (i + k * str_ < 16ull * 4096 * 64) *(uint2*)(CCB + (i + k * str_) * 4) = make_uint2(pack2(v4[k].x, v4[k].y), pack2(v4[k].z, v4[k].w));
    }
  }
  {
    const float* CKR = (const float*)(WSB + O_CKR);
    bf16_t* CKVN = (bf16_t*)(WSB + O_CKVN);
    bf16_t* KRB = (bf16_t*)(WSB + O_KRB);
    bf16_t* KRS = (bf16_t*)(WSB + O_KRS) + (size_t)l * 16 * KPAD * 32;
    const float* kvn = PIN(I_KVN) + l * 256;
    const int wid = BIDX * 4 + (tid >> 6), nw = GDIM * 4;
    const float4 g = *(const float4*)(kvn + lane * 4);
    for (int row0 = wid; row0 < NTOK; row0 += 4 * nw) {
      int rws[4]; bool ok4[4];
      float4 v[4]; float x1[4], x2[4]; float2 cs[4];
#pragma unroll
      for (int k = 0; k < 4; ++k) {
        ok4[k] = row0 + k * nw < NTOK;
        rws[k] = ok4[k] ? row0 + k * nw : row0;
        const float* src = CKR + (size_t)rws[k] * 288;
        v[k] = *(const float4*)(src + lane * 4);
        x1[k] = src[256 + (lane & 15)]; x2[k] = src[272 + (lane & 15)];
        cs[k] = ROPE[(size_t)pos_index(rws[k]) * 16 + (lane & 15)];
      }
#pragma unroll
      for (int k = 0; k < 4; ++k) {
        if (ok4[k]) {
          const int row = rws[k];
          float ss = wave_sum(v[k].x * v[k].x + v[k].y * v[k].y + v[k].z * v[k].z + v[k].w * v[k].w);
          const float rs = rsqrtf(ss * (1.f / 256.f) + EPS);
          const float4 o = make_float4(v[k].x * rs * g.x, v[k].y * rs * g.y, v[k].z * rs * g.z, v[k].w * rs * g.w);
          float* oc = row < TP ? OUTB + OUT_CKV_P + ((size_t)l * TP + row) * 256 : OUTB + OUT_CKV_S + ((size_t)l * TS + (row - TP)) * 256;
          *(float4*)(oc + lane * 4) = o;
          *(uint2*)(CKVN + (size_t)row * 256 + lane * 4) = make_uint2(pack2(o.x, o.y), pack2(o.z, o.w));
          if (lane < 16) {
            const float o1 = x1[k] * cs[k].x - x2[k] * cs[k].y, o2 = x2[k] * cs[k].x + x1[k] * cs[k].y;
            float* okp = row < TP ? OUTB + OUT_KR_P + ((size_t)l * TP + row) * 32 : OUTB + OUT_KR_S + ((size_t)l * TS + (row - TP)) * 32;
            okp[lane] = o1;
            okp[16 + lane] = o2;
            bf16_t* kb = row < TP ? KRB + (size_t)row * 32 : KRS + ((size_t)((row - TP) >> 5) * KPAD + 4096 + ((row - TP) & 31)) * 32;
            kb[lane] = f2bf(o1);
            kb[16 + lane] = f2bf(o2);
          }
        }
      }
    }
  }
}

DEVI void phase_p3(const int TIDX, const int BIDX, const int GDIM, KAP KA, unsigned char* WSB, float* OUTB, int l, unsigned char* smem) {
  const bf16_t* W = (const bf16_t*)(WSB + O_WS) + (size_t)l * WO_END + WO_KV;
  const bf16_t* CKVN = (const bf16_t*)(WSB + O_CKVN);
  bf16_t* KN = (bf16_t*)(WSB + O_KN);
  bf16_t* VT = (bf16_t*)(WSB + O_VT);
  bf16_t* KNS = (bf16_t*)(WSB + O_KNS);
  bf16_t* VTS = (bf16_t*)(WSB + O_VTS);
  const bf16_t* cache = (const bf16_t*)(WSB + O_CCB);
  for (int i = BIDX * 256 + TIDX; i < 16 * 8 * 64 * 4; i += GDIM * 256) {
    const uint32_t z = __float_as_uint(zero_f());
    *(uint4*)(VTS + (size_t)(i >> 2) * KPAD + 4128 + (i & 3) * 8) = make_uint4(z, z, z, z);
  }
  for (int item = (BIDX & 7) * (GDIM >> 3) + (BIDX >> 3); item < (516 + 512) * 8; item += GDIM) {
    const int mt = item >> 3, nt = item & 7;
    const bool is_cache = mt >= 516;
    const int m0 = is_cache ? (mt - 516) * 128 : mt * 128;
    f32x4 acc[4][4];
    zero_acc(acc);
    bf16_t* kdst; bf16_t* vdst; size_t ldv; int key0;
    if (is_cache) { const int b = m0 >> 12; key0 = m0 & 4095; kdst = KNS + ((size_t)b * KPAD + key0) * 512; vdst = VTS + (size_t)b * 8 * 64 * KPAD; ldv = KPAD; }
    else if (m0 >= TP) { kdst = nullptr; vdst = nullptr; ldv = KPAD; key0 = 0; }
    else { const int b = m0 >> 11; key0 = m0 & 2047; kdst = KN + (size_t)m0 * 512; vdst = VT + (size_t)b * 8 * 64 * 2048; ldv = 2048; }
    if (nt < 4) {
      if (is_cache) { RowLin rp{(const unsigned char*)(cache + (size_t)m0 * 256), 512}; gemm_main<true>(TIDX, BIDX, GDIM, acc, rp, W + (size_t)nt * 128 * 256, 256, 256, smem); }
      else { RowLin rp{(const unsigned char*)(CKVN + (size_t)m0 * 256), 512}; gemm_main<true>(TIDX, BIDX, GDIM, acc, rp, W + (size_t)nt * 128 * 256, 256, 256, smem); }
      EPI_SWAP_BEGIN(0, nt * 128)
        const f32x4 a = acc[mi][ni];
        bf16_t* d;
        if (kdst) d = kdst + (size_t)row * 512 + col;
        else { const int sr = m0 - TP + row; d = KNS + ((size_t)(sr >> 5) * KPAD + 4096 + (sr & 31)) * 512 + col; }
        *(uint2*)d = make_uint2(pack2(a[0], a[1]), pack2(a[2], a[3]));
      EPI_END
    } else {
      if (is_cache) { RowLin rp{(const unsigned char*)(cache + (size_t)m0 * 256), 512}; gemm_main<false>(TIDX, BIDX, GDIM, acc, rp, W + (size_t)nt * 128 * 256, 256, 256, smem); }
      else { RowLin rp{(const unsigned char*)(CKVN + (size_t)m0 * 256), 512}; gemm_main<false>(TIDX, BIDX, GDIM, acc, rp, W + (size_t)nt * 128 * 256, 256, 256, smem); }
      const int lane = TIDX & 63, w = TIDX >> 6;
      const int rb = (w >> 1) * 64 + 4 * (lane >> 4), cb = (nt - 4) * 128 + (w & 1) * 64 + (lane & 15);
#pragma unroll
      for (int mi = 0; mi < 4; ++mi) {
        const int row = rb + mi * 16;
#pragma unroll
        for (int ni = 0; ni < 4; ++ni) {
          const int hv = cb + ni * 16;
          const f32x4 a = acc[mi][ni];
          bf16_t* d;
          if (vdst) d = vdst + (size_t)hv * ldv + key0 + row;
          else { const int sr = m0 - TP + row; d = VTS + ((size_t)(sr >> 5) * 512 + hv) * KPAD + 4096 + (sr & 31); }
          *(uint2*)d = make_uint2(pack2(a[0], a[1]), pack2(a[2], a[3]));
        }
      }
    }
  }
}

DEVI void attn_item(const int TIDX, const int BIDX, const int GDIM, const bf16_t* __restrict__ Q, int qrow0, int nq, int ng, const bf16_t* __restrict__ Kn, const bf16_t* __restrict__ Kr,
                    const bf16_t* __restrict__ VT, size_t ldv, int nkeys, bf16_t* __restrict__ O, unsigned char* smem) {
  const int tid = TIDX, lane = tid & 63, w = tid >> 6, li = lane & 15, lg = lane >> 4;
  const int ql = 16 * w + li;
  bf16x8 qf[2][3];
  f32x4 oT[2][4];
  float mrun[2], lrun[2];
  const float zf = zero_f();
#pragma unroll
  for (int g = 0; g < 2; ++g) {
    const int qr = qrow0 + (g == 0 ? (ql < nq ? ql : nq - 1) : 64 + ql);
    const int qrc = (g == 1 && ng < 2) ? qrow0 : qr;
#pragma unroll
    for (int ds = 0; ds < 3; ++ds) qf[g][ds] = *(const bf16x8*)(Q + (size_t)qrc * 768 + ds * 32 + lg * 8);
#pragma unroll
    for (int i = 0; i < 4; ++i) oT[g][i] = (f32x4){zf, zf, zf, zf};
    mrun[g] = -INFINITY; lrun[g] = 0.f;
  }
  const int nt = (nkeys + 63) >> 6;
  const int r8 = lane >> 3;
  const uint32_t sch = (uint32_t)((lane & 7) ^ (((lane >> 4) + 4 * (w & 1)) & 7)) * 16u;
  const unsigned char* kn0 = (const unsigned char*)Kn + (size_t)(w * 8 + r8) * 1024 + sch;
  const unsigned char* kr0 = (const unsigned char*)Kr + (size_t)(w * 16 + (lane >> 2)) * 64 + (uint32_t)((lane & 3) ^ (((lane >> 5) & 1) << 1)) * 16u;
  const unsigned char* v0 = (const unsigned char*)VT + (size_t)(w * 8 + r8) * ldv * 2 + sch;
  const size_t v32 = (size_t)32 * ldv * 2;
  unsigned char* sw = smem + w * 1024;
#define ATT_STAGE(kt_)                                                                                                  \
  {                                                                                                                     \
    unsigned char* st_ = sw + ((kt_) % 3) * 20480;                                                                      \
    const size_t kb_ = (size_t)(kt_) * 64;                                                                              \
    __builtin_amdgcn_global_load_lds((const unsigned*)(kn0 + kb_ * 1024), (unsigned*)(st_), 16, 0, 0);                  \
    __builtin_amdgcn_global_load_lds((const unsigned*)(kn0 + kb_ * 1024 + 32768), (unsigned*)(st_ + 4096), 16, 0, 0);   \
    __builtin_amdgcn_global_load_lds((const unsigned*)(kr0 + kb_ * 64), (unsigned*)(st_ + 8192), 16, 0, 0);             \
    __builtin_amdgcn_global_load_lds((const unsigned*)(v0 + kb_ * 2), (unsigned*)(st_ + 12288), 16, 0, 0);              \
    __builtin_amdgcn_global_load_lds((const unsigned*)(v0 + v32 + kb_ * 2), (unsigned*)(st_ + 12288 + 4096), 16, 0, 0); \
  }
  ATT_STAGE(0);
  if (nt > 1) ATT_STAGE(1);
  const int pk0 = (lg ^ (li >> 1)) * 16;
  const int pkr = (lg ^ (((li >> 3) & 1) << 1)) * 16;
  const int pv0 = ((lg >> 1) ^ (li >> 1)) * 16 + (lg & 1) * 8;
  for (int kt = 0; kt < nt; ++kt) {
    if (kt + 1 < nt) asm volatile("s_waitcnt vmcnt(5)" ::: "memory");
    else asm volatile("s_waitcnt vmcnt(0)" ::: "memory");
    __builtin_amdgcn_s_barrier();
    asm volatile("" ::: "memory");
    if (kt + 2 < nt) ATT_STAGE(kt + 2);
    const unsigned char* st = smem + (kt % 3) * 20480;
    const bool tail = (kt == nt - 1) && (nkeys & 63);
    const bool two = (ng == 2);
    const bool g0on = !(two && kt == nt - 1);
    f32x4 sT[2][4];
#pragma unroll
    for (int kb = 0; kb < 4; ++kb) {
      const unsigned char* kr_ = st + (kb * 16 + li) * 128;
      const bf16x8 k0 = *(const bf16x8*)(kr_ + pk0), k1 = *(const bf16x8*)(kr_ + (pk0 ^ 64)), k2 = *(const bf16x8*)(st + 8192 + (kb * 16 + li) * 64 + pkr);
      sT[0][kb] = (f32x4){zf, zf, zf, zf};
      sT[1][kb] = (f32x4){zf, zf, zf, zf};
      if (g0on) {
        sT[0][kb] = mfma16(k0, qf[0][0], sT[0][kb]);
        sT[0][kb] = mfma16(k1, qf[0][1], sT[0][kb]);
        sT[0][kb] = mfma16(k2, qf[0][2], sT[0][kb]);
      }
      if (two) {
        sT[1][kb] = mfma16(k0, qf[1][0], sT[1][kb]);
        sT[1][kb] = mfma16(k1, qf[1][1], sT[1][kb]);
        sT[1][kb] = mfma16(k2, qf[1][2], sT[1][kb]);
      }
    }
    bf16x8 pf[2][2];
#pragma unroll
    for (int g = 0; g < 2; ++g) {
      if (g == 0 ? g0on : two) {
        if (tail) {
#pragma unroll
          for (int kb = 0; kb < 4; ++kb)
#pragma unroll
            for (int r = 0; r < 4; ++r)
              if (kt * 64 + kb * 16 + 4 * lg + r >= nkeys) sT[g][kb][r] = -INFINITY;
        }
        float mx = sT[g][0][0];
#pragma unroll
        for (int kb = 0; kb < 4; ++kb)
#pragma unroll
          for (int r = 0; r < 4; ++r) mx = fmaxf(mx, sT[g][kb][r]);
        mx = fmaxf(mx, __shfl_xor(mx, 16));
        mx = fmaxf(mx, __shfl_xor(mx, 32));
        const float mnew = fmaxf(mrun[g], mx);
        const float alpha = __builtin_amdgcn_exp2f(mrun[g] - mnew);
        mrun[g] = mnew;
        float ps = 0.f;
#pragma unroll
        for (int kb = 0; kb < 4; ++kb)
#pragma unroll
          for (int r = 0; r < 4; ++r) { const float pv = __builtin_amdgcn_exp2f(sT[g][kb][r] - mnew); sT[g][kb][r] = pv; ps += pv; }
        lrun[g] = lrun[g] * alpha + ps;
#pragma unroll
        for (int vb = 0; vb < 4; ++vb) oT[g][vb] *= alpha;
      }
#pragma unroll
      for (int s2 = 0; s2 < 2; ++s2)
        pf[g][s2] = mk8(pack2(sT[g][2 * s2][0], sT[g][2 * s2][1]), pack2(sT[g][2 * s2][2], sT[g][2 * s2][3]),
                        pack2(sT[g][2 * s2 + 1][0], sT[g][2 * s2 + 1][1]), pack2(sT[g][2 * s2 + 1][2], sT[g][2 * s2 + 1][3]));
    }
#pragma unroll
    for (int s2 = 0; s2 < 2; ++s2) {
#pragma unroll
      for (int vb = 0; vb < 4; ++vb) {
        const unsigned char* vr_ = st + 12288 + (vb * 16 + li) * 128;
        const uint2 lo = *(const uint2*)(vr_ + (pv0 ^ (s2 * 64)));
        const uint2 hi = *(const uint2*)(vr_ + (pv0 ^ (s2 * 64) ^ 32));
        const bf16x8 vfr = mk8(lo, hi);
        if (g0on) oT[0][vb] = mfma16(vfr, pf[0][s2], oT[0][vb]);
        if (two) oT[1][vb] = mfma16(vfr, pf[1][s2], oT[1][vb]);
      }
    }
  }
#pragma unroll
  for (int g = 0; g < 2; ++g) {
    float lr = lrun[g];
    lr += __shfl_xor(lr, 16);
    lr += __shfl_xor(lr, 32);
    const float inv = 1.f / lr;
    const bool st_ok = g == 0 ? (ql < nq) : (ng == 2);
    if (st_ok) {
#pragma unroll
      for (int vb = 0; vb < 4; ++vb) {
        const f32x4 o = oT[g][vb] * inv;
        *(uint2*)(O + (size_t)(qrow0 + g * 64 + ql) * 512 + vb * 16 + 4 * lg) = make_uint2(pack2(o[0], o[1]), pack2(o[2], o[3]));
      }
    }
  }
  __syncthreads();
}

DEVI void hgrn_item(const int TIDX, const int BIDX, const int GDIM, KAP KA, unsigned char* WSB, float* OUTB, int l, int g0, int nchunks, int h, const float* __restrict__ S0, float* __restrict__ Sout, int rowbase,
                    unsigned char* smem) {
  constexpr int STG = 35840;
  const unsigned char* QT = WSB + O_QT;
  const unsigned char* KHT = WSB + O_KHT;
  const unsigned char* AM = WSB + O_AM;
  const unsigned char* EBp = WSB + O_EB;
  const unsigned char* VT2 = WSB + O_VT2;
  const unsigned char* G = WSB + O_G;
  bf16_t* HO = (bf16_t*)(WSB + O_HO);
  const float* hgn = PIN(I_HGN) + l * 512 + h * 128;
  float* sred = (float*)(smem + SMEM_GEMM);
  const int tid = TIDX, lane = tid & 63, w = tid >> 6, c = lane & 31, hh = lane >> 5;
  const int dvg = 32 * w + c;
  f32x16 S[4];
#pragma unroll
  for (int kt = 0; kt < 4; ++kt)
#pragma unroll
    for (int r = 0; r < 16; ++r) S[kt][r] = S0 ? S0[(size_t)(32 * kt + (r & 3) + 8 * (r >> 2) + 4 * hh) * 128 + dvg] : 0.f;
  float4 gn[4];
#pragma unroll
  for (int q = 0; q < 4; ++q) gn[q] = *(const float4*)(hgn + 32 * w + 8 * q + 4 * hh);
  const uint32_t lo16 = (uint32_t)lane * 16u;
  const uint32_t goff = (uint32_t)(w * 4 + (lane >> 4)) * 1024u + (uint32_t)h * 256u + (uint32_t)(lane & 15) * 16u;
#define HG_STAGE(ch_)                                                                                                                  \
  {                                                                                                                                    \
    unsigned char* st_ = smem + ((ch_) & 1) * STG + w * 1024;                                                                          \
    const size_t cid_ = (size_t)(g0 + (ch_)) * 4 + h;                                                                                  \
    const size_t grow_ = ((size_t)rowbase + (size_t)(ch_) * 32) * 1024;                                                                \
    __builtin_amdgcn_global_load_lds((const unsigned*)(QT + cid_ * 8192 + w * 1024 + lo16), (unsigned*)(st_), 16, 0, 0);              \
    __builtin_amdgcn_global_load_lds((const unsigned*)(QT + cid_ * 8192 + 4096 + w * 1024 + lo16), (unsigned*)(st_ + 4096), 16, 0, 0); \
    __builtin_amdgcn_global_load_lds((const unsigned*)(KHT + cid_ * 8192 + w * 1024 + lo16), (unsigned*)(st_ + 8192), 16, 0, 0);       \
    __builtin_amdgcn_global_load_lds((const unsigned*)(KHT + cid_ * 8192 + 4096 + w * 1024 + lo16), (unsigned*)(st_ + 12288), 16, 0, 0); \
    __builtin_amdgcn_global_load_lds((const unsigned*)(VT2 + cid_ * 8192 + w * 1024 + lo16), (unsigned*)(st_ + 16384), 16, 0, 0);      \
    __builtin_amdgcn_global_load_lds((const unsigned*)(VT2 + cid_ * 8192 + 4096 + w * 1024 + lo16), (unsigned*)(st_ + 20480), 16, 0, 0); \
    __builtin_amdgcn_global_load_lds((const unsigned*)(G + grow_ + goff), (unsigned*)(st_ + 24576), 16, 0, 0);                         \
    __builtin_amdgcn_global_load_lds((const unsigned*)(G + grow_ + 16384 + goff), (unsigned*)(st_ + 28672), 16, 0, 0);                 \
    if (w < 2) __builtin_amdgcn_global_load_lds((const unsigned*)(AM + cid_ * 2048 + w * 1024 + lo16), (unsigned*)(st_ + 32768), 16, 0, 0); \
    else if (w == 2) __builtin_amdgcn_global_load_lds((const unsigned*)(EBp + cid_ * 512 + lo16), (unsigned*)(smem + ((ch_) & 1) * STG + 34816), 16, 0, 0); \
  }
  HG_STAGE(0);
  for (int ch = 0; ch < nchunks; ++ch) {
    asm volatile("s_waitcnt vmcnt(0)" ::: "memory");
    __builtin_amdgcn_s_barrier();
    asm volatile("" ::: "memory");
    if (ch + 1 < nchunks) HG_STAGE(ch + 1);
    const unsigned char* st = smem + (ch & 1) * STG;
    bf16x8 vf[2], af[2];
#pragma unroll
    for (int s2 = 0; s2 < 2; ++s2) {
      vf[s2] = *(const bf16x8*)(st + 16384 + dvg * 64 + 32 * s2 + 16 * hh);
      af[s2] = *(const bf16x8*)(st + 32768 + c * 64 + 32 * s2 + 16 * hh);
    }
    f32x16 oT;
    const float zf = zero_f();
#pragma unroll
    for (int r = 0; r < 16; ++r) oT[r] = zf;
#pragma unroll
    for (int kt = 0; kt < 4; ++kt) {
#pragma unroll
      for (int s2 = 0; s2 < 2; ++s2) {
        const uint2 lo = *(const uint2*)(st + c * 256 + 64 * kt + 32 * s2 + 8 * hh);
        const uint2 hi = *(const uint2*)(st + c * 256 + 64 * kt + 32 * s2 + 16 + 8 * hh);
        const bf16x8 sa = mk8(pack2(S[kt][8 * s2 + 0], S[kt][8 * s2 + 1]), pack2(S[kt][8 * s2 + 2], S[kt][8 * s2 + 3]),
                              pack2(S[kt][8 * s2 + 4], S[kt][8 * s2 + 5]), pack2(S[kt][8 * s2 + 6], S[kt][8 * s2 + 7]));
        oT = mfma32(sa, mk8(lo, hi), oT);
      }
    }
#pragma unroll
    for (int s2 = 0; s2 < 2; ++s2) oT = mfma32(vf[s2], af[s2], oT);
#pragma unroll
    for (int kt = 0; kt < 4; ++kt) {
#pragma unroll
      for (int q = 0; q < 4; ++q) {
        const float4 e = *(const float4*)(st + 34816 + (32 * kt + 8 * q + 4 * hh) * 4);
        S[kt][4 * q + 0] *= e.x; S[kt][4 * q + 1] *= e.y; S[kt][4 * q + 2] *= e.z; S[kt][4 * q + 3] *= e.w;
      }
#pragma unroll
      for (int s2 = 0; s2 < 2; ++s2) {
        const bf16x8 kf = *(const bf16x8*)(st + 8192 + (32 * kt + c) * 64 + 32 * s2 + 16 * hh);
        S[kt] = mfma32(kf, vf[s2], S[kt]);
      }
    }
    float ss = 0.f;
#pragma unroll
    for (int r = 0; r < 16; ++r) ss += oT[r] * oT[r];
    ss += __shfl_xor(ss, 32);
    float* sr = sred + (ch & 1) * 128;
    if (lane < 32) sr[w * 32 + c] = ss;
    asm volatile("s_waitcnt lgkmcnt(0)" ::: "memory");
    __builtin_amdgcn_s_barrier();
    asm volatile("" ::: "memory");
    const float tot = sr[c] + sr[32 + c] + sr[64 + c] + sr[96 + c];
    const float rs = rsqrtf(tot * (1.f / 128.f) + EPS);
    const size_t row = (size_t)rowbase + ch * 32 + c;
#pragma unroll
    for (int q = 0; q < 4; ++q) {
      const int dv0 = 32 * w + 8 * q + 4 * hh;
      const uint2 gp = *(const uint2*)(st + 24576 + c * 256 + dv0 * 2);
      const float o0 = oT[4 * q + 0] * rs * gn[q].x * siluf_(lo2f(gp.x));
      const float o1 = oT[4 * q + 1] * rs * gn[q].y * siluf_(hi2f(gp.x));
      const float o2 = oT[4 * q + 2] * rs * gn[q].z * siluf_(lo2f(gp.y));
      const float o3 = oT[4 * q + 3] * rs * gn[q].w * siluf_(hi2f(gp.y));
      *(uint2*)(HO + row * 512 + h * 128 + dv0) = make_uint2(pack2(o0, o1), pack2(o2, o3));
    }
  }
#pragma unroll
  for (int kt = 0; kt < 4; ++kt)
#pragma unroll
    for (int r = 0; r < 16; ++r) Sout[(size_t)(32 * kt + (r & 3) + 8 * (r >> 2) + 4 * hh) * 128 + dvg] = S[kt][r];
  __syncthreads();
}

DEVI void phase_p4(const int TIDX, const int BIDX, const int GDIM, KAP KA, unsigned char* WSB, float* OUTB, int l, unsigned char* smem, int dup = 0) {
  const int q = BIDX & 7;
  int* qctr = (int*)(WSB + O_CNT) + 3072 + (l * 8 + q) * 32 + 16 * dup;
  int* sitem = (int*)(smem + SMEM_GEMM + 1024);
  const bf16_t* QB = (const bf16_t*)(WSB + O_QB);
  bf16_t* AO = (bf16_t*)(WSB + O_AO);
  const int total = 16 + 16 + 512 + 8;
  for (;;) {
    if (TIDX == 0) *sitem = atomicAdd(qctr, 1);
    __syncthreads();
    const int it = *sitem;
    __syncthreads();
    if (it >= total) break;
    if (it < 16) {
      const int i2 = q * 16 + it, b = i2 >> 2, h = i2 & 3;
      hgrn_item(TIDX, BIDX, GDIM, KA, WSB, OUTB, l, b * 64, 64, h, nullptr, OUTB + OUT_ST_P + ((size_t)(l * 32 + b) * 4 + h) * 16384, b * 2048, smem);
    } else if (it < 32) {
      const int b = it - 16, h = q;
      attn_item(TIDX, BIDX, GDIM, QB + h * 96, TP + b * 32, 32, 1, (const bf16_t*)(WSB + O_KNS) + (size_t)b * KPAD * 512 + h * 64,
                (const bf16_t*)(WSB + O_KRS) + ((size_t)l * 16 + b) * KPAD * 32,
                (const bf16_t*)(WSB + O_VTS) + (size_t)(b * 8 + h) * 64 * KPAD, KPAD, 4128, AO + h * 64, smem);
    } else if (it < 32 + 512) {
      const int jj = it - 32, b = jj >> 4, cp = 15 - (jj & 15), h = q;
      attn_item(TIDX, BIDX, GDIM, QB + h * 96, b * 2048 + cp * 128, 64, 2, (const bf16_t*)(WSB + O_KN) + (size_t)b * 2048 * 512 + h * 64,
                (const bf16_t*)(WSB + O_KRB) + (size_t)b * 2048 * 32,
                (const bf16_t*)(WSB + O_VT) + (size_t)(b * 8 + h) * 64 * 2048, 2048, 128 * (cp + 1), AO + h * 64, smem);
    } else {
      const int i2 = q * 8 + (it - 32 - 512), b = i2 >> 2, h = i2 & 3;
      hgrn_item(TIDX, BIDX, GDIM, KA, WSB, OUTB, l, 2048 + b, 1, h, PIN(I_ST) + ((size_t)(l * 16 + b) * 4 + h) * 16384,
                OUTB + OUT_ST_S + ((size_t)(l * 16 + b) * 4 + h) * 16384, TP + b * 32, smem);
    }
  }
}

DEVI void phase_p5(const int TIDX, const int BIDX, const int GDIM, KAP KA, unsigned char* WSB, float* OUTB, int l, unsigned char* smem) {
  const bf16_t* XB = (const bf16_t*)(WSB + O_XB);
  const bf16_t* AO = (const bf16_t*)(WSB + O_AO);
  const bf16_t* HO = (const bf16_t*)(WSB + O_HO);
  const bf16_t* W = (const bf16_t*)(WSB + O_WS) + (size_t)l * WO_END;
  bf16_t* MG = (bf16_t*)(WSB + O_MG);
  for (int item = (BIDX & 7) * (GDIM >> 3) + (BIDX >> 3); item < 516 * 8; item += GDIM) {
    const int mt = item >> 3, nt = item & 7, m0 = mt * 128, n0 = nt * 128;
    f32x4 acc[4][4];
    bf16_t* TMP = (bf16_t*)(WSB + O_G);
    RowLin rx{(const unsigned char*)(XB + (size_t)m0 * 1024), 2048};
    RowLin ra{(const unsigned char*)(AO + (size_t)m0 * 512), 1024};
    RowLin ro{(const unsigned char*)(HO + (size_t)m0 * 512), 1024};
    zero_acc(acc);
    gemm_main<true>(TIDX, BIDX, GDIM, acc, rx, W + WO_G + (size_t)n0 * 1024, 1024, 1024, smem);
    EPI_SWAP_BEGIN(m0, n0)
      const f32x4 a = acc[mi][ni];
      *(uint2*)(MG + (size_t)row * 1024 + col) = make_uint2(pack2(sigmoidf_(a[0]), sigmoidf_(a[1])), pack2(sigmoidf_(a[2]), sigmoidf_(a[3])));
    EPI_END
    zero_acc(acc);
    gemm_main<true>(TIDX, BIDX, GDIM, acc, rx, W + WO_G + (size_t)(1024 + n0) * 1024, 1024, 1024, smem);
    EPI_SWAP_BEGIN(m0, n0)
      const f32x4 a = acc[mi][ni];
      *(uint2*)(TMP + (size_t)row * 1024 + col) = make_uint2(pack2(sigmoidf_(a[0]), sigmoidf_(a[1])), pack2(sigmoidf_(a[2]), sigmoidf_(a[3])));
    EPI_END
    zero_acc(acc);
    gemm_main<true>(TIDX, BIDX, GDIM, acc, ra, W + WO_BRA + (size_t)n0 * 512, 512, 512, smem);
    EPI_SWAP_BEGIN(m0, n0)
      const f32x4 a = acc[mi][ni];
      const uint2 g = *(const uint2*)(MG + (size_t)row * 1024 + col);
      *(uint2*)(MG + (size_t)row * 1024 + col) = make_uint2(pack2(a[0] * lo2f(g.x), a[1] * hi2f(g.x)), pack2(a[2] * lo2f(g.y), a[3] * hi2f(g.y)));
    EPI_END
    zero_acc(acc);
    gemm_main<true>(TIDX, BIDX, GDIM, acc, ro, W + WO_BRB + (size_t)n0 * 512, 512, 512, smem);
    EPI_SWAP_BEGIN(m0, n0)
      const f32x4 a = acc[mi][ni];
      const uint2 g = *(const uint2*)(TMP + (size_t)row * 1024 + col), m = *(const uint2*)(MG + (size_t)row * 1024 + col);
      const float o0 = lo2f(m.x) + a[0] * lo2f(g.x), o1 = hi2f(m.x) + a[1] * hi2f(g.x), o2 = lo2f(m.y) + a[2] * lo2f(g.y), o3 = hi2f(m.y) + a[3] * hi2f(g.y);
      *(uint2*)(MG + (size_t)row * 1024 + col) = make_uint2(pack2(o0, o1), pack2(o2, o3));
    EPI_END
  }
}

DEVI void phase_p6(const int TIDX, const int BIDX, const int GDIM, KAP KA, unsigned char* WSB, float* OUTB, int l, unsigned char* smem) {
  const bf16_t* MG = (const bf16_t*)(WSB + O_MG);
  const bf16_t* W = (const bf16_t*)(WSB + O_WS) + (size_t)l * WO_END + WO_OUT;
  float* PRE = (float*)(WSB + O_PRE);
  for (int item = (BIDX & 7) * (GDIM >> 3) + (BIDX >> 3); item < 516 * 8; item += GDIM) {
    const int mt = item >> 3, nt = item & 7, m0 = mt * 128, n0 = nt * 128;
    f32x4 acc[4][4];
    zero_acc(acc);
    RowLin rp{(const unsigned char*)(MG + (size_t)m0 * 1024), 2048};
    gemm_main<true>(TIDX, BIDX, GDIM, acc, rp, W + (size_t)n0 * 1024, 1024, 1024, smem);
    EPI_SWAP_BEGIN(m0, n0)
      const f32x4 a = acc[mi][ni];
      *(uint2*)((bf16_t*)PRE + (size_t)row * 1024 + col) = make_uint2(pack2(a[0], a[1]), pack2(a[2], a[3]));
    EPI_END
  }
}

DEVI void phase_p7(const int TIDX, const int BIDX, const int GDIM, KAP KA, unsigned char* WSB, float* OUTB, int l, unsigned char* smem) {
  const int tid = TIDX, lane = tid & 63;
  {
    const float* PRE = (const float*)(WSB + O_PRE);
    bf16_t* XB = (bf16_t*)(WSB + O_XB);
    const float* WR = (const float*)(WSB + O_WR) + (size_t)l * 36 * 1024;
    int* cnt = (int*)(WSB + O_CNT) + 1024 + l * 1024;
    int* ltok = (int*)(WSB + O_LTOK);
    float* lw = (float*)(WSB + O_LW);
    const float* g1 = PIN(I_LN1G) + l * 1024; const float* b1 = PIN(I_LN1B) + l * 1024;
    const int wid = BIDX * 4 + (tid >> 6), nw = GDIM * 4;
    for (int r4 = wid; r4 < NTOK / 4; r4 += nw) {
      float4 v[4][4];
#pragma unroll
      for (int t = 0; t < 4; ++t) {
        const size_t row = (size_t)r4 * 4 + t;
#pragma unroll
        for (int j = 0; j < 4; ++j) v[t][j] = resid_plus(*(const uint2*)(XB + row * 1024 + j * 256 + lane * 4), *(const uint2*)((const bf16_t*)PRE + row * 1024 + j * 256 + lane * 4));
        ln_inplace(v[t], g1, b1, lane);
        store_row(v[t], OUTB + row * 1024, XB + row * 1024, lane);
      }
      float mine[4] = {0.f, 0.f, 0.f, 0.f};
#pragma unroll 4
      for (int c = 0; c < 36; ++c) {
        float4 wv[4];
#pragma unroll
        for (int j = 0; j < 4; ++j) wv[j] = *(const float4*)(WR + c * 1024 + j * 256 + lane * 4);
#pragma unroll
        for (int t = 0; t < 4; ++t) {
          float s = 0.f;
#pragma unroll
          for (int j = 0; j < 4; ++j) s += v[t][j].x * wv[j].x + v[t][j].y * wv[j].y + v[t][j].z * wv[j].z + v[t][j].w * wv[j].w;
          s = wave_sum(s);
          if (lane == c) mine[t] = s;
        }
      }
      int my_e = 0, my_tk = 0; float my_w = 0.f;
#pragma unroll
      for (int t = 0; t < 4; ++t) {
        const int tok = r4 * 4 + t;
        float gl[4];
#pragma unroll
        for (int j = 0; j < 4; ++j) gl[j] = __shfl(mine[t], j);
        int gi = 0; float gm = gl[0];
#pragma unroll
        for (int j = 1; j < 4; ++j) if (gl[j] > gm) { gm = gl[j]; gi = j; }
        float gs = 0.f;
#pragma unroll
        for (int j = 0; j < 4; ++j) gs += expf(gl[j] - gm);
        const float gtop = 1.f / gs;
        float el[8];
#pragma unroll
        for (int j = 0; j < 8; ++j) el[j] = __shfl(mine[t], 4 + gi * 8 + j);
        float em = el[0];
#pragma unroll
        for (int j = 1; j < 8; ++j) em = fmaxf(em, el[j]);
        float pe[8], es = 0.f;
#pragma unroll
        for (int j = 0; j < 8; ++j) { pe[j] = expf(el[j] - em); es += pe[j]; }
#pragma unroll
        for (int j = 0; j < 8; ++j) pe[j] = pe[j] / es;
        int i1 = 0; float p1 = pe[0];
#pragma unroll
        for (int j = 1; j < 8; ++j) if (pe[j] > p1) { p1 = pe[j]; i1 = j; }
        int i2 = -1; float p2 = -1.f;
#pragma unroll
        for (int j = 0; j < 8; ++j) if (j != i1 && pe[j] > p2) { p2 = pe[j]; i2 = j; }
        const float den = p1 + p2;
        if (lane == 2 * t) { my_e = gi * 8 + i1; my_w = gtop * (p1 / den); my_tk = tok * 2; }
        if (lane == 2 * t + 1) { my_e = gi * 8 + i2; my_w = gtop * (p2 / den); my_tk = tok * 2 + 1; }
      }
      if (lane < 8) {
        const int sl = atomicAdd(cnt + my_e * 32, 1);
        ltok[(size_t)my_e * NTOK + sl] = my_tk;
        lw[(size_t)my_e * NTOK + sl] = my_w;
      }
    }
  }
  {
    bf16_t* PLEB = (bf16_t*)(WSB + O_YM);
    const float* pp = PIN(I_PP) + (size_t)l * TP * 256;
    const float* ps = PIN(I_PS) + (size_t)l * TS * 256;
    const size_t tot_ = (size_t)NTOK * 64, str_ = (size_t)GDIM * 256;
    for (size_t i = (size_t)BIDX * 256 + tid; i < tot_; i += 4 * str_) {
      float4 v4[4];
#pragma unroll
      for (int k = 0; k < 4; ++k) {
        const size_t ii = i + k * str_ < tot_ ? i + k * str_ : i, e = ii * 4;
        v4[k] = e < (size_t)TP * 256 ? *(const float4*)(pp + e) : *(const float4*)(ps + (e - (size_t)TP * 256));
      }
#pragma unroll
      for (int k = 0; k < 4; ++k)
        if (i + k * str_ < tot_) *(uint2*)(PLEB + (i + k * str_) * 4) = make_uint2(pack2(v4[k].x, v4[k].y), pack2(v4[k].z, v4[k].w));
    }
  }
  {
    float* tile = (float*)smem;
    bf16_t* WE = (bf16_t*)(WSB + O_WE);
    CMap cm{0};
    for (int t = BIDX; t < 96 * 128; t += GDIM) {
      const int mat = t >> 7, tt = t & 127, kind = mat >> 5, e = mat & 31;
      const float* src = PIN(kind == 0 ? I_WE1 : (kind == 1 ? I_WE3 : I_WE2)) + ((size_t)l * 32 + e) * 524288;
      bf16_t* dst = WE + ((size_t)kind * 32 + e) * 524288;
      if (kind < 2) transpose_tile(TIDX, BIDX, GDIM, src, 512, 1024, dst, (tt & 15) * 64, (tt >> 4) * 64, cm, nullptr, tile);
      else transpose_tile(TIDX, BIDX, GDIM, src, 1024, 512, dst, (tt & 7) * 64, (tt >> 3) * 64, cm, nullptr, tile);
    }
  }
}

DEVI int moe_table(const int TIDX, const int BIDX, const int GDIM, KAP KA, unsigned char* WSB, float* OUTB, int l, int* tstart  ) {
  if (TIDX == 0) {
    const int* cnt = (const int*)(WSB + O_CNT) + 1024 + l * 1024;
    int acc = 0;
    for (int e = 0; e < 32; ++e) { tstart[e] = acc; acc += (cnt[e * 32] + 127) >> 7; }
    tstart[32] = acc;
  }
  __syncthreads();
  return tstart[32];
}
DEVI int moe_find(const int* tstart, int mt) {
  int e = 0;
  for (int i = 1; i < 32; ++i) if (mt >= tstart[i]) e = i;
  return e;
}
struct RowGather {
  const unsigned char* base; const int* ltok; int pos0; int cnt;
  DEVI uint32_t operator()(int r) const {
    const int pos = pos0 + r;
    return pos < cnt ? (uint32_t)(ltok[pos] >> 1) * 2048u : (uint32_t)NTOK * 2048u;
  }
};

DEVI void phase_p8(const int TIDX, const int BIDX, const int GDIM, KAP KA, unsigned char* WSB, float* OUTB, int l, unsigned char* smem) {
  int* tstart = (int*)(smem + SMEM_GEMM + 1024 + 64);
  const int NT = moe_table(TIDX, BIDX, GDIM, KA, WSB, OUTB, l, tstart);
  const bf16_t* XB = (const bf16_t*)(WSB + O_XB);
  const bf16_t* WE = (const bf16_t*)(WSB + O_WE);
  bf16_t* H = (bf16_t*)(WSB + O_H);
  const int* cnt = (const int*)(WSB + O_CNT) + 1024 + l * 1024;
  const int* ltok = (const int*)(WSB + O_LTOK);
  for (int item = (BIDX & 7) * (GDIM >> 3) + (BIDX >> 3); item < NT * 4; item += GDIM) {
    const int mt = item >> 2, nt = item & 3, e = moe_find(tstart, mt), lt = mt - tstart[e];
    RowGather rg{(const unsigned char*)XB, ltok + (size_t)e * NTOK, lt * 128, cnt[e * 32]};
    f32x4 acc[4][4];
    uint2 sg[4][4];
    zero_acc(acc);
    gemm_main<true>(TIDX, BIDX, GDIM, acc, rg, WE + ((size_t)e * 512 + nt * 128) * 1024, 1024, 1024, smem);
#pragma unroll
    for (int i = 0; i < 4; ++i)
#pragma unroll
      for (int j = 0; j < 4; ++j) sg[i][j] = make_uint2(pack2(siluf_(acc[i][j][0]), siluf_(acc[i][j][1])), pack2(siluf_(acc[i][j][2]), siluf_(acc[i][j][3])));
    zero_acc(acc);
    gemm_main<true>(TIDX, BIDX, GDIM, acc, rg, WE + ((size_t)(32 + e) * 512 + nt * 128) * 1024, 1024, 1024, smem);
    EPI_SWAP_BEGIN(mt * 128, nt * 128)
      const f32x4 a = acc[mi][ni];
      const uint2 g = sg[mi][ni];
      *(uint2*)(H + (size_t)row * 512 + col) = make_uint2(pack2(a[0] * lo2f(g.x), a[1] * hi2f(g.x)), pack2(a[2] * lo2f(g.y), a[3] * hi2f(g.y)));
    EPI_END
  }
  {
    const bf16_t* W = (const bf16_t*)(WSB + O_WS) + (size_t)l * WO_END;
    float* PRE = (float*)(WSB + O_PRE);
    for (int item = (BIDX & 7) * (GDIM >> 3) + (BIDX >> 3); item < 516 * 8; item += GDIM) {
      const int mt = item >> 3, nt = item & 7, m0 = mt * 128, n0 = nt * 128;
      f32x4 acc[4][4];
      uint2 gp[4][4];
      zero_acc(acc);
      RowLin rx{(const unsigned char*)(XB + (size_t)m0 * 1024), 2048};
      gemm_main<true>(TIDX, BIDX, GDIM, acc, rx, W + WO_PG + (size_t)n0 * 1024, 1024, 1024, smem);
#pragma unroll
      for (int i = 0; i < 4; ++i)
#pragma unroll
        for (int j = 0; j < 4; ++j) gp[i][j] = make_uint2(pack2(sigmoidf_(acc[i][j][0]), sigmoidf_(acc[i][j][1])), pack2(sigmoidf_(acc[i][j][2]), sigmoidf_(acc[i][j][3])));
      zero_acc(acc);
      RowLin rpl{(const unsigned char*)((const bf16_t*)(WSB + O_YM) + (size_t)m0 * 256), 512};
      gemm_main<true>(TIDX, BIDX, GDIM, acc, rpl, W + WO_PLE + (size_t)n0 * 256, 256, 256, smem);
      EPI_SWAP_BEGIN(m0, n0)
        const f32x4 a = acc[mi][ni];
        const uint2 g = gp[mi][ni];
        *(uint2*)((bf16_t*)PRE + (size_t)row * 1024 + col) = make_uint2(pack2(a[0] * lo2f(g.x), a[1] * hi2f(g.x)), pack2(a[2] * lo2f(g.y), a[3] * hi2f(g.y)));
      EPI_END
    }
  }
}

DEVI void phase_p9(const int TIDX, const int BIDX, const int GDIM, KAP KA, unsigned char* WSB, float* OUTB, int l, unsigned char* smem) {
  int* tstart = (int*)(smem + SMEM_GEMM + 1024 + 64);
  const int NT = moe_table(TIDX, BIDX, GDIM, KA, WSB, OUTB, l, tstart);
  const bf16_t* WE = (const bf16_t*)(WSB + O_WE) + 64ull * 524288;
  const bf16_t* H = (const bf16_t*)(WSB + O_H);
  bf16_t* YM = (bf16_t*)(WSB + O_YM);
  const int* cnt = (const int*)(WSB + O_CNT) + 1024 + l * 1024;
  const int* ltok = (const int*)(WSB + O_LTOK);
  const float* lw = (const float*)(WSB + O_LW);
  for (int item = (BIDX & 7) * (GDIM >> 3) + (BIDX >> 3); item < NT * 8; item += GDIM) {
    const int mt = item >> 3, nt = item & 7, e = moe_find(tstart, mt), lt = mt - tstart[e], ce = cnt[e * 32];
    f32x4 acc[4][4];
    zero_acc(acc);
    RowLin rp{(const unsigned char*)(H + (size_t)mt * 128 * 512), 1024};
    gemm_main<true>(TIDX, BIDX, GDIM, acc, rp, WE + ((size_t)e * 1024 + nt * 128) * 512, 512, 512, smem);
    EPI_SWAP_BEGIN(0, nt * 128)
      const int pos = lt * 128 + row;
      if (pos < ce) {
        const int tk = ltok[(size_t)e * NTOK + pos];
        const float wt = lw[(size_t)e * NTOK + pos];
        const f32x4 a = acc[mi][ni] * wt;
        *(uint2*)(YM + (size_t)tk * 1024 + col) = make_uint2(pack2(a[0], a[1]), pack2(a[2], a[3]));
      }
    EPI_END
  }
}

DEVI void phase_p10(const int TIDX, const int BIDX, const int GDIM, KAP KA, unsigned char* WSB, float* OUTB, int l) {
  const int tid = TIDX, lane = tid & 63;
  const float* PRE = (const float*)(WSB + O_PRE);
  const bf16_t* YM = (const bf16_t*)(WSB + O_YM);
  bf16_t* XB = (bf16_t*)(WSB + O_XB);
  const float* g2 = PIN(I_LN2G) + l * 1024; const float* b2 = PIN(I_LN2B) + l * 1024;
  const int wid = BIDX * 4 + (tid >> 6), nw = GDIM * 4;
  for (int row = wid; row < NTOK; row += 2 * nw) {
    const bool hb = row + nw < NTOK;
    const int rws[2] = {row, hb ? row + nw : row};
    float4 v[2][4];
    uint2 y0[2][4], y1[2][4];
#pragma unroll
    for (int k = 0; k < 2; ++k)
#pragma unroll
      for (int j = 0; j < 4; ++j) {
        v[k][j] = resid_plus(*(const uint2*)(XB + (size_t)rws[k] * 1024 + j * 256 + lane * 4), *(const uint2*)((const bf16_t*)PRE + (size_t)rws[k] * 1024 + j * 256 + lane * 4));
        y0[k][j] = *(const uint2*)(YM + (size_t)rws[k] * 2048 + j * 256 + lane * 4);
        y1[k][j] = *(const uint2*)(YM + (size_t)rws[k] * 2048 + 1024 + j * 256 + lane * 4);
      }
#pragma unroll
    for (int k = 0; k < 2; ++k) {
      if (k == 0 || hb) {
#pragma unroll
        for (int j = 0; j < 4; ++j) {
          v[k][j].x += lo2f(y0[k][j].x) + lo2f(y1[k][j].x); v[k][j].y += hi2f(y0[k][j].x) + hi2f(y1[k][j].x);
          v[k][j].z += lo2f(y0[k][j].y) + lo2f(y1[k][j].y); v[k][j].w += hi2f(y0[k][j].y) + hi2f(y1[k][j].y);
        }
        ln_inplace(v[k], g2, b2, lane);
        const size_t r = (size_t)rws[k];
        if (l == 0) store_row(v[k], OUTB + r * 1024, XB + r * 1024, lane);
        else {
#pragma unroll
          for (int j = 0; j < 4; ++j) *(float4*)(OUTB + r * 1024 + j * 256 + lane * 4) = v[k][j];
        }
      }
    }
  }
}

DEVI void* launder_ptr(const void* q) {
  uint32_t lo = (uint32_t)(uintptr_t)q, hi = (uint32_t)((uintptr_t)q >> 32);
  asm volatile("" : "+v"(lo), "+v"(hi));
  lo = __builtin_amdgcn_readfirstlane(lo);
  hi = __builtin_amdgcn_readfirstlane(hi);
  return (void*)(((uintptr_t)hi << 32) | lo);
}
DEVI void grid_barrier(const int TIDX, const int BIDX, const int GDIM, unsigned* bar, unsigned k) {
  __syncthreads();
  if (TIDX == 0) {
    __threadfence();
    const unsigned g = (unsigned)BIDX & 7u, gs = (unsigned)GDIM >> 3;
    const unsigned old = __hip_atomic_fetch_add(bar + 32 * (1 + g), 1u, __ATOMIC_RELAXED, __HIP_MEMORY_SCOPE_AGENT);
    if (old + 1u == gs * k) {
      __threadfence();
      __hip_atomic_fetch_add(bar, 1u, __ATOMIC_RELAXED, __HIP_MEMORY_SCOPE_AGENT);
    }
    unsigned spins = 0;
    while (__hip_atomic_load(bar, __ATOMIC_RELAXED, __HIP_MEMORY_SCOPE_AGENT) < 8u * k) {
      __builtin_amdgcn_s_sleep(1);
      if (++spins > (1u << 27)) break;
    }
    __threadfence();
  }
  __syncthreads();
}
__global__ void __launch_bounds__(256, 2) mega(Params p, int ph0, int ph1) {
  __shared__ __attribute__((aligned(16))) unsigned char smem[SMEM_TOTAL];
  const int wave_in_block = __builtin_amdgcn_readfirstlane((int)(__builtin_amdgcn_workitem_id_x() >> 6));
  for (int ph = ph0; ph < ph1; ++ph) {
    int wv_ = wave_in_block;
    asm volatile("" : "+s"(wv_));
    int TIDX = wv_ * 64 + (int)__lane_id();
    asm volatile("" : "+v"(TIDX));
    int BIDX = __builtin_amdgcn_workgroup_id_x(), GDIM = (int)gridDim.x;
    asm volatile("" : "+s"(BIDX), "+s"(GDIM));
    KAP KA;
    {
      uintptr_t q = (uintptr_t)__builtin_amdgcn_kernarg_segment_ptr();
      uint32_t lo = (uint32_t)q, hi = (uint32_t)(q >> 32);
      asm volatile("" : "+s"(lo), "+s"(hi));
      KA = (KAP)(((uintptr_t)hi << 32) | lo);
    }
    float* OUTB = (float*)PIN(31);
    unsigned char* WSB = (unsigned char*)PIN(32);
#ifndef PHSEL
#define PHSEL -1
#endif
    if (ph == 0) { if (PHSEL < 0 || PHSEL == 10) phase_prep(TIDX, BIDX, GDIM, KA, WSB, OUTB, smem); }
    else {
      const int l = (ph - 1) / 10, s = (ph - 1) % 10;
      switch (s) {
        case 0: if (PHSEL < 0 || PHSEL == 0) phase_p1(TIDX, BIDX, GDIM, KA, WSB, OUTB, l, smem); break;
        case 1: if (PHSEL < 0 || PHSEL == 1) phase_p2(TIDX, BIDX, GDIM, KA, WSB, OUTB, l, smem); break;
        case 2: if (PHSEL < 0 || PHSEL == 2) phase_p3(TIDX, BIDX, GDIM, KA, WSB, OUTB, l, smem); break;
        case 3: if (PHSEL < 0 || PHSEL == 3) phase_p4(TIDX, BIDX, GDIM, KA, WSB, OUTB, l, smem); break;
        case 4: if (PHSEL < 0 || PHSEL == 4) phase_p5(TIDX, BIDX, GDIM, KA, WSB, OUTB, l, smem); break;
        case 5: if (PHSEL < 0 || PHSEL == 5) phase_p6(TIDX, BIDX, GDIM, KA, WSB, OUTB, l, smem); break;
        case 6: if (PHSEL < 0 || PHSEL == 6) phase_p7(TIDX, BIDX, GDIM, KA, WSB, OUTB, l, smem); break;
        case 7: if (PHSEL < 0 || PHSEL == 7) phase_p8(TIDX, BIDX, GDIM, KA, WSB, OUTB, l, smem); break;
        case 8: if (PHSEL < 0 || PHSEL == 8) phase_p9(TIDX, BIDX, GDIM, KA, WSB, OUTB, l, smem); break;
        default: if (PHSEL < 0 || PHSEL == 9) phase_p10(TIDX, BIDX, GDIM, KA, WSB, OUTB, l); break;
      }
    }
#ifdef PROBE_DUP
    if (ph > 0 && (ph - 1) % 10 == PROBE_DUP) {
      cg::this_grid().sync();
      const int l = (ph - 1) / 10;
      switch (PROBE_DUP) {
        case 0: phase_p1(TIDX, BIDX, GDIM, KA, WSB, OUTB, l, smem); break;
        case 1: phase_p2(TIDX, BIDX, GDIM, KA, WSB, OUTB, l, smem); break;
        case 2: phase_p3(TIDX, BIDX, GDIM, KA, WSB, OUTB, l, smem); break;
        case 3: phase_p4(TIDX, BIDX, GDIM, KA, WSB, OUTB, l, smem, 1); break;
        case 4: phase_p5(TIDX, BIDX, GDIM, KA, WSB, OUTB, l, smem); break;
        case 5: phase_p6(TIDX, BIDX, GDIM, KA, WSB, OUTB, l, smem); break;
        case 7: phase_p8(TIDX, BIDX, GDIM, KA, WSB, OUTB, l, smem); break;
        case 8: phase_p9(TIDX, BIDX, GDIM, KA, WSB, OUTB, l, smem); break;
        case 9: phase_p10(TIDX, BIDX, GDIM, KA, WSB, OUTB, l); break;
        default: break;
      }
    }
#endif
    if (ph + 1 < ph1) {
      if (ph == ph0) cg::this_grid().sync();
      else grid_barrier(TIDX, BIDX, GDIM, (unsigned*)(WSB + O_CNT + 2048), (unsigned)(ph - ph0));
    }
  }
}

#ifndef MK_MULTI
#define MK_MULTI 0
#endif

extern "C" void kernel_launch(void* const* d_in, const int* in_sizes, int n_in, void* d_out, int out_size, void* d_ws, size_t ws_size,
                              hipStream_t stream) {
  static int grid_blocks = 0;
  if (!grid_blocks) {
    int dev = 0, cus = 0, per_cu = 0;
    hipGetDevice(&dev);
    hipDeviceGetAttribute(&cus, hipDeviceAttributeMultiprocessorCount, dev);
    hipOccupancyMaxActiveBlocksPerMultiprocessor(&per_cu, mega, 256, 0);
    if (per_cu > 2) per_cu = 2;
    if (per_cu < 1) per_cu = 1;
    grid_blocks = cus * per_cu;
  }
  Params p{};
  for (int i = 0; i < 31; ++i) p.in[i] = (const float*)d_in[i];
  p.out_ = (float*)d_out;
  p.ws_ = (unsigned char*)d_ws;
  if (ws_size < WS_END) fprintf(stderr, "workspace too small: %zu < %zu\n", ws_size, (size_t)WS_END);
#if MK_MULTI
  for (int ph = 0; ph < 21; ++ph) mega<<<dim3(grid_blocks), dim3(256), 0, stream>>>(p, ph, ph + 1);
#else
  (void)hipMemsetAsync((unsigned char*)d_ws + O_CNT + 2048, 0, 2048, stream);
  int ph0 = 0, ph1 = 21;
  void* args[] = {&p, &ph0, &ph1};
  hipError_t e = hipLaunchCooperativeKernel((void*)mega, dim3(grid_blocks), dim3(256), args, 0, stream);
  if (e != hipSuccess) fprintf(stderr, "cooperative launch failed: %s (grid %d)\n", hipGetErrorString(e), grid_blocks);
#endif
}
```

```cpp
#include <hip/hip_runtime.h>
#include <hip/hip_cooperative_groups.h>
#include <stdint.h>
#include <stdio.h>
namespace cg = cooperative_groups;

#define DEVI __device__ __forceinline__
typedef unsigned short bf16_t;
typedef short bf16x8 __attribute__((ext_vector_type(8)));
typedef float f32x4 __attribute__((ext_vector_type(4)));
typedef float f32x16 __attribute__((ext_vector_type(16)));

constexpr int NTOK = 66048, TP = 65536, TS = 512;
constexpr int NCH = NTOK / 32;
constexpr int KPAD = 4160;
constexpr float DN_ALPHA = 1.4142135623730951f;
constexpr float EPS = 1e-6f;
constexpr float QSCALE = 0.10206207261596575f * 1.4426950408889634f;

constexpr size_t OUT_Y = 0;
constexpr size_t OUT_CKV_P = 67633152ull;
constexpr size_t OUT_KR_P = 101187584ull;
constexpr size_t OUT_ST_P = 105381888ull;
constexpr size_t OUT_CKV_S = 109576192ull;
constexpr size_t OUT_KR_S = 109838336ull;
constexpr size_t OUT_ST_S = 109871104ull;

constexpr size_t WO_IN = 0, WO_G = WO_IN + 2816ull * 1024, WO_UQ = WO_G + 2048ull * 1024, WO_KV = WO_UQ + 768ull * 384,
                 WO_BRA = WO_KV + 1024ull * 256, WO_BRB = WO_BRA + 1024ull * 512, WO_OUT = WO_BRB + 1024ull * 512,
                 WO_PG = WO_OUT + 1024ull * 1024, WO_PLE = WO_PG + 1024ull * 1024, WO_END = WO_PLE + 1024ull * 256;
static_assert(WO_END == 8945664ull, "small weights");

constexpr size_t al(size_t x) { return (x + 255) & ~size_t(255); }
constexpr size_t SZ_XB = (size_t)(NTOK + 1) * 1024 * 2, SZ_LIST = 32ull * NTOK * 4, SZ_KRS = 2ull * 16 * KPAD * 32 * 2,
                 SZ_G = (size_t)NTOK * 512 * 2, SZ_CQ = (size_t)NTOK * 384 * 2, SZ_CKR = (size_t)NTOK * 288 * 4,
                 SZ_FQ = (size_t)NTOK * 1024 * 2, SZ_CKVN = (size_t)NTOK * 256 * 2, SZ_KRB = (size_t)NTOK * 32 * 2,
                 SZ_QB = (size_t)NTOK * 768 * 2, SZ_AM = (size_t)NCH * 4 * 32 * 32 * 2, SZ_EB = (size_t)NCH * 4 * 128 * 4,
                 SZ_VT = 32ull * 8 * 64 * 2048 * 2, SZ_KNS = 16ull * KPAD * 512 * 2, SZ_VTS = 16ull * 8 * 64 * KPAD * 2,
                 SZ_PRE = (size_t)NTOK * 1024 * 4, SZ_WE = 3ull * 32 * 512 * 1024 * 2, SZ_H = 1064ull * 128 * 512 * 2,
                 SZ_YM = (size_t)NTOK * 2 * 1024 * 2;
constexpr size_t O_WS = 0;
constexpr size_t O_WR = O_WS + al(2 * WO_END * 2);
constexpr size_t O_ROPE = O_WR + al(2ull * 36 * 1024 * 4);
constexpr size_t O_CNT = O_ROPE + al(2080ull * 16 * 2 * 4);
constexpr size_t O_XB = O_CNT + 16384;
constexpr size_t O_LTOK = O_XB + al(SZ_XB);
constexpr size_t O_LW = O_LTOK + al(SZ_LIST);
constexpr size_t O_KRS = O_LW + al(SZ_LIST);
constexpr size_t O_G = O_KRS + al(SZ_KRS);
constexpr size_t O_VT2 = O_G + al(SZ_G);
constexpr size_t O_CQ = O_VT2 + al(SZ_G);
constexpr size_t O_CKR = O_CQ + al(SZ_CQ);
constexpr size_t O_FQ = O_CKR + al(SZ_CKR);
constexpr size_t O_CKVN = O_FQ + al(SZ_FQ);
constexpr size_t O_KRB = O_CKVN + al(SZ_CKVN);
constexpr size_t O_QB = O_KRB + al(SZ_KRB);
constexpr size_t O_QT = O_QB + al(SZ_QB);
constexpr size_t O_KHT = O_QT + al(SZ_G);
constexpr size_t O_AM = O_KHT + al(SZ_G);
constexpr size_t O_EB = O_AM + al(SZ_AM);
constexpr size_t O_KN = O_EB + al(SZ_EB);
constexpr size_t O_HO = O_KN + al(SZ_G);
constexpr size_t O_CCB = O_HO + al(SZ_G);
constexpr size_t WS_END = O_CCB + 16ull * 4096 * 256 * 2;
constexpr size_t O_VT = O_CQ;
constexpr size_t O_KNS = O_VT + al(SZ_VT);
constexpr size_t O_VTS = O_KNS + al(SZ_KNS);
constexpr size_t O_AO = O_VTS + al(SZ_VTS);
constexpr size_t O_MG = O_QB;
constexpr size_t O_PRE = O_G;
constexpr size_t O_WE = O_VTS;
constexpr size_t O_H = O_WE + al(SZ_WE);
constexpr size_t O_YM = O_H + al(SZ_H);
static_assert(O_AO + SZ_G <= O_KRB, "AO");
static_assert(O_AO >= O_VTS + SZ_VTS, "AO2");
static_assert(O_MG + SZ_XB <= O_KN, "MG");
static_assert(O_PRE + SZ_PRE <= O_WE, "PRE");
static_assert(O_YM + SZ_YM <= WS_END, "YM");
static_assert(WS_END <= (1ull << 30), "workspace");

struct Params { const float* in[31]; float* out_; unsigned char* ws_; };
typedef const __attribute__((address_space(4))) unsigned char* KAP;
#define PIN(i) (*(const float* const __attribute__((address_space(4)))*)(KA + 8 * (i)))

enum { I_XP = 0, I_XS, I_PP, I_PS, I_CCKV, I_CKR, I_ST, I_LN0G, I_LN0B, I_WIN, I_QN, I_WUQ, I_KVN, I_WUK, I_WUV, I_HGLB, I_HGN,
       I_WBRA, I_WBRB, I_WOUT, I_LN1G, I_LN1B, I_WRG, I_WRE, I_WE1, I_WE3, I_WE2, I_WPLE, I_WPG, I_LN2G, I_LN2B };

DEVI float bf2f(bf16_t h) { return __uint_as_float(((uint32_t)h) << 16); }
DEVI bf16_t f2bf(float f) { uint32_t u = __float_as_uint(f); u += 0x7fffu + ((u >> 16) & 1u); return (bf16_t)(u >> 16); }
typedef float f32x2_t __attribute__((ext_vector_type(2)));
typedef __bf16 bf16x2_t __attribute__((ext_vector_type(2)));
DEVI uint32_t pack2(float lo, float hi) { f32x2_t v = {lo, hi}; bf16x2_t b = __builtin_convertvector(v, bf16x2_t); return __builtin_bit_cast(uint32_t, b); }
DEVI float lo2f(uint32_t u) { return __uint_as_float(u << 16); }
DEVI float hi2f(uint32_t u) { return __uint_as_float(u & 0xffff0000u); }
DEVI float dpp_add_(float v, const int ctrl_sel) {
  const int iv = __float_as_int(v);
  int o;
  if (ctrl_sel == 0) o = __builtin_amdgcn_update_dpp(0, iv, 0xB1, 0xf, 0xf, true);
  else if (ctrl_sel == 1) o = __builtin_amdgcn_update_dpp(0, iv, 0x4E, 0xf, 0xf, true);
  else if (ctrl_sel == 2) o = __builtin_amdgcn_update_dpp(0, iv, 0x141, 0xf, 0xf, true);
  else o = __builtin_amdgcn_update_dpp(0, iv, 0x140, 0xf, 0xf, true);
  return v + __int_as_float(o);
}
DEVI float wave_sum(float v) {
  v = dpp_add_(v, 0);
  v = dpp_add_(v, 1);
  v = dpp_add_(v, 2);
  v = dpp_add_(v, 3);
  const int iv = __float_as_int(v);
  const float r0 = __int_as_float(__builtin_amdgcn_readlane(iv, 0)), r1 = __int_as_float(__builtin_amdgcn_readlane(iv, 16));
  const float r2 = __int_as_float(__builtin_amdgcn_readlane(iv, 32)), r3 = __int_as_float(__builtin_amdgcn_readlane(iv, 48));
  return (r0 + r1) + (r2 + r3);
}
DEVI float sigmoidf_(float x) { return 1.f / (1.f + __expf(-x)); }
DEVI float siluf_(float x) { return x / (1.f + __expf(-x)); }
DEVI f32x4 mfma16(bf16x8 a, bf16x8 b, f32x4 c) { return __builtin_amdgcn_mfma_f32_16x16x32_bf16(a, b, c, 0, 0, 0); }
DEVI f32x16 mfma32(bf16x8 a, bf16x8 b, f32x16 c) { return __builtin_amdgcn_mfma_f32_32x32x16_bf16(a, b, c, 0, 0, 0); }
DEVI bf16x8 mk8(uint32_t a, uint32_t b, uint32_t c, uint32_t d) { uint4 u = make_uint4(a, b, c, d); return *(bf16x8*)&u; }
DEVI bf16x8 mk8(uint2 lo, uint2 hi) { uint4 u = make_uint4(lo.x, lo.y, hi.x, hi.y); return *(bf16x8*)&u; }

constexpr int SMEM_GEMM = 2 * 2 * 128 * 72 * 2;
constexpr int SMEM_TOTAL = SMEM_GEMM + 2048;

template <bool SWAP, class RP>
DEVI void gemm_main(const int TIDX, const int BIDX, const int GDIM, f32x4 (&acc)[4][4], RP rowoff, const bf16_t* __restrict__ Bt, int ldb, int K, unsigned char* smem) {
  int tid = TIDX;
  asm volatile("" : "+v"(tid));
  const int lane = tid & 63, w = tid >> 6, wr = w >> 1, wc = w & 1, li = lane & 15, lg = lane >> 4;
  const unsigned char* abase = rowoff.base;
  const unsigned char* bbase = (const unsigned char*)Bt;
  const uint32_t schunk = (uint32_t)((lane & 7) ^ (((lane >> 4) + 4 * (w & 1)) & 7)) * 16u;
  uint32_t ao0, ao1, ao2, ao3;
  const int rsub = w * 8 + (lane >> 3);
  ao0 = rowoff(rsub) + schunk; ao1 = rowoff(rsub + 32) + schunk; ao2 = rowoff(rsub + 64) + schunk; ao3 = rowoff(rsub + 96) + schunk;
  const uint32_t bo = (uint32_t)(rsub * ldb) * 2u + schunk, bstep = (uint32_t)(32 * ldb) * 2u;
  unsigned char* sbase = smem + w * 1024;
#define GM_STAGE(kt_, buf_)                                                                                                       \
  {                                                                                                                              \
    unsigned char* da_ = sbase + (buf_) * 32768;                                                                                 \
    unsigned char* db_ = da_ + 16384;                                                                                            \
    const uint32_t ko_ = (uint32_t)(kt_) * 128u;                                                                                 \
    __builtin_amdgcn_global_load_lds((const unsigned*)(abase + ao0 + ko_), (unsigned*)(da_), 16, 0, 0);                         \
    __builtin_amdgcn_global_load_lds((const unsigned*)(abase + ao1 + ko_), (unsigned*)(da_ + 4096), 16, 0, 0);                  \
    __builtin_amdgcn_global_load_lds((const unsigned*)(abase + ao2 + ko_), (unsigned*)(da_ + 8192), 16, 0, 0);                  \
    __builtin_amdgcn_global_load_lds((const unsigned*)(abase + ao3 + ko_), (unsigned*)(da_ + 12288), 16, 0, 0);                 \
    __builtin_amdgcn_global_load_lds((const unsigned*)(bbase + bo + ko_), (unsigned*)(db_), 16, 0, 0);                          \
    __builtin_amdgcn_global_load_lds((const unsigned*)(bbase + bo + bstep + ko_), (unsigned*)(db_ + 4096), 16, 0, 0);           \
    __builtin_amdgcn_global_load_lds((const unsigned*)(bbase + bo + 2u * bstep + ko_), (unsigned*)(db_ + 8192), 16, 0, 0);      \
    __builtin_amdgcn_global_load_lds((const unsigned*)(bbase + bo + 3u * bstep + ko_), (unsigned*)(db_ + 12288), 16, 0, 0);     \
  }
  const int nk = K >> 6;
  const int px = lg ^ (li >> 1);
  GM_STAGE(0, 0);
  for (int kt = 0; kt < nk; ++kt) {
    const int buf = kt & 1;
    asm volatile("s_waitcnt vmcnt(0)" ::: "memory");
    __syncthreads();
    if (kt + 1 < nk) GM_STAGE(kt + 1, buf ^ 1);
    const unsigned char* A = smem + buf * 32768 + (wr * 64 + li) * 128;
    const unsigned char* B = smem + buf * 32768 + 16384 + (wc * 64 + li) * 128;
#pragma unroll
    for (int ks = 0; ks < 2; ++ks) {
      const int po = (px ^ (ks * 4)) * 16;
      bf16x8 af[4], bfr[4];
#pragma unroll
      for (int i = 0; i < 4; ++i) {
        af[i] = *(const bf16x8*)(A + i * 2048 + po);
        bfr[i] = *(const bf16x8*)(B + i * 2048 + po);
      }
#pragma unroll
      for (int mi = 0; mi < 4; ++mi)
#pragma unroll
        for (int ni = 0; ni < 4; ++ni)
          acc[mi][ni] = SWAP ? mfma16(bfr[ni], af[mi], acc[mi][ni]) : mfma16(af[mi], bfr[ni], acc[mi][ni]);
    }
  }
  __syncthreads();
}
DEVI float zero_f() { float z = 0.f; asm volatile("" : "+v"(z)); return z; }
DEVI void zero_acc(f32x4 (&acc)[4][4]) {
  const float z = zero_f();
#pragma unroll
  for (int i = 0; i < 4; ++i)
#pragma unroll
    for (int j = 0; j < 4; ++j) acc[i][j] = (f32x4){z, z, z, z};
}
#define EPI_SWAP_BEGIN(m0, n0)                                                                     \
  {                                                                                                \
    const int _lane = TIDX & 63, _w = TIDX >> 6;                                     \
    const int _rb = (m0) + (_w >> 1) * 64 + (_lane & 15), _cb = (n0) + (_w & 1) * 64 + 4 * (_lane >> 4); \
    _Pragma("unroll") for (int mi = 0; mi < 4; ++mi) {                                             \
      const int row = _rb + mi * 16;                                                               \
      _Pragma("unroll") for (int ni = 0; ni < 4; ++ni) {                                           \
        const int col = _cb + ni * 16;
#define EPI_END } __builtin_amdgcn_sched_barrier(0); } }

struct RowLin {
  const unsigned char* base; uint32_t stride;
  DEVI uint32_t operator()(int r) const { return (uint32_t)r * stride; }
};

struct CMap {
  int mode;
  DEVI int operator()(int n) const {
    if (mode == 0) return n;
    if (mode == 1) return n < 672 ? n : (n < 768 ? -1 : n - 96);
    if (mode == 2) return n + 2720;
    if (n < 512) return (n >> 6) * 96 + (n & 63);
    const int m = n - 512, h = m >> 5, w = m & 31;
    return h * 96 + (w < 16 ? 64 + w : 80 + (w - 16));
  }
};
DEVI void transpose_tile(const int TIDX, const int BIDX, const int GDIM, const float* __restrict__ src, int ld, int K, bf16_t* __restrict__ dst, int k0, int n0, CMap cm,
                         const float* kscale, float* tile) {
  const int t = TIDX;
  {
    const int n4 = (t & 15) * 4, kr = t >> 4;
    const int sc = cm(n0 + n4);
#pragma unroll
    for (int p = 0; p < 4; ++p) {
      const int k = kr + 16 * p;
      float4 v = make_float4(0.f, 0.f, 0.f, 0.f);
      if (sc >= 0) {
        v = *(const float4*)(src + (size_t)(k0 + k) * ld + sc);
        if (kscale) { const float sck = kscale[k0 + k]; v.x *= sck; v.y *= sck; v.z *= sck; v.w *= sck; }
      }
      float* d = tile + k * 65 + n4;
      d[0] = v.x; d[1] = v.y; d[2] = v.z; d[3] = v.w;
    }
  }
  __syncthreads();
  {
    const int kc = (t & 7) * 8, nr = t >> 3;
#pragma unroll
    for (int q = 0; q < 2; ++q) {
      const int n = nr + 32 * q;
      const float* sp = tile + kc * 65 + n;
      const uint4 o = make_uint4(pack2(sp[0], sp[65]), pack2(sp[130], sp[195]), pack2(sp[260], sp[325]), pack2(sp[390], sp[455]));
      *(uint4*)(dst + (size_t)(n0 + n) * K + k0 + kc) = o;
    }
  }
  __syncthreads();
}
DEVI void run_transpose(const int TIDX, const int BIDX, const int GDIM, const float* src, int ld, int K, int N, bf16_t* dst, int mode, const float* kscale, float* tile) {
  const int nkt = K >> 6, tiles = nkt * (N >> 6);
  CMap cm{mode};
  for (int t = BIDX; t < tiles; t += GDIM) transpose_tile(TIDX, BIDX, GDIM, src, ld, K, dst, (t % nkt) * 64, (t / nkt) * 64, cm, kscale, tile);
}

DEVI void ln_inplace(float4 (&v)[4], const float* __restrict__ g, const float* __restrict__ b, int lane) {
  float s = 0.f;
#pragma unroll
  for (int j = 0; j < 4; ++j) s += v[j].x + v[j].y + v[j].z + v[j].w;
  s = wave_sum(s);
  const float mu = s * (1.f / 1024.f);
  float q = 0.f;
#pragma unroll
  for (int j = 0; j < 4; ++j) {
    float a = v[j].x - mu, bq = v[j].y - mu, cq = v[j].z - mu, d = v[j].w - mu;
    q += a * a + bq * bq + cq * cq + d * d;
  }
  q = wave_sum(q);
  const float rs = rsqrtf(q * (1.f / 1024.f) + EPS);
#pragma unroll
  for (int j = 0; j < 4; ++j) {
    const float4 gg = *(const float4*)(g + j * 256 + lane * 4), bb = *(const float4*)(b + j * 256 + lane * 4);
    v[j].x = (v[j].x - mu) * rs * gg.x + bb.x;
    v[j].y = (v[j].y - mu) * rs * gg.y + bb.y;
    v[j].z = (v[j].z - mu) * rs * gg.z + bb.z;
    v[j].w = (v[j].w - mu) * rs * gg.w + bb.w;
  }
}
DEVI void store_row(const float4 (&v)[4], float* x32, bf16_t* x16, int lane) {
#pragma unroll
  for (int j = 0; j < 4; ++j) {
    *(uint2*)(x16 + j * 256 + lane * 4) = make_uint2(pack2(v[j].x, v[j].y), pack2(v[j].z, v[j].w));
  }
}
DEVI float4 resid_plus(const uint2 xb, const uint2 mb) {
  return make_float4(lo2f(xb.x) * DN_ALPHA + lo2f(mb.x), hi2f(xb.x) * DN_ALPHA + hi2f(mb.x), lo2f(xb.y) * DN_ALPHA + lo2f(mb.y), hi2f(xb.y) * DN_ALPHA + hi2f(mb.y));
}
DEVI int pos_index(int row) { return row < TP ? (row & 2047) : 2048 + ((row - TP) & 31); }

DEVI void phase_prep(const int TIDX, const int BIDX, const int GDIM, KAP KA, unsigned char* WSB, float* OUTB, unsigned char* smem) {
  float* tile = (float*)smem;
  bf16_t* WS = (bf16_t*)(WSB + O_WS);
  const int tid = TIDX, gtid = BIDX * 256 + tid, gsz = GDIM * 256;
  if (gtid < 512) ((int*)(WSB + O_CNT))[gtid] = 0;
  if (gtid < 64) ((int*)(WSB + O_CNT))[1024 + gtid * 32] = 0;
  if (gtid < 32) ((int*)(WSB + O_CNT))[3072 + (gtid >> 1) * 32 + (gtid & 1) * 16] = 0;
  if (gtid < 512) ((uint32_t*)(WSB + O_XB + (size_t)NTOK * 2048))[gtid] = 0u;
  for (int i = gtid; i < 2080 * 16; i += gsz) {
    const int pi = i >> 4, k = i & 15;
    const int pos = pi < 2048 ? pi : 4096 + (pi - 2048);
    const float inv = exp2f(-(float)k * (13.287712379549449f / 16.f));
    const float ang = (float)pos * inv;
    double rev = (double)ang * 0.15915494309189535;
    rev -= __builtin_rint(rev);
    const float fr = (float)rev;
    float2 cs = make_float2(__builtin_amdgcn_cosf(fr), __builtin_amdgcn_sinf(fr));
    ((float2*)(WSB + O_ROPE))[i] = cs;
  }
  for (int i = gtid; i < 2 * 36 * 1024; i += gsz) {
    const int l = i / (36 * 1024), r = i % (36 * 1024), c = r >> 10, k = r & 1023;
    float v = c < 4 ? PIN(I_WRG)[((size_t)l * 1024 + k) * 4 + c] : PIN(I_WRE)[((size_t)l * 1024 + k) * 32 + (c - 4)];
    ((float*)(WSB + O_WR))[i] = v;
  }
  for (int i = gtid; i < 2 * 16 * 4096 * 8; i += gsz) {
    const int e = i * 4, lb = e / (4096 * 32), r = e % (4096 * 32);
    const float4 v = *(const float4*)(PIN(I_CKR) + (size_t)e);
    *(uint2*)((bf16_t*)(WSB + O_KRS) + (size_t)lb * KPAD * 32 + r) = make_uint2(pack2(v.x, v.y), pack2(v.z, v.w));
  }
  {
    const int lane = tid & 63, wid = BIDX * 4 + (tid >> 6), nw = GDIM * 4;
    for (int row = wid; row < NTOK; row += 2 * nw) {
      const bool hb = row + nw < NTOK;
      const int rws[2] = {row, hb ? row + nw : row};
      float4 v[2][4];
#pragma unroll
      for (int k = 0; k < 2; ++k) {
        const float* src = rws[k] < TP ? PIN(I_XP) + (size_t)rws[k] * 1024 : PIN(I_XS) + (size_t)(rws[k] - TP) * 1024;
#pragma unroll
        for (int j = 0; j < 4; ++j) v[k][j] = *(const float4*)(src + j * 256 + lane * 4);
      }
#pragma unroll
      for (int k = 0; k < 2; ++k) {
        if (k == 0 || hb) {
          ln_inplace(v[k], PIN(I_LN0G), PIN(I_LN0B), lane);
          store_row(v[k], OUTB + (size_t)rws[k] * 1024, (bf16_t*)(WSB + O_XB) + (size_t)rws[k] * 1024, lane);
        }
      }
    }
  }
  for (int l = 0; l < 2; ++l) {
    bf16_t* W = WS + (size_t)l * WO_END;
    run_transpose(TIDX, BIDX, GDIM, PIN(I_WIN) + (size_t)l * 1024 * 4768, 4768, 1024, 2816, W + WO_IN, 1, nullptr, tile);
    run_transpose(TIDX, BIDX, GDIM, PIN(I_WIN) + (size_t)l * 1024 * 4768, 4768, 1024, 2048, W + WO_G, 2, nullptr, tile);
    run_transpose(TIDX, BIDX, GDIM, PIN(I_WUQ) + (size_t)l * 384 * 768, 768, 384, 768, W + WO_UQ, 3, PIN(I_QN) + l * 384, tile);
    run_transpose(TIDX, BIDX, GDIM, PIN(I_WUK) + (size_t)l * 256 * 512, 512, 256, 512, W + WO_KV, 0, nullptr, tile);
    run_transpose(TIDX, BIDX, GDIM, PIN(I_WUV) + (size_t)l * 256 * 512, 512, 256, 512, W + WO_KV + 512 * 256, 0, nullptr, tile);
    run_transpose(TIDX, BIDX, GDIM, PIN(I_WBRA) + (size_t)l * 512 * 1024, 1024, 512, 1024, W + WO_BRA, 0, nullptr, tile);
    run_transpose(TIDX, BIDX, GDIM, PIN(I_WBRB) + (size_t)l * 512 * 1024, 1024, 512, 1024, W + WO_BRB, 0, nullptr, tile);
    run_transpose(TIDX, BIDX, GDIM, PIN(I_WOUT) + (size_t)l * 1024 * 1024, 1024, 1024, 1024, W + WO_OUT, 0, nullptr, tile);
    run_transpose(TIDX, BIDX, GDIM, PIN(I_WPG) + (size_t)l * 1024 * 1024, 1024, 1024, 1024, W + WO_PG, 0, nullptr, tile);
    run_transpose(TIDX, BIDX, GDIM, PIN(I_WPLE) + (size_t)l * 256 * 1024, 1024, 256, 1024, W + WO_PLE, 0, nullptr, tile);
  }
}

DEVI void phase_p1(const int TIDX, const int BIDX, const int GDIM, KAP KA, unsigned char* WSB, float* OUTB, int l, unsigned char* smem) {
  const bf16_t* XB = (const bf16_t*)(WSB + O_XB);
  const bf16_t* W = (const bf16_t*)(WSB + O_WS) + (size_t)l * WO_END + WO_IN;
  bf16_t* CQ = (bf16_t*)(WSB + O_CQ);
  float* CKR = (float*)(WSB + O_CKR);
  bf16_t* FQ = (bf16_t*)(WSB + O_FQ);
  bf16_t* VT2 = (bf16_t*)(WSB + O_VT2);
  bf16_t* G = (bf16_t*)(WSB + O_G);
  for (int item = (BIDX & 7) * (GDIM >> 3) + (BIDX >> 3); item < 516 * 22; item += GDIM) {
    const int mt = item / 22, nt = item % 22, m0 = mt * 128;
    f32x4 acc[4][4];
    zero_acc(acc);
    RowLin rp{(const unsigned char*)(XB + (size_t)m0 * 1024), 2048};
    if (nt >= 14 && nt < 18) {
      gemm_main<false>(TIDX, BIDX, GDIM, acc, rp, W + (size_t)nt * 128 * 1024, 1024, 1024, smem);
      const int h = nt - 14, lane = TIDX & 63, w = TIDX >> 6;
      const int rb = m0 + (w >> 1) * 64 + 4 * (lane >> 4), cb = (w & 1) * 64 + (lane & 15);
#pragma unroll
      for (int mi = 0; mi < 4; ++mi) {
        const int row = rb + mi * 16, ch = row >> 5, s = row & 31;
#pragma unroll
        for (int ni = 0; ni < 4; ++ni) {
          const int dv = cb + ni * 16;
          const f32x4 a = acc[mi][ni];
          *(uint2*)(VT2 + ((size_t)(ch * 4 + h) * 128 + dv) * 32 + s) = make_uint2(pack2(a[0], a[1]), pack2(a[2], a[3]));
        }
      }
    } else {
      gemm_main<true>(TIDX, BIDX, GDIM, acc, rp, W + (size_t)nt * 128 * 1024, 1024, 1024, smem);
      EPI_SWAP_BEGIN(m0, 0)
        const f32x4 a = acc[mi][ni];
        if (nt < 3) {
          *(uint2*)(CQ + (size_t)row * 384 + nt * 128 + col) = make_uint2(pack2(a[0], a[1]), pack2(a[2], a[3]));
        } else if (nt < 5) {
          *(f32x4*)(CKR + (size_t)row * 288 + (nt - 3) * 128 + col) = a;
        } else if (nt == 5) {
          if (col < 32) *(f32x4*)(CKR + (size_t)row * 288 + 256 + col) = a;
        } else if (nt < 14) {
          *(uint2*)(FQ + (size_t)row * 1024 + (nt - 6) * 128 + col) = make_uint2(pack2(a[0], a[1]), pack2(a[2], a[3]));
        } else {
          *(uint2*)(G + (size_t)row * 512 + (nt - 18) * 128 + col) = make_uint2(pack2(a[0], a[1]), pack2(a[2], a[3]));
        }
      EPI_END
    }
  }
}

DEVI void phase_p2(const int TIDX, const int BIDX, const int GDIM, KAP KA, unsigned char* WSB, float* OUTB, int l, unsigned char* smem) {
  const int tid = TIDX, lane = tid & 63;
  const float2* ROPE = (const float2*)(WSB + O_ROPE);
  {
    const bf16_t* CQ = (const bf16_t*)(WSB + O_CQ);
    const bf16_t* W = (const bf16_t*)(WSB + O_WS) + (size_t)l * WO_END + WO_UQ;
    bf16_t* QB = (bf16_t*)(WSB + O_QB);
    float* srow = (float*)(smem + SMEM_GEMM);
    for (int item = (BIDX & 7) * (GDIM >> 3) + (BIDX >> 3); item < 516 * 6; item += GDIM) {
      const int mt = item / 6, nt = item % 6, m0 = mt * 128;
      {
        const int r = tid >> 1, hf = tid & 1;
        const uint4* s = (const uint4*)(CQ + (size_t)(m0 + r) * 384 + hf * 192);
        float ss = 0.f;
#pragma unroll 4
        for (int j = 0; j < 24; ++j) {
          const uint4 u = s[j];
          float a;
          a = lo2f(u.x); ss += a * a; a = hi2f(u.x); ss += a * a;
          a = lo2f(u.y); ss += a * a; a = hi2f(u.y); ss += a * a;
          a = lo2f(u.z); ss += a * a; a = hi2f(u.z); ss += a * a;
          a = lo2f(u.w); ss += a * a; a = hi2f(u.w); ss += a * a;
        }
        ss += __shfl_xor(ss, 1);
        if (hf == 0) srow[r] = rsqrtf(ss * (1.f / 384.f) + EPS) * QSCALE;
      }
      f32x4 acc[4][4];
      zero_acc(acc);
      RowLin rp{(const unsigned char*)(CQ + (size_t)m0 * 384), 768};
      gemm_main<true>(TIDX, BIDX, GDIM, acc, rp, W + (size_t)nt * 128 * 384, 384, 384, smem);
      if (nt < 4) {
        EPI_SWAP_BEGIN(m0, nt * 128)
          const float sc = srow[row - m0];
          const f32x4 a = acc[mi][ni] * sc;
          const int hh = col >> 6, d = col & 63;
          *(uint2*)(QB + (size_t)row * 768 + hh * 96 + d) = make_uint2(pack2(a[0], a[1]), pack2(a[2], a[3]));
        EPI_END
      } else {
        const int w = tid >> 6;
        const int rb = m0 + (w >> 1) * 64 + (lane & 15), i0 = 4 * (lane >> 4);
#pragma unroll
        for (int mi = 0; mi < 4; ++mi) {
          const int row = rb + mi * 16;
          const float sc = srow[row - m0];
          const float2* rt = ROPE + (size_t)pos_index(row) * 16 + i0;
#pragma unroll
          for (int pr = 0; pr < 2; ++pr) {
            const int hh = (nt - 4) * 4 + (w & 1) * 2 + pr;
            const f32x4 x1 = acc[mi][2 * pr] * sc, x2 = acc[mi][2 * pr + 1] * sc;
            float o1[4], o2[4];
#pragma unroll
            for (int r = 0; r < 4; ++r) {
              const float2 cs = rt[r];
              o1[r] = x1[r] * cs.x - x2[r] * cs.y;
              o2[r] = x2[r] * cs.x + x1[r] * cs.y;
            }
            *(uint2*)(QB + (size_t)row * 768 + hh * 96 + 64 + i0) = make_uint2(pack2(o1[0], o1[1]), pack2(o1[2], o1[3]));
            *(uint2*)(QB + (size_t)row * 768 + hh * 96 + 80 + i0) = make_uint2(pack2(o2[0], o2[1]), pack2(o2[2], o2[3]));
          }
        }
      }
      __syncthreads();
    }
  }
  {
    const bf16_t* FQ = (const bf16_t*)(WSB + O_FQ);
    bf16_t* QT = (bf16_t*)(WSB + O_QT);
    bf16_t* KHT = (bf16_t*)(WSB + O_KHT);
    bf16_t* AM = (bf16_t*)(WSB + O_AM);
    float* EBp = (float*)(WSB + O_EB);
    bf16_t* sQ = (bf16_t*)smem;
    bf16_t* sK = sQ + 32 * 136;
    for (int item = BIDX; item < NCH * 4; item += GDIM) {
      const int ch = item >> 2, h = item & 3, cid = item;
      {
        const int k = tid & 127, half = tid >> 7, colh = h * 128 + k;
        float* sB = (float*)(smem + 2 * 32 * 136 * 2);
        float lb = 0.f;
        if (l == 1) { const float a0 = PIN(I_HGLB)[colh], a1 = PIN(I_HGLB)[512 + colh]; lb = 1.f / (1.f + expf(a0 - a1)); }
        const float oml = 1.f - lb;
        float bt[16], kk[16], qv[16];
        float bl = 0.f;
#pragma unroll
        for (int j = 0; j < 16; ++j) {
          const size_t row = (size_t)ch * 32 + half * 16 + j;
          const float z = bf2f(FQ[row * 1024 + colh]);
          qv[j] = bf2f(FQ[row * 1024 + 512 + colh]);
          const float e = __expf(-z);
          const float inv = __builtin_amdgcn_rcpf(1.f + e);
          const float f = lb + oml * inv;
          kk[j] = oml * e * inv;
          bl += __logf(f);
          bt[j] = bl;
        }
        sB[half * 128 + k] = bl;
        __syncthreads();
        const float b0 = sB[k], b1 = sB[128 + k];
        const float off = half ? b0 : 0.f, bend = b0 + b1;
        uint32_t pk[8];
#pragma unroll
        for (int j = 0; j < 16; ++j) {
          const int t = half * 16 + j;
          const float b = bt[j] + off;
          const float qs = qv[j] * __builtin_amdgcn_rcpf(1.f + __expf(-qv[j]));
          const bf16_t qt = f2bf(qs * __expf(b));
          QT[((size_t)cid * 32 + t) * 128 + k] = qt;
          sQ[t * 136 + k] = qt;
          sK[t * 136 + k] = f2bf(kk[j] * __expf(fminf(-b, 80.f)));
          bt[j] = kk[j] * __expf(bend - b);
        }
#pragma unroll
        for (int j = 0; j < 8; ++j) pk[j] = pack2(bt[2 * j], bt[2 * j + 1]);
        if (half == 0) EBp[(size_t)cid * 128 + k] = __expf(bend);
        uint4* dst = (uint4*)(KHT + ((size_t)cid * 128 + k) * 32 + half * 16);
        dst[0] = make_uint4(pk[0], pk[1], pk[2], pk[3]);
        dst[1] = make_uint4(pk[4], pk[5], pk[6], pk[7]);
      }
      __syncthreads();
      if (tid < 64) {
        const int c = lane & 31, hh = lane >> 5;
        f32x16 am;
        const float zf = zero_f();
#pragma unroll
        for (int r = 0; r < 16; ++r) am[r] = zf;
#pragma unroll
        for (int st = 0; st < 8; ++st) {
          const bf16x8 a = *(const bf16x8*)(sQ + c * 136 + st * 16 + hh * 8);
          const bf16x8 bb = *(const bf16x8*)(sK + c * 136 + st * 16 + hh * 8);
          am = mfma32(a, bb, am);
        }
#pragma unroll
        for (int r = 0; r < 16; ++r) {
          const int t = (r & 3) + 8 * (r >> 2) + 4 * hh;
          AM[((size_t)cid * 32 + t) * 32 + c] = f2bf(c <= t ? am[r] : 0.f);
        }
      }
      __syncthreads();
    }
  }
  {
    const float* src = PIN(I_CCKV) + (size_t)l * 16 * 4096 * 256;
    bf16_t* CCB = (bf16_t*)(WSB + O_CCB);
    const size_t str_ = (size_t)GDIM * 256;
    for (size_t i = (size_t)BIDX * 256 + tid; i < 16ull * 4096 * 64; i += 4 * str_) {
      float4 v4[4];
#pragma unroll
      for (int k = 0; k < 4; ++k) { const size_t ii = i + k * str_ < 16ull * 4096 * 64 ? i + k * str_ : i; v4[k] = *(const float4*)(src + ii * 4); }
#pragma unroll
      for (int k = 0; k < 4; ++k) if (i + k * str_ < 16ull * 4096 * 64) *(uint2*)(CCB + (i + k * str_) * 4) = make_uint2(pack2(v4[k].x, v4[k].y), pack2(v4[k].z, v4[k].w));
    }
  }
  {
    const float* CKR = (const float*)(WSB + O_CKR);
    bf16_t* CKVN = (bf16_t*)(WSB + O_CKVN);
    bf16_t* KRB = (bf16_t*)(WSB + O_KRB);
    bf16_t* KRS = (bf16_t*)(WSB + O_KRS) + (size_t)l * 16 * KPAD * 32;
    const float* kvn = PIN(I_KVN) + l * 256;
    const int wid = BIDX * 4 + (tid >> 6), nw = GDIM * 4;
    const float4 g = *(const float4*)(kvn + lane * 4);
    for (int row0 = wid; row0 < NTOK; row0 += 4 * nw) {
      int rws[4]; bool ok4[4];
      float4 v[4]; float x1[4], x2[4]; float2 cs[4];
#pragma unroll
      for (int k = 0; k < 4; ++k) {
        ok4[k] = row0 + k * nw < NTOK;
        rws[k] = ok4[k] ? row0 + k * nw : row0;
        const float* src = CKR + (size_t)rws[k] * 288;
        v[k] = *(const float4*)(src + lane * 4);
        x1[k] = src[256 + (lane & 15)]; x2[k] = src[272 + (lane & 15)];
        cs[k] = ROPE[(size_t)pos_index(rws[k]) * 16 + (lane & 15)];
      }
#pragma unroll
      for (int k = 0; k < 4; ++k) {
        if (ok4[k]) {
          const int row = rws[k];
          float ss = wave_sum(v[k].x * v[k].x + v[k].y * v[k].y + v[k].z * v[k].z + v[k].w * v[k].w);
          const float rs = rsqrtf(ss * (1.f / 256.f) + EPS);
          const float4 o = make_float4(v[k].x * rs * g.x, v[k].y * rs * g.y, v[k].z * rs * g.z, v[k].w * rs * g.w);
          float* oc = row < TP ? OUTB + OUT_CKV_P + ((size_t)l * TP + row) * 256 : OUTB + OUT_CKV_S + ((size_t)l * TS + (row - TP)) * 256;
          *(float4*)(oc + lane * 4) = o;
          *(uint2*)(CKVN + (size_t)row * 256 + lane * 4) = make_uint2(pack2(o.x, o.y), pack2(o.z, o.w));
          if (lane < 16) {
            const float o1 = x1[k] * cs[k].x - x2[k] * cs[k].y, o2 = x2[k] * cs[k].x + x1[k] * cs[k].y;
            float* okp = row < TP ? OUTB + OUT_KR_P + ((size_t)l * TP + row) * 32 : OUTB + OUT_KR_S + ((size_t)l * TS + (row - TP)) * 32;
            okp[lane] = o1;
            okp[16 + lane] = o2;
            bf16_t* kb = row < TP ? KRB + (size_t)row * 32 : KRS + ((size_t)((row - TP) >> 5) * KPAD + 4096 + ((row - TP) & 31)) * 32;
            kb[lane] = f2bf(o1);
            kb[16 + lane] = f2bf(o2);
          }
        }
      }
    }
  }
}

DEVI void phase_p3(const int TIDX, const int BIDX, const int GDIM, KAP KA, unsigned char* WSB, float* OUTB, int l, unsigned char* smem) {
  const bf16_t* W = (const bf16_t*)(WSB + O_WS) + (size_t)l * WO_END + WO_KV;
  const bf16_t* CKVN = (const bf16_t*)(WSB + O_CKVN);
  bf16_t* KN = (bf16_t*)(WSB + O_KN);
  bf16_t* VT = (bf16_t*)(WSB + O_VT);
  bf16_t* KNS = (bf16_t*)(WSB + O_KNS);
  bf16_t* VTS = (bf16_t*)(WSB + O_VTS);
  const bf16_t* cache = (const bf16_t*)(WSB + O_CCB);
  for (int i = BIDX * 256 + TIDX; i < 16 * 8 * 64 * 4; i += GDIM * 256) {
    const uint32_t z = __float_as_uint(zero_f());
    *(uint4*)(VTS + (size_t)(i >> 2) * KPAD + 4128 + (i & 3) * 8) = make_uint4(z, z, z, z);
  }
  for (int item = (BIDX & 7) * (GDIM >> 3) + (BIDX >> 3); item < (516 + 512) * 8; item += GDIM) {
    const int mt = item >> 3, nt = item & 7;
    const bool is_cache = mt >= 516;
    const int m0 = is_cache ? (mt - 516) * 128 : mt * 128;
    f32x4 acc[4][4];
    zero_acc(acc);
    bf16_t* kdst; bf16_t* vdst; size_t ldv; int key0;
    if (is_cache) { const int b = m0 >> 12; key0 = m0 & 4095; kdst = KNS + ((size_t)b * KPAD + key0) * 512; vdst = VTS + (size_t)b * 8 * 64 * KPAD; ldv = KPAD; }
    else if (m0 >= TP) { kdst = nullptr; vdst = nullptr; ldv = KPAD; key0 = 0; }
    else { const int b = m0 >> 11; key0 = m0 & 2047; kdst = KN + (size_t)m0 * 512; vdst = VT + (size_t)b * 8 * 64 * 2048; ldv = 2048; }
    if (nt < 4) {
      if (is_cache) { RowLin rp{(const unsigned char*)(cache + (size_t)m0 * 256), 512}; gemm_main<true>(TIDX, BIDX, GDIM, acc, rp, W + (size_t)nt * 128 * 256, 256, 256, smem); }
      else { RowLin rp{(const unsigned char*)(CKVN + (size_t)m0 * 256), 512}; gemm_main<true>(TIDX, BIDX, GDIM, acc, rp, W + (size_t)nt * 128 * 256, 256, 256, smem); }
      EPI_SWAP_BEGIN(0, nt * 128)
        const f32x4 a = acc[mi][ni];
        bf16_t* d;
        if (kdst) d = kdst + (size_t)row * 512 + col;
        else { const int sr = m0 - TP + row; d = KNS + ((size_t)(sr >> 5) * KPAD + 4096 + (sr & 31)) * 512 + col; }
        *(uint2*)d = make_uint2(pack2(a[0], a[1]), pack2(a[2], a[3]));
      EPI_END
    } else {
      if (is_cache) { RowLin rp{(const unsigned char*)(cache + (size_t)m0 * 256), 512}; gemm_main<false>(TIDX, BIDX, GDIM, acc, rp, W + (size_t)nt * 128 * 256, 256, 256, smem); }
      else { RowLin rp{(const unsigned char*)(CKVN + (size_t)m0 * 256), 512}; gemm_main<false>(TIDX, BIDX, GDIM, acc, rp, W + (size_t)nt * 128 * 256, 256, 256, smem); }
      const int lane = TIDX & 63, w = TIDX >> 6;
      const int rb = (w >> 1) * 64 + 4 * (lane >> 4), cb = (nt - 4) * 128 + (w & 1) * 64 + (lane & 15);
#pragma unroll
      for (int mi = 0; mi < 4; ++mi) {
        const int row = rb + mi * 16;
#pragma unroll
        for (int ni = 0; ni < 4; ++ni) {
          const int hv = cb + ni * 16;
          const f32x4 a = acc[mi][ni];
          bf16_t* d;
          if (vdst) d = vdst + (size_t)hv * ldv + key0 + row;
          else { const int sr = m0 - TP + row; d = VTS + ((size_t)(sr >> 5) * 512 + hv) * KPAD + 4096 + (sr & 31); }
          *(uint2*)d = make_uint2(pack2(a[0], a[1]), pack2(a[2], a[3]));
        }
      }
    }
  }
}

DEVI void attn_item(const int TIDX, const int BIDX, const int GDIM, const bf16_t* __restrict__ Q, int qrow0, int nq, int ng, const bf16_t* __restrict__ Kn, const bf16_t* __restrict__ Kr,
                    const bf16_t* __restrict__ VT, size_t ldv, int nkeys, bf16_t* __restrict__ O, unsigned char* smem) {
  const int tid = TIDX, lane = tid & 63, w = tid >> 6, li = lane & 15, lg = lane >> 4;
  const int ql = 16 * w + li;
  bf16x8 qf[2][3];
  f32x4 oT[2][4];
  float mrun[2], lrun[2];
  const float zf = zero_f();
#pragma unroll
  for (int g = 0; g < 2; ++g) {
    const int qr = qrow0 + (g == 0 ? (ql < nq ? ql : nq - 1) : 64 + ql);
    const int qrc = (g == 1 && ng < 2) ? qrow0 : qr;
#pragma unroll
    for (int ds = 0; ds < 3; ++ds) qf[g][ds] = *(const bf16x8*)(Q + (size_t)qrc * 768 + ds * 32 + lg * 8);
#pragma unroll
    for (int i = 0; i < 4; ++i) oT[g][i] = (f32x4){zf, zf, zf, zf};
    mrun[g] = -INFINITY; lrun[g] = 0.f;
  }
  const int nt = (nkeys + 63) >> 6;
  const int r8 = lane >> 3;
  const uint32_t sch = (uint32_t)((lane & 7) ^ (((lane >> 4) + 4 * (w & 1)) & 7)) * 16u;
  const unsigned char* kn0 = (const unsigned char*)Kn + (size_t)(w * 8 + r8) * 1024 + sch;
  const unsigned char* kr0 = (const unsigned char*)Kr + (size_t)(w * 16 + (lane >> 2)) * 64 + (uint32_t)((lane & 3) ^ (((lane >> 5) & 1) << 1)) * 16u;
  const unsigned char* v0 = (const unsigned char*)VT + (size_t)(w * 8 + r8) * ldv * 2 + sch;
  const size_t v32 = (size_t)32 * ldv * 2;
  unsigned char* sw = smem + w * 1024;
#define ATT_STAGE(kt_)                                                                                                  \
  {                                                                                                                     \
    unsigned char* st_ = sw + ((kt_) % 3) * 20480;                                                                      \
    const size_t kb_ = (size_t)(kt_) * 64;                                                                              \
    __builtin_amdgcn_global_load_lds((const unsigned*)(kn0 + kb_ * 1024), (unsigned*)(st_), 16, 0, 0);                  \
    __builtin_amdgcn_global_load_lds((const unsigned*)(kn0 + kb_ * 1024 + 32768), (unsigned*)(st_ + 4096), 16, 0, 0);   \
    __builtin_amdgcn_global_load_lds((const unsigned*)(kr0 + kb_ * 64), (unsigned*)(st_ + 8192), 16, 0, 0);             \
    __builtin_amdgcn_global_load_lds((const unsigned*)(v0 + kb_ * 2), (unsigned*)(st_ + 12288), 16, 0, 0);              \
    __builtin_amdgcn_global_load_lds((const unsigned*)(v0 + v32 + kb_ * 2), (unsigned*)(st_ + 12288 + 4096), 16, 0, 0); \
  }
  ATT_STAGE(0);
  if (nt > 1) ATT_STAGE(1);
  const int pk0 = (lg ^ (li >> 1)) * 16;
  const int pkr = (lg ^ (((li >> 3) & 1) << 1)) * 16;
  const int pv0 = ((lg >> 1) ^ (li >> 1)) * 16 + (lg & 1) * 8;
  for (int kt = 0; kt < nt; ++kt) {
    if (kt + 1 < nt) asm volatile("s_waitcnt vmcnt(5)" ::: "memory");
    else asm volatile("s_waitcnt vmcnt(0)" ::: "memory");
    __builtin_amdgcn_s_barrier();
    asm volatile("" ::: "memory");
    if (kt + 2 < nt) ATT_STAGE(kt + 2);
    const unsigned char* st = smem + (kt % 3) * 20480;
    const bool tail = (kt == nt - 1) && (nkeys & 63);
    const bool two = (ng == 2);
    const bool g0on = !(two && kt == nt - 1);
    f32x4 sT[2][4];
#pragma unroll
    for (int kb = 0; kb < 4; ++kb) {
      const unsigned char* kr_ = st + (kb * 16 + li) * 128;
      const bf16x8 k0 = *(const bf16x8*)(kr_ + pk0), k1 = *(const bf16x8*)(kr_ + (pk0 ^ 64)), k2 = *(const bf16x8*)(st + 8192 + (kb * 16 + li) * 64 + pkr);
      sT[0][kb] = (f32x4){zf, zf, zf, zf};
      sT[1][kb] = (f32x4){zf, zf, zf, zf};
      if (g0on) {
        sT[0][kb] = mfma16(k0, qf[0][0], sT[0][kb]);
        sT[0][kb] = mfma16(k1, qf[0][1], sT[0][kb]);
        sT[0][kb] = mfma16(k2, qf[0][2], sT[0][kb]);
      }
      if (two) {
        sT[1][kb] = mfma16(k0, qf[1][0], sT[1][kb]);
        sT[1][kb] = mfma16(k1, qf[1][1], sT[1][kb]);
        sT[1][kb] = mfma16(k2, qf[1][2], sT[1][kb]);
      }
    }
    bf16x8 pf[2][2];
#pragma unroll
    for (int g = 0; g < 2; ++g) {
      if (g == 0 ? g0on : two) {
        if (tail) {
#pragma unroll
          for (int kb = 0; kb < 4; ++kb)
#pragma unroll
            for (int r = 0; r < 4; ++r)
              if (kt * 64 + kb * 16 + 4 * lg + r >= nkeys) sT[g][kb][r] = -INFINITY;
        }
        float mx = sT[g][0][0];
#pragma unroll
        for (int kb = 0; kb < 4; ++kb)
#pragma unroll
          for (int r = 0; r < 4; ++r) mx = fmaxf(mx, sT[g][kb][r]);
        mx = fmaxf(mx, __shfl_xor(mx, 16));
        mx = fmaxf(mx, __shfl_xor(mx, 32));
        const float mnew = fmaxf(mrun[g], mx);
        const float alpha = __builtin_amdgcn_exp2f(mrun[g] - mnew);
        mrun[g] = mnew;
        float ps = 0.f;
#pragma unroll
        for (int kb = 0; kb < 4; ++kb)
#pragma unroll
          for (int r = 0; r < 4; ++r) { const float pv = __builtin_amdgcn_exp2f(sT[g][kb][r] - mnew); sT[g][kb][r] = pv; ps += pv; }
        lrun[g] = lrun[g] * alpha + ps;
#pragma unroll
        for (int vb = 0; vb < 4; ++vb) oT[g][vb] *= alpha;
      }
#pragma unroll
      for (int s2 = 0; s2 < 2; ++s2)
        pf[g][s2] = mk8(pack2(sT[g][2 * s2][0], sT[g][2 * s2][1]), pack2(sT[g][2 * s2][2], sT[g][2 * s2][3]),
                        pack2(sT[g][2 * s2 + 1][0], sT[g][2 * s2 + 1][1]), pack2(sT[g][2 * s2 + 1][2], sT[g][2 * s2 + 1][3]));
    }
#pragma unroll
    for (int s2 = 0; s2 < 2; ++s2) {
#pragma unroll
      for (int vb = 0; vb < 4; ++vb) {
        const unsigned char* vr_ = st + 12288 + (vb * 16 + li) * 128;
        const uint2 lo = *(const uint2*)(vr_ + (pv0 ^ (s2 * 64)));
        const uint2 hi = *(const uint2*)(vr_ + (pv0 ^ (s2 * 64) ^ 32));
        const bf16x8 vfr = mk8(lo, hi);
        if (g0on) oT[0][vb] = mfma16(vfr, pf[0][s2], oT[0][vb]);
        if (two) oT[1][vb] = mfma16(vfr, pf[1][s2], oT[1][vb]);
      }
    }
  }
#pragma unroll
  for (int g = 0; g < 2; ++g) {
    float lr = lrun[g];
    lr += __shfl_xor(lr, 16);
    lr += __shfl_xor(lr, 32);
    const float inv = 1.f / lr;
    const bool st_ok = g == 0 ? (ql < nq) : (ng == 2);
    if (st_ok) {
#pragma unroll
      for (int vb = 0; vb < 4; ++vb) {
        const f32x4 o = oT[g][vb] * inv;
        *(uint2*)(O + (size_t)(qrow0 + g * 64 + ql) * 512 + vb * 16 + 4 * lg) = make_uint2(pack2(o[0], o[1]), pack2(o[2], o[3]));
      }
    }
  }
  __syncthreads();
}

DEVI void hgrn_item(const int TIDX, const int BIDX, const int GDIM, KAP KA, unsigned char* WSB, float* OUTB, int l, int g0, int nchunks, int h, const float* __restrict__ S0, float* __restrict__ Sout, int rowbase,
                    unsigned char* smem) {
  constexpr int STG = 35840;
  const unsigned char* QT = WSB + O_QT;
  const unsigned char* KHT = WSB + O_KHT;
  const unsigned char* AM = WSB + O_AM;
  const unsigned char* EBp = WSB + O_EB;
  const unsigned char* VT2 = WSB + O_VT2;
  const unsigned char* G = WSB + O_G;
  bf16_t* HO = (bf16_t*)(WSB + O_HO);
  const float* hgn = PIN(I_HGN) + l * 512 + h * 128;
  float* sred = (float*)(smem + SMEM_GEMM);
  const int tid = TIDX, lane = tid & 63, w = tid >> 6, c = lane & 31, hh = lane >> 5;
  const int dvg = 32 * w + c;
  f32x16 S[4];
#pragma unroll
  for (int kt = 0; kt < 4; ++kt)
#pragma unroll
    for (int r = 0; r < 16; ++r) S[kt][r] = S0 ? S0[(size_t)(32 * kt + (r & 3) + 8 * (r >> 2) + 4 * hh) * 128 + dvg] : 0.f;
  float4 gn[4];
#pragma unroll
  for (int q = 0; q < 4; ++q) gn[q] = *(const float4*)(hgn + 32 * w + 8 * q + 4 * hh);
  const uint32_t lo16 = (uint32_t)lane * 16u;
  const uint32_t goff = (uint32_t)(w * 4 + (lane >> 4)) * 1024u + (uint32_t)h * 256u + (uint32_t)(lane & 15) * 16u;
#define HG_STAGE(ch_)                                                                                                                  \
  {                                                                                                                                    \
    unsigned char* st_ = smem + ((ch_) & 1) * STG + w * 1024;                                                                          \
    const size_t cid_ = (size_t)(g0 + (ch_)) * 4 + h;                                                                                  \
    const size_t grow_ = ((size_t)rowbase + (size_t)(ch_) * 32) * 1024;                                                                \
    __builtin_amdgcn_global_load_lds((const unsigned*)(QT + cid_ * 8192 + w * 1024 + lo16), (unsigned*)(st_), 16, 0, 0);              \
    __builtin_amdgcn_global_load_lds((const unsigned*)(QT + cid_ * 8192 + 4096 + w * 1024 + lo16), (unsigned*)(st_ + 4096), 16, 0, 0); \
    __builtin_amdgcn_global_load_lds((const unsigned*)(KHT + cid_ * 8192 + w * 1024 + lo16), (unsigned*)(st_ + 8192), 16, 0, 0);       \
    __builtin_amdgcn_global_load_lds((const unsigned*)(KHT + cid_ * 8192 + 4096 + w * 1024 + lo16), (unsigned*)(st_ + 12288), 16, 0, 0); \
    __builtin_amdgcn_global_load_lds((const unsigned*)(VT2 + cid_ * 8192 + w * 1024 + lo16), (unsigned*)(st_ + 16384), 16, 0, 0);      \
    __builtin_amdgcn_global_load_lds((const unsigned*)(VT2 + cid_ * 8192 + 4096 + w * 1024 + lo16), (unsigned*)(st_ + 20480), 16, 0, 0); \
    __builtin_amdgcn_global_load_lds((const unsigned*)(G + grow_ + goff), (unsigned*)(st_ + 24576), 16, 0, 0);                         \
    __builtin_amdgcn_global_load_lds((const unsigned*)(G + grow_ + 16384 + goff), (unsigned*)(st_ + 28672), 16, 0, 0);                 \
    if (w < 2) __builtin_amdgcn_global_load_lds((const unsigned*)(AM + cid_ * 2048 + w * 1024 + lo16), (unsigned*)(st_ + 32768), 16, 0, 0); \
    else if (w == 2) __builtin_amdgcn_global_load_lds((const unsigned*)(EBp + cid_ * 512 + lo16), (unsigned*)(smem + ((ch_) & 1) * STG + 34816), 16, 0, 0); \
  }
  HG_STAGE(0);
  for (int ch = 0; ch < nchunks; ++ch) {
    asm volatile("s_waitcnt vmcnt(0)" ::: "memory");
    __builtin_amdgcn_s_barrier();
    asm volatile("" ::: "memory");
    if (ch + 1 < nchunks) HG_STAGE(ch + 1);
    const unsigned char* st = smem + (ch & 1) * STG;
    bf16x8 vf[2], af[2];
#pragma unroll
    for (int s2 = 0; s2 < 2; ++s2) {
      vf[s2] = *(const bf16x8*)(st + 16384 + dvg * 64 + 32 * s2 + 16 * hh);
      af[s2] = *(const bf16x8*)(st + 32768 + c * 64 + 32 * s2 + 16 * hh);
    }
    f32x16 oT;
    const float zf = zero_f();
#pragma unroll
    for (int r = 0; r < 16; ++r) oT[r] = zf;
#pragma unroll
    for (int kt = 0; kt < 4; ++kt) {
#pragma unroll
      for (int s2 = 0; s2 < 2; ++s2) {
        const uint2 lo = *(const uint2*)(st + c * 256 + 64 * kt + 32 * s2 + 8 * hh);
        const uint2 hi = *(const uint2*)(st + c * 256 + 64 * kt + 32 * s2 + 16 + 8 * hh);
        const bf16x8 sa = mk8(pack2(S[kt][8 * s2 + 0], S[kt][8 * s2 + 1]), pack2(S[kt][8 * s2 + 2], S[kt][8 * s2 + 3]),
                              pack2(S[kt][8 * s2 + 4], S[kt][8 * s2 + 5]), pack2(S[kt][8 * s2 + 6], S[kt][8 * s2 + 7]));
        oT = mfma32(sa, mk8(lo, hi), oT);
      }
    }
#pragma unroll
    for (int s2 = 0; s2 < 2; ++s2) oT = mfma32(vf[s2], af[s2], oT);
#pragma unroll
    for (int kt = 0; kt < 4; ++kt) {
#pragma unroll
      for (int q = 0; q < 4; ++q) {
        const float4 e = *(const float4*)(st + 34816 + (32 * kt + 8 * q + 4 * hh) * 4);
        S[kt][4 * q + 0] *= e.x; S[kt][4 * q + 1] *= e.y; S[kt][4 * q + 2] *= e.z; S[kt][4 * q + 3] *= e.w;
      }
#pragma unroll
      for (int s2 = 0; s2 < 2; ++s2) {
        const bf16x8 kf = *(const bf16x8*)(st + 8192 + (32 * kt + c) * 64 + 32 * s2 + 16 * hh);
        S[kt] = mfma32(kf, vf[s2], S[kt]);
      }
    }
    float ss = 0.f;
#pragma unroll
    for (int r = 0; r < 16; ++r) ss += oT[r] * oT[r];
    ss += __shfl_xor(ss, 32);
    float* sr = sred + (ch & 1) * 128;
    if (lane < 32) sr[w * 32 + c] = ss;
    asm volatile("s_waitcnt lgkmcnt(0)" ::: "memory");
    __builtin_amdgcn_s_barrier();
    asm volatile("" ::: "memory");
    const float tot = sr[c] + sr[32 + c] + sr[64 + c] + sr[96 + c];
    const float rs = rsqrtf(tot * (1.f / 128.f) + EPS);
    const size_t row = (size_t)rowbase + ch * 32 + c;
#pragma unroll
    for (int q = 0; q < 4; ++q) {
      const int dv0 = 32 * w + 8 * q + 4 * hh;
      const uint2 gp = *(const uint2*)(st + 24576 + c * 256 + dv0 * 2);
      const float o0 = oT[4 * q + 0] * rs * gn[q].x * siluf_(lo2f(gp.x));
      const float o1 = oT[4 * q + 1] * rs * gn[q].y * siluf_(hi2f(gp.x));
      const float o2 = oT[4 * q + 2] * rs * gn[q].z * siluf_(lo2f(gp.y));
      const float o3 = oT[4 * q + 3] * rs * gn[q].w * siluf_(hi2f(gp.y));
      *(uint2*)(HO + row * 512 + h * 128 + dv0) = make_uint2(pack2(o0, o1), pack2(o2, o3));
    }
  }
#pragma unroll
  for (int kt = 0; kt < 4; ++kt)
#pragma unroll
    for (int r = 0; r < 16; ++r) Sout[(size_t)(32 * kt + (r & 3) + 8 * (r >> 2) + 4 * hh) * 128 + dvg] = S[kt][r];
  __syncthreads();
}

DEVI void phase_p4(const int TIDX, const int BIDX, const int GDIM, KAP KA, unsigned char* WSB, float* OUTB, int l, unsigned char* smem, int dup = 0) {
  const int q = BIDX & 7;
  int* qctr = (int*)(WSB + O_CNT) + 3072 + (l * 8 + q) * 32 + 16 * dup;
  int* sitem = (int*)(smem + SMEM_GEMM + 1024);
  const bf16_t* QB = (const bf16_t*)(WSB + O_QB);
  bf16_t* AO = (bf16_t*)(WSB + O_AO);
  const int total = 16 + 16 + 512 + 8;
  for (;;) {
    if (TIDX == 0) *sitem = atomicAdd(qctr, 1);
    __syncthreads();
    const int it = *sitem;
    __syncthreads();
    if (it >= total) break;
    if (it < 16) {
      const int i2 = q * 16 + it, b = i2 >> 2, h = i2 & 3;
      hgrn_item(TIDX, BIDX, GDIM, KA, WSB, OUTB, l, b * 64, 64, h, nullptr, OUTB + OUT_ST_P + ((size_t)(l * 32 + b) * 4 + h) * 16384, b * 2048, smem);
    } else if (it < 32) {
      const int b = it - 16, h = q;
      attn_item(TIDX, BIDX, GDIM, QB + h * 96, TP + b * 32, 32, 1, (const bf16_t*)(WSB + O_KNS) + (size_t)b * KPAD * 512 + h * 64,
                (const bf16_t*)(WSB + O_KRS) + ((size_t)l * 16 + b) * KPAD * 32,
                (const bf16_t*)(WSB + O_VTS) + (size_t)(b * 8 + h) * 64 * KPAD, KPAD, 4128, AO + h * 64, smem);
    } else if (it < 32 + 512) {
      const int jj = it - 32, b = jj >> 4, cp = 15 - (jj & 15), h = q;
      attn_item(TIDX, BIDX, GDIM, QB + h * 96, b * 2048 + cp * 128, 64, 2, (const bf16_t*)(WSB + O_KN) + (size_t)b * 2048 * 512 + h * 64,
                (const bf16_t*)(WSB + O_KRB) + (size_t)b * 2048 * 32,
                (const bf16_t*)(WSB + O_VT) + (size_t)(b * 8 + h) * 64 * 2048, 2048, 128 * (cp + 1), AO + h * 64, smem);
    } else {
      const int i2 = q * 8 + (it - 32 - 512), b = i2 >> 2, h = i2 & 3;
      hgrn_item(TIDX, BIDX, GDIM, KA, WSB, OUTB, l, 2048 + b, 1, h, PIN(I_ST) + ((size_t)(l * 16 + b) * 4 + h) * 16384,
                OUTB + OUT_ST_S + ((size_t)(l * 16 + b) * 4 + h) * 16384, TP + b * 32, smem);
    }
  }
}

DEVI void phase_p5(const int TIDX, const int BIDX, const int GDIM, KAP KA, unsigned char* WSB, float* OUTB, int l, unsigned char* smem) {
  const bf16_t* XB = (const bf16_t*)(WSB + O_XB);
  const bf16_t* AO = (const bf16_t*)(WSB + O_AO);
  const bf16_t* HO = (const bf16_t*)(WSB + O_HO);
  const bf16_t* W = (const bf16_t*)(WSB + O_WS) + (size_t)l * WO_END;
  bf16_t* MG = (bf16_t*)(WSB + O_MG);
  for (int item = (BIDX & 7) * (GDIM >> 3) + (BIDX >> 3); item < 516 * 8; item += GDIM) {
    const int mt = item >> 3, nt = item & 7, m0 = mt * 128, n0 = nt * 128;
    f32x4 acc[4][4];
    uint2 gp[4][4];
    RowLin rx{(const unsigned char*)(XB + (size_t)m0 * 1024), 2048};
    RowLin ra{(const unsigned char*)(AO + (size_t)m0 * 512), 1024};
    RowLin ro{(const unsigned char*)(HO + (size_t)m0 * 512), 1024};
    zero_acc(acc);
    gemm_main<true>(TIDX, BIDX, GDIM, acc, rx, W + WO_G + (size_t)n0 * 1024, 1024, 1024, smem);
#pragma unroll
    for (int i = 0; i < 4; ++i)
#pragma unroll
      for (int j = 0; j < 4; ++j) gp[i][j] = make_uint2(pack2(sigmoidf_(acc[i][j][0]), sigmoidf_(acc[i][j][1])), pack2(sigmoidf_(acc[i][j][2]), sigmoidf_(acc[i][j][3])));
    zero_acc(acc);
    gemm_main<true>(TIDX, BIDX, GDIM, acc, ra, W + WO_BRA + (size_t)n0 * 512, 512, 512, smem);
    EPI_SWAP_BEGIN(m0, n0)
      const f32x4 a = acc[mi][ni];
      const uint2 g = gp[mi][ni];
      *(uint2*)(MG + (size_t)row * 1024 + col) = make_uint2(pack2(a[0] * lo2f(g.x), a[1] * hi2f(g.x)), pack2(a[2] * lo2f(g.y), a[3] * hi2f(g.y)));
    EPI_END
    zero_acc(acc);
    gemm_main<true>(TIDX, BIDX, GDIM, acc, rx, W + WO_G + (size_t)(1024 + n0) * 1024, 1024, 1024, smem);
#pragma unroll
    for (int i = 0; i < 4; ++i)
#pragma unroll
      for (int j = 0; j < 4; ++j) gp[i][j] = make_uint2(pack2(sigmoidf_(acc[i][j][0]), sigmoidf_(acc[i][j][1])), pack2(sigmoidf_(acc[i][j][2]), sigmoidf_(acc[i][j][3])));
    zero_acc(acc);
    gemm_main<true>(TIDX, BIDX, GDIM, acc, ro, W + WO_BRB + (size_t)n0 * 512, 512, 512, smem);
    EPI_SWAP_BEGIN(m0, n0)
      const f32x4 a = acc[mi][ni];
      const uint2 g = gp[mi][ni], m = *(const uint2*)(MG + (size_t)row * 1024 + col);
      const float o0 = lo2f(m.x) + a[0] * lo2f(g.x), o1 = hi2f(m.x) + a[1] * hi2f(g.x), o2 = lo2f(m.y) + a[2] * lo2f(g.y), o3 = hi2f(m.y) + a[3] * hi2f(g.y);
      *(uint2*)(MG + (size_t)row * 1024 + col) = make_uint2(pack2(o0, o1), pack2(o2, o3));
    EPI_END
  }
}

DEVI void phase_p6(const int TIDX, const int BIDX, const int GDIM, KAP KA, unsigned char* WSB, float* OUTB, int l, unsigned char* smem) {
  const bf16_t* MG = (const bf16_t*)(WSB + O_MG);
  const bf16_t* W = (const bf16_t*)(WSB + O_WS) + (size_t)l * WO_END + WO_OUT;
  float* PRE = (float*)(WSB + O_PRE);
  for (int item = (BIDX & 7) * (GDIM >> 3) + (BIDX >> 3); item < 516 * 8; item += GDIM) {
    const int mt = item >> 3, nt = item & 7, m0 = mt * 128, n0 = nt * 128;
    f32x4 acc[4][4];
    zero_acc(acc);
    RowLin rp{(const unsigned char*)(MG + (size_t)m0 * 1024), 2048};
    gemm_main<true>(TIDX, BIDX, GDIM, acc, rp, W + (size_t)n0 * 1024, 1024, 1024, smem);
    EPI_SWAP_BEGIN(m0, n0)
      const f32x4 a = acc[mi][ni];
      *(uint2*)((bf16_t*)PRE + (size_t)row * 1024 + col) = make_uint2(pack2(a[0], a[1]), pack2(a[2], a[3]));
    EPI_END
  }
}

DEVI void phase_p7(const int TIDX, const int BIDX, const int GDIM, KAP KA, unsigned char* WSB, float* OUTB, int l, unsigned char* smem) {
  const int tid = TIDX, lane = tid & 63;
  {
    const float* PRE = (const float*)(WSB + O_PRE);
    bf16_t* XB = (bf16_t*)(WSB + O_XB);
    const float* WR = (const float*)(WSB + O_WR) + (size_t)l * 36 * 1024;
    int* cnt = (int*)(WSB + O_CNT) + 1024 + l * 1024;
    int* ltok = (int*)(WSB + O_LTOK);
    float* lw = (float*)(WSB + O_LW);
    const float* g1 = PIN(I_LN1G) + l * 1024; const float* b1 = PIN(I_LN1B) + l * 1024;
    const int wid = BIDX * 4 + (tid >> 6), nw = GDIM * 4;
    for (int r4 = wid; r4 < NTOK / 4; r4 += nw) {
      float4 v[4][4];
#pragma unroll
      for (int t = 0; t < 4; ++t) {
        const size_t row = (size_t)r4 * 4 + t;
#pragma unroll
        for (int j = 0; j < 4; ++j) v[t][j] = resid_plus(*(const uint2*)(XB + row * 1024 + j * 256 + lane * 4), *(const uint2*)((const bf16_t*)PRE + row * 1024 + j * 256 + lane * 4));
        ln_inplace(v[t], g1, b1, lane);
        store_row(v[t], OUTB + row * 1024, XB + row * 1024, lane);
      }
      float mine[4] = {0.f, 0.f, 0.f, 0.f};
#pragma unroll 4
      for (int c = 0; c < 36; ++c) {
        float4 wv[4];
#pragma unroll
        for (int j = 0; j < 4; ++j) wv[j] = *(const float4*)(WR + c * 1024 + j * 256 + lane * 4);
#pragma unroll
        for (int t = 0; t < 4; ++t) {
          float s = 0.f;
#pragma unroll
          for (int j = 0; j < 4; ++j) s += v[t][j].x * wv[j].x + v[t][j].y * wv[j].y + v[t][j].z * wv[j].z + v[t][j].w * wv[j].w;
          s = wave_sum(s);
          if (lane == c) mine[t] = s;
        }
      }
      int my_e = 0, my_tk = 0; float my_w = 0.f;
#pragma unroll
      for (int t = 0; t < 4; ++t) {
        const int tok = r4 * 4 + t;
        float gl[4];
#pragma unroll
        for (int j = 0; j < 4; ++j) gl[j] = __shfl(mine[t], j);
        int gi = 0; float gm = gl[0];
#pragma unroll
        for (int j = 1; j < 4; ++j) if (gl[j] > gm) { gm = gl[j]; gi = j; }
        float gs = 0.f;
#pragma unroll
        for (int j = 0; j < 4; ++j) gs += expf(gl[j] - gm);
        const float gtop = 1.f / gs;
        float el[8];
#pragma unroll
        for (int j = 0; j < 8; ++j) el[j] = __shfl(mine[t], 4 + gi * 8 + j);
        float em = el[0];
#pragma unroll
        for (int j = 1; j < 8; ++j) em = fmaxf(em, el[j]);
        float pe[8], es = 0.f;
#pragma unroll
        for (int j = 0; j < 8; ++j) { pe[j] = expf(el[j] - em); es += pe[j]; }
#pragma unroll
        for (int j = 0; j < 8; ++j) pe[j] = pe[j] / es;
        int i1 = 0; float p1 = pe[0];
#pragma unroll
        for (int j = 1; j < 8; ++j) if (pe[j] > p1) { p1 = pe[j]; i1 = j; }
        int i2 = -1; float p2 = -1.f;
#pragma unroll
        for (int j = 0; j < 8; ++j) if (j != i1 && pe[j] > p2) { p2 = pe[j]; i2 = j; }
        const float den = p1 + p2;
        if (lane == 2 * t) { my_e = gi * 8 + i1; my_w = gtop * (p1 / den); my_tk = tok * 2; }
        if (lane == 2 * t + 1) { my_e = gi * 8 + i2; my_w = gtop * (p2 / den); my_tk = tok * 2 + 1; }
      }
      if (lane < 8) {
        const int sl = atomicAdd(cnt + my_e * 32, 1);
        ltok[(size_t)my_e * NTOK + sl] = my_tk;
        lw[(size_t)my_e * NTOK + sl] = my_w;
      }
    }
  }
  {
    bf16_t* PLEB = (bf16_t*)(WSB + O_YM);
    const float* pp = PIN(I_PP) + (size_t)l * TP * 256;
    const float* ps = PIN(I_PS) + (size_t)l * TS * 256;
    const size_t tot_ = (size_t)NTOK * 64, str_ = (size_t)GDIM * 256;
    for (size_t i = (size_t)BIDX * 256 + tid; i < tot_; i += 4 * str_) {
      float4 v4[4];
#pragma unroll
      for (int k = 0; k < 4; ++k) {
        const size_t ii = i + k * str_ < tot_ ? i + k * str_ : i, e = ii * 4;
        v4[k] = e < (size_t)TP * 256 ? *(const float4*)(pp + e) : *(const float4*)(ps + (e - (size_t)TP * 256));
      }
#pragma unroll
      for (int k = 0; k < 4; ++k)
        if (i + k * str_ < tot_) *(uint2*)(PLEB + (i + k * str_) * 4) = make_uint2(pack2(v4[k].x, v4[k].y), pack2(v4[k].z, v4[k].w));
    }
  }
  {
    float* tile = (float*)smem;
    bf16_t* WE = (bf16_t*)(WSB + O_WE);
    const int t = TIDX, n4 = (t & 15) * 4, kr = t >> 4, kc = (t & 7) * 8, nr = t >> 3;
    for (int p = BIDX; p < 96 * 64; p += GDIM) {
      const int mat = p >> 6, tp = (p & 63) * 2, kind = mat >> 5, e = mat & 31;
      const float* src = PIN(kind == 0 ? I_WE1 : (kind == 1 ? I_WE3 : I_WE2)) + ((size_t)l * 32 + e) * 524288;
      bf16_t* dst = WE + ((size_t)kind * 32 + e) * 524288;
      const int ld = kind < 2 ? 512 : 1024, K = kind < 2 ? 1024 : 512, nkt = K >> 6;
      int k0[2], n0[2];
#pragma unroll
      for (int u = 0; u < 2; ++u) { const int tt = tp + u; k0[u] = (tt % nkt) * 64; n0[u] = (tt / nkt) * 64; }
      float4 v[2][4];
#pragma unroll
      for (int u = 0; u < 2; ++u)
#pragma unroll
        for (int q = 0; q < 4; ++q) v[u][q] = *(const float4*)(src + (size_t)(k0[u] + kr + 16 * q) * ld + n0[u] + n4);
#pragma unroll
      for (int u = 0; u < 2; ++u)
#pragma unroll
        for (int q = 0; q < 4; ++q) {
          float* d = tile + u * 4160 + (kr + 16 * q) * 65 + n4;
          d[0] = v[u][q].x; d[1] = v[u][q].y; d[2] = v[u][q].z; d[3] = v[u][q].w;
        }
      __syncthreads();
#pragma unroll
      for (int u = 0; u < 2; ++u)
#pragma unroll
        for (int q = 0; q < 2; ++q) {
          const int n = nr + 32 * q;
          const float* sp = tile + u * 4160 + kc * 65 + n;
          const uint4 o = make_uint4(pack2(sp[0], sp[65]), pack2(sp[130], sp[195]), pack2(sp[260], sp[325]), pack2(sp[390], sp[455]));
          *(uint4*)(dst + (size_t)(n0[u] + n) * K + k0[u] + kc) = o;
        }
      __syncthreads();
    }
  }
}

DEVI int moe_table(const int TIDX, const int BIDX, const int GDIM, KAP KA, unsigned char* WSB, float* OUTB, int l, int* tstart  ) {
  if (TIDX == 0) {
    const int* cnt = (const int*)(WSB + O_CNT) + 1024 + l * 1024;
    int acc = 0;
    for (int e = 0; e < 32; ++e) { tstart[e] = acc; acc += (cnt[e * 32] + 127) >> 7; }
    tstart[32] = acc;
  }
  __syncthreads();
  return tstart[32];
}
DEVI int moe_find(const int* tstart, int mt) {
  int e = 0;
  for (int i = 1; i < 32; ++i) if (mt >= tstart[i]) e = i;
  return e;
}
struct RowGather {
  const unsigned char* base; const int* ltok; int pos0; int cnt;
  DEVI uint32_t operator()(int r) const {
    const int pos = pos0 + r;
    return pos < cnt ? (uint32_t)(ltok[pos] >> 1) * 2048u : (uint32_t)NTOK * 2048u;
  }
};

DEVI void phase_p8(const int TIDX, const int BIDX, const int GDIM, KAP KA, unsigned char* WSB, float* OUTB, int l, unsigned char* smem) {
  int* tstart = (int*)(smem + SMEM_GEMM + 1024 + 64);
  const int NT = moe_table(TIDX, BIDX, GDIM, KA, WSB, OUTB, l, tstart);
  const bf16_t* XB = (const bf16_t*)(WSB + O_XB);
  const bf16_t* WE = (const bf16_t*)(WSB + O_WE);
  bf16_t* H = (bf16_t*)(WSB + O_H);
  const int* cnt = (const int*)(WSB + O_CNT) + 1024 + l * 1024;
  const int* ltok = (const int*)(WSB + O_LTOK);
  for (int item = (BIDX & 7) * (GDIM >> 3) + (BIDX >> 3); item < NT * 4; item += GDIM) {
    const int mt = item >> 2, nt = item & 3, e = moe_find(tstart, mt), lt = mt - tstart[e];
    RowGather rg{(const unsigned char*)XB, ltok + (size_t)e * NTOK, lt * 128, cnt[e * 32]};
    f32x4 acc[4][4];
    uint2 sg[4][4];
    zero_acc(acc);
    gemm_main<true>(TIDX, BIDX, GDIM, acc, rg, WE + ((size_t)e * 512 + nt * 128) * 1024, 1024, 1024, smem);
#pragma unroll
    for (int i = 0; i < 4; ++i)
#pragma unroll
      for (int j = 0; j < 4; ++j) sg[i][j] = make_uint2(pack2(siluf_(acc[i][j][0]), siluf_(acc[i][j][1])), pack2(siluf_(acc[i][j][2]), siluf_(acc[i][j][3])));
    zero_acc(acc);
    gemm_main<true>(TIDX, BIDX, GDIM, acc, rg, WE + ((size_t)(32 + e) * 512 + nt * 128) * 1024, 1024, 1024, smem);
    EPI_SWAP_BEGIN(mt * 128, nt * 128)
      const f32x4 a = acc[mi][ni];
      const uint2 g = sg[mi][ni];
      *(uint2*)(H + (size_t)row * 512 + col) = make_uint2(pack2(a[0] * lo2f(g.x), a[1] * hi2f(g.x)), pack2(a[2] * lo2f(g.y), a[3] * hi2f(g.y)));
    EPI_END
  }
  {
    const bf16_t* W = (const bf16_t*)(WSB + O_WS) + (size_t)l * WO_END;
    float* PRE = (float*)(WSB + O_PRE);
    for (int item = (BIDX & 7) * (GDIM >> 3) + (BIDX >> 3); item < 516 * 8; item += GDIM) {
      const int mt = item >> 3, nt = item & 7, m0 = mt * 128, n0 = nt * 128;
      f32x4 acc[4][4];
      uint2 gp[4][4];
      zero_acc(acc);
      RowLin rx{(const unsigned char*)(XB + (size_t)m0 * 1024), 2048};
      gemm_main<true>(TIDX, BIDX, GDIM, acc, rx, W + WO_PG + (size_t)n0 * 1024, 1024, 1024, smem);
#pragma unroll
      for (int i = 0; i < 4; ++i)
#pragma unroll
        for (int j = 0; j < 4; ++j) gp[i][j] = make_uint2(pack2(sigmoidf_(acc[i][j][0]), sigmoidf_(acc[i][j][1])), pack2(sigmoidf_(acc[i][j][2]), sigmoidf_(acc[i][j][3])));
      zero_acc(acc);
      RowLin rpl{(const unsigned char*)((const bf16_t*)(WSB + O_YM) + (size_t)m0 * 256), 512};
      gemm_main<true>(TIDX, BIDX, GDIM, acc, rpl, W + WO_PLE + (size_t)n0 * 256, 256, 256, smem);
      EPI_SWAP_BEGIN(m0, n0)
        const f32x4 a = acc[mi][ni];
        const uint2 g = gp[mi][ni];
        *(uint2*)((bf16_t*)PRE + (size_t)row * 1024 + col) = make_uint2(pack2(a[0] * lo2f(g.x), a[1] * hi2f(g.x)), pack2(a[2] * lo2f(g.y), a[3] * hi2f(g.y)));
      EPI_END
    }
  }
}

DEVI void phase_p9(const int TIDX, const int BIDX, const int GDIM, KAP KA, unsigned char* WSB, float* OUTB, int l, unsigned char* smem) {
  int* tstart = (int*)(smem + SMEM_GEMM + 1024 + 64);
  const int NT = moe_table(TIDX, BIDX, GDIM, KA, WSB, OUTB, l, tstart);
  const bf16_t* WE = (const bf16_t*)(WSB + O_WE) + 64ull * 524288;
  const bf16_t* H = (const bf16_t*)(WSB + O_H);
  bf16_t* YM = (bf16_t*)(WSB + O_YM);
  const int* cnt = (const int*)(WSB + O_CNT) + 1024 + l * 1024;
  const int* ltok = (const int*)(WSB + O_LTOK);
  const float* lw = (const float*)(WSB + O_LW);
  for (int item = (BIDX & 7) * (GDIM >> 3) + (BIDX >> 3); item < NT * 8; item += GDIM) {
    const int mt = item >> 3, nt = item & 7, e = moe_find(tstart, mt), lt = mt - tstart[e], ce = cnt[e * 32];
    f32x4 acc[4][4];
    zero_acc(acc);
    RowLin rp{(const unsigned char*)(H + (size_t)mt * 128 * 512), 1024};
    gemm_main<true>(TIDX, BIDX, GDIM, acc, rp, WE + ((size_t)e * 1024 + nt * 128) * 512, 512, 512, smem);
    EPI_SWAP_BEGIN(0, nt * 128)
      const int pos = lt * 128 + row;
      if (pos < ce) {
        const int tk = ltok[(size_t)e * NTOK + pos];
        const float wt = lw[(size_t)e * NTOK + pos];
        const f32x4 a = acc[mi][ni] * wt;
        *(uint2*)(YM + (size_t)tk * 1024 + col) = make_uint2(pack2(a[0], a[1]), pack2(a[2], a[3]));
      }
    EPI_END
  }
}

DEVI void phase_p10(const int TIDX, const int BIDX, const int GDIM, KAP KA, unsigned char* WSB, float* OUTB, int l) {
  const int tid = TIDX, lane = tid & 63;
  const float* PRE = (const float*)(WSB + O_PRE);
  const bf16_t* YM = (const bf16_t*)(WSB + O_YM);
  bf16_t* XB = (bf16_t*)(WSB + O_XB);
  const float* g2 = PIN(I_LN2G) + l * 1024; const float* b2 = PIN(I_LN2B) + l * 1024;
  const int wid = BIDX * 4 + (tid >> 6), nw = GDIM * 4;
  for (int row = wid; row < NTOK; row += 2 * nw) {
    const bool hb = row + nw < NTOK;
    const int rws[2] = {row, hb ? row + nw : row};
    float4 v[2][4];
    uint2 y0[2][4], y1[2][4];
#pragma unroll
    for (int k = 0; k < 2; ++k)
#pragma unroll
      for (int j = 0; j < 4; ++j) {
        v[k][j] = resid_plus(*(const uint2*)(XB + (size_t)rws[k] * 1024 + j * 256 + lane * 4), *(const uint2*)((const bf16_t*)PRE + (size_t)rws[k] * 1024 + j * 256 + lane * 4));
        y0[k][j] = *(const uint2*)(YM + (size_t)rws[k] * 2048 + j * 256 + lane * 4);
        y1[k][j] = *(const uint2*)(YM + (size_t)rws[k] * 2048 + 1024 + j * 256 + lane * 4);
      }
#pragma unroll
    for (int k = 0; k < 2; ++k) {
      if (k == 0 || hb) {
#pragma unroll
        for (int j = 0; j < 4; ++j) {
          v[k][j].x += lo2f(y0[k][j].x) + lo2f(y1[k][j].x); v[k][j].y += hi2f(y0[k][j].x) + hi2f(y1[k][j].x);
          v[k][j].z += lo2f(y0[k][j].y) + lo2f(y1[k][j].y); v[k][j].w += hi2f(y0[k][j].y) + hi2f(y1[k][j].y);
        }
        ln_inplace(v[k], g2, b2, lane);
        const size_t r = (size_t)rws[k];
        if (l == 0) store_row(v[k], OUTB + r * 1024, XB + r * 1024, lane);
        else {
#pragma unroll
          for (int j = 0; j < 4; ++j) *(float4*)(OUTB + r * 1024 + j * 256 + lane * 4) = v[k][j];
        }
      }
    }
  }
}

DEVI void* launder_ptr(const void* q) {
  uint32_t lo = (uint32_t)(uintptr_t)q, hi = (uint32_t)((uintptr_t)q >> 32);
  asm volatile("" : "+v"(lo), "+v"(hi));
  lo = __builtin_amdgcn_readfirstlane(lo);
  hi = __builtin_amdgcn_readfirstlane(hi);
  return (void*)(((uintptr_t)hi << 32) | lo);
}
DEVI void grid_barrier(const int TIDX, const int BIDX, const int GDIM, unsigned* bar, unsigned k) {
  __syncthreads();
  if (TIDX == 0) {
    __threadfence();
    const unsigned g = (unsigned)BIDX & 7u, gs = (unsigned)GDIM >> 3;
    const unsigned old = __hip_atomic_fetch_add(bar + 32 * (1 + g), 1u, __ATOMIC_RELAXED, __HIP_MEMORY_SCOPE_AGENT);
    if (old + 1u == gs * k) {
      __threadfence();
      __hip_atomic_fetch_add(bar, 1u, __ATOMIC_RELAXED, __HIP_MEMORY_SCOPE_AGENT);
    }
    unsigned spins = 0;
    while (__hip_atomic_load(bar, __ATOMIC_RELAXED, __HIP_MEMORY_SCOPE_AGENT) < 8u * k) {
      __builtin_amdgcn_s_sleep(1);
      if (++spins > (1u << 27)) break;
    }
    __threadfence();
  }
  __syncthreads();
}
__global__ void __launch_bounds__(256, 2) mega(Params p, int ph0, int ph1) {
  __shared__ __attribute__((aligned(16))) unsigned char smem[SMEM_TOTAL];
  const int wave_in_block = __builtin_amdgcn_readfirstlane((int)(__builtin_amdgcn_workitem_id_x() >> 6));
  for (int ph = ph0; ph < ph1; ++ph) {
    int wv_ = wave_in_block;
    asm volatile("" : "+s"(wv_));
    int TIDX = wv_ * 64 + (int)__lane_id();
    asm volatile("" : "+v"(TIDX));
    int BIDX = __builtin_amdgcn_workgroup_id_x(), GDIM = (int)gridDim.x;
    asm volatile("" : "+s"(BIDX), "+s"(GDIM));
    KAP KA;
    {
      uintptr_t q = (uintptr_t)__builtin_amdgcn_kernarg_segment_ptr();
      uint32_t lo = (uint32_t)q, hi = (uint32_t)(q >> 32);
      asm volatile("" : "+s"(lo), "+s"(hi));
      KA = (KAP)(((uintptr_t)hi << 32) | lo);
    }
    float* OUTB = (float*)PIN(31);
    unsigned char* WSB = (unsigned char*)PIN(32);
#ifndef PHSEL
#define PHSEL -1
#endif
    if (ph == 0) { if (PHSEL < 0 || PHSEL == 10) phase_prep(TIDX, BIDX, GDIM, KA, WSB, OUTB, smem); }
    else {
      const int l = (ph - 1) / 10, s = (ph - 1) % 10;
      switch (s) {
        case 0: if (PHSEL < 0 || PHSEL == 0) phase_p1(TIDX, BIDX, GDIM, KA, WSB, OUTB, l, smem); break;
        case 1: if (PHSEL < 0 || PHSEL == 1) phase_p2(TIDX, BIDX, GDIM, KA, WSB, OUTB, l, smem); break;
        case 2: if (PHSEL < 0 || PHSEL == 2) phase_p3(TIDX, BIDX, GDIM, KA, WSB, OUTB, l, smem); break;
        case 3: if (PHSEL < 0 || PHSEL == 3) phase_p4(TIDX, BIDX, GDIM, KA, WSB, OUTB, l, smem); break;
        case 4: if (PHSEL < 0 || PHSEL == 4) phase_p5(TIDX, BIDX, GDIM, KA, WSB, OUTB, l, smem); break;
        case 5: if (PHSEL < 0 || PHSEL == 5) phase_p6(TIDX, BIDX, GDIM, KA, WSB, OUTB, l, smem); break;
        case 6: if (PHSEL < 0 || PHSEL == 6) phase_p7(TIDX, BIDX, GDIM, KA, WSB, OUTB, l, smem); break;
        case 7: if (PHSEL < 0 || PHSEL == 7) phase_p8(TIDX, BIDX, GDIM, KA, WSB, OUTB, l, smem); break;
        case 8: if (PHSEL < 0 || PHSEL == 8) phase_p9(TIDX, BIDX, GDIM, KA, WSB, OUTB, l, smem); break;
        default: if (PHSEL < 0 || PHSEL == 9) phase_p10(TIDX, BIDX, GDIM, KA, WSB, OUTB, l); break;
      }
    }
#ifdef PROBE_DUP
    if (ph > 0 && (ph - 1) % 10 == PROBE_DUP) {
      cg::this_grid().sync();
      const int l = (ph - 1) / 10;
      switch (PROBE_DUP) {
        case 0: phase_p1(TIDX, BIDX, GDIM, KA, WSB, OUTB, l, smem); break;
        case 1: phase_p2(TIDX, BIDX, GDIM, KA, WSB, OUTB, l, smem); break;
        case 2: phase_p3(TIDX, BIDX, GDIM, KA, WSB, OUTB, l, smem); break;
        case 3: phase_p4(TIDX, BIDX, GDIM, KA, WSB, OUTB, l, smem, 1); break;
        case 4: phase_p5(TIDX, BIDX, GDIM, KA, WSB, OUTB, l, smem); break;
        case 5: phase_p6(TIDX, BIDX, GDIM, KA, WSB, OUTB, l, smem); break;
        case 7: phase_p8(TIDX, BIDX, GDIM, KA, WSB, OUTB, l, smem); break;
        case 8: phase_p9(TIDX, BIDX, GDIM, KA, WSB, OUTB, l, smem); break;
        case 9: phase_p10(TIDX, BIDX, GDIM, KA, WSB, OUTB, l); break;
        default: break;
      }
    }
#endif
    if (ph + 1 < ph1) {
      if (ph == ph0) cg::this_grid().sync();
      else grid_barrier(TIDX, BIDX, GDIM, (unsigned*)(WSB + O_CNT + 2048), (unsigned)(ph - ph0));
    }
  }
}

#ifndef MK_MULTI
#define MK_MULTI 0
#endif

extern "C" void kernel_launch(void* const* d_in, const int* in_sizes, int n_in, void* d_out, int out_size, void* d_ws, size_t ws_size,
                              hipStream_t stream) {
  static int grid_blocks = 0;
  if (!grid_blocks) {
    int dev = 0, cus = 0, per_cu = 0;
    hipGetDevice(&dev);
    hipDeviceGetAttribute(&cus, hipDeviceAttributeMultiprocessorCount, dev);
    hipOccupancyMaxActiveBlocksPerMultiprocessor(&per_cu, mega, 256, 0);
    if (per_cu > 2) per_cu = 2;
    if (per_cu < 1) per_cu = 1;
    grid_blocks = cus * per_cu;
  }
  Params p{};
  for (int i = 0; i < 31; ++i) p.in[i] = (const float*)d_in[i];
  p.out_ = (float*)d_out;
  p.ws_ = (unsigned char*)d_ws;
  if (ws_size < WS_END) fprintf(stderr, "workspace too small: %zu < %zu\n", ws_size, (size_t)WS_END);
#if MK_MULTI
  for (int ph = 0; ph < 21; ++ph) mega<<<dim3(grid_blocks), dim3(256), 0, stream>>>(p, ph, ph + 1);
#else
  (void)hipMemsetAsync((unsigned char*)d_ws + O_CNT + 2048, 0, 2048, stream);
  int ph0 = 0, ph1 = 21;
  void* args[] = {&p, &ph0, &ph1};
  hipError_t e = hipLaunchCooperativeKernel((void*)mega, dim3(grid_blocks), dim3(256), args, 0, stream);
  if (e != hipSuccess) fprintf(stderr, "cooperative launch failed: %s (grid %d)\n", hipGetErrorString(e), grid_blocks);
#endif
}
```

```cpp
#include <hip/hip_runtime.h>
#include <hip/hip_cooperative_groups.h>
#include <stdint.h>
#include <stdio.h>
namespace cg = cooperative_groups;

#define DEVI __device__ __forceinline__
typedef unsigned short bf16_t;
typedef short bf16x8 __attribute__((ext_vector_type(8)));
typedef float f32x4 __attribute__((ext_vector_type(4)));
typedef float f32x16 __attribute__((ext_vector_type(16)));

constexpr int NTOK = 66048, TP = 65536, TS = 512;
constexpr int NCH = NTOK / 32;
constexpr int KPAD = 4160;
constexpr float DN_ALPHA = 1.4142135623730951f;
constexpr float EPS = 1e-6f;
constexpr float QSCALE = 0.10206207261596575f * 1.4426950408889634f;

constexpr size_t OUT_Y = 0;
constexpr size_t OUT_CKV_P = 67633152ull;
constexpr size_t OUT_KR_P = 101187584ull;
constexpr size_t OUT_ST_P = 105381888ull;
constexpr size_t OUT_CKV_S = 109576192ull;
constexpr size_t OUT_KR_S = 109838336ull;
constexpr size_t OUT_ST_S = 109871104ull;

constexpr size_t WO_IN = 0, WO_G = WO_IN + 2816ull * 1024, WO_UQ = WO_G + 2048ull * 1024, WO_KV = WO_UQ + 768ull * 384,
                 WO_BRA = WO_KV + 1024ull * 256, WO_BRB = WO_BRA + 1024ull * 512, WO_OUT = WO_BRB + 1024ull * 512,
                 WO_PG = WO_OUT + 1024ull * 1024, WO_PLE = WO_PG + 1024ull * 1024, WO_END = WO_PLE + 1024ull * 256;
static_assert(WO_END == 8945664ull, "small weights");

constexpr size_t al(size_t x) { return (x + 255) & ~size_t(255); }
constexpr size_t SZ_XB = (size_t)(NTOK + 1) * 1024 * 2, SZ_LIST = 32ull * NTOK * 4, SZ_KRS = 2ull * 16 * KPAD * 32 * 2,
                 SZ_G = (size_t)NTOK * 512 * 2, SZ_CQ = (size_t)NTOK * 384 * 2, SZ_CKR = (size_t)NTOK * 288 * 4,
                 SZ_FQ = (size_t)NTOK * 1024 * 2, SZ_CKVN = (size_t)NTOK * 256 * 2, SZ_KRB = (size_t)NTOK * 32 * 2,
                 SZ_QB = (size_t)NTOK * 768 * 2, SZ_AM = (size_t)NCH * 4 * 32 * 32 * 2, SZ_EB = (size_t)NCH * 4 * 128 * 4,
                 SZ_VT = 32ull * 8 * 64 * 2048 * 2, SZ_KNS = 16ull * KPAD * 512 * 2, SZ_VTS = 16ull * 8 * 64 * KPAD * 2,
                 SZ_PRE = (size_t)NTOK * 1024 * 4, SZ_WE = 3ull * 32 * 512 * 1024 * 2, SZ_H = 1064ull * 128 * 512 * 2,
                 SZ_YM = (size_t)NTOK * 2 * 1024 * 2;
constexpr size_t O_WS = 0;
constexpr size_t O_WR = O_WS + al(2 * WO_END * 2);
constexpr size_t O_ROPE = O_WR + al(2ull * 36 * 1024 * 4);
constexpr size_t O_CNT = O_ROPE + al(2080ull * 16 * 2 * 4);
constexpr size_t O_XB = O_CNT + 16384;
constexpr size_t O_LTOK = O_XB + al(SZ_XB);
constexpr size_t O_LW = O_LTOK + al(SZ_LIST);
constexpr size_t O_KRS = O_LW + al(SZ_LIST);
constexpr size_t O_G = O_KRS + al(SZ_KRS);
constexpr size_t O_VT2 = O_G + al(SZ_G);
constexpr size_t O_CQ = O_VT2 + al(SZ_G);
constexpr size_t O_CKR = O_CQ + al(SZ_CQ);
constexpr size_t O_FQ = O_CKR + al(SZ_CKR);
constexpr size_t O_CKVN = O_FQ + al(SZ_FQ);
constexpr size_t O_KRB = O_CKVN + al(SZ_CKVN);
constexpr size_t O_QB = O_KRB + al(SZ_KRB);
constexpr size_t O_QT = O_QB + al(SZ_QB);
constexpr size_t O_KHT = O_QT + al(SZ_G);
constexpr size_t O_AM = O_KHT + al(SZ_G);
constexpr size_t O_EB = O_AM + al(SZ_AM);
constexpr size_t O_KN = O_EB + al(SZ_EB);
constexpr size_t O_HO = O_KN + al(SZ_G);
constexpr size_t O_CCB = O_HO + al(SZ_G);
constexpr size_t WS_END = O_CCB + 16ull * 4096 * 256 * 2;
constexpr size_t O_VT = O_CQ;
constexpr size_t O_KNS = O_VT + al(SZ_VT);
constexpr size_t O_VTS = O_KNS + al(SZ_KNS);
constexpr size_t O_AO = O_VTS + al(SZ_VTS);
constexpr size_t O_MG = O_QB;
constexpr size_t O_PRE = O_G;
constexpr size_t O_WE = O_VTS;
constexpr size_t O_H = O_WE + al(SZ_WE);
constexpr size_t O_YM = O_H + al(SZ_H);
static_assert(O_AO + SZ_G <= O_KRB, "AO");
static_assert(O_AO >= O_VTS + SZ_VTS, "AO2");
static_assert(O_MG + SZ_XB <= O_KN, "MG");
static_assert(O_PRE + SZ_PRE <= O_WE, "PRE");
static_assert(O_YM + SZ_YM <= WS_END, "YM");
static_assert(WS_END <= (1ull << 30), "workspace");

struct Params { const float* in[31]; float* out_; unsigned char* ws_; };
typedef const __attribute__((address_space(4))) unsigned char* KAP;
#define PIN(i) (*(const float* const __attribute__((address_space(4)))*)(KA + 8 * (i)))

enum { I_XP = 0, I_XS, I_PP, I_PS, I_CCKV, I_CKR, I_ST, I_LN0G, I_LN0B, I_WIN, I_QN, I_WUQ, I_KVN, I_WUK, I_WUV, I_HGLB, I_HGN,
       I_WBRA, I_WBRB, I_WOUT, I_LN1G, I_LN1B, I_WRG, I_WRE, I_WE1, I_WE3, I_WE2, I_WPLE, I_WPG, I_LN2G, I_LN2B };

DEVI float bf2f(bf16_t h) { return __uint_as_float(((uint32_t)h) << 16); }
DEVI bf16_t f2bf(float f) { uint32_t u = __float_as_uint(f); u += 0x7fffu + ((u >> 16) & 1u); return (bf16_t)(u >> 16); }
typedef float f32x2_t __attribute__((ext_vector_type(2)));
typedef __bf16 bf16x2_t __attribute__((ext_vector_type(2)));
DEVI uint32_t pack2(float lo, float hi) { f32x2_t v = {lo, hi}; bf16x2_t b = __builtin_convertvector(v, bf16x2_t); return __builtin_bit_cast(uint32_t, b); }
DEVI float lo2f(uint32_t u) { return __uint_as_float(u << 16); }
DEVI float hi2f(uint32_t u) { return __uint_as_float(u & 0xffff0000u); }
DEVI float dpp_add_(float v, const int ctrl_sel) {
  const int iv = __float_as_int(v);
  int o;
  if (ctrl_sel == 0) o = __builtin_amdgcn_update_dpp(0, iv, 0xB1, 0xf, 0xf, true);
  else if (ctrl_sel == 1) o = __builtin_amdgcn_update_dpp(0, iv, 0x4E, 0xf, 0xf, true);
  else if (ctrl_sel == 2) o = __builtin_amdgcn_update_dpp(0, iv, 0x141, 0xf, 0xf, true);
  else o = __builtin_amdgcn_update_dpp(0, iv, 0x140, 0xf, 0xf, true);
  return v + __int_as_float(o);
}
DEVI float wave_sum(float v) {
  v = dpp_add_(v, 0);
  v = dpp_add_(v, 1);
  v = dpp_add_(v, 2);
  v = dpp_add_(v, 3);
  const int iv = __float_as_int(v);
  const float r0 = __int_as_float(__builtin_amdgcn_readlane(iv, 0)), r1 = __int_as_float(__builtin_amdgcn_readlane(iv, 16));
  const float r2 = __int_as_float(__builtin_amdgcn_readlane(iv, 32)), r3 = __int_as_float(__builtin_amdgcn_readlane(iv, 48));
  return (r0 + r1) + (r2 + r3);
}
DEVI float sigmoidf_(float x) { return 1.f / (1.f + __expf(-x)); }
DEVI float silu_fast(float x) { return x * __builtin_amdgcn_rcpf(1.f + __expf(-x)); }
DEVI float siluf_(float x) { return x / (1.f + __expf(-x)); }
DEVI f32x4 mfma16(bf16x8 a, bf16x8 b, f32x4 c) { return __builtin_amdgcn_mfma_f32_16x16x32_bf16(a, b, c, 0, 0, 0); }
DEVI f32x16 mfma32(bf16x8 a, bf16x8 b, f32x16 c) { return __builtin_amdgcn_mfma_f32_32x32x16_bf16(a, b, c, 0, 0, 0); }
DEVI bf16x8 mk8(uint32_t a, uint32_t b, uint32_t c, uint32_t d) { uint4 u = make_uint4(a, b, c, d); return *(bf16x8*)&u; }
DEVI bf16x8 mk8(uint2 lo, uint2 hi) { uint4 u = make_uint4(lo.x, lo.y, hi.x, hi.y); return *(bf16x8*)&u; }

constexpr int SMEM_GEMM = 2 * 2 * 128 * 72 * 2;
constexpr int SMEM_TOTAL = SMEM_GEMM + 2048;

template <bool SWAP, class RP>
DEVI void gemm_main(const int TIDX, const int BIDX, const int GDIM, f32x4 (&acc)[4][4], RP rowoff, const bf16_t* __restrict__ Bt, int ldb, int K, unsigned char* smem) {
  int tid = TIDX;
  asm volatile("" : "+v"(tid));
  const int lane = tid & 63, w = tid >> 6, wr = w >> 1, wc = w & 1, li = lane & 15, lg = lane >> 4;
  const unsigned char* abase = rowoff.base;
  const unsigned char* bbase = (const unsigned char*)Bt;
  const uint32_t schunk = (uint32_t)((lane & 7) ^ (((lane >> 4) + 4 * (w & 1)) & 7)) * 16u;
  uint32_t ao0, ao1, ao2, ao3;
  const int rsub = w * 8 + (lane >> 3);
  ao0 = rowoff(rsub) + schunk; ao1 = rowoff(rsub + 32) + schunk; ao2 = rowoff(rsub + 64) + schunk; ao3 = rowoff(rsub + 96) + schunk;
  const uint32_t bo = (uint32_t)(rsub * ldb) * 2u + schunk, bstep = (uint32_t)(32 * ldb) * 2u;
  unsigned char* sbase = smem + w * 1024;
#define GM_STAGE(kt_, buf_)                                                                                                       \
  {                                                                                                                              \
    unsigned char* da_ = sbase + (buf_) * 32768;                                                                                 \
    unsigned char* db_ = da_ + 16384;                                                                                            \
    const uint32_t ko_ = (uint32_t)(kt_) * 128u;                                                                                 \
    __builtin_amdgcn_global_load_lds((const unsigned*)(abase + ao0 + ko_), (unsigned*)(da_), 16, 0, 0);                         \
    __builtin_amdgcn_global_load_lds((const unsigned*)(abase + ao1 + ko_), (unsigned*)(da_ + 4096), 16, 0, 0);                  \
    __builtin_amdgcn_global_load_lds((const unsigned*)(abase + ao2 + ko_), (unsigned*)(da_ + 8192), 16, 0, 0);                  \
    __builtin_amdgcn_global_load_lds((const unsigned*)(abase + ao3 + ko_), (unsigned*)(da_ + 12288), 16, 0, 0);                 \
    __builtin_amdgcn_global_load_lds((const unsigned*)(bbase + bo + ko_), (unsigned*)(db_), 16, 0, 0);                          \
    __builtin_amdgcn_global_load_lds((const unsigned*)(bbase + bo + bstep + ko_), (unsigned*)(db_ + 4096), 16, 0, 0);           \
    __builtin_amdgcn_global_load_lds((const unsigned*)(bbase + bo + 2u * bstep + ko_), (unsigned*)(db_ + 8192), 16, 0, 0);      \
    __builtin_amdgcn_global_load_lds((const unsigned*)(bbase + bo + 3u * bstep + ko_), (unsigned*)(db_ + 12288), 16, 0, 0);     \
  }
  const int nk = K >> 6;
  const int px = lg ^ (li >> 1);
  GM_STAGE(0, 0);
  for (int kt = 0; kt < nk; ++kt) {
    const int buf = kt & 1;
    asm volatile("s_waitcnt vmcnt(0)" ::: "memory");
    __syncthreads();
    if (kt + 1 < nk) GM_STAGE(kt + 1, buf ^ 1);
    const unsigned char* A = smem + buf * 32768 + (wr * 64 + li) * 128;
    const unsigned char* B = smem + buf * 32768 + 16384 + (wc * 64 + li) * 128;
#pragma unroll
    for (int ks = 0; ks < 2; ++ks) {
      const int po = (px ^ (ks * 4)) * 16;
      bf16x8 af[4], bfr[4];
#pragma unroll
      for (int i = 0; i < 4; ++i) {
        af[i] = *(const bf16x8*)(A + i * 2048 + po);
        bfr[i] = *(const bf16x8*)(B + i * 2048 + po);
      }
#pragma unroll
      for (int mi = 0; mi < 4; ++mi)
#pragma unroll
        for (int ni = 0; ni < 4; ++ni)
          acc[mi][ni] = SWAP ? mfma16(bfr[ni], af[mi], acc[mi][ni]) : mfma16(af[mi], bfr[ni], acc[mi][ni]);
    }
  }
  __syncthreads();
}
DEVI float zero_f() { float z = 0.f; asm volatile("" : "+v"(z)); return z; }
DEVI void zero_acc(f32x4 (&acc)[4][4]) {
  const float z = zero_f();
#pragma unroll
  for (int i = 0; i < 4; ++i)
#pragma unroll
    for (int j = 0; j < 4; ++j) acc[i][j] = (f32x4){z, z, z, z};
}
#define EPI_SWAP_BEGIN(m0, n0)                                                                     \
  {                                                                                                \
    const int _lane = TIDX & 63, _w = TIDX >> 6;                                     \
    const int _rb = (m0) + (_w >> 1) * 64 + (_lane & 15), _cb = (n0) + (_w & 1) * 64 + 4 * (_lane >> 4); \
    _Pragma("unroll") for (int mi = 0; mi < 4; ++mi) {                                             \
      const int row = _rb + mi * 16;                                                               \
      _Pragma("unroll") for (int ni = 0; ni < 4; ++ni) {                                           \
        const int col = _cb + ni * 16;
#define EPI_END } __builtin_amdgcn_sched_barrier(0); } }

struct RowLin {
  const unsigned char* base; uint32_t stride;
  DEVI uint32_t operator()(int r) const { return (uint32_t)r * stride; }
};

struct CMap {
  int mode;
  DEVI int operator()(int n) const {
    if (mode == 0) return n;
    if (mode == 1) return n < 672 ? n : (n < 768 ? -1 : n - 96);
    if (mode == 2) return n + 2720;
    if (n < 512) return (n >> 6) * 96 + (n & 63);
    const int m = n - 512, h = m >> 5, w = m & 31;
    return h * 96 + (w < 16 ? 64 + w : 80 + (w - 16));
  }
};
DEVI void transpose_tile(const int TIDX, const int BIDX, const int GDIM, const float* __restrict__ src, int ld, int K, bf16_t* __restrict__ dst, int k0, int n0, CMap cm,
                         const float* kscale, float* tile) {
  const int t = TIDX;
  {
    const int n4 = (t & 15) * 4, kr = t >> 4;
    const int sc = cm(n0 + n4);
#pragma unroll
    for (int p = 0; p < 4; ++p) {
      const int k = kr + 16 * p;
      float4 v = make_float4(0.f, 0.f, 0.f, 0.f);
      if (sc >= 0) {
        v = *(const float4*)(src + (size_t)(k0 + k) * ld + sc);
        if (kscale) { const float sck = kscale[k0 + k]; v.x *= sck; v.y *= sck; v.z *= sck; v.w *= sck; }
      }
      float* d = tile + k * 65 + n4;
      d[0] = v.x; d[1] = v.y; d[2] = v.z; d[3] = v.w;
    }
  }
  __syncthreads();
  {
    const int kc = (t & 7) * 8, nr = t >> 3;
#pragma unroll
    for (int q = 0; q < 2; ++q) {
      const int n = nr + 32 * q;
      const float* sp = tile + kc * 65 + n;
      const uint4 o = make_uint4(pack2(sp[0], sp[65]), pack2(sp[130], sp[195]), pack2(sp[260], sp[325]), pack2(sp[390], sp[455]));
      *(uint4*)(dst + (size_t)(n0 + n) * K + k0 + kc) = o;
    }
  }
  __syncthreads();
}
DEVI void run_transpose(const int TIDX, const int BIDX, const int GDIM, const float* src, int ld, int K, int N, bf16_t* dst, int mode, const float* kscale, float* tile) {
  const int nkt = K >> 6, tiles = nkt * (N >> 6);
  CMap cm{mode};
  for (int t = BIDX; t < tiles; t += GDIM) transpose_tile(TIDX, BIDX, GDIM, src, ld, K, dst, (t % nkt) * 64, (t / nkt) * 64, cm, kscale, tile);
}

DEVI void ln_inplace(float4 (&v)[4], const float* __restrict__ g, const float* __restrict__ b, int lane) {
  float s = 0.f;
#pragma unroll
  for (int j = 0; j < 4; ++j) s += v[j].x + v[j].y + v[j].z + v[j].w;
  s = wave_sum(s);
  const float mu = s * (1.f / 1024.f);
  float q = 0.f;
#pragma unroll
  for (int j = 0; j < 4; ++j) {
    float a = v[j].x - mu, bq = v[j].y - mu, cq = v[j].z - mu, d = v[j].w - mu;
    q += a * a + bq * bq + cq * cq + d * d;
  }
  q = wave_sum(q);
  const float rs = rsqrtf(q * (1.f / 1024.f) + EPS);
#pragma unroll
  for (int j = 0; j < 4; ++j) {
    const float4 gg = *(const float4*)(g + j * 256 + lane * 4), bb = *(const float4*)(b + j * 256 + lane * 4);
    v[j].x = (v[j].x - mu) * rs * gg.x + bb.x;
    v[j].y = (v[j].y - mu) * rs * gg.y + bb.y;
    v[j].z = (v[j].z - mu) * rs * gg.z + bb.z;
    v[j].w = (v[j].w - mu) * rs * gg.w + bb.w;
  }
}
DEVI void store_row(const float4 (&v)[4], float* x32, bf16_t* x16, int lane) {
#pragma unroll
  for (int j = 0; j < 4; ++j) {
    *(uint2*)(x16 + j * 256 + lane * 4) = make_uint2(pack2(v[j].x, v[j].y), pack2(v[j].z, v[j].w));
  }
}
DEVI float4 resid_plus(const uint2 xb, const uint2 mb) {
  return make_float4(lo2f(xb.x) * DN_ALPHA + lo2f(mb.x), hi2f(xb.x) * DN_ALPHA + hi2f(mb.x), lo2f(xb.y) * DN_ALPHA + lo2f(mb.y), hi2f(xb.y) * DN_ALPHA + hi2f(mb.y));
}
DEVI int pos_index(int row) { return row < TP ? (row & 2047) : 2048 + ((row - TP) & 31); }

DEVI void phase_prep(const int TIDX, const int BIDX, const int GDIM, KAP KA, unsigned char* WSB, float* OUTB, unsigned char* smem) {
  float* tile = (float*)smem;
  bf16_t* WS = (bf16_t*)(WSB + O_WS);
  const int tid = TIDX, gtid = BIDX * 256 + tid, gsz = GDIM * 256;
  if (gtid < 512) ((int*)(WSB + O_CNT))[gtid] = 0;
  if (gtid < 64) ((int*)(WSB + O_CNT))[1024 + gtid * 32] = 0;
  if (gtid < 32) ((int*)(WSB + O_CNT))[3072 + (gtid >> 1) * 32 + (gtid & 1) * 16] = 0;
  if (gtid < 512) ((uint32_t*)(WSB + O_XB + (size_t)NTOK * 2048))[gtid] = 0u;
  for (int i = gtid; i < 2080 * 16; i += gsz) {
    const int pi = i >> 4, k = i & 15;
    const int pos = pi < 2048 ? pi : 4096 + (pi - 2048);
    const float inv = exp2f(-(float)k * (13.287712379549449f / 16.f));
    const float ang = (float)pos * inv;
    double rev = (double)ang * 0.15915494309189535;
    rev -= __builtin_rint(rev);
    const float fr = (float)rev;
    float2 cs = make_float2(__builtin_amdgcn_cosf(fr), __builtin_amdgcn_sinf(fr));
    ((float2*)(WSB + O_ROPE))[i] = cs;
  }
  for (int i = gtid; i < 2 * 36 * 1024; i += gsz) {
    const int l = i / (36 * 1024), r = i % (36 * 1024), c = r >> 10, k = r & 1023;
    float v = c < 4 ? PIN(I_WRG)[((size_t)l * 1024 + k) * 4 + c] : PIN(I_WRE)[((size_t)l * 1024 + k) * 32 + (c - 4)];
    ((float*)(WSB + O_WR))[i] = v;
  }
  for (int i = gtid; i < 2 * 16 * 4096 * 8; i += gsz) {
    const int e = i * 4, lb = e / (4096 * 32), r = e % (4096 * 32);
    const float4 v = *(const float4*)(PIN(I_CKR) + (size_t)e);
    *(uint2*)((bf16_t*)(WSB + O_KRS) + (size_t)lb * KPAD * 32 + r) = make_uint2(pack2(v.x, v.y), pack2(v.z, v.w));
  }
  {
    const int lane = tid & 63, wid = BIDX * 4 + (tid >> 6), nw = GDIM * 4;
    for (int row = wid; row < NTOK; row += 2 * nw) {
      const bool hb = row + nw < NTOK;
      const int rws[2] = {row, hb ? row + nw : row};
      float4 v[2][4];
#pragma unroll
      for (int k = 0; k < 2; ++k) {
        const float* src = rws[k] < TP ? PIN(I_XP) + (size_t)rws[k] * 1024 : PIN(I_XS) + (size_t)(rws[k] - TP) * 1024;
#pragma unroll
        for (int j = 0; j < 4; ++j) v[k][j] = *(const float4*)(src + j * 256 + lane * 4);
      }
#pragma unroll
      for (int k = 0; k < 2; ++k) {
        if (k == 0 || hb) {
          ln_inplace(v[k], PIN(I_LN0G), PIN(I_LN0B), lane);
          store_row(v[k], OUTB + (size_t)rws[k] * 1024, (bf16_t*)(WSB + O_XB) + (size_t)rws[k] * 1024, lane);
        }
      }
    }
  }
  for (int l = 0; l < 2; ++l) {
    bf16_t* W = WS + (size_t)l * WO_END;
    run_transpose(TIDX, BIDX, GDIM, PIN(I_WIN) + (size_t)l * 1024 * 4768, 4768, 1024, 2816, W + WO_IN, 1, nullptr, tile);
    run_transpose(TIDX, BIDX, GDIM, PIN(I_WIN) + (size_t)l * 1024 * 4768, 4768, 1024, 2048, W + WO_G, 2, nullptr, tile);
    run_transpose(TIDX, BIDX, GDIM, PIN(I_WUQ) + (size_t)l * 384 * 768, 768, 384, 768, W + WO_UQ, 3, PIN(I_QN) + l * 384, tile);
    run_transpose(TIDX, BIDX, GDIM, PIN(I_WUK) + (size_t)l * 256 * 512, 512, 256, 512, W + WO_KV, 0, nullptr, tile);
    run_transpose(TIDX, BIDX, GDIM, PIN(I_WUV) + (size_t)l * 256 * 512, 512, 256, 512, W + WO_KV + 512 * 256, 0, nullptr, tile);
    run_transpose(TIDX, BIDX, GDIM, PIN(I_WBRA) + (size_t)l * 512 * 1024, 1024, 512, 1024, W + WO_BRA, 0, nullptr, tile);
    run_transpose(TIDX, BIDX, GDIM, PIN(I_WBRB) + (size_t)l * 512 * 1024, 1024, 512, 1024, W + WO_BRB, 0, nullptr, tile);
    run_transpose(TIDX, BIDX, GDIM, PIN(I_WOUT) + (size_t)l * 1024 * 1024, 1024, 1024, 1024, W + WO_OUT, 0, nullptr, tile);
    run_transpose(TIDX, BIDX, GDIM, PIN(I_WPG) + (size_t)l * 1024 * 1024, 1024, 1024, 1024, W + WO_PG, 0, nullptr, tile);
    run_transpose(TIDX, BIDX, GDIM, PIN(I_WPLE) + (size_t)l * 256 * 1024, 1024, 256, 1024, W + WO_PLE, 0, nullptr, tile);
  }
}

DEVI void phase_p1(const int TIDX, const int BIDX, const int GDIM, KAP KA, unsigned char* WSB, float* OUTB, int l, unsigned char* smem) {
  const bf16_t* XB = (const bf16_t*)(WSB + O_XB);
  const bf16_t* W = (const bf16_t*)(WSB + O_WS) + (size_t)l * WO_END + WO_IN;
  bf16_t* CQ = (bf16_t*)(WSB + O_CQ);
  float* CKR = (float*)(WSB + O_CKR);
  bf16_t* FQ = (bf16_t*)(WSB + O_FQ);
  bf16_t* VT2 = (bf16_t*)(WSB + O_VT2);
  bf16_t* G = (bf16_t*)(WSB + O_G);
  for (int item = (BIDX & 7) * (GDIM >> 3) + (BIDX >> 3); item < 516 * 22; item += GDIM) {
    const int mt = item / 22, nt = item % 22, m0 = mt * 128;
    f32x4 acc[4][4];
    zero_acc(acc);
    RowLin rp{(const unsigned char*)(XB + (size_t)m0 * 1024), 2048};
    if (nt >= 14 && nt < 18) {
      gemm_main<false>(TIDX, BIDX, GDIM, acc, rp, W + (size_t)nt * 128 * 1024, 1024, 1024, smem);
      const int h = nt - 14, lane = TIDX & 63, w = TIDX >> 6;
      const int rb = m0 + (w >> 1) * 64 + 4 * (lane >> 4), cb = (w & 1) * 64 + (lane & 15);
#pragma unroll
      for (int mi = 0; mi < 4; ++mi) {
        const int row = rb + mi * 16, ch = row >> 5, s = row & 31;
#pragma unroll
        for (int ni = 0; ni < 4; ++ni) {
          const int dv = cb + ni * 16;
          const f32x4 a = acc[mi][ni];
          *(uint2*)(VT2 + ((size_t)(ch * 4 + h) * 128 + dv) * 32 + s) = make_uint2(pack2(a[0], a[1]), pack2(a[2], a[3]));
        }
      }
    } else {
      gemm_main<true>(TIDX, BIDX, GDIM, acc, rp, W + (size_t)nt * 128 * 1024, 1024, 1024, smem);
      EPI_SWAP_BEGIN(m0, 0)
        const f32x4 a = acc[mi][ni];
        if (nt < 3) {
          *(uint2*)(CQ + (size_t)row * 384 + nt * 128 + col) = make_uint2(pack2(a[0], a[1]), pack2(a[2], a[3]));
        } else if (nt < 5) {
          *(f32x4*)(CKR + (size_t)row * 288 + (nt - 3) * 128 + col) = a;
        } else if (nt == 5) {
          if (col < 32) *(f32x4*)(CKR + (size_t)row * 288 + 256 + col) = a;
        } else if (nt < 14) {
          *(uint2*)(FQ + (size_t)row * 1024 + (nt - 6) * 128 + col) = make_uint2(pack2(a[0], a[1]), pack2(a[2], a[3]));
        } else {
          *(uint2*)(G + (size_t)row * 512 + (nt - 18) * 128 + col) = make_uint2(pack2(a[0], a[1]), pack2(a[2], a[3]));
        }
      EPI_END
    }
  }
}

DEVI void phase_p2(const int TIDX, const int BIDX, const int GDIM, KAP KA, unsigned char* WSB, float* OUTB, int l, unsigned char* smem) {
  const int tid = TIDX, lane = tid & 63;
  const float2* ROPE = (const float2*)(WSB + O_ROPE);
  {
    const bf16_t* CQ = (const bf16_t*)(WSB + O_CQ);
    const bf16_t* W = (const bf16_t*)(WSB + O_WS) + (size_t)l * WO_END + WO_UQ;
    bf16_t* QB = (bf16_t*)(WSB + O_QB);
    float* srow = (float*)(smem + SMEM_GEMM);
    for (int item = (BIDX & 7) * (GDIM >> 3) + (BIDX >> 3); item < 516 * 6; item += GDIM) {
      const int mt = item / 6, nt = item % 6, m0 = mt * 128;
      {
        const int r = tid >> 1, hf = tid & 1;
        const uint4* s = (const uint4*)(CQ + (size_t)(m0 + r) * 384 + hf * 192);
        float ss = 0.f;
#pragma unroll 4
        for (int j = 0; j < 24; ++j) {
          const uint4 u = s[j];
          float a;
          a = lo2f(u.x); ss += a * a; a = hi2f(u.x); ss += a * a;
          a = lo2f(u.y); ss += a * a; a = hi2f(u.y); ss += a * a;
          a = lo2f(u.z); ss += a * a; a = hi2f(u.z); ss += a * a;
          a = lo2f(u.w); ss += a * a; a = hi2f(u.w); ss += a * a;
        }
        ss += __shfl_xor(ss, 1);
        if (hf == 0) srow[r] = rsqrtf(ss * (1.f / 384.f) + EPS) * QSCALE;
      }
      f32x4 acc[4][4];
      zero_acc(acc);
      RowLin rp{(const unsigned char*)(CQ + (size_t)m0 * 384), 768};
      gemm_main<true>(TIDX, BIDX, GDIM, acc, rp, W + (size_t)nt * 128 * 384, 384, 384, smem);
      if (nt < 4) {
        EPI_SWAP_BEGIN(m0, nt * 128)
          const float sc = srow[row - m0];
          const f32x4 a = acc[mi][ni] * sc;
          const int hh = col >> 6, d = col & 63;
          *(uint2*)(QB + (size_t)row * 768 + hh * 96 + d) = make_uint2(pack2(a[0], a[1]), pack2(a[2], a[3]));
        EPI_END
      } else {
        const int w = tid >> 6;
        const int rb = m0 + (w >> 1) * 64 + (lane & 15), i0 = 4 * (lane >> 4);
#pragma unroll
        for (int mi = 0; mi < 4; ++mi) {
          const int row = rb + mi * 16;
          const float sc = srow[row - m0];
          const float2* rt = ROPE + (size_t)pos_index(row) * 16 + i0;
#pragma unroll
          for (int pr = 0; pr < 2; ++pr) {
            const int hh = (nt - 4) * 4 + (w & 1) * 2 + pr;
            const f32x4 x1 = acc[mi][2 * pr] * sc, x2 = acc[mi][2 * pr + 1] * sc;
            float o1[4], o2[4];
#pragma unroll
            for (int r = 0; r < 4; ++r) {
              const float2 cs = rt[r];
              o1[r] = x1[r] * cs.x - x2[r] * cs.y;
              o2[r] = x2[r] * cs.x + x1[r] * cs.y;
            }
            *(uint2*)(QB + (size_t)row * 768 + hh * 96 + 64 + i0) = make_uint2(pack2(o1[0], o1[1]), pack2(o1[2], o1[3]));
            *(uint2*)(QB + (size_t)row * 768 + hh * 96 + 80 + i0) = make_uint2(pack2(o2[0], o2[1]), pack2(o2[2], o2[3]));
          }
        }
      }
      __syncthreads();
    }
  }
  {
    const bf16_t* FQ = (const bf16_t*)(WSB + O_FQ);
    bf16_t* QT = (bf16_t*)(WSB + O_QT);
    bf16_t* KHT = (bf16_t*)(WSB + O_KHT);
    bf16_t* AM = (bf16_t*)(WSB + O_AM);
    float* EBp = (float*)(WSB + O_EB);
    bf16_t* sQ = (bf16_t*)smem;
    bf16_t* sK = sQ + 32 * 136;
    for (int item = BIDX; item < NCH * 4; item += GDIM) {
      const int ch = item >> 2, h = item & 3, cid = item;
      {
        const int k = tid & 127, half = tid >> 7, colh = h * 128 + k;
        float* sB = (float*)(smem + 2 * 32 * 136 * 2);
        float lb = 0.f;
        if (l == 1) { const float a0 = PIN(I_HGLB)[colh], a1 = PIN(I_HGLB)[512 + colh]; lb = 1.f / (1.f + expf(a0 - a1)); }
        const float oml = 1.f - lb;
        float bt[16], kk[16], qv[16];
        float bl = 0.f;
#pragma unroll
        for (int j = 0; j < 16; ++j) {
          const size_t row = (size_t)ch * 32 + half * 16 + j;
          const float z = bf2f(FQ[row * 1024 + colh]);
          qv[j] = bf2f(FQ[row * 1024 + 512 + colh]);
          const float e = __expf(-z);
          const float inv = __builtin_amdgcn_rcpf(1.f + e);
          const float f = lb + oml * inv;
          kk[j] = oml * e * inv;
          bl += __logf(f);
          bt[j] = bl;
        }
        sB[half * 128 + k] = bl;
        __syncthreads();
        const float b0 = sB[k], b1 = sB[128 + k];
        const float off = half ? b0 : 0.f, bend = b0 + b1;
        uint32_t pk[8];
#pragma unroll
        for (int j = 0; j < 16; ++j) {
          const int t = half * 16 + j;
          const float b = bt[j] + off;
          const float qs = qv[j] * __builtin_amdgcn_rcpf(1.f + __expf(-qv[j]));
          const bf16_t qt = f2bf(qs * __expf(b));
          QT[((size_t)cid * 32 + t) * 128 + k] = qt;
          sQ[t * 136 + k] = qt;
          sK[t * 136 + k] = f2bf(kk[j] * __expf(fminf(-b, 80.f)));
          bt[j] = kk[j] * __expf(bend - b);
        }
#pragma unroll
        for (int j = 0; j < 8; ++j) pk[j] = pack2(bt[2 * j], bt[2 * j + 1]);
        if (half == 0) EBp[(size_t)cid * 128 + k] = __expf(bend);
        uint4* dst = (uint4*)(KHT + ((size_t)cid * 128 + k) * 32 + half * 16);
        dst[0] = make_uint4(pk[0], pk[1], pk[2], pk[3]);
        dst[1] = make_uint4(pk[4], pk[5], pk[6], pk[7]);
      }
      __syncthreads();
      if (tid < 64) {
        const int c = lane & 31, hh = lane >> 5;
        f32x16 am;
        const float zf = zero_f();
#pragma unroll
        for (int r = 0; r < 16; ++r) am[r] = zf;
#pragma unroll
        for (int st = 0; st < 8; ++st) {
          const bf16x8 a = *(const bf16x8*)(sQ + c * 136 + st * 16 + hh * 8);
          const bf16x8 bb = *(const bf16x8*)(sK + c * 136 + st * 16 + hh * 8);
          am = mfma32(a, bb, am);
        }
#pragma unroll
        for (int r = 0; r < 16; ++r) {
          const int t = (r & 3) + 8 * (r >> 2) + 4 * hh;
          AM[((size_t)cid * 32 + t) * 32 + c] = f2bf(c <= t ? am[r] : 0.f);
        }
      }
      __syncthreads();
    }
  }
  {
    const float* src = PIN(I_CCKV) + (size_t)l * 16 * 4096 * 256;
    bf16_t* CCB = (bf16_t*)(WSB + O_CCB);
    const size_t str_ = (size_t)GDIM * 256;
    for (size_t i = (size_t)BIDX * 256 + tid; i < 16ull * 4096 * 64; i += 4 * str_) {
      float4 v4[4];
#pragma unroll
      for (int k = 0; k < 4; ++k) { const size_t ii = i + k * str_ < 16ull * 4096 * 64 ? i + k * str_ : i; v4[k] = *(const float4*)(src + ii * 4); }
#pragma unroll
      for (int k = 0; k < 4; ++k) if (i + k * str_ < 16ull * 4096 * 64) *(uint2*)(CCB + (i + k * str_) * 4) = make_uint2(pack2(v4[k].x, v4[k].y), pack2(v4[k].z, v4[k].w));
    }
  }
  {
    const float* CKR = (const float*)(WSB + O_CKR);
    bf16_t* CKVN = (bf16_t*)(WSB + O_CKVN);
    bf16_t* KRB = (bf16_t*)(WSB + O_KRB);
    bf16_t* KRS = (bf16_t*)(WSB + O_KRS) + (size_t)l * 16 * KPAD * 32;
    const float* kvn = PIN(I_KVN) + l * 256;
    const int wid = BIDX * 4 + (tid >> 6), nw = GDIM * 4;
    const float4 g = *(const float4*)(kvn + lane * 4);
    for (int row0 = wid; row0 < NTOK; row0 += 4 * nw) {
      int rws[4]; bool ok4[4];
      float4 v[4]; float x1[4], x2[4]; float2 cs[4];
#pragma unroll
      for (int k = 0; k < 4; ++k) {
        ok4[k] = row0 + k * nw < NTOK;
        rws[k] = ok4[k] ? row0 + k * nw : row0;
        const float* src = CKR + (size_t)rws[k] * 288;
        v[k] = *(const float4*)(src + lane * 4);
        x1[k] = src[256 + (lane & 15)]; x2[k] = src[272 + (lane & 15)];
        cs[k] = ROPE[(size_t)pos_index(rws[k]) * 16 + (lane & 15)];
      }
#pragma unroll
      for (int k = 0; k < 4; ++k) {
        if (ok4[k]) {
          const int row = rws[k];
          float ss = wave_sum(v[k].x * v[k].x + v[k].y * v[k].y + v[k].z * v[k].z + v[k].w * v[k].w);
          const float rs = rsqrtf(ss * (1.f / 256.f) + EPS);
          const float4 o = make_float4(v[k].x * rs * g.x, v[k].y * rs * g.y, v[k].z * rs * g.z, v[k].w * rs * g.w);
          float* oc = row < TP ? OUTB + OUT_CKV_P + ((size_t)l * TP + row) * 256 : OUTB + OUT_CKV_S + ((size_t)l * TS + (row - TP)) * 256;
          *(float4*)(oc + lane * 4) = o;
          *(uint2*)(CKVN + (size_t)row * 256 + lane * 4) = make_uint2(pack2(o.x, o.y), pack2(o.z, o.w));
          if (lane < 16) {
            const float o1 = x1[k] * cs[k].x - x2[k] * cs[k].y, o2 = x2[k] * cs[k].x + x1[k] * cs[k].y;
            float* okp = row < TP ? OUTB + OUT_KR_P + ((size_t)l * TP + row) * 32 : OUTB + OUT_KR_S + ((size_t)l * TS + (row - TP)) * 32;
            okp[lane] = o1;
            okp[16 + lane] = o2;
            bf16_t* kb = row < TP ? KRB + (size_t)row * 32 : KRS + ((size_t)((row - TP) >> 5) * KPAD + 4096 + ((row - TP) & 31)) * 32;
            kb[lane] = f2bf(o1);
            kb[16 + lane] = f2bf(o2);
          }
        }
      }
    }
  }
}

DEVI void phase_p3(const int TIDX, const int BIDX, const int GDIM, KAP KA, unsigned char* WSB, float* OUTB, int l, unsigned char* smem) {
  const bf16_t* W = (const bf16_t*)(WSB + O_WS) + (size_t)l * WO_END + WO_KV;
  const bf16_t* CKVN = (const bf16_t*)(WSB + O_CKVN);
  bf16_t* KN = (bf16_t*)(WSB + O_KN);
  bf16_t* VT = (bf16_t*)(WSB + O_VT);
  bf16_t* KNS = (bf16_t*)(WSB + O_KNS);
  bf16_t* VTS = (bf16_t*)(WSB + O_VTS);
  const bf16_t* cache = (const bf16_t*)(WSB + O_CCB);
  for (int i = BIDX * 256 + TIDX; i < 16 * 8 * 64 * 4; i += GDIM * 256) {
    const uint32_t z = __float_as_uint(zero_f());
    *(uint4*)(VTS + (size_t)(i >> 2) * KPAD + 4128 + (i & 3) * 8) = make_uint4(z, z, z, z);
  }
  for (int item = (BIDX & 7) * (GDIM >> 3) + (BIDX >> 3); item < (516 + 512) * 8; item += GDIM) {
    const int mt = item >> 3, nt = item & 7;
    const bool is_cache = mt >= 516;
    const int m0 = is_cache ? (mt - 516) * 128 : mt * 128;
    f32x4 acc[4][4];
    zero_acc(acc);
    bf16_t* kdst; bf16_t* vdst; size_t ldv; int key0;
    if (is_cache) { const int b = m0 >> 12; key0 = m0 & 4095; kdst = KNS + ((size_t)b * KPAD + key0) * 512; vdst = VTS + (size_t)b * 8 * 64 * KPAD; ldv = KPAD; }
    else if (m0 >= TP) { kdst = nullptr; vdst = nullptr; ldv = KPAD; key0 = 0; }
    else { const int b = m0 >> 11; key0 = m0 & 2047; kdst = KN + (size_t)m0 * 512; vdst = VT + (size_t)b * 8 * 64 * 2048; ldv = 2048; }
    if (nt < 4) {
      if (is_cache) { RowLin rp{(const unsigned char*)(cache + (size_t)m0 * 256), 512}; gemm_main<true>(TIDX, BIDX, GDIM, acc, rp, W + (size_t)nt * 128 * 256, 256, 256, smem); }
      else { RowLin rp{(const unsigned char*)(CKVN + (size_t)m0 * 256), 512}; gemm_main<true>(TIDX, BIDX, GDIM, acc, rp, W + (size_t)nt * 128 * 256, 256, 256, smem); }
      EPI_SWAP_BEGIN(0, nt * 128)
        const f32x4 a = acc[mi][ni];
        bf16_t* d;
        if (kdst) d = kdst + (size_t)row * 512 + col;
        else { const int sr = m0 - TP + row; d = KNS + ((size_t)(sr >> 5) * KPAD + 4096 + (sr & 31)) * 512 + col; }
        *(uint2*)d = make_uint2(pack2(a[0], a[1]), pack2(a[2], a[3]));
      EPI_END
    } else {
      if (is_cache) { RowLin rp{(const unsigned char*)(cache + (size_t)m0 * 256), 512}; gemm_main<false>(TIDX, BIDX, GDIM, acc, rp, W + (size_t)nt * 128 * 256, 256, 256, smem); }
      else { RowLin rp{(const unsigned char*)(CKVN + (size_t)m0 * 256), 512}; gemm_main<false>(TIDX, BIDX, GDIM, acc, rp, W + (size_t)nt * 128 * 256, 256, 256, smem); }
      const int lane = TIDX & 63, w = TIDX >> 6;
      const int rb = (w >> 1) * 64 + 4 * (lane >> 4), cb = (nt - 4) * 128 + (w & 1) * 64 + (lane & 15);
#pragma unroll
      for (int mi = 0; mi < 4; ++mi) {
        const int row = rb + mi * 16;
#pragma unroll
        for (int ni = 0; ni < 4; ++ni) {
          const int hv = cb + ni * 16;
          const f32x4 a = acc[mi][ni];
          bf16_t* d;
          if (vdst) d = vdst + (size_t)hv * ldv + key0 + row;
          else { const int sr = m0 - TP + row; d = VTS + ((size_t)(sr >> 5) * 512 + hv) * KPAD + 4096 + (sr & 31); }
          *(uint2*)d = make_uint2(pack2(a[0], a[1]), pack2(a[2], a[3]));
        }
      }
    }
  }
}

DEVI void attn_item(const int TIDX, const int BIDX, const int GDIM, const bf16_t* __restrict__ Q, int qrow0, int nq, int ng, const bf16_t* __restrict__ Kn, const bf16_t* __restrict__ Kr,
                    const bf16_t* __restrict__ VT, size_t ldv, int nkeys, bf16_t* __restrict__ O, unsigned char* smem) {
  const int tid = TIDX, lane = tid & 63, w = tid >> 6, li = lane & 15, lg = lane >> 4;
  const int ql = 16 * w + li;
  bf16x8 qf[2][3];
  f32x4 oT[2][4];
  float mrun[2], lrun[2];
  const float zf = zero_f();
#pragma unroll
  for (int g = 0; g < 2; ++g) {
    const int qr = qrow0 + (g == 0 ? (ql < nq ? ql : nq - 1) : 64 + ql);
    const int qrc = (g == 1 && ng < 2) ? qrow0 : qr;
#pragma unroll
    for (int ds = 0; ds < 3; ++ds) qf[g][ds] = *(const bf16x8*)(Q + (size_t)qrc * 768 + ds * 32 + lg * 8);
#pragma unroll
    for (int i = 0; i < 4; ++i) oT[g][i] = (f32x4){zf, zf, zf, zf};
    mrun[g] = -INFINITY; lrun[g] = 0.f;
  }
  const int nt = (nkeys + 63) >> 6;
  const int r8 = lane >> 3;
  const uint32_t sch = (uint32_t)((lane & 7) ^ (((lane >> 4) + 4 * (w & 1)) & 7)) * 16u;
  const unsigned char* kn0 = (const unsigned char*)Kn + (size_t)(w * 8 + r8) * 1024 + sch;
  const unsigned char* kr0 = (const unsigned char*)Kr + (size_t)(w * 16 + (lane >> 2)) * 64 + (uint32_t)((lane & 3) ^ (((lane >> 5) & 1) << 1)) * 16u;
  const unsigned char* v0 = (const unsigned char*)VT + (size_t)(w * 8 + r8) * ldv * 2 + sch;
  const size_t v32 = (size_t)32 * ldv * 2;
  unsigned char* sw = smem + w * 1024;
#define ATT_STAGE(kt_)                                                                                                  \
  {                                                                                                                     \
    unsigned char* st_ = sw + ((kt_) % 3) * 20480;                                                                      \
    const size_t kb_ = (size_t)(kt_) * 64;                                                                              \
    __builtin_amdgcn_global_load_lds((const unsigned*)(kn0 + kb_ * 1024), (unsigned*)(st_), 16, 0, 0);                  \
    __builtin_amdgcn_global_load_lds((const unsigned*)(kn0 + kb_ * 1024 + 32768), (unsigned*)(st_ + 4096), 16, 0, 0);   \
    __builtin_amdgcn_global_load_lds((const unsigned*)(kr0 + kb_ * 64), (unsigned*)(st_ + 8192), 16, 0, 0);             \
    __builtin_amdgcn_global_load_lds((const unsigned*)(v0 + kb_ * 2), (unsigned*)(st_ + 12288), 16, 0, 0);              \
    __builtin_amdgcn_global_load_lds((const unsigned*)(v0 + v32 + kb_ * 2), (unsigned*)(st_ + 12288 + 4096), 16, 0, 0); \
  }
  ATT_STAGE(0);
  if (nt > 1) ATT_STAGE(1);
  const int pk0 = (lg ^ (li >> 1)) * 16;
  const int pkr = (lg ^ (((li >> 3) & 1) << 1)) * 16;
  const int pv0 = ((lg >> 1) ^ (li >> 1)) * 16 + (lg & 1) * 8;
  for (int kt = 0; kt < nt; ++kt) {
    if (kt + 1 < nt) asm volatile("s_waitcnt vmcnt(5)" ::: "memory");
    else asm volatile("s_waitcnt vmcnt(0)" ::: "memory");
    __builtin_amdgcn_s_barrier();
    asm volatile("" ::: "memory");
    if (kt + 2 < nt) ATT_STAGE(kt + 2);
    const unsigned char* st = smem + (kt % 3) * 20480;
    const bool tail = (kt == nt - 1) && (nkeys & 63);
    const bool two = (ng == 2);
    const bool g0on = !(two && kt == nt - 1);
    f32x4 sT[2][4];
#pragma unroll
    for (int kb = 0; kb < 4; ++kb) {
      const unsigned char* kr_ = st + (kb * 16 + li) * 128;
      const bf16x8 k0 = *(const bf16x8*)(kr_ + pk0), k1 = *(const bf16x8*)(kr_ + (pk0 ^ 64)), k2 = *(const bf16x8*)(st + 8192 + (kb * 16 + li) * 64 + pkr);
      sT[0][kb] = (f32x4){zf, zf, zf, zf};
      sT[1][kb] = (f32x4){zf, zf, zf, zf};
      if (g0on) {
        sT[0][kb] = mfma16(k0, qf[0][0], sT[0][kb]);
        sT[0][kb] = mfma16(k1, qf[0][1], sT[0][kb]);
        sT[0][kb] = mfma16(k2, qf[0][2], sT[0][kb]);
      }
      if (two) {
        sT[1][kb] = mfma16(k0, qf[1][0], sT[1][kb]);
        sT[1][kb] = mfma16(k1, qf[1][1], sT[1][kb]);
        sT[1][kb] = mfma16(k2, qf[1][2], sT[1][kb]);
      }
    }
    bf16x8 pf[2][2];
#pragma unroll
    for (int g = 0; g < 2; ++g) {
      if (g == 0 ? g0on : two) {
        if (tail) {
#pragma unroll
          for (int kb = 0; kb < 4; ++kb)
#pragma unroll
            for (int r = 0; r < 4; ++r)
              if (kt * 64 + kb * 16 + 4 * lg + r >= nkeys) sT[g][kb][r] = -INFINITY;
        }
        float mx = sT[g][0][0];
#pragma unroll
        for (int kb = 0; kb < 4; ++kb)
#pragma unroll
          for (int r = 0; r < 4; ++r) mx = fmaxf(mx, sT[g][kb][r]);
        mx = fmaxf(mx, __shfl_xor(mx, 16));
        mx = fmaxf(mx, __shfl_xor(mx, 32));
        const float mnew = fmaxf(mrun[g], mx);
        const float alpha = __builtin_amdgcn_exp2f(mrun[g] - mnew);
        mrun[g] = mnew;
        float ps = 0.f;
#pragma unroll
        for (int kb = 0; kb < 4; ++kb)
#pragma unroll
          for (int r = 0; r < 4; ++r) { const float pv = __builtin_amdgcn_exp2f(sT[g][kb][r] - mnew); sT[g][kb][r] = pv; ps += pv; }
        lrun[g] = lrun[g] * alpha + ps;
#pragma unroll
        for (int vb = 0; vb < 4; ++vb) oT[g][vb] *= alpha;
      }
#pragma unroll
      for (int s2 = 0; s2 < 2; ++s2)
        pf[g][s2] = mk8(pack2(sT[g][2 * s2][0], sT[g][2 * s2][1]), pack2(sT[g][2 * s2][2], sT[g][2 * s2][3]),
                        pack2(sT[g][2 * s2 + 1][0], sT[g][2 * s2 + 1][1]), pack2(sT[g][2 * s2 + 1][2], sT[g][2 * s2 + 1][3]));
    }
#pragma unroll
    for (int s2 = 0; s2 < 2; ++s2) {
#pragma unroll
      for (int vb = 0; vb < 4; ++vb) {
        const unsigned char* vr_ = st + 12288 + (vb * 16 + li) * 128;
        const uint2 lo = *(const uint2*)(vr_ + (pv0 ^ (s2 * 64)));
        const uint2 hi = *(const uint2*)(vr_ + (pv0 ^ (s2 * 64) ^ 32));
        const bf16x8 vfr = mk8(lo, hi);
        if (g0on) oT[0][vb] = mfma16(vfr, pf[0][s2], oT[0][vb]);
        if (two) oT[1][vb] = mfma16(vfr, pf[1][s2], oT[1][vb]);
      }
    }
  }
#pragma unroll
  for (int g = 0; g < 2; ++g) {
    float lr = lrun[g];
    lr += __shfl_xor(lr, 16);
    lr += __shfl_xor(lr, 32);
    const float inv = 1.f / lr;
    const bool st_ok = g == 0 ? (ql < nq) : (ng == 2);
    if (st_ok) {
#pragma unroll
      for (int vb = 0; vb < 4; ++vb) {
        const f32x4 o = oT[g][vb] * inv;
        *(uint2*)(O + (size_t)(qrow0 + g * 64 + ql) * 512 + vb * 16 + 4 * lg) = make_uint2(pack2(o[0], o[1]), pack2(o[2], o[3]));
      }
    }
  }
  __syncthreads();
}

DEVI void hgrn_item(const int TIDX, const int BIDX, const int GDIM, KAP KA, unsigned char* WSB, float* OUTB, int l, int g0, int nchunks, int h, const float* __restrict__ S0, float* __restrict__ Sout, int rowbase,
                    unsigned char* smem) {
  constexpr int STG = 35840;
  const unsigned char* QT = WSB + O_QT;
  const unsigned char* KHT = WSB + O_KHT;
  const unsigned char* AM = WSB + O_AM;
  const unsigned char* EBp = WSB + O_EB;
  const unsigned char* VT2 = WSB + O_VT2;
  const unsigned char* G = WSB + O_G;
  bf16_t* HO = (bf16_t*)(WSB + O_HO);
  const float* hgn = PIN(I_HGN) + l * 512 + h * 128;
  float* sred = (float*)(smem + SMEM_GEMM);
  const int tid = TIDX, lane = tid & 63, w = tid >> 6, c = lane & 31, hh = lane >> 5;
  const int dvg = 32 * w + c;
  f32x16 S[4];
  if (S0 != nullptr) {
#pragma unroll
    for (int kt = 0; kt < 4; ++kt)
#pragma unroll
      for (int r = 0; r < 16; ++r) S[kt][r] = S0[(size_t)(32 * kt + (r & 3) + 8 * (r >> 2) + 4 * hh) * 128 + dvg];
  } else {
    const float z0 = zero_f();
#pragma unroll
    for (int kt = 0; kt < 4; ++kt)
#pragma unroll
      for (int r = 0; r < 16; ++r) S[kt][r] = z0;
  }
  float4 gn[4];
#pragma unroll
  for (int q = 0; q < 4; ++q) gn[q] = *(const float4*)(hgn + 32 * w + 8 * q + 4 * hh);
  const uint32_t lo16 = (uint32_t)lane * 16u;
  const uint32_t goff = (uint32_t)(w * 4 + (lane >> 4)) * 1024u + (uint32_t)h * 256u + (uint32_t)(lane & 15) * 16u;
#define HG_STAGE(ch_)                                                                                                                  \
  {                                                                                                                                    \
    unsigned char* st_ = smem + ((ch_) & 1) * STG + w * 1024;                                                                          \
    const size_t cid_ = (size_t)(g0 + (ch_)) * 4 + h;                                                                                  \
    const size_t grow_ = ((size_t)rowbase + (size_t)(ch_) * 32) * 1024;                                                                \
    __builtin_amdgcn_global_load_lds((const unsigned*)(QT + cid_ * 8192 + w * 1024 + lo16), (unsigned*)(st_), 16, 0, 0);              \
    __builtin_amdgcn_global_load_lds((const unsigned*)(QT + cid_ * 8192 + 4096 + w * 1024 + lo16), (unsigned*)(st_ + 4096), 16, 0, 0); \
    __builtin_amdgcn_global_load_lds((const unsigned*)(KHT + cid_ * 8192 + w * 1024 + lo16), (unsigned*)(st_ + 8192), 16, 0, 0);       \
    __builtin_amdgcn_global_load_lds((const unsigned*)(KHT + cid_ * 8192 + 4096 + w * 1024 + lo16), (unsigned*)(st_ + 12288), 16, 0, 0); \
    __builtin_amdgcn_global_load_lds((const unsigned*)(VT2 + cid_ * 8192 + w * 1024 + lo16), (unsigned*)(st_ + 16384), 16, 0, 0);      \
    __builtin_amdgcn_global_load_lds((const unsigned*)(VT2 + cid_ * 8192 + 4096 + w * 1024 + lo16), (unsigned*)(st_ + 20480), 16, 0, 0); \
    __builtin_amdgcn_global_load_lds((const unsigned*)(G + grow_ + goff), (unsigned*)(st_ + 24576), 16, 0, 0);                         \
    __builtin_amdgcn_global_load_lds((const unsigned*)(G + grow_ + 16384 + goff), (unsigned*)(st_ + 28672), 16, 0, 0);                 \
    if (w < 2) __builtin_amdgcn_global_load_lds((const unsigned*)(AM + cid_ * 2048 + w * 1024 + lo16), (unsigned*)(st_ + 32768), 16, 0, 0); \
    else if (w == 2) __builtin_amdgcn_global_load_lds((const unsigned*)(EBp + cid_ * 512 + lo16), (unsigned*)(smem + ((ch_) & 1) * STG + 34816), 16, 0, 0); \
  }
  HG_STAGE(0);
  for (int ch = 0; ch < nchunks; ++ch) {
    asm volatile("s_waitcnt vmcnt(0)" ::: "memory");
    __builtin_amdgcn_s_barrier();
    asm volatile("" ::: "memory");
    if (ch + 1 < nchunks) HG_STAGE(ch + 1);
    const unsigned char* st = smem + (ch & 1) * STG;
    bf16x8 vf[2], af[2];
#pragma unroll
    for (int s2 = 0; s2 < 2; ++s2) {
      vf[s2] = *(const bf16x8*)(st + 16384 + dvg * 64 + 32 * s2 + 16 * hh);
      af[s2] = *(const bf16x8*)(st + 32768 + c * 64 + 32 * s2 + 16 * hh);
    }
    f32x16 oT;
    const float zf = zero_f();
#pragma unroll
    for (int r = 0; r < 16; ++r) oT[r] = zf;
#pragma unroll
    for (int kt = 0; kt < 4; ++kt) {
#pragma unroll
      for (int s2 = 0; s2 < 2; ++s2) {
        const uint2 lo = *(const uint2*)(st + c * 256 + 64 * kt + 32 * s2 + 8 * hh);
        const uint2 hi = *(const uint2*)(st + c * 256 + 64 * kt + 32 * s2 + 16 + 8 * hh);
        const bf16x8 sa = mk8(pack2(S[kt][8 * s2 + 0], S[kt][8 * s2 + 1]), pack2(S[kt][8 * s2 + 2], S[kt][8 * s2 + 3]),
                              pack2(S[kt][8 * s2 + 4], S[kt][8 * s2 + 5]), pack2(S[kt][8 * s2 + 6], S[kt][8 * s2 + 7]));
        oT = mfma32(sa, mk8(lo, hi), oT);
      }
    }
#pragma unroll
    for (int s2 = 0; s2 < 2; ++s2) oT = mfma32(vf[s2], af[s2], oT);
#pragma unroll
    for (int kt = 0; kt < 4; ++kt) {
#pragma unroll
      for (int q = 0; q < 4; ++q) {
        const float4 e = *(const float4*)(st + 34816 + (32 * kt + 8 * q + 4 * hh) * 4);
        S[kt][4 * q + 0] *= e.x; S[kt][4 * q + 1] *= e.y; S[kt][4 * q + 2] *= e.z; S[kt][4 * q + 3] *= e.w;
      }
#pragma unroll
      for (int s2 = 0; s2 < 2; ++s2) {
        const bf16x8 kf = *(const bf16x8*)(st + 8192 + (32 * kt + c) * 64 + 32 * s2 + 16 * hh);
        S[kt] = mfma32(kf, vf[s2], S[kt]);
      }
    }
    float ss = 0.f;
#pragma unroll
    for (int r = 0; r < 16; ++r) ss += oT[r] * oT[r];
    ss += __shfl_xor(ss, 32);
    float* sr = sred + (ch & 1) * 128;
    if (lane < 32) sr[w * 32 + c] = ss;
    asm volatile("s_waitcnt lgkmcnt(0)" ::: "memory");
    __builtin_amdgcn_s_barrier();
    asm volatile("" ::: "memory");
    const float tot = sr[c] + sr[32 + c] + sr[64 + c] + sr[96 + c];
    const float rs = rsqrtf(tot * (1.f / 128.f) + EPS);
    const size_t row = (size_t)rowbase + ch * 32 + c;
#pragma unroll
    for (int q = 0; q < 4; ++q) {
      const int dv0 = 32 * w + 8 * q + 4 * hh;
      const uint2 gp = *(const uint2*)(st + 24576 + c * 256 + dv0 * 2);
      const float o0 = oT[4 * q + 0] * rs * gn[q].x * silu_fast(lo2f(gp.x));
      const float o1 = oT[4 * q + 1] * rs * gn[q].y * silu_fast(hi2f(gp.x));
      const float o2 = oT[4 * q + 2] * rs * gn[q].z * silu_fast(lo2f(gp.y));
      const float o3 = oT[4 * q + 3] * rs * gn[q].w * silu_fast(hi2f(gp.y));
      *(uint2*)(HO + row * 512 + h * 128 + dv0) = make_uint2(pack2(o0, o1), pack2(o2, o3));
    }
  }
#pragma unroll
  for (int kt = 0; kt < 4; ++kt)
#pragma unroll
    for (int r = 0; r < 16; ++r) Sout[(size_t)(32 * kt + (r & 3) + 8 * (r >> 2) + 4 * hh) * 128 + dvg] = S[kt][r];
  __syncthreads();
}

DEVI void phase_p4(const int TIDX, const int BIDX, const int GDIM, KAP KA, unsigned char* WSB, float* OUTB, int l, unsigned char* smem, int dup = 0) {
  const int q = BIDX & 7;
  int* qctr = (int*)(WSB + O_CNT) + 3072 + (l * 8 + q) * 32 + 16 * dup;
  int* sitem = (int*)(smem + SMEM_GEMM + 1024);
  const bf16_t* QB = (const bf16_t*)(WSB + O_QB);
  bf16_t* AO = (bf16_t*)(WSB + O_AO);
  const int total = 16 + 16 + 512 + 8;
  for (;;) {
    if (TIDX == 0) *sitem = atomicAdd(qctr, 1);
    __syncthreads();
    const int it = *sitem;
    __syncthreads();
    if (it >= total) break;
    if (it < 16) {
      const int i2 = q * 16 + it, b = i2 >> 2, h = i2 & 3;
      hgrn_item(TIDX, BIDX, GDIM, KA, WSB, OUTB, l, b * 64, 64, h, nullptr, OUTB + OUT_ST_P + ((size_t)(l * 32 + b) * 4 + h) * 16384, b * 2048, smem);
    } else if (it < 24) {
      const int i2 = q * 8 + (it - 16), b = i2 >> 2, h = i2 & 3;
      hgrn_item(TIDX, BIDX, GDIM, KA, WSB, OUTB, l, 2048 + b, 1, h, PIN(I_ST) + ((size_t)(l * 16 + b) * 4 + h) * 16384,
                OUTB + OUT_ST_S + ((size_t)(l * 16 + b) * 4 + h) * 16384, TP + b * 32, smem);
    } else if (it < 40) {
      const int b = it - 24, h = q;
      attn_item(TIDX, BIDX, GDIM, QB + h * 96, TP + b * 32, 32, 1, (const bf16_t*)(WSB + O_KNS) + (size_t)b * KPAD * 512 + h * 64,
                (const bf16_t*)(WSB + O_KRS) + ((size_t)l * 16 + b) * KPAD * 32,
                (const bf16_t*)(WSB + O_VTS) + (size_t)(b * 8 + h) * 64 * KPAD, KPAD, 4128, AO + h * 64, smem);
    } else {
      const int jj = it - 40, b = jj >> 4, cp = 15 - (jj & 15), h = q;
      attn_item(TIDX, BIDX, GDIM, QB + h * 96, b * 2048 + cp * 128, 64, 2, (const bf16_t*)(WSB + O_KN) + (size_t)b * 2048 * 512 + h * 64,
                (const bf16_t*)(WSB + O_KRB) + (size_t)b * 2048 * 32,
                (const bf16_t*)(WSB + O_VT) + (size_t)(b * 8 + h) * 64 * 2048, 2048, 128 * (cp + 1), AO + h * 64, smem);
    }
  }
}

DEVI void phase_p5(const int TIDX, const int BIDX, const int GDIM, KAP KA, unsigned char* WSB, float* OUTB, int l, unsigned char* smem) {
  const bf16_t* XB = (const bf16_t*)(WSB + O_XB);
  const bf16_t* AO = (const bf16_t*)(WSB + O_AO);
  const bf16_t* HO = (const bf16_t*)(WSB + O_HO);
  const bf16_t* W = (const bf16_t*)(WSB + O_WS) + (size_t)l * WO_END;
  bf16_t* MG = (bf16_t*)(WSB + O_MG);
  for (int item = (BIDX & 7) * (GDIM >> 3) + (BIDX >> 3); item < 516 * 8; item += GDIM) {
    const int mt = item >> 3, nt = item & 7, m0 = mt * 128, n0 = nt * 128;
    f32x4 acc[4][4];
    uint2 gp[4][4];
    RowLin rx{(const unsigned char*)(XB + (size_t)m0 * 1024), 2048};
    RowLin ra{(const unsigned char*)(AO + (size_t)m0 * 512), 1024};
    RowLin ro{(const unsigned char*)(HO + (size_t)m0 * 512), 1024};
    zero_acc(acc);
    gemm_main<true>(TIDX, BIDX, GDIM, acc, rx, W + WO_G + (size_t)n0 * 1024, 1024, 1024, smem);
#pragma unroll
    for (int i = 0; i < 4; ++i)
#pragma unroll
      for (int j = 0; j < 4; ++j) gp[i][j] = make_uint2(pack2(sigmoidf_(acc[i][j][0]), sigmoidf_(acc[i][j][1])), pack2(sigmoidf_(acc[i][j][2]), sigmoidf_(acc[i][j][3])));
    zero_acc(acc);
    gemm_main<true>(TIDX, BIDX, GDIM, acc, ra, W + WO_BRA + (size_t)n0 * 512, 512, 512, smem);
    EPI_SWAP_BEGIN(m0, n0)
      const f32x4 a = acc[mi][ni];
      const uint2 g = gp[mi][ni];
      *(uint2*)(MG + (size_t)row * 1024 + col) = make_uint2(pack2(a[0] * lo2f(g.x), a[1] * hi2f(g.x)), pack2(a[2] * lo2f(g.y), a[3] * hi2f(g.y)));
    EPI_END
    zero_acc(acc);
    gemm_main<true>(TIDX, BIDX, GDIM, acc, rx, W + WO_G + (size_t)(1024 + n0) * 1024, 1024, 1024, smem);
#pragma unroll
    for (int i = 0; i < 4; ++i)
#pragma unroll
      for (int j = 0; j < 4; ++j) gp[i][j] = make_uint2(pack2(sigmoidf_(acc[i][j][0]), sigmoidf_(acc[i][j][1])), pack2(sigmoidf_(acc[i][j][2]), sigmoidf_(acc[i][j][3])));
    zero_acc(acc);
    gemm_main<true>(TIDX, BIDX, GDIM, acc, ro, W + WO_BRB + (size_t)n0 * 512, 512, 512, smem);
    EPI_SWAP_BEGIN(m0, n0)
      const f32x4 a = acc[mi][ni];
      const uint2 g = gp[mi][ni], m = *(const uint2*)(MG + (size_t)row * 1024 + col);
      const float o0 = lo2f(m.x) + a[0] * lo2f(g.x), o1 = hi2f(m.x) + a[1] * hi2f(g.x), o2 = lo2f(m.y) + a[2] * lo2f(g.y), o3 = hi2f(m.y) + a[3] * hi2f(g.y);
      *(uint2*)(MG + (size_t)row * 1024 + col) = make_uint2(pack2(o0, o1), pack2(o2, o3));
    EPI_END
  }
}

DEVI void phase_p6(const int TIDX, const int BIDX, const int GDIM, KAP KA, unsigned char* WSB, float* OUTB, int l, unsigned char* smem) {
  const bf16_t* MG = (const bf16_t*)(WSB + O_MG);
  const bf16_t* W = (const bf16_t*)(WSB + O_WS) + (size_t)l * WO_END + WO_OUT;
  float* PRE = (float*)(WSB + O_PRE);
  for (int item = (BIDX & 7) * (GDIM >> 3) + (BIDX >> 3); item < 516 * 8; item += GDIM) {
    const int mt = item >> 3, nt = item & 7, m0 = mt * 128, n0 = nt * 128;
    f32x4 acc[4][4];
    zero_acc(acc);
    RowLin rp{(const unsigned char*)(MG + (size_t)m0 * 1024), 2048};
    gemm_main<true>(TIDX, BIDX, GDIM, acc, rp, W + (size_t)n0 * 1024, 1024, 1024, smem);
    EPI_SWAP_BEGIN(m0, n0)
      const f32x4 a = acc[mi][ni];
      *(uint2*)((bf16_t*)PRE + (size_t)row * 1024 + col) = make_uint2(pack2(a[0], a[1]), pack2(a[2], a[3]));
    EPI_END
  }
}

DEVI void phase_p7(const int TIDX, const int BIDX, const int GDIM, KAP KA, unsigned char* WSB, float* OUTB, int l, unsigned char* smem) {
  const int tid = TIDX, lane = tid & 63;
  {
    const float* PRE = (const float*)(WSB + O_PRE);
    bf16_t* XB = (bf16_t*)(WSB + O_XB);
    const float* WR = (const float*)(WSB + O_WR) + (size_t)l * 36 * 1024;
    int* cnt = (int*)(WSB + O_CNT) + 1024 + l * 1024;
    int* ltok = (int*)(WSB + O_LTOK);
    float* lw = (float*)(WSB + O_LW);
    const float* g1 = PIN(I_LN1G) + l * 1024; const float* b1 = PIN(I_LN1B) + l * 1024;
    const int wid = BIDX * 4 + (tid >> 6), nw = GDIM * 4;
    for (int r4 = wid; r4 < NTOK / 4; r4 += nw) {
      float4 v[4][4];
#pragma unroll
      for (int t = 0; t < 4; ++t) {
        const size_t row = (size_t)r4 * 4 + t;
#pragma unroll
        for (int j = 0; j < 4; ++j) v[t][j] = resid_plus(*(const uint2*)(XB + row * 1024 + j * 256 + lane * 4), *(const uint2*)((const bf16_t*)PRE + row * 1024 + j * 256 + lane * 4));
        ln_inplace(v[t], g1, b1, lane);
        store_row(v[t], OUTB + row * 1024, XB + row * 1024, lane);
      }
      float mine[4] = {0.f, 0.f, 0.f, 0.f};
#pragma unroll 4
      for (int c = 0; c < 36; ++c) {
        float4 wv[4];
#pragma unroll
        for (int j = 0; j < 4; ++j) wv[j] = *(const float4*)(WR + c * 1024 + j * 256 + lane * 4);
#pragma unroll
        for (int t = 0; t < 4; ++t) {
          float s = 0.f;
#pragma unroll
          for (int j = 0; j < 4; ++j) s += v[t][j].x * wv[j].x + v[t][j].y * wv[j].y + v[t][j].z * wv[j].z + v[t][j].w * wv[j].w;
          s = wave_sum(s);
          if (lane == c) mine[t] = s;
        }
      }
      int my_e = 0, my_tk = 0; float my_w = 0.f;
#pragma unroll
      for (int t = 0; t < 4; ++t) {
        const int tok = r4 * 4 + t;
        float gl[4];
#pragma unroll
        for (int j = 0; j < 4; ++j) gl[j] = __shfl(mine[t], j);
        int gi = 0; float gm = gl[0];
#pragma unroll
        for (int j = 1; j < 4; ++j) if (gl[j] > gm) { gm = gl[j]; gi = j; }
        float gs = 0.f;
#pragma unroll
        for (int j = 0; j < 4; ++j) gs += expf(gl[j] - gm);
        const float gtop = 1.f / gs;
        float el[8];
#pragma unroll
        for (int j = 0; j < 8; ++j) el[j] = __shfl(mine[t], 4 + gi * 8 + j);
        float em = el[0];
#pragma unroll
        for (int j = 1; j < 8; ++j) em = fmaxf(em, el[j]);
        float pe[8], es = 0.f;
#pragma unroll
        for (int j = 0; j < 8; ++j) { pe[j] = expf(el[j] - em); es += pe[j]; }
#pragma unroll
        for (int j = 0; j < 8; ++j) pe[j] = pe[j] / es;
        int i1 = 0; float p1 = pe[0];
#pragma unroll
        for (int j = 1; j < 8; ++j) if (pe[j] > p1) { p1 = pe[j]; i1 = j; }
        int i2 = -1; float p2 = -1.f;
#pragma unroll
        for (int j = 0; j < 8; ++j) if (j != i1 && pe[j] > p2) { p2 = pe[j]; i2 = j; }
        const float den = p1 + p2;
        if (lane == 2 * t) { my_e = gi * 8 + i1; my_w = gtop * (p1 / den); my_tk = tok * 2; }
        if (lane == 2 * t + 1) { my_e = gi * 8 + i2; my_w = gtop * (p2 / den); my_tk = tok * 2 + 1; }
      }
      if (lane < 8) {
        const int sl = atomicAdd(cnt + my_e * 32, 1);
        ltok[(size_t)my_e * NTOK + sl] = my_tk;
        lw[(size_t)my_e * NTOK + sl] = my_w;
      }
    }
  }
  {
    bf16_t* PLEB = (bf16_t*)(WSB + O_YM);
    const float* pp = PIN(I_PP) + (size_t)l * TP * 256;
    const float* ps = PIN(I_PS) + (size_t)l * TS * 256;
    const size_t tot_ = (size_t)NTOK * 64, str_ = (size_t)GDIM * 256;
    for (size_t i = (size_t)BIDX * 256 + tid; i < tot_; i += 4 * str_) {
      float4 v4[4];
#pragma unroll
      for (int k = 0; k < 4; ++k) {
        const size_t ii = i + k * str_ < tot_ ? i + k * str_ : i, e = ii * 4;
        v4[k] = e < (size_t)TP * 256 ? *(const float4*)(pp + e) : *(const float4*)(ps + (e - (size_t)TP * 256));
      }
#pragma unroll
      for (int k = 0; k < 4; ++k)
        if (i + k * str_ < tot_) *(uint2*)(PLEB + (i + k * str_) * 4) = make_uint2(pack2(v4[k].x, v4[k].y), pack2(v4[k].z, v4[k].w));
    }
  }
  {
    float* tile = (float*)smem;
    bf16_t* WE = (bf16_t*)(WSB + O_WE);
    const int t = TIDX, n4 = (t & 15) * 4, kr = t >> 4, kc = (t & 7) * 8, nr = t >> 3;
    for (int p = BIDX; p < 96 * 64; p += GDIM) {
      const int mat = p >> 6, tp = (p & 63) * 2, kind = mat >> 5, e = mat & 31;
      const float* src = PIN(kind == 0 ? I_WE1 : (kind == 1 ? I_WE3 : I_WE2)) + ((size_t)l * 32 + e) * 524288;
      bf16_t* dst = WE + ((size_t)kind * 32 + e) * 524288;
      const int ld = kind < 2 ? 512 : 1024, K = kind < 2 ? 1024 : 512, nkt = K >> 6;
      int k0[2], n0[2];
#pragma unroll
      for (int u = 0; u < 2; ++u) { const int tt = tp + u; k0[u] = (tt % nkt) * 64; n0[u] = (tt / nkt) * 64; }
      float4 v[2][4];
#pragma unroll
      for (int u = 0; u < 2; ++u)
#pragma unroll
        for (int q = 0; q < 4; ++q) v[u][q] = *(const float4*)(src + (size_t)(k0[u] + kr + 16 * q) * ld + n0[u] + n4);
#pragma unroll
      for (int u = 0; u < 2; ++u)
#pragma unroll
        for (int q = 0; q < 4; ++q) {
          float* d = tile + u * 4160 + (kr + 16 * q) * 65 + n4;
          d[0] = v[u][q].x; d[1] = v[u][q].y; d[2] = v[u][q].z; d[3] = v[u][q].w;
        }
      __syncthreads();
#pragma unroll
      for (int u = 0; u < 2; ++u)
#pragma unroll
        for (int q = 0; q < 2; ++q) {
          const int n = nr + 32 * q;
          const float* sp = tile + u * 4160 + kc * 65 + n;
          const uint4 o = make_uint4(pack2(sp[0], sp[65]), pack2(sp[130], sp[195]), pack2(sp[260], sp[325]), pack2(sp[390], sp[455]));
          *(uint4*)(dst + (size_t)(n0[u] + n) * K + k0[u] + kc) = o;
        }
      __syncthreads();
    }
  }
}

DEVI int moe_table(const int TIDX, const int BIDX, const int GDIM, KAP KA, unsigned char* WSB, float* OUTB, int l, int* tstart  ) {
  if (TIDX == 0) {
    const int* cnt = (const int*)(WSB + O_CNT) + 1024 + l * 1024;
    int acc = 0;
    for (int e = 0; e < 32; ++e) { tstart[e] = acc; acc += (cnt[e * 32] + 127) >> 7; }
    tstart[32] = acc;
  }
  __syncthreads();
  return tstart[32];
}
DEVI int moe_find(const int* tstart, int mt) {
  int e = 0;
  for (int i = 1; i < 32; ++i) if (mt >= tstart[i]) e = i;
  return e;
}
struct RowGather {
  const unsigned char* base; const int* ltok; int pos0; int cnt;
  DEVI uint32_t operator()(int r) const {
    const int pos = pos0 + r;
    return pos < cnt ? (uint32_t)(ltok[pos] >> 1) * 2048u : (uint32_t)NTOK * 2048u;
  }
};

DEVI void phase_p8(const int TIDX, const int BIDX, const int GDIM, KAP KA, unsigned char* WSB, float* OUTB, int l, unsigned char* smem) {
  int* tstart = (int*)(smem + SMEM_GEMM + 1024 + 64);
  const int NT = moe_table(TIDX, BIDX, GDIM, KA, WSB, OUTB, l, tstart);
  const bf16_t* XB = (const bf16_t*)(WSB + O_XB);
  const bf16_t* WE = (const bf16_t*)(WSB + O_WE);
  bf16_t* H = (bf16_t*)(WSB + O_H);
  const int* cnt = (const int*)(WSB + O_CNT) + 1024 + l * 1024;
  const int* ltok = (const int*)(WSB + O_LTOK);
  for (int item = (BIDX & 7) * (GDIM >> 3) + (BIDX >> 3); item < NT * 4; item += GDIM) {
    const int mt = item >> 2, nt = item & 3, e = moe_find(tstart, mt), lt = mt - tstart[e];
    RowGather rg{(const unsigned char*)XB, ltok + (size_t)e * NTOK, lt * 128, cnt[e * 32]};
    f32x4 acc[4][4];
    uint2 sg[4][4];
    zero_acc(acc);
    gemm_main<true>(TIDX, BIDX, GDIM, acc, rg, WE + ((size_t)e * 512 + nt * 128) * 1024, 1024, 1024, smem);
#pragma unroll
    for (int i = 0; i < 4; ++i)
#pragma unroll
      for (int j = 0; j < 4; ++j) sg[i][j] = make_uint2(pack2(siluf_(acc[i][j][0]), siluf_(acc[i][j][1])), pack2(siluf_(acc[i][j][2]), siluf_(acc[i][j][3])));
    zero_acc(acc);
    gemm_main<true>(TIDX, BIDX, GDIM, acc, rg, WE + ((size_t)(32 + e) * 512 + nt * 128) * 1024, 1024, 1024, smem);
    EPI_SWAP_BEGIN(mt * 128, nt * 128)
      const f32x4 a = acc[mi][ni];
      const uint2 g = sg[mi][ni];
      *(uint2*)(H + (size_t)row * 512 + col) = make_uint2(pack2(a[0] * lo2f(g.x), a[1] * hi2f(g.x)), pack2(a[2] * lo2f(g.y), a[3] * hi2f(g.y)));
    EPI_END
  }
  {
    const bf16_t* W = (const bf16_t*)(WSB + O_WS) + (size_t)l * WO_END;
    float* PRE = (float*)(WSB + O_PRE);
    for (int item = (BIDX & 7) * (GDIM >> 3) + (BIDX >> 3); item < 516 * 8; item += GDIM) {
      const int mt = item >> 3, nt = item & 7, m0 = mt * 128, n0 = nt * 128;
      f32x4 acc[4][4];
      uint2 gp[4][4];
      zero_acc(acc);
      RowLin rx{(const unsigned char*)(XB + (size_t)m0 * 1024), 2048};
      gemm_main<true>(TIDX, BIDX, GDIM, acc, rx, W + WO_PG + (size_t)n0 * 1024, 1024, 1024, smem);
#pragma unroll
      for (int i = 0; i < 4; ++i)
#pragma unroll
        for (int j = 0; j < 4; ++j) gp[i][j] = make_uint2(pack2(sigmoidf_(acc[i][j][0]), sigmoidf_(acc[i][j][1])), pack2(sigmoidf_(acc[i][j][2]), sigmoidf_(acc[i][j][3])));
      zero_acc(acc);
      RowLin rpl{(const unsigned char*)((const bf16_t*)(WSB + O_YM) + (size_t)m0 * 256), 512};
      gemm_main<true>(TIDX, BIDX, GDIM, acc, rpl, W + WO_PLE + (size_t)n0 * 256, 256, 256, smem);
      EPI_SWAP_BEGIN(m0, n0)
        const f32x4 a = acc[mi][ni];
        const uint2 g = gp[mi][ni];
        *(uint2*)((bf16_t*)PRE + (size_t)row * 1024 + col) = make_uint2(pack2(a[0] * lo2f(g.x), a[1] * hi2f(g.x)), pack2(a[2] * lo2f(g.y), a[3] * hi2f(g.y)));
      EPI_END
    }
  }
}

DEVI void phase_p9(const int TIDX, const int BIDX, const int GDIM, KAP KA, unsigned char* WSB, float* OUTB, int l, unsigned char* smem) {
  int* tstart = (int*)(smem + SMEM_GEMM + 1024 + 64);
  const int NT = moe_table(TIDX, BIDX, GDIM, KA, WSB, OUTB, l, tstart);
  const bf16_t* WE = (const bf16_t*)(WSB + O_WE) + 64ull * 524288;
  const bf16_t* H = (const bf16_t*)(WSB + O_H);
  bf16_t* YM = (bf16_t*)(WSB + O_YM);
  const int* cnt = (const int*)(WSB + O_CNT) + 1024 + l * 1024;
  const int* ltok = (const int*)(WSB + O_LTOK);
  const float* lw = (const float*)(WSB + O_LW);
  for (int item = (BIDX & 7) * (GDIM >> 3) + (BIDX >> 3); item < NT * 8; item += GDIM) {
    const int mt = item >> 3, nt = item & 7, e = moe_find(tstart, mt), lt = mt - tstart[e], ce = cnt[e * 32];
    f32x4 acc[4][4];
    zero_acc(acc);
    RowLin rp{(const unsigned char*)(H + (size_t)mt * 128 * 512), 1024};
    gemm_main<true>(TIDX, BIDX, GDIM, acc, rp, WE + ((size_t)e * 1024 + nt * 128) * 512, 512, 512, smem);
    EPI_SWAP_BEGIN(0, nt * 128)
      const int pos = lt * 128 + row;
      if (pos < ce) {
        const int tk = ltok[(size_t)e * NTOK + pos];
        const float wt = lw[(size_t)e * NTOK + pos];
        const f32x4 a = acc[mi][ni] * wt;
        *(uint2*)(YM + (size_t)tk * 1024 + col) = make_uint2(pack2(a[0], a[1]), pack2(a[2], a[3]));
      }
    EPI_END
  }
}

DEVI void phase_p10(const int TIDX, const int BIDX, const int GDIM, KAP KA, unsigned char* WSB, float* OUTB, int l) {
  const int tid = TIDX, lane = tid & 63;
  const float* PRE = (const float*)(WSB + O_PRE);
  const bf16_t* YM = (const bf16_t*)(WSB + O_YM);
  bf16_t* XB = (bf16_t*)(WSB + O_XB);
  const float* g2 = PIN(I_LN2G) + l * 1024; const float* b2 = PIN(I_LN2B) + l * 1024;
  const int wid = BIDX * 4 + (tid >> 6), nw = GDIM * 4;
  for (int row = wid; row < NTOK; row += 2 * nw) {
    const bool hb = row + nw < NTOK;
    const int rws[2] = {row, hb ? row + nw : row};
    float4 v[2][4];
    uint2 y0[2][4], y1[2][4];
#pragma unroll
    for (int k = 0; k < 2; ++k)
#pragma unroll
      for (int j = 0; j < 4; ++j) {
        v[k][j] = resid_plus(*(const uint2*)(XB + (size_t)rws[k] * 1024 + j * 256 + lane * 4), *(const uint2*)((const bf16_t*)PRE + (size_t)rws[k] * 1024 + j * 256 + lane * 4));
        y0[k][j] = *(const uint2*)(YM + (size_t)rws[k] * 2048 + j * 256 + lane * 4);
        y1[k][j] = *(const uint2*)(YM + (size_t)rws[k] * 2048 + 1024 + j * 256 + lane * 4);
      }
#pragma unroll
    for (int k = 0; k < 2; ++k) {
      if (k == 0 || hb) {
#pragma unroll
        for (int j = 0; j < 4; ++j) {
          v[k][j].x += lo2f(y0[k][j].x) + lo2f(y1[k][j].x); v[k][j].y += hi2f(y0[k][j].x) + hi2f(y1[k][j].x);
          v[k][j].z += lo2f(y0[k][j].y) + lo2f(y1[k][j].y); v[k][j].w += hi2f(y0[k][j].y) + hi2f(y1[k][j].y);
        }
        ln_inplace(v[k], g2, b2, lane);
        const size_t r = (size_t)rws[k];
        if (l == 0) store_row(v[k], OUTB + r * 1024, XB + r * 1024, lane);
        else {
#pragma unroll
          for (int j = 0; j < 4; ++j) *(float4*)(OUTB + r * 1024 + j * 256 + lane * 4) = v[k][j];
        }
      }
    }
  }
}

DEVI void* launder_ptr(const void* q) {
  uint32_t lo = (uint32_t)(uintptr_t)q, hi = (uint32_t)((uintptr_t)q >> 32);
  asm volatile("" : "+v"(lo), "+v"(hi));
  lo = __builtin_amdgcn_readfirstlane(lo);
  hi = __builtin_amdgcn_readfirstlane(hi);
  return (void*)(((uintptr_t)hi << 32) | lo);
}
DEVI void grid_barrier(const int TIDX, const int BIDX, const int GDIM, unsigned* bar, unsigned k) {
  __syncthreads();
  if (TIDX == 0) {
    __threadfence();
    const unsigned g = (unsigned)BIDX & 7u, gs = (unsigned)GDIM >> 3;
    const unsigned old = __hip_atomic_fetch_add(bar + 32 * (1 + g), 1u, __ATOMIC_RELAXED, __HIP_MEMORY_SCOPE_AGENT);
    if (old + 1u == gs * k) {
      __threadfence();
      __hip_atomic_fetch_add(bar, 1u, __ATOMIC_RELAXED, __HIP_MEMORY_SCOPE_AGENT);
    }
    unsigned spins = 0;
    while (__hip_atomic_load(bar, __ATOMIC_RELAXED, __HIP_MEMORY_SCOPE_AGENT) < 8u * k) {
      __builtin_amdgcn_s_sleep(1);
      if (++spins > (1u << 27)) break;
    }
    __threadfence();
  }
  __syncthreads();
}
__global__ void __launch_bounds__(256, 2) mega(Params p, int ph0, int ph1) {
  __shared__ __attribute__((aligned(16))) unsigned char smem[SMEM_TOTAL];
  const int wave_in_block = __builtin_amdgcn_readfirstlane((int)(__builtin_amdgcn_workitem_id_x() >> 6));
  for (int ph = ph0; ph < ph1; ++ph) {
    int wv_ = wave_in_block;
    asm volatile("" : "+s"(wv_));
    int TIDX = wv_ * 64 + (int)__lane_id();
    asm volatile("" : "+v"(TIDX));
    int BIDX = __builtin_amdgcn_workgroup_id_x(), GDIM = (int)gridDim.x;
    asm volatile("" : "+s"(BIDX), "+s"(GDIM));
    KAP KA;
    {
      uintptr_t q = (uintptr_t)__builtin_amdgcn_kernarg_segment_ptr();
      uint32_t lo = (uint32_t)q, hi = (uint32_t)(q >> 32);
      asm volatile("" : "+s"(lo), "+s"(hi));
      KA = (KAP)(((uintptr_t)hi << 32) | lo);
    }
    float* OUTB = (float*)PIN(31);
    unsigned char* WSB = (unsigned char*)PIN(32);
#ifndef PHSEL
#define PHSEL -1
#endif
    if (ph == 0) { if (PHSEL < 0 || PHSEL == 10) phase_prep(TIDX, BIDX, GDIM, KA, WSB, OUTB, smem); }
    else {
      const int l = (ph - 1) / 10, s = (ph - 1) % 10;
      switch (s) {
        case 0: if (PHSEL < 0 || PHSEL == 0) phase_p1(TIDX, BIDX, GDIM, KA, WSB, OUTB, l, smem); break;
        case 1: if (PHSEL < 0 || PHSEL == 1) phase_p2(TIDX, BIDX, GDIM, KA, WSB, OUTB, l, smem); break;
        case 2: if (PHSEL < 0 || PHSEL == 2) phase_p3(TIDX, BIDX, GDIM, KA, WSB, OUTB, l, smem); break;
        case 3: if (PHSEL < 0 || PHSEL == 3) phase_p4(TIDX, BIDX, GDIM, KA, WSB, OUTB, l, smem); break;
        case 4: if (PHSEL < 0 || PHSEL == 4) phase_p5(TIDX, BIDX, GDIM, KA, WSB, OUTB, l, smem); break;
        case 5: if (PHSEL < 0 || PHSEL == 5) phase_p6(TIDX, BIDX, GDIM, KA, WSB, OUTB, l, smem); break;
        case 6: if (PHSEL < 0 || PHSEL == 6) phase_p7(TIDX, BIDX, GDIM, KA, WSB, OUTB, l, smem); break;
        case 7: if (PHSEL < 0 || PHSEL == 7) phase_p8(TIDX, BIDX, GDIM, KA, WSB, OUTB, l, smem); break;
        case 8: if (PHSEL < 0 || PHSEL == 8) phase_p9(TIDX, BIDX, GDIM, KA, WSB, OUTB, l, smem); break;
        default: if (PHSEL < 0 || PHSEL == 9) phase_p10(TIDX, BIDX, GDIM, KA, WSB, OUTB, l); break;
      }
    }
#ifdef PROBE_DUP
    if (ph > 0 && (ph - 1) % 10 == PROBE_DUP) {
      cg::this_grid().sync();
      const int l = (ph - 1) / 10;
      switch (PROBE_DUP) {
        case 0: phase_p1(TIDX, BIDX, GDIM, KA, WSB, OUTB, l, smem); break;
        case 1: phase_p2(TIDX, BIDX, GDIM, KA, WSB, OUTB, l, smem); break;
        case 2: phase_p3(TIDX, BIDX, GDIM, KA, WSB, OUTB, l, smem); break;
        case 3: phase_p4(TIDX, BIDX, GDIM, KA, WSB, OUTB, l, smem, 1); break;
        case 4: phase_p5(TIDX, BIDX, GDIM, KA, WSB, OUTB, l, smem); break;
        case 5: phase_p6(TIDX, BIDX, GDIM, KA, WSB, OUTB, l, smem); break;
        case 7: phase_p8(TIDX, BIDX, GDIM, KA, WSB, OUTB, l, smem); break;
        case 8: phase_p9(TIDX, BIDX, GDIM, KA, WSB, OUTB, l, smem); break;
        case 9: phase_p10(TIDX, BIDX, GDIM, KA, WSB, OUTB, l); break;
        default: break;
      }
    }
#endif
    if (ph + 1 < ph1) {
      if (ph == ph0) cg::this_grid().sync();
      else grid_barrier(TIDX, BIDX, GDIM, (unsigned*)(WSB + O_CNT + 2048), (unsigned)(ph - ph0));
    }
  }
}

#ifndef MK_MULTI
#define MK_MULTI 0
#endif

extern "C" void kernel_launch(void* const* d_in, const int* in_sizes, int n_in, void* d_out, int out_size, void* d_ws, size_t ws_size,
                              hipStream_t stream) {
  static int grid_blocks = 0;
  if (!grid_blocks) {
    int dev = 0, cus = 0, per_cu = 0;
    hipGetDevice(&dev);
    hipDeviceGetAttribute(&cus, hipDeviceAttributeMultiprocessorCount, dev);
    hipOccupancyMaxActiveBlocksPerMultiprocessor(&per_cu, mega, 256, 0);
    if (per_cu > 2) per_cu = 2;
    if (per_cu < 1) per_cu = 1;
    grid_blocks = cus * per_cu;
  }
  Params p{};
  for (int i = 0; i < 31; ++i) p.in[i] = (const float*)d_in[i];
  p.out_ = (float*)d_out;
  p.ws_ = (unsigned char*)d_ws;
  if (ws_size < WS_END) fprintf(stderr, "workspace too small: %zu < %zu\n", ws_size, (size_t)WS_END);
#if MK_MULTI
  for (int ph = 0; ph < 21; ++ph) mega<<<dim3(grid_blocks), dim3(256), 0, stream>>>(p, ph, ph + 1);
#else
  (void)hipMemsetAsync((unsigned char*)d_ws + O_CNT + 2048, 0, 2048, stream);
  int ph0 = 0, ph1 = 21;
  void* args[] = {&p, &ph0, &ph1};
  hipError_t e = hipLaunchCooperativeKernel((void*)mega, dim3(grid_blocks), dim3(256), args, 0, stream);
  if (e != hipSuccess) fprintf(stderr, "cooperative launch failed: %s (grid %d)\n", hipGetErrorString(e), grid_blocks);
#endif
}
```
